# Optimizing an MI355X kernel written in HIP

```python
import jax, jax.numpy as jnp
from jax import lax
import numpy as np

D_MODEL = 1024
BATCH = 8
SEQ = 8192
DEPTH = 1

CTX_LEN = 256
GRID_W = 64
N_MOD = 9
EPS = 1e-6
D_FF = 2816
ATTN_HEADS = 8
ATTN_KV_HEADS = 2
HEAD_DIM = 64
ROPE_AXIS_DIM = HEAD_DIM // 2
ROPE_THETA = 10000.0
BLOCK_Q = 128
GLA_HEADS = 4
GLA_DK = 64
GLA_DV = 128
GLA_RANK = 16
GLA_GATE_NORM = 16.0
GLA_CHUNK = 64
ATTN_Q_W = ATTN_HEADS * HEAD_DIM
ATTN_KV_W = ATTN_KV_HEADS * HEAD_DIM
GLA_K_W = GLA_HEADS * GLA_DK
GLA_V_W = GLA_HEADS * GLA_DV
N_BRANCH = 2
IN_SIZES = (ATTN_Q_W, ATTN_KV_W, ATTN_KV_W, GLA_K_W, GLA_K_W, GLA_V_W, GLA_V_W, 2 * GLA_RANK, N_BRANCH * D_MODEL)
IN_SPLITS = tuple(int(v) for v in np.cumsum(IN_SIZES)[:-1])
IN_WIDTH = int(sum(IN_SIZES))

kernel_name = "hybrid_gqa_gla_macaron_dit_layer"


def rms_norm(x, g):
    xf = x.astype(jnp.float32)
    y = xf * lax.rsqrt(jnp.mean(xf * xf, axis=-1, keepdims=True) + EPS)
    return y.astype(x.dtype) * g


def modulate(n, shift, scale):
    return n * (1 + scale) + shift


def swiglu(n, w_up, w_down):
    a, b = jnp.split(n @ w_up, 2, axis=-1)
    return (jax.nn.silu(a) * b) @ w_down


def half_ffn(h, mod, i, g, w_up, w_down):
    shift, scale, gate = mod[..., 3 * i, :], mod[..., 3 * i + 1, :], mod[..., 3 * i + 2, :]
    return h + 0.5 * gate * swiglu(modulate(rms_norm(h, g), shift, scale), w_up, w_down)


def axial_rope(T):
    rows = T // GRID_W
    row = jnp.repeat(jnp.arange(rows, dtype=jnp.float32), GRID_W)
    col = jnp.tile(jnp.arange(GRID_W, dtype=jnp.float32), rows)
    freqs = ROPE_THETA ** (-jnp.arange(0, ROPE_AXIS_DIM, 2, dtype=jnp.float32) / ROPE_AXIS_DIM)
    ang = jnp.concatenate([row[:, None] * freqs, col[:, None] * freqs], axis=-1)
    return jnp.cos(ang)[:, None, :], jnp.sin(ang)[:, None, :]


def apply_rope(x, cos, sin):
    xf = x.astype(jnp.float32)
    x1, x2 = xf[..., :HEAD_DIM // 2], xf[..., HEAD_DIM // 2:]
    return jnp.concatenate([x1 * cos - x2 * sin, x1 * sin + x2 * cos], axis=-1).astype(x.dtype)


def attn_heads(part, n_heads, g):
    return rms_norm(part.reshape(*part.shape[:-1], n_heads, HEAD_DIM), g)


def block_attention(q, k, v):
    B, T, Hq, hd = q.shape
    Hkv = k.shape[2]
    G = Hq // Hkv
    nblk = T // BLOCK_Q
    qb = q.reshape(B, nblk, BLOCK_Q, Hkv, G, hd).transpose(1, 0, 3, 4, 2, 5)
    kt = k.transpose(0, 2, 1, 3)
    vt = v.transpose(0, 2, 1, 3)
    scale = hd ** -0.5

    def one_block(qi):
        s = jnp.einsum('bkgqd,bksd->bkgqs', qi, kt).astype(jnp.float32) * scale
        p = jax.nn.softmax(s, axis=-1).astype(vt.dtype)
        return jnp.einsum('bkgqs,bksd->bkgqd', p, vt)

    o = lax.map(one_block, qb)
    return o.transpose(1, 0, 4, 2, 3, 5).reshape(B, T, Hq * hd)


def to_heads(a, n_heads):
    B, T, _ = a.shape
    return a.reshape(B, T, n_heads, -1).transpose(0, 2, 1, 3)


def gla_chunked(q, k, v, log_a, s0):
    dtype = v.dtype
    q, k, v, log_a = (a.astype(jnp.float32) for a in (q, k, v, log_a))
    B, H, T, dk = q.shape
    dv = v.shape[-1]
    n = T // GLA_CHUNK

    def to_chunks(a):
        return jnp.moveaxis(a.reshape(B, H, n, GLA_CHUNK, a.shape[-1]), 2, 0)

    idx = jnp.arange(GLA_CHUNK)
    lower = (idx[:, None] >= idx[None, :])[:, :, None]

    def step(s, inp):
        qi, ki, vi, gi = inp
        b = jnp.cumsum(gi, axis=2)
        o_inter = jnp.einsum('bhcd,bhde->bhce', qi * jnp.exp(b), s)
        diff = b[:, :, :, None, :] - b[:, :, None, :, :]
        decay = jnp.exp(jnp.where(lower, diff, -jnp.inf))
        A = jnp.einsum('bhid,bhjd,bhijd->bhij', qi, ki, decay)
        o_intra = jnp.einsum('bhij,bhje->bhie', A, vi)
        b_last = b[:, :, -1, :]
        s_new = jnp.exp(b_last)[..., None] * s + jnp.einsum(
            'bhcd,bhce->bhde', ki * jnp.exp(b_last[:, :, None, :] - b), vi)
        return s_new, o_inter + o_intra

    s_fin, o = lax.scan(step, s0, (to_chunks(q), to_chunks(k), to_chunks(v), to_chunks(log_a)))
    o = jnp.moveaxis(o, 0, 2).reshape(B, H, T, dv)
    return o.astype(dtype), s_fin


def gla_bidirectional(parts, w_dec, b_dec, s0_f, s0_b):
    gq = to_heads(parts[3], GLA_HEADS) * (GLA_DK ** -0.5)
    gk = to_heads(parts[4], GLA_HEADS)
    gv = to_heads(parts[5], GLA_HEADS)
    low_f, low_b = jnp.split(parts[7], 2, axis=-1)
    la_f = to_heads(jax.nn.log_sigmoid((low_f @ w_dec[0] + b_dec[0]).astype(jnp.float32)) / GLA_GATE_NORM, GLA_HEADS)
    la_b = to_heads(jax.nn.log_sigmoid((low_b @ w_dec[1] + b_dec[1]).astype(jnp.float32)) / GLA_GATE_NORM, GLA_HEADS)
    o_f, s_f = gla_chunked(gq, gk, gv, la_f, s0_f)
    flip = lambda a: jnp.flip(a, axis=2)
    o_b, s_b = gla_chunked(flip(gq), flip(gk), flip(gv), flip(la_b), s0_b)
    return o_f + flip(o_b), s_f, s_b


def merge_branches(parts, attn_o, gla_o, g_gla, w_branch, b_gate, w_out):
    B, H, T, _ = gla_o.shape
    gla_o = rms_norm(gla_o.transpose(0, 2, 1, 3), g_gla).reshape(B, T, GLA_V_W) * jax.nn.silu(parts[6])
    y_attn = attn_o @ w_branch[0]
    y_gla = gla_o @ w_branch[1]
    g_attn, g_gla_b = jnp.split(jax.nn.sigmoid(parts[8] + b_gate), 2, axis=-1)
    return (g_attn * y_attn + g_gla_b * y_gla) @ w_out


def setup_inputs(seed: int = 0) -> dict:
    key = jax.random.key(seed)
    ks = jax.random.split(key, 19)

    def nrm(k, shape, scale):
        return jax.random.normal(k, shape, jnp.float32) * scale

    D = D_MODEL
    return {
        "x": nrm(ks[0], (BATCH, SEQ, D), 1.0),
        "c": nrm(ks[1], (BATCH, D), 1.0),
        "ctx": nrm(ks[2], (BATCH, CTX_LEN, D), 1.0),
        "c_ctx": nrm(ks[3], (D,), 1.0),
        "w_mod": nrm(ks[4], (DEPTH, D, N_MOD * D), 0.5 * D ** -0.5),
        "b_mod": nrm(ks[5], (DEPTH, N_MOD * D), 0.02),
        "g_norm": 1.0 + nrm(ks[6], (DEPTH, 3, D), 0.02),
        "w_ffn_up": nrm(ks[7], (DEPTH, 2, D, 2 * D_FF), D ** -0.5),
        "w_ffn_down": nrm(ks[8], (DEPTH, 2, D_FF, D), D_FF ** -0.5),
        "w_in": nrm(ks[9], (DEPTH, D, IN_WIDTH), D ** -0.5),
        "g_q": 1.0 + nrm(ks[10], (DEPTH, HEAD_DIM), 0.02),
        "g_k": 1.0 + nrm(ks[11], (DEPTH, HEAD_DIM), 0.02),
        "w_decay": nrm(ks[12], (DEPTH, 2, GLA_RANK, GLA_K_W), GLA_RANK ** -0.5),
        "b_decay": nrm(ks[13], (DEPTH, 2, GLA_K_W), 0.1),
        "g_gla": 1.0 + nrm(ks[14], (DEPTH, GLA_DV), 0.02),
        "w_branch": nrm(ks[15], (DEPTH, N_BRANCH, ATTN_Q_W, D), ATTN_Q_W ** -0.5),
        "b_gate": nrm(ks[16], (DEPTH, N_BRANCH * D), 0.1),
        "w_out": nrm(ks[17], (DEPTH, D, D), D ** -0.5),
        "g_final": 1.0 + nrm(ks[18], (D,), 0.02),
    }


def reference(x, c, ctx, c_ctx, w_mod, b_mod, g_norm, w_ffn_up, w_ffn_down, w_in, g_q, g_k,
              w_decay, b_decay, g_gla, w_branch, b_gate, w_out, g_final):
    B, T, _ = x.shape
    cos, sin = axial_rope(T)
    s_zero = jnp.zeros((B, GLA_HEADS, GLA_DK, GLA_DV), jnp.float32)
    h, hc = x, ctx
    for l in range(DEPTH):
        last = l == DEPTH - 1
        m_lat = (jax.nn.silu(c) @ w_mod[l] + b_mod[l]).reshape(B, 1, N_MOD, D_MODEL)
        m_ctx = (jax.nn.silu(c_ctx) @ w_mod[l] + b_mod[l]).reshape(N_MOD, D_MODEL)

        h = half_ffn(h, m_lat, 0, g_norm[l, 0], w_ffn_up[l, 0], w_ffn_down[l, 0])
        hc = half_ffn(hc, m_ctx, 0, g_norm[l, 0], w_ffn_up[l, 0], w_ffn_down[l, 0])

        n_lat = modulate(rms_norm(h, g_norm[l, 1]), m_lat[..., 3, :], m_lat[..., 4, :])
        n_ctx = modulate(rms_norm(hc, g_norm[l, 1]), m_ctx[3], m_ctx[4])
        p_lat = jnp.split(n_lat @ w_in[l], IN_SPLITS, axis=-1)
        p_ctx = jnp.split(n_ctx @ w_in[l], IN_SPLITS, axis=-1)

        k_ctx = attn_heads(p_ctx[1], ATTN_KV_HEADS, g_k[l])
        v_ctx = p_ctx[2].reshape(*p_ctx[2].shape[:-1], ATTN_KV_HEADS, HEAD_DIM)
        q_lat = apply_rope(attn_heads(p_lat[0], ATTN_HEADS, g_q[l]), cos, sin)
        k_lat = apply_rope(attn_heads(p_lat[1], ATTN_KV_HEADS, g_k[l]), cos, sin)
        v_lat = p_lat[2].reshape(B, T, ATTN_KV_HEADS, HEAD_DIM)
        attn_lat = block_attention(q_lat, jnp.concatenate([k_lat, k_ctx], axis=1),
                                   jnp.concatenate([v_lat, v_ctx], axis=1))

        gla_ctx, s_f, s_b = gla_bidirectional(p_ctx, w_decay[l], b_decay[l], s_zero, s_zero)
        gla_lat, _, _ = gla_bidirectional(p_lat, w_decay[l], b_decay[l], s_f, s_b)

        h = h + m_lat[..., 5, :] * merge_branches(p_lat, attn_lat, gla_lat, g_gla[l], w_branch[l], b_gate[l], w_out[l])

        if not last:
            q_ctx = attn_heads(p_ctx[0], ATTN_HEADS, g_q[l])
            attn_ctx = block_attention(q_ctx, k_ctx, v_ctx)
            hc = hc + m_ctx[5] * merge_branches(p_ctx, attn_ctx, gla_ctx, g_gla[l], w_branch[l], b_gate[l], w_out[l])
            hc = half_ffn(hc, m_ctx, 2, g_norm[l, 2], w_ffn_up[l, 1], w_ffn_down[l, 1])

        h = half_ffn(h, m_lat, 2, g_norm[l, 2], w_ffn_up[l, 1], w_ffn_down[l, 1])
    return rms_norm(h, g_final)
```

```cpp
#include <hip/hip_runtime.h>
#include <cstdio>
#include <cstdint>
#ifndef MK_STAGE
#define MK_STAGE 3
#endif
__device__ __forceinline__ int opaque_tid() { int t; asm volatile("v_mov_b32 %0, %1" : "=v"(t) : "v"((int)threadIdx.x)); return t; }
namespace pg8 {
#define PG8_LAS __attribute__((address_space(3)))
typedef unsigned short bf16_t;
typedef short bf16x8 __attribute__((ext_vector_type(8)));
typedef float f32x4 __attribute__((ext_vector_type(4)));
typedef unsigned u32x4 __attribute__((ext_vector_type(4)));
constexpr int BM = 256, BK = 64, HALF = 128, HTB = HALF * BK * 2  , STAGE_BYTES = 8 * HTB, NXCD = 8, WGM = 8;

__host__ __device__ __forceinline__ int lds_byte(int r, int c) { const int st = (r >> 4) * 2 + (c >> 5), rr = r & 15, cc = c & 31, ob = rr * 64 + cc * 2; return st * 1024 + (ob ^ (((ob >> 9) & 1) << 5)); }
__host__ __device__ __forceinline__ void stage_rc(int b, int& R, int& C) { const int st = b / 1024, sb = b % 1024, swz = sb ^ (((sb >> 9) & 1) << 5); R = (st >> 1) * 16 + swz / 64; C = (st & 1) * 32 + (swz % 64) / 2; }
__host__ __device__ __forceinline__ int perm32(int rho) { const int n = rho >> 4, i = rho & 15; return 8 * (i >> 2) + 4 * n + (i & 3); }

struct Unit { int pm, pn; };
struct Gemm { const bf16_t* A; const bf16_t* Bt; int M, N, K, lda, ldb; };

struct StaticOrder {
    int nM, nN, nwg, G, c, skip;
    __host__ __device__ void init(int M, int N, int G_, int c_, int skip_ = 0) { nM = M / BM; nN = N / BM; nwg = nM * nN; G = G_; c = c_; skip = skip_; }
    __host__ __device__ bool next(int i, Unit& u) const {
        const long L = (long)i * G + c; if (L >= nwg) return false;
        int wgid = (int)L; { const int q = nwg / NXCD, r = nwg % NXCD, xcd = wgid % NXCD, off = wgid / NXCD; wgid = (xcd < r ? xcd * (q + 1) : r * (q + 1) + (xcd - r) * q) + off; }
        const int nig = WGM * nN, gid = wgid / nig, fm = gid * WGM, gsz = (nM - fm) < WGM ? (nM - fm) : WGM;
        u.pm = fm + ((wgid % nig) % gsz); u.pn = (wgid % nig) / gsz; if (skip) u.pm += u.pm / 32; return true;
    }
    __device__ __forceinline__ void a_ready(const Unit&) const {}
    __device__ __forceinline__ void done(const Unit&) const {}
};

__device__ __forceinline__ unsigned cvt_pk_bf16(float lo, float hi) { unsigned r; asm volatile("v_cvt_pk_bf16_f32 %0, %1, %2" : "=v"(r) : "v"(lo), "v"(hi)); return r; }
__device__ __forceinline__ float fsigmoid(float x) { return __builtin_amdgcn_rcpf(1.f + __builtin_amdgcn_exp2f(-1.4426950408889634f * x)); }
__device__ __forceinline__ float bflo(unsigned w) { return __uint_as_float(w << 16); }
__device__ __forceinline__ float bfhi(unsigned w) { return __uint_as_float(w & 0xffff0000u); }
constexpr int TPB = 33;
constexpr int PWID = 4608;

struct EpiPlain {
    static constexpr bool PERM = true, AFTER_DRAIN = false;
    bf16_t* O; int ldc;
    __device__ __forceinline__ void operator()(const f32x4 (&acc)[2][2][4][2], const Unit& u, int wr, int wc, int fr, int fq) const {
        const int row0 = u.pm * BM + wr * 64 + fr, col0 = u.pn * BM + wc * 32 + 8 * fq;
#pragma unroll
        for (int ai = 0; ai < 2; ++ai)
#pragma unroll
            for (int m = 0; m < 4; ++m) { bf16_t* rowp = O + (size_t)(row0 + ai * HALF + m * 16) * ldc + col0;
#pragma unroll
                for (int bj = 0; bj < 2; ++bj) { const f32x4 v0 = acc[ai][bj][m][0], v1 = acc[ai][bj][m][1];
                    u32x4 w; w.x = cvt_pk_bf16(v0[0], v0[1]); w.y = cvt_pk_bf16(v0[2], v0[3]); w.z = cvt_pk_bf16(v1[0], v1[1]); w.w = cvt_pk_bf16(v1[2], v1[3]);
                    *(u32x4*)(rowp + bj * HALF) = w; } }
    }
};
struct EpiSwiglu {
    static constexpr bool PERM = true, AFTER_DRAIN = false;
    bf16_t* O; int ldc;
    __device__ __forceinline__ void operator()(const f32x4 (&acc)[2][2][4][2], const Unit& u, int wr, int wc, int fr, int fq) const {
        const int row0 = u.pm * BM + wr * 64 + fr, col0 = u.pn * HALF + wc * 32 + 8 * fq;
#pragma unroll
        for (int ai = 0; ai < 2; ++ai)
#pragma unroll
            for (int m = 0; m < 4; ++m) { bf16_t* rowp = O + (size_t)(row0 + ai * HALF + m * 16) * ldc + col0;
                float h[8];
#pragma unroll
                for (int n = 0; n < 2; ++n)
#pragma unroll
                    for (int k = 0; k < 4; ++k) { const float a = acc[ai][0][m][n][k], b = acc[ai][1][m][n][k]; h[n * 4 + k] = a * fsigmoid(a) * b; }
                u32x4 w; w.x = cvt_pk_bf16(h[0], h[1]); w.y = cvt_pk_bf16(h[2], h[3]); w.z = cvt_pk_bf16(h[4], h[5]); w.w = cvt_pk_bf16(h[6], h[7]);
                *(u32x4*)rowp = w; }
    }
};
struct EpiRes {
    static constexpr bool PERM = true, AFTER_DRAIN = false;
    const float* src_lat; const float* src_ctx; float* dst_lat; float* dst_ctx; const float* mod; int gidx; float coef;
    __device__ __forceinline__ void operator()(const f32x4 (&acc)[2][2][4][2], const Unit& u, int wr, int wc, int fr, int fq) const {
        const int b = u.pm / TPB, j = u.pm % TPB; const bool isctx = (j == TPB - 1);
        const float* src = isctx ? src_ctx + (size_t)b * 256 * 1024 : src_lat + (size_t)(b * 8192 + j * 256) * 1024;
        float* dst = isctx ? dst_ctx + (size_t)b * 256 * 1024 : dst_lat + (size_t)(b * 8192 + j * 256) * 1024;
        const float* g = mod + (size_t)(isctx ? 8 : b) * 9216 + gidx * 1024;
        const int col0 = u.pn * BM + wc * 32 + 8 * fq;
        f32x4 gv[2][2];
#pragma unroll
        for (int bj = 0; bj < 2; ++bj)
#pragma unroll
            for (int n = 0; n < 2; ++n) gv[bj][n] = *(const f32x4*)(g + col0 + bj * HALF + 4 * n) * coef;
#pragma unroll
        for (int ai = 0; ai < 2; ++ai)
#pragma unroll
            for (int m = 0; m < 4; ++m) { const size_t off = (size_t)(ai * HALF + wr * 64 + m * 16 + fr) * 1024 + col0;
#pragma unroll
                for (int bj = 0; bj < 2; ++bj)
#pragma unroll
                    for (int n = 0; n < 2; ++n) { const f32x4 s = *(const f32x4*)(src + off + bj * HALF + 4 * n);
                        *(f32x4*)(dst + off + bj * HALF + 4 * n) = s + gv[bj][n] * acc[ai][bj][m][n]; } }
    }
};
template <int SECOND> struct EpiGate {
    static constexpr bool PERM = true, AFTER_DRAIN = false;
    const bf16_t* P; const float* bgate; bf16_t* Z;
    __device__ __forceinline__ void operator()(const f32x4 (&acc)[2][2][4][2], const Unit& u, int wr, int wc, int fr, int fq) const {
        const int row0 = u.pm * BM + wr * 64 + fr, col0 = u.pn * BM + wc * 32 + 8 * fq;
        f32x4 bg[2][2];
#pragma unroll
        for (int bj = 0; bj < 2; ++bj)
#pragma unroll
            for (int n = 0; n < 2; ++n) bg[bj][n] = *(const f32x4*)(bgate + 1024 * SECOND + col0 + bj * HALF + 4 * n);
#pragma unroll
        for (int ai = 0; ai < 2; ++ai)
#pragma unroll
            for (int m = 0; m < 4; ++m) { const size_t row = (size_t)(row0 + ai * HALF + m * 16);
#pragma unroll
                for (int bj = 0; bj < 2; ++bj) { const int c = col0 + bj * HALF;
                    const u32x4 gr = *(const u32x4*)(P + row * PWID + 2304 + 1024 * SECOND + c);
                    float v[8];
                    v[0] = fsigmoid(bflo(gr.x) + bg[bj][0][0]) * acc[ai][bj][m][0][0]; v[1] = fsigmoid(bfhi(gr.x) + bg[bj][0][1]) * acc[ai][bj][m][0][1];
                    v[2] = fsigmoid(bflo(gr.y) + bg[bj][0][2]) * acc[ai][bj][m][0][2]; v[3] = fsigmoid(bfhi(gr.y) + bg[bj][0][3]) * acc[ai][bj][m][0][3];
                    v[4] = fsigmoid(bflo(gr.z) + bg[bj][1][0]) * acc[ai][bj][m][1][0]; v[5] = fsigmoid(bfhi(gr.z) + bg[bj][1][1]) * acc[ai][bj][m][1][1];
                    v[6] = fsigmoid(bflo(gr.w) + bg[bj][1][2]) * acc[ai][bj][m][1][2]; v[7] = fsigmoid(bfhi(gr.w) + bg[bj][1][3]) * acc[ai][bj][m][1][3];
                    bf16_t* zp = Z + row * 1024 + c;
                    if (SECOND) { const u32x4 zr = *(const u32x4*)zp;
                        v[0] += bflo(zr.x); v[1] += bfhi(zr.x); v[2] += bflo(zr.y); v[3] += bfhi(zr.y); v[4] += bflo(zr.z); v[5] += bfhi(zr.z); v[6] += bflo(zr.w); v[7] += bfhi(zr.w); }
                    u32x4 w; w.x = cvt_pk_bf16(v[0], v[1]); w.y = cvt_pk_bf16(v[2], v[3]); w.z = cvt_pk_bf16(v[4], v[5]); w.w = cvt_pk_bf16(v[6], v[7]);
                    *(u32x4*)zp = w; } }
    }
};
template <class Epi, class Sched, bool ALIGN_EPI = false, bool SP2 = false>
__device__ __forceinline__ void gemm_phase(PG8_LAS unsigned char* lds, const Gemm g, const Sched& S, const Epi& E) {
    const int tid = opaque_tid(), wid = __builtin_amdgcn_readfirstlane(tid >> 6), lane = tid & 63, wr = wid >> 2, wc = wid & 3, fr = lane & 15, fq = lane >> 4;
    const int K = g.K, nt = K / BK;
    unsigned voffA[2], voffB[2];
#pragma unroll
    for (int i = 0; i < 2; ++i) { int R, C; stage_rc(tid * 16 + i * 8192, R, C); const int Rb = Epi::PERM ? ((R & ~31) + perm32(R & 31)) : R;
        voffA[i] = (unsigned)(R * g.lda + C) * 2u; voffB[i] = (unsigned)(Rb * g.ldb + C) * 2u; }
    const size_t kstep = (size_t)(BK * 2);
    const size_t hstepA = (size_t)HALF * g.lda * 2, hstepB = (size_t)HALF * g.ldb * 2;
    const size_t tstepA = 2 * hstepA, tstepB = 2 * hstepB;
    const unsigned ldsw = (unsigned)wid * 1024u;
    const int aoff = lds_byte(wr * 64 + fr, fq * 8), boff = lds_byte(wc * 32 + fr, fq * 8);
#define PG8_SA(b, h) (((b) * 2 + (h)) * HTB)
#define PG8_SB(b, h) ((4 + (b) * 2 + (h)) * HTB)
#define PG8_STAGE(bufoff, gbase, voff) do { _Pragma("unroll") for (int _i = 0; _i < 2; ++_i) \
        __builtin_amdgcn_global_load_lds((const unsigned*)((const char*)(gbase) + (voff)[_i]), (PG8_LAS unsigned*)(lds + (bufoff) + ldsw + _i * 8192), 16, 0, 0); } while (0)
#define PG8_LDA(dst, b, h) do { _Pragma("unroll") for (int m = 0; m < 4; ++m) _Pragma("unroll") for (int k = 0; k < 2; ++k) dst[m][k] = *(const PG8_LAS bf16x8*)(lds + PG8_SA(b, h) + aoff + m * 2048 + k * 1024); } while (0)
#define PG8_LDB(dst, b, h) do { _Pragma("unroll") for (int n = 0; n < 2; ++n) _Pragma("unroll") for (int k = 0; k < 2; ++k) dst[n][k] = *(const PG8_LAS bf16x8*)(lds + PG8_SB(b, h) + boff + n * 2048 + k * 1024); } while (0)
#define PG8_MMA(ai, bj, At, Bt) do { __builtin_amdgcn_s_setprio(1); _Pragma("unroll") for (int m = 0; m < 4; ++m) _Pragma("unroll") for (int n = 0; n < 2; ++n) _Pragma("unroll") for (int k = 0; k < 2; ++k) \
        acc[ai][bj][m][n] = __builtin_amdgcn_mfma_f32_16x16x32_bf16(Bt[n][k], At[m][k], acc[ai][bj][m][n], 0, 0, 0); __builtin_amdgcn_s_setprio(0); } while (0)
#define PG8_WAIT_V(n) asm volatile("s_waitcnt vmcnt(" #n ")" ::: "memory")
#define PG8_WAIT_L(n) asm volatile("s_waitcnt lgkmcnt(" #n ")" ::: "memory")
#define PG8_BAR __builtin_amdgcn_s_barrier()
#define PG8_SCHED __builtin_amdgcn_sched_barrier(0)
    Unit cur, nxt; int ui = 0;
    if (!S.next(0, cur)) return;
    f32x4 acc[2][2][4][2];
#pragma unroll
    for (int a = 0; a < 2; ++a)
#pragma unroll
        for (int b = 0; b < 2; ++b)
#pragma unroll
            for (int m = 0; m < 4; ++m)
#pragma unroll
                for (int n = 0; n < 2; ++n) acc[a][b][m][n] = (f32x4){0.f, 0.f, 0.f, 0.f};
    bf16x8 At[4][2], B0[2][2], B1[2][2];
    const char* cA = (const char*)g.A + (size_t)cur.pm * tstepA; const char* cB = (const char*)g.Bt + (size_t)cur.pn * tstepB;
    S.a_ready(cur);
    if constexpr (SP2) {
        PG8_STAGE(PG8_SB(0, 0), cB, voffB); PG8_STAGE(PG8_SB(0, 1), cB + hstepB, voffB); PG8_STAGE(PG8_SA(0, 0), cA, voffA); PG8_STAGE(PG8_SA(0, 1), cA + hstepA, voffA);
        if (wr == 1) PG8_BAR;
        PG8_WAIT_V(2); PG8_BAR;
        PG8_STAGE(PG8_SB(1, 0), cB + kstep, voffB); PG8_STAGE(PG8_SA(1, 0), cA + kstep, voffA); PG8_STAGE(PG8_SB(1, 1), cB + hstepB + kstep, voffB);
        PG8_WAIT_V(6); PG8_BAR;
    } else {
        PG8_STAGE(PG8_SB(0, 0), cB, voffB); PG8_STAGE(PG8_SA(0, 0), cA, voffA); PG8_STAGE(PG8_SB(0, 1), cB + hstepB, voffB); PG8_STAGE(PG8_SA(0, 1), cA + hstepA, voffA);
        if (wr == 1) PG8_BAR;
        PG8_WAIT_V(4); PG8_BAR;
        PG8_STAGE(PG8_SB(1, 0), cB + kstep, voffB); PG8_STAGE(PG8_SA(1, 0), cA + kstep, voffA); PG8_STAGE(PG8_SB(1, 1), cB + hstepB + kstep, voffB);
        PG8_WAIT_V(6); PG8_BAR;
    }
    for (;;) {
        const bool has_next = S.next(ui + 1, nxt);
        const char* nA = has_next ? (const char*)g.A + (size_t)nxt.pm * tstepA : cA; const char* nB = has_next ? (const char*)g.Bt + (size_t)nxt.pn * tstepB : cB;
        for (int t = 0; t < nt; t += 2) {
            const bool last = (t == nt - 2);
            const char* a1 = cA + (size_t)(t + 1) * kstep;
            const char* a2 = last ? nA : cA + (size_t)(t + 2) * kstep; const char* b2 = last ? nB : cB + (size_t)(t + 2) * kstep;
            const char* a3 = a2 + kstep; const char* b3 = b2 + kstep;
            if (last && has_next) S.a_ready(nxt);
            if constexpr (SP2) {
            PG8_LDB(B0, 0, 0); PG8_LDB(B1, 0, 1); PG8_SCHED; PG8_LDA(At, 0, 0); PG8_STAGE(PG8_SA(1, 1), a1 + hstepA, voffA);
            PG8_WAIT_V(8); PG8_WAIT_L(0); PG8_BAR; PG8_MMA(0, 0, At, B0); PG8_MMA(0, 1, At, B1); PG8_BAR; PG8_SCHED;
            PG8_LDA(At, 0, 1); PG8_STAGE(PG8_SB(0, 0), b2, voffB); PG8_STAGE(PG8_SB(0, 1), b2 + hstepB, voffB); PG8_STAGE(PG8_SA(0, 0), a2, voffA);
            PG8_WAIT_V(8); PG8_WAIT_L(0); PG8_BAR; PG8_MMA(1, 0, At, B0); PG8_MMA(1, 1, At, B1); PG8_BAR; PG8_SCHED;
            PG8_LDB(B0, 1, 0); PG8_LDB(B1, 1, 1); PG8_SCHED; PG8_LDA(At, 1, 0); PG8_STAGE(PG8_SA(0, 1), a2 + hstepA, voffA);
            PG8_WAIT_V(8); PG8_WAIT_L(0); PG8_BAR; PG8_MMA(0, 0, At, B0); PG8_MMA(0, 1, At, B1); PG8_BAR; PG8_SCHED;
            PG8_LDA(At, 1, 1); PG8_STAGE(PG8_SB(1, 0), b3, voffB); PG8_STAGE(PG8_SB(1, 1), b3 + hstepB, voffB); PG8_STAGE(PG8_SA(1, 0), a3, voffA);
            PG8_WAIT_V(8); PG8_WAIT_L(0); PG8_BAR; PG8_MMA(1, 0, At, B0); PG8_MMA(1, 1, At, B1); PG8_BAR; PG8_SCHED;
            } else {
            PG8_LDB(B0, 0, 0); PG8_SCHED; PG8_LDA(At, 0, 0); PG8_STAGE(PG8_SA(1, 1), a1 + hstepA, voffA);
            PG8_WAIT_L(8); PG8_BAR; PG8_WAIT_L(0); PG8_MMA(0, 0, At, B0); PG8_BAR; PG8_SCHED;
            PG8_LDB(B1, 0, 1); PG8_STAGE(PG8_SB(0, 0), b2, voffB);
            PG8_BAR; PG8_WAIT_L(0); PG8_MMA(0, 1, At, B1); PG8_BAR;
            PG8_LDA(At, 0, 1); PG8_STAGE(PG8_SA(0, 0), a2, voffA);
            PG8_BAR; PG8_WAIT_L(0); PG8_MMA(1, 0, At, B0); PG8_BAR; PG8_SCHED;
            PG8_STAGE(PG8_SB(0, 1), b2 + hstepB, voffB);
            PG8_WAIT_V(6); PG8_BAR; PG8_MMA(1, 1, At, B1); PG8_BAR;
            PG8_LDB(B0, 1, 0); PG8_SCHED; PG8_LDA(At, 1, 0); PG8_STAGE(PG8_SA(0, 1), a2 + hstepA, voffA);
            PG8_WAIT_L(8); PG8_BAR; PG8_WAIT_L(0); PG8_MMA(0, 0, At, B0); PG8_BAR; PG8_SCHED;
            PG8_LDB(B1, 1, 1); PG8_STAGE(PG8_SB(1, 0), b3, voffB);
            PG8_BAR; PG8_WAIT_L(0); PG8_MMA(0, 1, At, B1); PG8_BAR;
            PG8_LDA(At, 1, 1); PG8_STAGE(PG8_SA(1, 0), a3, voffA);
            PG8_BAR; PG8_WAIT_L(0); PG8_MMA(1, 0, At, B0); PG8_BAR; PG8_SCHED;
            PG8_STAGE(PG8_SB(1, 1), b3 + hstepB, voffB);
            PG8_WAIT_V(6); PG8_BAR; PG8_MMA(1, 1, At, B1); PG8_BAR;
            }
        }
        if constexpr (ALIGN_EPI) { if (wr == 0) PG8_BAR; }
        if constexpr (!Epi::AFTER_DRAIN) { E(acc, cur, wr, wc, fr, fq); S.done(cur); }
        if (!has_next) break;
#pragma unroll
        for (int a = 0; a < 2; ++a)
#pragma unroll
            for (int b = 0; b < 2; ++b)
#pragma unroll
                for (int m = 0; m < 4; ++m)
#pragma unroll
                    for (int n = 0; n < 2; ++n) acc[a][b][m][n] = (f32x4){0.f, 0.f, 0.f, 0.f};
        cur = nxt; cA = nA; cB = nB; ++ui;
        if constexpr (ALIGN_EPI) { if (wr == 1) PG8_BAR; }
    }
    PG8_WAIT_V(0);
    if constexpr (!ALIGN_EPI) { if (wr == 0) PG8_BAR; }
    PG8_BAR;
    if constexpr (Epi::AFTER_DRAIN) { E.fused(acc, cur, wr, wc, fr, fq, lds, wid, lane); S.done(cur); }
#undef PG8_SA
#undef PG8_SB
#undef PG8_STAGE
#undef PG8_LDA
#undef PG8_LDB
#undef PG8_MMA
#undef PG8_WAIT_V
#undef PG8_WAIT_L
#undef PG8_BAR
#undef PG8_SCHED
}
}
#include <hip/hip_bf16.h>
#include <cmath>
namespace attn_body {
using bf16=__hip_bfloat16;
using bf16x8=__attribute__((ext_vector_type(8)))short;
using s16x4=__attribute__((ext_vector_type(4)))short;
using f32x16=__attribute__((ext_vector_type(16)))float;
using u32x4=__attribute__((ext_vector_type(4)))unsigned;
constexpr int SEQ=8448,D=64,DM=4608,NTILES=132;
constexpr int NW=8,QBLK=32,QB=QBLK*NW,KVBLK=64;
constexpr int ATTN_PITCH=DM, ATTN_UNIT_ROWS=QB;
__device__ __forceinline__ int crow(int r,int hi){return (r&3)+8*(r>>2)+4*hi;}
#define SBAR() __builtin_amdgcn_sched_barrier(0)
__device__ __forceinline__ void cmask(f32x16&p0,f32x16&p1,int jb,int qrel,int hi){
  const float NEG=-INFINITY; int kb=64*jb+4*hi;
  #pragma unroll
  for(int r=0;r<16;++r){int kv=kb+(r&3)+8*(r>>2); if(kv>qrel)p0[r]=NEG; if(kv+32>qrel)p1[r]=NEG;}
}

constexpr int NSLOT=3, SLOTB=8192;
constexpr int LDS_K=0, LDS_V=NSLOT*SLOTB, LDS_WS=2*NSLOT*SLOTB, LDS_OST=LDS_WS+NW*64*4, LDS_BYTES=LDS_OST+NW*4096;
constexpr float C2=0.125f*1.4426950408889634f;
__device__ __forceinline__ void glds16(const void*gsrc,unsigned lds_dst){unsigned keep;
  asm volatile("s_mov_b32 %0, m0\n\ts_mov_b32 m0, %2\n\ts_nop 0\n\tglobal_load_lds_dwordx4 %1, off\n\ts_mov_b32 m0, %0":"=&s"(keep):"v"(gsrc),"s"(lds_dst):"memory");}
__device__ __forceinline__ float max3f(float a,float b,float c){float r;asm("v_max3_f32 %0, %1, %2, %3":"=v"(r):"v"(a),"v"(b),"v"(c));return r;}
__device__ __forceinline__ float max2f(float a,float b){float r;asm("v_max_f32_e32 %0, %1, %2":"=v"(r):"v"(a),"v"(b));return r;}
__device__ __forceinline__ float fadd_s(float a,float b){float r;asm("v_add_f32_e32 %0, %1, %2":"=v"(r):"v"(a),"v"(b));return r;}
__device__ __forceinline__ float fsub_s(float a,float b){float r;asm("v_sub_f32_e32 %0, %1, %2":"=v"(r):"v"(a),"v"(b));return r;}
typedef float f32x2_t __attribute__((ext_vector_type(2))); typedef __bf16 bf16x2_t __attribute__((ext_vector_type(2)));
__device__ __forceinline__ unsigned cvtpk_s(float lo,float hi){f32x2_t v={lo,hi};bf16x2_t b=__builtin_convertvector(v,bf16x2_t);return __builtin_bit_cast(unsigned,b);}
#define WAIT_BAR(N) asm volatile("s_waitcnt vmcnt(" #N ") lgkmcnt(0)\n\ts_barrier":::"memory")

__device__ __forceinline__ void qkt(f32x16&p0,f32x16&p1,const char*Kslot,const bf16x8*qr,const f32x16&negm,int r32,int hi){
  const char*kb=Kslot+hi*1024+r32*16;
  #pragma unroll
  for(int d0=0;d0<4;++d0){
    const bf16x8 b0=*reinterpret_cast<const bf16x8*>(kb+d0*2048);
    const bf16x8 b1=*reinterpret_cast<const bf16x8*>(kb+d0*2048+512);
    if(d0==0){p0=__builtin_amdgcn_mfma_f32_32x32x16_bf16(b0,qr[0],negm,0,0,0);p1=__builtin_amdgcn_mfma_f32_32x32x16_bf16(b1,qr[0],negm,0,0,0);}
    else{p0=__builtin_amdgcn_mfma_f32_32x32x16_bf16(b0,qr[d0],p0,0,0,0);p1=__builtin_amdgcn_mfma_f32_32x32x16_bf16(b1,qr[d0],p1,0,0,0);}}
}
typedef __attribute__((address_space(3))) const char* lds_cptr;
typedef short v4i16_t __attribute__((ext_vector_type(4)));
__device__ __forceinline__ void kload8(bf16x8*kf,lds_cptr kp){
  kf[0]=*(const __attribute__((address_space(3))) bf16x8*)(kp);      kf[1]=*(const __attribute__((address_space(3))) bf16x8*)(kp+512);
  kf[2]=*(const __attribute__((address_space(3))) bf16x8*)(kp+2048); kf[3]=*(const __attribute__((address_space(3))) bf16x8*)(kp+2560);
  kf[4]=*(const __attribute__((address_space(3))) bf16x8*)(kp+4096); kf[5]=*(const __attribute__((address_space(3))) bf16x8*)(kp+4608);
  kf[6]=*(const __attribute__((address_space(3))) bf16x8*)(kp+6144); kf[7]=*(const __attribute__((address_space(3))) bf16x8*)(kp+6656);
}
__device__ __forceinline__ void kload2(bf16x8*kf,lds_cptr kp,int j){ kf[2*j]=*(const __attribute__((address_space(3))) bf16x8*)(kp+j*2048); kf[2*j+1]=*(const __attribute__((address_space(3))) bf16x8*)(kp+j*2048+512); }
__device__ __forceinline__ s16x4 vtr(lds_cptr p){ return __builtin_bit_cast(s16x4,__builtin_amdgcn_ds_read_tr16_b64_v4i16((__attribute__((address_space(3))) v4i16_t*)p)); }
__device__ __forceinline__ float rowmax(const f32x16&p0,const f32x16&p1){
  float a=max3f(p0[0],p0[1],p1[0]),b=max3f(p0[2],p0[3],p1[1]);a=max3f(a,p1[2],p1[3]);
  #pragma unroll
  for(int r=4;r<16;r+=4){a=max3f(a,p0[r],p0[r+1]);b=max3f(b,p0[r+2],p0[r+3]);a=max3f(a,p1[r],p1[r+1]);b=max3f(b,p1[r+2],p1[r+3]);}
  const float m=max2f(a,b);
  auto rr=__builtin_amdgcn_permlane32_swap(__float_as_uint(m),__float_as_uint(m),false,false);
  return max2f(__uint_as_float(rr[0]),__uint_as_float(rr[1]));
}
__device__ __forceinline__ void pv(f32x16*o,int vb,bf16x8 pa0,bf16x8 pa1,bf16x8 pa2,bf16x8 pa3){
  #pragma unroll
  for(int d0=0;d0<2;++d0){s16x4 lo[4],hi[4];
    #pragma unroll
    for(int ks=0;ks<4;++ks){
      asm volatile("ds_read_b64_tr_b16 %0,%1 offset:%c2":"=&v"(lo[ks]):"v"(vb),"i"(d0*4096+ks*1024):"memory");
      asm volatile("ds_read_b64_tr_b16 %0,%1 offset:%c2":"=&v"(hi[ks]):"v"(vb),"i"(d0*4096+ks*1024+512):"memory");}
    asm volatile("s_waitcnt lgkmcnt(0)":::"memory");SBAR();
    #define PK(k) (bf16x8){lo[k][0],lo[k][1],lo[k][2],lo[k][3],hi[k][0],hi[k][1],hi[k][2],hi[k][3]}
    o[d0]=__builtin_amdgcn_mfma_f32_32x32x16_bf16(pa0,PK(0),o[d0],0,0,0);
    o[d0]=__builtin_amdgcn_mfma_f32_32x32x16_bf16(pa1,PK(1),o[d0],0,0,0);
    o[d0]=__builtin_amdgcn_mfma_f32_32x32x16_bf16(pa2,PK(2),o[d0],0,0,0);
    o[d0]=__builtin_amdgcn_mfma_f32_32x32x16_bf16(pa3,PK(3),o[d0],0,0,0);
    #undef PK
  }
}

#ifndef ATTN_STORE16
#define ATTN_STORE16(p,v) (*(u32x4*)(p)=(v))
#endif
template<int THRL> __device__ __forceinline__ void attn_unit(int b,int h,int hk,int qb,const bf16*Q,const bf16*__restrict__ K,const bf16*__restrict__ V,bf16*O,char*shm){
  const int tid=opaque_tid(),lane=tid&63,r32=lane&31,hi=lane>>5; const int wid=__builtin_amdgcn_readfirstlane(tid>>6);
  const long rowbase=(long)b*SEQ; const int q0=qb*QB;
  const bf16*Qw=Q+(rowbase+q0+wid*QBLK)*DM+h*D;
  const bf16*Kh=K+rowbase*DM+hk*D,*Vh=V+rowbase*DM+hk*D;
  const unsigned lds0=(unsigned)(uintptr_t)shm;
  float*wsf=(float*)(shm+LDS_WS)+wid*64;
  const bf16*ksrc=Kh+(long)lane*DM+wid*8;
  const bf16*vsrc=Vh+(long)(16*(wid&3)+(lane>>2))*DM+(wid>>2)*32+(lane&3)*8;
  const unsigned kdst=lds0+LDS_K+wid*1024, vdst=lds0+LDS_V+wid*1024;
  #define DMA_K(t,slot) glds16(ksrc+(long)(t)*KVBLK*DM,(unsigned)__builtin_amdgcn_readfirstlane(kdst+(slot)))
  #define DMA_V(t,slot) glds16(vsrc+(long)(t)*KVBLK*DM,(unsigned)__builtin_amdgcn_readfirstlane(vdst+(slot)))
  const int vb0=(int)(lds0+LDS_V)+((lane>>4)&1)*32+(lane&3)*8+(4*hi+((lane&15)>>2))*64;
  const char*Kbase=shm+LDS_K; bf16x8 kf[8];
  const lds_cptr shm3=(lds_cptr)shm; const lds_cptr kp0=shm3+LDS_K+hi*1024+r32*16; const lds_cptr vp0=shm3+LDS_V+((lane>>4)&1)*32+(lane&3)*8+(4*hi+((lane&15)>>2))*64;
  constexpr int NT=NTILES;
  DMA_K(0,0);DMA_V(0,0);DMA_K(1,SLOTB);
  bf16x8 qr[4];
  #pragma unroll
  for(int d0=0;d0<4;++d0)qr[d0]=*reinterpret_cast<const bf16x8*>(&Qw[(long)r32*DM+d0*16+hi*8]);
  float mhat=0.f,l_reg=0.f;f32x16 o[2];o[0]=f32x16{};o[1]=f32x16{};f32x16 negm=f32x16{};asm volatile("":"+v"(negm));
  #define CMASK(P0,P1,t) do{}while(0)
  bool resc=false;
  #define START(P0,P1) do{ const float rm=rowmax(P0,P1); resc=false; \
    { const float dl=rm; mhat=fadd_s(mhat,dl); \
      _Pragma("unroll") for(int r=0;r<16;++r){P0[r]=fsub_s(P0[r],dl);P1[r]=fsub_s(P1[r],dl);} \
      _Pragma("unroll") for(int r=0;r<16;++r)negm[r]=-mhat; asm volatile("":"+v"(negm)); } \
    _Pragma("unroll") for(int r=0;r<16;++r)P0[r]=__builtin_amdgcn_exp2f(P0[r]); }while(0)
  #define RESC() do{ if(resc){ asm volatile("s_waitcnt lgkmcnt(0)":::"memory"); \
      _Pragma("unroll") for(int d_=0;d_<2;++d_) _Pragma("unroll") for(int r=0;r<16;++r)o[d_][r]*=wsf[crow(r,hi)]; } }while(0)
  f32x16 pA0,pA1,pB0,pB1;
  int sl_prev=0,sl_cur=0,sl_next=SLOTB;
  #define ROT() do{sl_prev=sl_cur;sl_cur=sl_next;sl_next=(sl_next==(NSLOT-1)*SLOTB)?0:sl_next+SLOTB;}while(0)
  DMA_K(2,2*SLOTB);
  WAIT_BAR(3);
  qkt(pA0,pA1,Kbase,qr,negm,r32,hi);asm volatile("s_nop 15\n\ts_nop 7":"+v"(pA0),"+v"(pA1));CMASK(pA0,pA1,0);
  START(pA0,pA1);
  _Pragma("unroll") for(int r=0;r<16;++r)pA1[r]=__builtin_amdgcn_exp2f(pA1[r]);
  WAIT_BAR(0);
  DMA_K(3,0);DMA_V(1,SLOTB);
  ROT();
  kload8(kf,kp0+sl_cur);
  WAIT_BAR(2);
  s16x4 vlo[8],vhi[8]; u32x4 pw0,pw1,pw2,pw3;
  #define PKW(P,B) cvtpk_s(P[B],P[B+1])
  #define PAF(k) __builtin_bit_cast(bf16x8,pw##k)
  #define VFR(i) (bf16x8){vlo[i][0],vlo[i][1],vlo[i][2],vlo[i][3],vhi[i][0],vhi[i][1],vhi[i][2],vhi[i][3]}
  #define PIN(x) asm volatile("":"+v"(x))
  #define MX3(a,b,c) __builtin_fmaxf(__builtin_fmaxf((a),(b)),(c))
  #define GAPA(MF,A0,A1,A2,A3,W0,W1,PW) do{ MF; sacc+=A0; sacc+=A1; sacc+=A2; sacc+=A3; PIN(sacc); W0; W1; PIN(PW); SBAR(); }while(0)
  #define EX(v) __builtin_amdgcn_exp2f(v)
  #define GAPB(MF,X,B) do{ MF; X[B]=EX(X[B]); X[B+1]=EX(X[B+1]); X[B+2]=EX(X[B+2]); X[B+3]=EX(X[B+3]); PIN(X); SBAR(); }while(0)
  #define VRD(i) do{ vlo[i]=vtr(vp_+(((i)>>2)*4096+((i)&3)*1024)); vhi[i]=vtr(vp_+(((i)>>2)*4096+((i)&3)*1024+512)); }while(0)
  #define KRD(G,j) do{ if(G){ kload2(kf,kp0+sl_next,j); SBAR(); } }while(0)
  #define STEP(C0,C1,P0,P1,t,GK,GV,GL) do{ SBAR(); \
    const lds_cptr vp_=vp0+sl_prev; \
    VRD(0); SBAR(); float sacc=(P0[0]+P0[1]); \
    GAPA(C0=__builtin_amdgcn_mfma_f32_32x32x16_bf16(kf[0],qr[0],negm,0,0,0), P0[2],P0[3],P0[4],P0[5],     pw0[0]=PKW(P0,0), pw0[1]=PKW(P0,2), pw0); \
    VRD(4); SBAR(); GAPA(C1=__builtin_amdgcn_mfma_f32_32x32x16_bf16(kf[1],qr[0],negm,0,0,0), P0[6],P0[7],P0[8],P0[9],     pw0[2]=PKW(P0,4), pw0[3]=PKW(P0,6), pw0); \
    VRD(1); SBAR(); GAPA(C0=__builtin_amdgcn_mfma_f32_32x32x16_bf16(kf[2],qr[1],C0,0,0,0),   P0[10],P0[11],P0[12],P0[13], pw1[0]=PKW(P0,8), pw1[1]=PKW(P0,10), pw1); \
    VRD(5); SBAR(); GAPA(C1=__builtin_amdgcn_mfma_f32_32x32x16_bf16(kf[3],qr[1],C1,0,0,0),   P0[14],P0[15],P1[0],P1[1],   pw1[2]=PKW(P0,12),pw1[3]=PKW(P0,14), pw1); \
    VRD(2); SBAR(); GAPA(C0=__builtin_amdgcn_mfma_f32_32x32x16_bf16(kf[4],qr[2],C0,0,0,0),   P1[2],P1[3],P1[4],P1[5],     pw2[0]=PKW(P1,0), pw2[1]=PKW(P1,2), pw2); \
    VRD(6); SBAR(); GAPA(C1=__builtin_amdgcn_mfma_f32_32x32x16_bf16(kf[5],qr[2],C1,0,0,0),   P1[6],P1[7],P1[8],P1[9],     pw2[2]=PKW(P1,4), pw2[3]=PKW(P1,6), pw2); \
    VRD(3); SBAR(); GAPA(C0=__builtin_amdgcn_mfma_f32_32x32x16_bf16(kf[6],qr[3],C0,0,0,0),   P1[10],P1[11],P1[12],P1[13], pw3[0]=PKW(P1,8), pw3[1]=PKW(P1,10), pw3); \
    VRD(7); SBAR(); GAPA(C1=__builtin_amdgcn_mfma_f32_32x32x16_bf16(kf[7],qr[3],C1,0,0,0),   P1[14],P1[15],0.f,0.f,       pw3[2]=PKW(P1,12),pw3[3]=PKW(P1,14), pw3); \
    l_reg+=sacc; \
    if(GK){DMA_K((t)+3,sl_cur);} if(GV){DMA_V((t)+1,sl_next);} \
    CMASK(C0,C1,t); \
    { float a=MX3(C0[0],C0[1],C1[0]),b=MX3(C0[2],C0[3],C1[1]); a=MX3(a,C1[2],C1[3]); \
      _Pragma("unroll") for(int r=4;r<16;r+=4){a=MX3(a,C0[r],C0[r+1]);b=MX3(b,C0[r+2],C0[r+3]);a=MX3(a,C1[r],C1[r+1]);b=MX3(b,C1[r+2],C1[r+3]);} \
      float rm=__builtin_fmaxf(a,b); { auto rr=__builtin_amdgcn_permlane32_swap(__float_as_uint(rm),__float_as_uint(rm),false,false); rm=__builtin_fmaxf(__uint_as_float(rr[0]),__uint_as_float(rr[1])); } \
      resc=false; \
      if(__builtin_expect(__any(rm>(float)THRL),0)){ const float dl=__builtin_fmaxf(rm,0.f); mhat+=dl; \
        _Pragma("unroll") for(int r=0;r<16;++r){C0[r]-=dl;C1[r]-=dl;} \
        _Pragma("unroll") for(int r=0;r<16;++r)negm[r]=-mhat; asm volatile("":"+v"(negm)); \
        const float f=__builtin_amdgcn_exp2f(-dl); l_reg*=f; if(hi==0)wsf[r32]=f; resc=true; } } \
    SBAR(); \
    GAPB(o[0]=__builtin_amdgcn_mfma_f32_32x32x16_bf16(PAF(0),VFR(0),o[0],0,0,0), C0,0); \
    GAPB(o[1]=__builtin_amdgcn_mfma_f32_32x32x16_bf16(PAF(0),VFR(4),o[1],0,0,0), C0,4); \
    KRD(GL,0); GAPB(o[0]=__builtin_amdgcn_mfma_f32_32x32x16_bf16(PAF(1),VFR(1),o[0],0,0,0), C0,8); \
    KRD(GL,1); GAPB(o[1]=__builtin_amdgcn_mfma_f32_32x32x16_bf16(PAF(1),VFR(5),o[1],0,0,0), C0,12); \
    KRD(GL,2); GAPB(o[0]=__builtin_amdgcn_mfma_f32_32x32x16_bf16(PAF(2),VFR(2),o[0],0,0,0), C1,0); \
    KRD(GL,3); GAPB(o[1]=__builtin_amdgcn_mfma_f32_32x32x16_bf16(PAF(2),VFR(6),o[1],0,0,0), C1,4); \
    GAPB(o[0]=__builtin_amdgcn_mfma_f32_32x32x16_bf16(PAF(3),VFR(3),o[0],0,0,0), C1,8); \
    GAPB(o[1]=__builtin_amdgcn_mfma_f32_32x32x16_bf16(PAF(3),VFR(7),o[1],0,0,0), C1,12); \
    }while(0)
  int t=1;
  #undef CMASK
  #define CMASK(P0,P1,t) do{}while(0)
  for(;t+5<NT;t+=2){
    STEP(pB0,pB1,pA0,pA1,t,true,true,true);     WAIT_BAR(2); RESC(); ROT();
    STEP(pA0,pA1,pB0,pB1,t+1,true,true,true);   WAIT_BAR(2); RESC(); ROT();
  }
  #undef CMASK
  #define CMASK(P0,P1,t) do{}while(0)
  #define ENDW(tt) do{ if((tt)+3<NT){WAIT_BAR(2);} else if((tt)+2<NT){WAIT_BAR(1);} else {WAIT_BAR(0);} }while(0)
  for(;t+1<NT;t+=2){
    STEP(pB0,pB1,pA0,pA1,t,(t+3<NT),(t+1<NT),(t+1<NT));       ENDW(t);   RESC(); ROT();
    STEP(pA0,pA1,pB0,pB1,t+1,(t+4<NT),(t+2<NT),(t+2<NT));     ENDW(t+1); RESC(); ROT();
  }
  STEP(pB0,pB1,pA0,pA1,NT-1,false,false,false); RESC();
  { float sacc=pB0[0]+pB0[1]; _Pragma("unroll") for(int r=2;r<16;++r)sacc+=pB0[r]; _Pragma("unroll") for(int r=0;r<16;++r)sacc+=pB1[r]; l_reg+=sacc;
    pw0=(u32x4){PKW(pB0,0),PKW(pB0,2),PKW(pB0,4),PKW(pB0,6)};pw1=(u32x4){PKW(pB0,8),PKW(pB0,10),PKW(pB0,12),PKW(pB0,14)};pw2=(u32x4){PKW(pB1,0),PKW(pB1,2),PKW(pB1,4),PKW(pB1,6)};pw3=(u32x4){PKW(pB1,8),PKW(pB1,10),PKW(pB1,12),PKW(pB1,14)};
    SBAR(); pv(o,vb0+sl_cur,PAF(0),PAF(1),PAF(2),PAF(3)); }
  #undef PKW
  #undef PAF
  #undef VFR
  #undef PIN
  #undef MX3
  #undef GAPA
  #undef GAPB
  #undef EX
  #undef VRD
  #undef KRD
  #undef STEP
  #undef ENDW
  {auto rr=__builtin_amdgcn_permlane32_swap(__float_as_uint(l_reg),__float_as_uint(l_reg),false,false);l_reg=__uint_as_float(rr[0])+__uint_as_float(rr[1]);}
  if(hi==0)wsf[32+r32]=l_reg;asm volatile("s_waitcnt lgkmcnt(0)":::"memory");
  float rli[16];
  #pragma unroll
  for(int r=0;r<16;++r)rli[r]=__builtin_amdgcn_rcpf(wsf[32+crow(r,hi)]);
  bf16*Ow=O+(rowbase+q0+wid*QBLK)*DM+h*D;
  { bf16*stg=(bf16*)(shm+LDS_OST)+wid*2048;
    #pragma unroll
    for(int r=0;r<16;++r){const int orow=crow(r,hi);
      #pragma unroll
      for(int d0=0;d0<2;++d0)stg[orow*64+d0*32+r32]=__float2bfloat16(o[d0][r]*rli[r]);}
    asm volatile("s_waitcnt lgkmcnt(0)":::"memory");
    #pragma unroll
    for(int i=0;i<4;++i){const int row=i*8+(lane>>3),ch=lane&7; const u32x4 v=*(const u32x4*)(stg+row*64+ch*8); ATTN_STORE16(Ow+(long)row*DM+ch*8,v);} }
  asm volatile("s_waitcnt lgkmcnt(0)\n\ts_barrier":::"memory");
  #undef DMA_K
  #undef DMA_V
  #undef CMASK
  #undef START
  #undef RESC
  #undef ROT
}
constexpr int ATTN_LDS_BYTES=LDS_BYTES;
#undef SBAR
#undef WAIT_BAR
}
#include <hip/hip_cooperative_groups.h>
namespace cg = cooperative_groups;
#define LAS __attribute__((address_space(3)))
typedef unsigned short bf16;
typedef unsigned v4u __attribute__((ext_vector_type(4)));
typedef unsigned v2u __attribute__((ext_vector_type(2)));
typedef float f32x4 __attribute__((ext_vector_type(4)));
typedef short bf16x8 __attribute__((ext_vector_type(8)));

constexpr int NB = 8, TL = 8192, TC = 256, TB = TL + TC  , MR = NB * TB  , DM = 1024, DFF = 2816, PW = 4608, NMOD = 9216;
constexpr float EPS = 1e-6f;
constexpr int LDS_BYTES = 147456, NTHR = 512, NWAVES = 8;
constexpr int PC_Q = 0, PC_K = 512, PC_V = 640, PC_GQ = 768, PC_GK = 1024, PC_GV = 1280, PC_G6 = 1792, PC_GATE = 2304, PC_LOW = 4352;
constexpr int GLA_S = 132, GLA_ITEMS = 64 * GLA_S;
constexpr size_t MiB = 1u << 20;
constexpr size_t WS_MOD = 1 * MiB, WS_DN = 2 * MiB, WS_WUP1 = 8 * MiB, WS_WUP2 = 20 * MiB, WS_WDN1 = 32 * MiB, WS_WDN2 = 38 * MiB, WS_WIN = 44 * MiB, WS_WBR0 = 54 * MiB, WS_WBR1 = 55 * MiB, WS_WOUT = 56 * MiB,
                 WS_HCTX = 64 * MiB, WS_XN = 72 * MiB, WS_OF = 204 * MiB, WS_OB = 270 * MiB, WS_A = 336 * MiB, WS_END = 932 * MiB;
static_assert(WS_XN + (size_t)MR * DM * 2 <= WS_OF && WS_OF + (size_t)MR * 512 * 2 <= WS_OB && WS_OB + (size_t)MR * 512 * 2 <= WS_A && WS_A + (size_t)MR * PW * 2 <= WS_END, "ws map");
static_assert((size_t)GLA_ITEMS * 8192 * 2 <= (size_t)MR * DM * 2 && WS_DN + (size_t)GLA_ITEMS * 64 * 4 <= WS_WUP1, "gla ws");

__device__ __forceinline__ unsigned f2bf(float f) { unsigned u = __builtin_bit_cast(unsigned, f); return (u + 0x7fffu + ((u >> 16) & 1u)) >> 16; }
__device__ __forceinline__ unsigned pk2(float lo, float hi) { return f2bf(lo) | (f2bf(hi) << 16); }
__device__ __forceinline__ float bf2f(unsigned short h) { return __uint_as_float(((unsigned)h) << 16); }
__device__ __forceinline__ float wave_sum(float v) {
#pragma unroll
    for (int o = 1; o < 64; o <<= 1) v += __shfl_xor(v, o);
    return v;
}
__device__ __forceinline__ float silu_f(float v) { return v / (1.f + __expf(-v)); }

__device__ __forceinline__ void transpose_item(const float* W, int K, int N, bf16* WT, int k0, int n0, int drow0, LAS float* scr, int lane) {
#pragma unroll 8
    for (int i = 0; i < 32; ++i) { const int kk = 2 * i + (lane >> 5); scr[kk * 33 + (lane & 31)] = W[(size_t)(k0 + kk) * N + n0 + (lane & 31)]; }
    asm volatile("s_waitcnt lgkmcnt(0)" ::: "memory");
    const int c = lane & 7;
#pragma unroll
    for (int j = 0; j < 4; ++j) { const int n = (lane >> 3) + 8 * j; const LAS float* s = scr + (8 * c) * 33 + n;
        v4u o; o.x = pk2(s[0 * 33], s[1 * 33]); o.y = pk2(s[2 * 33], s[3 * 33]); o.z = pk2(s[4 * 33], s[5 * 33]); o.w = pk2(s[6 * 33], s[7 * 33]);
        *(v4u*)(WT + (size_t)(drow0 + n) * K + k0 + 8 * c) = o; }
    asm volatile("s_waitcnt lgkmcnt(0)" ::: "memory");
}
__device__ __forceinline__ int up_dest(int n0) { return n0 < DFF ? 256 * (n0 / 128) + (n0 % 128) : 256 * ((n0 - DFF) / 128) + 128 + ((n0 - DFF) % 128); }
__device__ __forceinline__ int win_dest(int n0) { return n0 < 2304 ? n0 : (n0 < 2336 ? n0 + 2048 : n0 - 32); }

__device__ __forceinline__ void norm_mod_rows(const float* lat, const float* ctxp, const float* mod, const float* g, int sub, bf16* XN, bool with_ctx, int gw, int NGW, int lane) {
    f32x4 gv[4];
#pragma unroll
    for (int j = 0; j < 4; ++j) gv[j] = *((const f32x4*)g + lane + 64 * j);
    for (int r = gw; r < MR; r += NGW) {
        const int b = r / TB, t = r % TB; const bool isctx = t >= TL;
        if (isctx && !with_ctx) continue;
        const float* src = isctx ? ctxp + (size_t)(b * TC + t - TL) * DM : lat + (size_t)(b * TL + t) * DM;
        const float* sh = mod + (size_t)(isctx ? 8 : b) * NMOD + (3 * sub) * DM; const float* sc = sh + DM;
        f32x4 v[4]; float s = 0.f;
#pragma unroll
        for (int j = 0; j < 4; ++j) { v[j] = *((const f32x4*)src + lane + 64 * j); s += (v[j].x * v[j].x + v[j].y * v[j].y) + (v[j].z * v[j].z + v[j].w * v[j].w); }
        const float rstd = 1.f / sqrtf(wave_sum(s) * (1.f / DM) + EPS);
        unsigned long long* o8 = (unsigned long long*)(XN + (size_t)r * DM) + lane;
#pragma unroll
        for (int j = 0; j < 4; ++j) { const f32x4 scv = *((const f32x4*)sc + lane + 64 * j), shv = *((const f32x4*)sh + lane + 64 * j);
            const f32x4 y = (v[j] * rstd * gv[j]) * (scv + 1.f) + shv;
            o8[64 * j] = (unsigned long long)pk2(y.x, y.y) | ((unsigned long long)pk2(y.z, y.w) << 32); }
    }
}

constexpr int GS = 72;
constexpr int GL_QE = 0, GL_KE = 9216, GL_KLT = 18432, GL_A = 27648, GL_VT = 36864, GL_LOW = 55296, GL_SEG = 59392;
#define GLA_ROWOF(c) (rowbase + (dir ? 63 - (c) : (c)))
template <int PASS> __device__ __forceinline__ void gla_item(LAS unsigned char* lds, const bf16* P, const float* w_decay, const float* b_decay, bf16* Ubuf, float* dn, bf16* OF, bf16* OB, int item) {
    const int tid = opaque_tid(), lane = tid & 63, w = __builtin_amdgcn_readfirstlane(tid >> 6), l15 = lane & 15, q4 = lane >> 4;
    const int chain = item / GLA_S, s = item % GLA_S, dir = chain & 1, h = (chain >> 1) & 3, b = chain >> 3;
    const int rowbase = b * TB + (s < 4 ? TL + (dir ? 3 - s : s) * 64 : (dir ? 127 - (s - 4) : s - 4) * 64);
    LAS bf16* qeL = (LAS bf16*)(lds + GL_QE); LAS bf16* keL = (LAS bf16*)(lds + GL_KE); LAS bf16* klT = (LAS bf16*)(lds + GL_KLT); LAS bf16* AL = (LAS bf16*)(lds + GL_A); LAS bf16* vT = (LAS bf16*)(lds + GL_VT);
    LAS float* lowL = (LAS float*)(lds + GL_LOW); LAS float* segT = (LAS float*)(lds + GL_SEG);
    { const int c = tid >> 3, r2 = (tid & 7) * 2; const unsigned wv = *(const unsigned*)(P + (size_t)GLA_ROWOF(c) * PW + PC_LOW + dir * 16 + r2);
      lowL[c * 16 + r2] = __uint_as_float(wv << 16); lowL[c * 16 + r2 + 1] = __uint_as_float(wv & 0xffff0000u); }
    const int d = tid & 63, cs = w;
    bf16x8 xs[2];
    if (PASS == 3) {
#pragma unroll
        for (int ks = 0; ks < 2; ++ks) xs[ks] = *(const bf16x8*)(Ubuf + (size_t)item * 8192 + (16 * w + l15) * 64 + 8 * q4 + 32 * ks);
    }
    float wd[16];
#pragma unroll
    for (int r = 0; r < 16; ++r) wd[r] = w_decay[(dir * 16 + r) * 256 + h * 64 + d];
    const float bd = b_decay[dir * 256 + h * 64 + d];
    { const int e = tid & 127, cq = tid >> 7; unsigned short vv[16];
#pragma unroll
      for (int i = 0; i < 16; ++i) vv[i] = P[(size_t)GLA_ROWOF(16 * cq + i) * PW + PC_GV + h * 128 + e];
      v4u o0, o1; o0.x = vv[0] | ((unsigned)vv[1] << 16); o0.y = vv[2] | ((unsigned)vv[3] << 16); o0.z = vv[4] | ((unsigned)vv[5] << 16); o0.w = vv[6] | ((unsigned)vv[7] << 16);
      o1.x = vv[8] | ((unsigned)vv[9] << 16); o1.y = vv[10] | ((unsigned)vv[11] << 16); o1.z = vv[12] | ((unsigned)vv[13] << 16); o1.w = vv[14] | ((unsigned)vv[15] << 16);
      *(LAS v4u*)(vT + e * GS + 16 * cq) = o0; *(LAS v4u*)(vT + e * GS + 16 * cq + 8) = o1; }
    unsigned short kraw[8], qraw[8];
#pragma unroll
    for (int i = 0; i < 8; ++i) { const size_t ro = (size_t)GLA_ROWOF(8 * cs + i) * PW + h * 64 + d; kraw[i] = P[ro + PC_GK]; if (PASS == 3) qraw[i] = P[ro + PC_GQ]; }
    __syncthreads();
    float bl[8]; float run = 0.f;
#pragma unroll
    for (int i = 0; i < 8; ++i) { const int c = 8 * cs + i; float z = bd;
#pragma unroll
        for (int r = 0; r < 16; ++r) z += lowL[c * 16 + r] * wd[r];
        const float ls = fminf(z, 0.f) - __logf(1.f + __expf(-fabsf(z)));
        run += ls * (1.f / 16.f); bl[i] = run; }
    segT[cs * 64 + d] = run;
    __syncthreads();
    float prefix = 0.f, btot = 0.f;
#pragma unroll
    for (int k = 0; k < 8; ++k) { const float v = segT[k * 64 + d]; btot += v; if (k < cs) prefix += v; }
    if (PASS == 1) {
        float kl[8];
#pragma unroll
        for (int i = 0; i < 8; ++i) kl[i] = bf2f(kraw[i]) * __expf(btot - (prefix + bl[i]));
        v4u o; o.x = pk2(kl[0], kl[1]); o.y = pk2(kl[2], kl[3]); o.z = pk2(kl[4], kl[5]); o.w = pk2(kl[6], kl[7]);
        *(LAS v4u*)(klT + d * GS + 8 * cs) = o;
        if (cs == 0) dn[(size_t)item * 64 + d] = __expf(btot);
    } else {
#pragma unroll
        for (int i = 0; i < 8; ++i) { const int c = 8 * cs + i; const float bi = prefix + bl[i];
            qeL[c * GS + d] = (bf16)f2bf(bf2f(qraw[i]) * __expf(bi) * 0.125f); keL[c * GS + d] = (bf16)f2bf(bf2f(kraw[i]) * __expf(-bi)); }
    }
    __syncthreads();
    if (PASS == 1) {
        bf16x8 y[2];
#pragma unroll
        for (int ks = 0; ks < 2; ++ks) y[ks] = *(const LAS bf16x8*)(vT + (16 * w + l15) * GS + 8 * q4 + 32 * ks);
#pragma unroll
        for (int dt = 0; dt < 4; ++dt) { f32x4 acc = {0.f, 0.f, 0.f, 0.f};
#pragma unroll
            for (int ks = 0; ks < 2; ++ks) { const bf16x8 x = *(const LAS bf16x8*)(klT + (16 * dt + l15) * GS + 8 * q4 + 32 * ks); acc = __builtin_amdgcn_mfma_f32_16x16x32_bf16(x, y[ks], acc, 0, 0, 0); }
            v2u o; o.x = pk2(acc[0], acc[1]); o.y = pk2(acc[2], acc[3]);
            *(v2u*)(Ubuf + (size_t)item * 8192 + (16 * w + l15) * 64 + 16 * dt + 4 * q4) = o; }
    } else {
        { const int it = w >> 1;
#pragma unroll
          for (int jj = 0; jj < 2; ++jj) { const int jt = (w & 1) * 2 + jj; f32x4 acc = {0.f, 0.f, 0.f, 0.f};
              if (jt <= it) {
#pragma unroll
                  for (int ks = 0; ks < 2; ++ks) { const bf16x8 x = *(const LAS bf16x8*)(keL + (16 * jt + l15) * GS + 8 * q4 + 32 * ks), y = *(const LAS bf16x8*)(qeL + (16 * it + l15) * GS + 8 * q4 + 32 * ks);
                      acc = __builtin_amdgcn_mfma_f32_16x16x32_bf16(x, y, acc, 0, 0, 0); }
                  const int i = 16 * it + l15, j0 = 16 * jt + 4 * q4;
#pragma unroll
                  for (int r = 0; r < 4; ++r) if (j0 + r > i) acc[r] = 0.f;
              }
              v2u o; o.x = pk2(acc[0], acc[1]); o.y = pk2(acc[2], acc[3]);
              *(LAS v2u*)(AL + (16 * it + l15) * GS + 16 * jt + 4 * q4) = o; } }
        __syncthreads();
        bf16x8 xv[2];
#pragma unroll
        for (int ks = 0; ks < 2; ++ks) xv[ks] = *(const LAS bf16x8*)(vT + (16 * w + l15) * GS + 8 * q4 + 32 * ks);
        bf16* Ob = dir ? OB : OF;
#pragma unroll
        for (int it = 0; it < 4; ++it) { f32x4 acc = {0.f, 0.f, 0.f, 0.f};
#pragma unroll
            for (int ks = 0; ks < 2; ++ks) { const bf16x8 y = *(const LAS bf16x8*)(AL + (16 * it + l15) * GS + 8 * q4 + 32 * ks); acc = __builtin_amdgcn_mfma_f32_16x16x32_bf16(xv[ks], y, acc, 0, 0, 0); }
#pragma unroll
            for (int ks = 0; ks < 2; ++ks) { const bf16x8 y = *(const LAS bf16x8*)(qeL + (16 * it + l15) * GS + 8 * q4 + 32 * ks); acc = __builtin_amdgcn_mfma_f32_16x16x32_bf16(xs[ks], y, acc, 0, 0, 0); }
            v2u o; o.x = pk2(acc[0], acc[1]); o.y = pk2(acc[2], acc[3]);
            *(v2u*)(Ob + (size_t)GLA_ROWOF(16 * it + l15) * 512 + h * 128 + 16 * w + 4 * q4) = o; }
    }
    __syncthreads();
}

struct Args { const float* in[19]; float* out; unsigned char* ws; };
__global__ void __launch_bounds__(NTHR, 2) mk_fwd(Args args) {
    extern __shared__ __attribute__((aligned(16))) unsigned char lds_raw[];
    cg::grid_group grid = cg::this_grid();
    LAS unsigned char* lds = (LAS unsigned char*)lds_raw;
    const int G = gridDim.x, bx = blockIdx.x, NGW = G * NWAVES;
#define PH_IDS const int tid = opaque_tid(), lane = tid & 63, wave = __builtin_amdgcn_readfirstlane(tid >> 6), gw = bx * NWAVES + wave; (void)lane; (void)gw
    unsigned char* ws = args.ws;
    const float* x = args.in[0]; const float* cvec = args.in[1]; const float* ctx = args.in[2]; const float* c_ctx = args.in[3]; const float* w_mod = args.in[4]; const float* b_mod = args.in[5];
    const float* g_norm = args.in[6]; const float* w_up = args.in[7]; const float* w_down = args.in[8]; const float* w_in = args.in[9]; const float* g_q = args.in[10]; const float* g_k = args.in[11];
    const float* w_decay = args.in[12]; const float* b_decay = args.in[13]; const float* g_gla = args.in[14]; const float* w_branch = args.in[15]; const float* b_gate = args.in[16]; const float* w_out = args.in[17]; const float* g_final = args.in[18];
    float* H = args.out;
    float* HC = (float*)(ws + WS_HCTX);
    float* mod = (float*)(ws + WS_MOD); float* dn = (float*)(ws + WS_DN);
    bf16* Wup1 = (bf16*)(ws + WS_WUP1); bf16* Wup2 = (bf16*)(ws + WS_WUP2); bf16* Wdn1 = (bf16*)(ws + WS_WDN1); bf16* Wdn2 = (bf16*)(ws + WS_WDN2); bf16* Win = (bf16*)(ws + WS_WIN);
    bf16* Wbr0 = (bf16*)(ws + WS_WBR0); bf16* Wbr1 = (bf16*)(ws + WS_WBR1); bf16* Wout = (bf16*)(ws + WS_WOUT);
    bf16* XN = (bf16*)(ws + WS_XN); bf16* OF = (bf16*)(ws + WS_OF); bf16* OB = (bf16*)(ws + WS_OB); bf16* PA = (bf16*)(ws + WS_A);
    bf16* HID = PA; bf16* Ubuf = XN; bf16* Z = XN;

    {
        PH_IDS;
        LAS float* sc = (LAS float*)lds; LAS float* red = sc + 9 * 1024;
        for (int idx = tid; idx < 9 * 1024; idx += NTHR) { const int j = idx >> 10, k = idx & 1023; const float v = j < 8 ? cvec[j * 1024 + k] : c_ctx[k]; sc[idx] = silu_f(v); }
        __syncthreads();
        for (int it = bx; it < NMOD / 32; it += G) {
            const int cc = tid & 31, ks = tid >> 5, col = it * 32 + cc;
            float a[9];
#pragma unroll
            for (int j = 0; j < 9; ++j) a[j] = 0.f;
#pragma unroll 4
            for (int kk = 0; kk < 64; ++kk) { const int k = ks * 64 + kk; const float wv = w_mod[(size_t)k * NMOD + col];
#pragma unroll
                for (int j = 0; j < 9; ++j) a[j] += sc[j * 1024 + k] * wv; }
#pragma unroll
            for (int j = 0; j < 9; ++j) red[(ks * 9 + j) * 32 + cc] = a[j];
            __syncthreads();
            if (tid < 288) { const int j = tid >> 5, c2 = tid & 31; float s = b_mod[it * 32 + c2];
#pragma unroll
                for (int k2 = 0; k2 < 16; ++k2) s += red[(k2 * 9 + j) * 32 + c2];
                mod[(size_t)j * NMOD + it * 32 + c2] = s; }
            __syncthreads();
        }
        LAS float* scr = (LAS float*)(lds + 65536) + wave * 2176;
        constexpr int I_UP = 16 * 176, I_DN = 44 * 32, I_IN = 16 * 137, I_BR = 8 * 32, I_OUT = 16 * 32;
        constexpr int NITEMS = 2 * I_UP + 2 * I_DN + I_IN + 2 * I_BR + I_OUT;
        for (int it = gw; it < NITEMS; it += NGW) {
            int r = it;
            if (r < 2 * I_UP) { const int l = r / I_UP; r %= I_UP; const int kb = r / 176, nb = r % 176; transpose_item(w_up + (size_t)l * 1024 * 5632, 1024, 5632, l ? Wup2 : Wup1, 64 * kb, 32 * nb, up_dest(32 * nb), scr, lane); continue; } r -= 2 * I_UP;
            if (r < 2 * I_DN) { const int l = r / I_DN; r %= I_DN; const int kb = r / 32, nb = r % 32; transpose_item(w_down + (size_t)l * DFF * 1024, DFF, 1024, l ? Wdn2 : Wdn1, 64 * kb, 32 * nb, 32 * nb, scr, lane); continue; } r -= 2 * I_DN;
            if (r < I_IN) { const int kb = r / 137, nb = r % 137; transpose_item(w_in, 1024, 4384, Win, 64 * kb, 32 * nb, win_dest(32 * nb), scr, lane); continue; } r -= I_IN;
            if (r < 2 * I_BR) { const int l = r / I_BR; r %= I_BR; const int kb = r / 32, nb = r % 32; transpose_item(w_branch + (size_t)l * 512 * 1024, 512, 1024, l ? Wbr1 : Wbr0, 64 * kb, 32 * nb, 32 * nb, scr, lane); continue; } r -= 2 * I_BR;
            { const int kb = r / 32, nb = r % 32; transpose_item(w_out, 1024, 1024, Wout, 64 * kb, 32 * nb, 32 * nb, scr, lane); }
        }
        for (int i = bx * NTHR + tid; i < 224 * 1024 / 8; i += G * NTHR) ((v4u*)(Win + (size_t)4384 * 1024))[i] = (v4u){0u, 0u, 0u, 0u};
    }
    grid.sync();
    { PH_IDS; norm_mod_rows(x, ctx, mod, g_norm + 0 * DM, 0, XN, true, gw, NGW, lane); }
    grid.sync();
    { pg8::Gemm g{XN, Wup1, MR, 5632, 1024, 1024, 1024}; pg8::StaticOrder S; S.init(MR, 5632, G, bx);
      pg8::EpiSwiglu E{HID, DFF}; pg8::gemm_phase<pg8::EpiSwiglu, pg8::StaticOrder, true, true>(lds, g, S, E); }
    grid.sync();
    { pg8::Gemm g{HID, Wdn1, MR, 1024, DFF, DFF, DFF}; pg8::StaticOrder S; S.init(MR, 1024, G, bx);
      pg8::EpiRes E{x, ctx, H, HC, mod, 2, 0.5f}; pg8::gemm_phase<pg8::EpiRes, pg8::StaticOrder, true, true>(lds, g, S, E); }
    grid.sync();
#if MK_STAGE >= 2
    { PH_IDS; norm_mod_rows(H, HC, mod, g_norm + 1 * DM, 1, XN, true, gw, NGW, lane); }
    grid.sync();
    { pg8::Gemm g{XN, Win, MR, PW, 1024, 1024, 1024}; pg8::StaticOrder S; S.init(MR, PW, G, bx);
      pg8::EpiPlain E{PA, PW}; pg8::gemm_phase<pg8::EpiPlain, pg8::StaticOrder, true, true>(lds, g, S, E); }
    grid.sync();
    { PH_IDS;
    for (int r = gw; r < MR; r += NGW) {
        const int t = r % TB; const bool isctx = t >= TL;
        const int i = lane & 31;
        const float fr_ = __builtin_amdgcn_exp2f(-(float)(i & 15) * (13.287712379549449f / 16.f));
        const float pos = (i < 16) ? (float)(t >> 6) : (float)(t & 63);
        const float ang = pos * fr_; const float cs_ = __cosf(ang), sn_ = __sinf(ang);
        for (int itx = isctx ? 4 : 0; itx < 5; ++itx) {
            const int hh = 2 * itx + (lane >> 5);
            bf16* p = PA + (size_t)r * PW + hh * 64 + i;
            const float x1 = bf2f(p[0]), x2 = bf2f(p[32]);
            float ss = x1 * x1 + x2 * x2;
#pragma unroll
            for (int o = 1; o < 32; o <<= 1) ss += __shfl_xor(ss, o);
            const float rstd = 1.f / sqrtf(ss * (1.f / 64.f) + EPS);
            const float* gp = hh < 8 ? g_q : g_k;
            float y1 = x1 * rstd * gp[i], y2 = x2 * rstd * gp[i + 32];
            if (hh < 8) { y1 *= attn_body::C2; y2 *= attn_body::C2; }
            float o1 = y1, o2 = y2;
            if (!isctx) { o1 = y1 * cs_ - y2 * sn_; o2 = y1 * sn_ + y2 * cs_; }
            p[0] = (bf16)f2bf(o1); p[32] = (bf16)f2bf(o2);
        }
    } }
    for (int it = bx; it < GLA_ITEMS; it += G) { if (it % GLA_S == GLA_S - 1) continue; gla_item<1>(lds, PA, w_decay, b_decay, Ubuf, dn, OF, OB, it); }
    grid.sync();
    { PH_IDS; const int tg = bx * NTHR + tid;
      for (int q = tg; q < 64 * 2048; q += G * NTHR) { const int chain = q >> 11, e4 = q & 2047; const int d0 = (4 * e4) & 63;
          f32x4 S = {0.f, 0.f, 0.f, 0.f};
          for (int s = 0; s < GLA_S; ++s) { const size_t item = (size_t)chain * GLA_S + s; v2u* p = (v2u*)(Ubuf + item * 8192 + 4 * e4);
              v2u uraw = {0u, 0u}; f32x4 dv = {0.f, 0.f, 0.f, 0.f};
              if (s < GLA_S - 1) { uraw = *p; dv = *(const f32x4*)(dn + item * 64 + d0); }
              v2u o; o.x = pk2(S[0], S[1]); o.y = pk2(S[2], S[3]); *p = o;
              S[0] = dv[0] * S[0] + __uint_as_float(uraw.x << 16); S[1] = dv[1] * S[1] + __uint_as_float(uraw.x & 0xffff0000u);
              S[2] = dv[2] * S[2] + __uint_as_float(uraw.y << 16); S[3] = dv[3] * S[3] + __uint_as_float(uraw.y & 0xffff0000u); } } }
    grid.sync();
    { const attn_body::bf16* Qp = (const attn_body::bf16*)(PA + PC_Q); const attn_body::bf16* Kp = (const attn_body::bf16*)(PA + PC_K); const attn_body::bf16* Vp = (const attn_body::bf16*)(PA + PC_V);
      if ((G & 7) == 0) { const int b = bx & 7, ci = bx >> 3, nper = G >> 3;
          for (int idx = ci; idx < 256; idx += nper) { const int h = idx >> 5, qb = idx & 31; attn_body::attn_unit<8>(b, h, h >> 2, qb, Qp, Kp, Vp, (attn_body::bf16*)(PA + PC_Q), (char*)lds_raw); } }
      else { for (int u = bx; u < 2048; u += G) { const int b = u >> 8, h = (u >> 5) & 7, qb = u & 31; attn_body::attn_unit<8>(b, h, h >> 2, qb, Qp, Kp, Vp, (attn_body::bf16*)(PA + PC_Q), (char*)lds_raw); } }
    }
    __syncthreads();
    for (int it = bx; it < GLA_ITEMS; it += G) { if (it % GLA_S < 4) continue; gla_item<3>(lds, PA, w_decay, b_decay, Ubuf, dn, OF, OB, it); }
    grid.sync();
    { PH_IDS;
    for (int r = gw; r < MR; r += NGW) {
        if (r % TB >= TL) continue;
        const int col = lane * 8;
        const v4u a = *(const v4u*)(OF + (size_t)r * 512 + col), bq = *(const v4u*)(OB + (size_t)r * 512 + col), gq = *(const v4u*)(PA + (size_t)r * PW + PC_G6 + col);
        float o[8], gg[8];
        o[0] = pg8::bflo(a.x) + pg8::bflo(bq.x); o[1] = pg8::bfhi(a.x) + pg8::bfhi(bq.x); o[2] = pg8::bflo(a.y) + pg8::bflo(bq.y); o[3] = pg8::bfhi(a.y) + pg8::bfhi(bq.y);
        o[4] = pg8::bflo(a.z) + pg8::bflo(bq.z); o[5] = pg8::bfhi(a.z) + pg8::bfhi(bq.z); o[6] = pg8::bflo(a.w) + pg8::bflo(bq.w); o[7] = pg8::bfhi(a.w) + pg8::bfhi(bq.w);
        gg[0] = pg8::bflo(gq.x); gg[1] = pg8::bfhi(gq.x); gg[2] = pg8::bflo(gq.y); gg[3] = pg8::bfhi(gq.y); gg[4] = pg8::bflo(gq.z); gg[5] = pg8::bfhi(gq.z); gg[6] = pg8::bflo(gq.w); gg[7] = pg8::bfhi(gq.w);
        float ss = 0.f;
#pragma unroll
        for (int k = 0; k < 8; ++k) ss += o[k] * o[k];
#pragma unroll
        for (int of = 1; of < 16; of <<= 1) ss += __shfl_xor(ss, of);
        const float rstd = 1.f / sqrtf(ss * (1.f / 128.f) + EPS);
        const int e0 = col & 127; float y[8];
#pragma unroll
        for (int k = 0; k < 8; ++k) y[k] = o[k] * rstd * g_gla[e0 + k] * silu_f(gg[k]);
        v4u w4; w4.x = pk2(y[0], y[1]); w4.y = pk2(y[2], y[3]); w4.z = pk2(y[4], y[5]); w4.w = pk2(y[6], y[7]);
        *(v4u*)(OF + (size_t)r * 512 + col) = w4;
    } }
    grid.sync();
    { pg8::Gemm g{PA + PC_Q, Wbr0, MR, 1024, 512, PW, 512}; pg8::StaticOrder S; S.init(NB * TL, 1024, G, bx, 1);
      pg8::EpiGate<0> E{PA, b_gate, Z}; pg8::gemm_phase<pg8::EpiGate<0>, pg8::StaticOrder, true, true>(lds, g, S, E); }
    __syncthreads();
    { pg8::Gemm g{OF, Wbr1, MR, 1024, 512, 512, 512}; pg8::StaticOrder S; S.init(NB * TL, 1024, G, bx, 1);
      pg8::EpiGate<1> E{PA, b_gate, Z}; pg8::gemm_phase<pg8::EpiGate<1>, pg8::StaticOrder, true, true>(lds, g, S, E); }
    grid.sync();
    { pg8::Gemm g{Z, Wout, MR, 1024, 1024, 1024, 1024}; pg8::StaticOrder S; S.init(NB * TL, 1024, G, bx, 1);
      pg8::EpiRes E{H, HC, H, HC, mod, 5, 1.0f}; pg8::gemm_phase<pg8::EpiRes, pg8::StaticOrder, true, true>(lds, g, S, E); }
    grid.sync();
#endif
#if MK_STAGE >= 3
    { PH_IDS; norm_mod_rows(H, HC, mod, g_norm + 2 * DM, 2, XN, false, gw, NGW, lane); }
    grid.sync();
    { pg8::Gemm g{XN, Wup2, MR, 5632, 1024, 1024, 1024}; pg8::StaticOrder S; S.init(NB * TL, 5632, G, bx, 1);
      pg8::EpiSwiglu E{HID, DFF}; pg8::gemm_phase<pg8::EpiSwiglu, pg8::StaticOrder, true, true>(lds, g, S, E); }
    grid.sync();
    { pg8::Gemm g{HID, Wdn2, MR, 1024, DFF, DFF, DFF}; pg8::StaticOrder S; S.init(NB * TL, 1024, G, bx, 1);
      pg8::EpiRes E{H, HC, H, HC, mod, 8, 0.5f}; pg8::gemm_phase<pg8::EpiRes, pg8::StaticOrder, true, true>(lds, g, S, E); }
    grid.sync();
#endif
    { PH_IDS; f32x4 gv[4];
#pragma unroll
      for (int j = 0; j < 4; ++j) gv[j] = *((const f32x4*)g_final + lane + 64 * j);
      for (int r = gw; r < NB * TL; r += NGW) { f32x4* p = (f32x4*)(H + (size_t)r * DM) + lane; f32x4 v[4]; float s = 0.f;
#pragma unroll
          for (int j = 0; j < 4; ++j) { v[j] = p[64 * j]; s += (v[j].x * v[j].x + v[j].y * v[j].y) + (v[j].z * v[j].z + v[j].w * v[j].w); }
          const float rstd = 1.f / sqrtf(wave_sum(s) * (1.f / DM) + EPS);
#pragma unroll
          for (int j = 0; j < 4; ++j) p[64 * j] = v[j] * rstd * gv[j]; } }
}

extern "C" void kernel_launch(void* const* d_in, const int* in_sizes, int n_in, void* d_out, int out_size, void* d_ws, size_t ws_size, hipStream_t stream) {
    static int grid = 0;
    if (grid == 0) {
        int dev = 0, cus = 0, per_cu = 0;
        hipGetDevice(&dev); hipDeviceGetAttribute(&cus, hipDeviceAttributeMultiprocessorCount, dev);
        hipFuncSetAttribute((const void*)mk_fwd, hipFuncAttributeMaxDynamicSharedMemorySize, LDS_BYTES);
        hipOccupancyMaxActiveBlocksPerMultiprocessor(&per_cu, (const void*)mk_fwd, NTHR, LDS_BYTES);
        if (per_cu < 1) per_cu = 1;
        grid = cus * per_cu;
        if (n_in != 19 || ws_size < WS_END) { fprintf(stderr, "kernel_launch: unexpected n_in %d or ws_size %zu\n", n_in, ws_size); }
    }
    Args a{};
    for (int i = 0; i < 19; ++i) a.in[i] = (const float*)d_in[i];
    a.out = (float*)d_out; a.ws = (unsigned char*)d_ws;
    void* kargs[] = {&a};
    hipError_t e = hipLaunchCooperativeKernel((const void*)mk_fwd, dim3(grid), dim3(NTHR), kargs, LDS_BYTES, stream);
    if (e != hipSuccess) fprintf(stderr, "cooperative launch failed: %s (grid %d)\n", hipGetErrorString(e), grid);
}
```

```cpp
#include <hip/hip_runtime.h>
#include <cstdio>
#include <cstdint>
#ifndef MK_STAGE
#define MK_STAGE 3
#endif
#define PROBE_MASK 0ull
#define PROBE_SYNC 0
#define PROBE_MULT 4
__device__ __forceinline__ int opaque_tid() { int t; asm volatile("v_mov_b32 %0, %1" : "=v"(t) : "v"((int)threadIdx.x)); return t; }
namespace pg8 {
#define PG8_LAS __attribute__((address_space(3)))
typedef unsigned short bf16_t;
typedef short bf16x8 __attribute__((ext_vector_type(8)));
typedef float f32x4 __attribute__((ext_vector_type(4)));
typedef unsigned u32x4 __attribute__((ext_vector_type(4)));
constexpr int BM = 256, BK = 64, HALF = 128, HTB = HALF * BK * 2  , STAGE_BYTES = 8 * HTB, NXCD = 8, WGM = 4;

__host__ __device__ __forceinline__ int lds_byte(int r, int c) { const int st = (r >> 4) * 2 + (c >> 5), rr = r & 15, cc = c & 31, ob = rr * 64 + cc * 2; return st * 1024 + (ob ^ (((ob >> 9) & 1) << 5)); }
__host__ __device__ __forceinline__ void stage_rc(int b, int& R, int& C) { const int st = b / 1024, sb = b % 1024, swz = sb ^ (((sb >> 9) & 1) << 5); R = (st >> 1) * 16 + swz / 64; C = (st & 1) * 32 + (swz % 64) / 2; }
__host__ __device__ __forceinline__ int perm32(int rho) { const int n = rho >> 4, i = rho & 15; return 8 * (i >> 2) + 4 * n + (i & 3); }

struct Unit { int pm, pn; };
struct Gemm { const bf16_t* A; const bf16_t* Bt; int M, N, K, lda, ldb; };

struct StaticOrder {
    int nM, nN, nwg, G, c, skip;
    __host__ __device__ void init(int M, int N, int G_, int c_, int skip_ = 0) { nM = M / BM; nN = N / BM; nwg = nM * nN; G = G_; c = c_; skip = skip_; }
    __host__ __device__ bool next(int i, Unit& u) const {
        const long L = (long)i * G + c; if (L >= nwg) return false;
        int wgid = (int)L; { const int q = nwg / NXCD, r = nwg % NXCD, xcd = wgid % NXCD, off = wgid / NXCD; wgid = (xcd < r ? xcd * (q + 1) : r * (q + 1) + (xcd - r) * q) + off; }
        const int nig = WGM * nN, gid = wgid / nig, fm = gid * WGM, gsz = (nM - fm) < WGM ? (nM - fm) : WGM;
        u.pm = fm + ((wgid % nig) % gsz); u.pn = (wgid % nig) / gsz; if (skip) u.pm += u.pm / 32; return true;
    }
    __device__ __forceinline__ void a_ready(const Unit&) const {}
    __device__ __forceinline__ void done(const Unit&) const {}
};

__device__ __forceinline__ unsigned cvt_pk_bf16(float lo, float hi) { unsigned r; asm volatile("v_cvt_pk_bf16_f32 %0, %1, %2" : "=v"(r) : "v"(lo), "v"(hi)); return r; }
__device__ __forceinline__ float fsigmoid(float x) { return __builtin_amdgcn_rcpf(1.f + __builtin_amdgcn_exp2f(-1.4426950408889634f * x)); }
__device__ __forceinline__ float bflo(unsigned w) { return __uint_as_float(w << 16); }
__device__ __forceinline__ float bfhi(unsigned w) { return __uint_as_float(w & 0xffff0000u); }
constexpr int TPB = 33;
constexpr int PWID = 4608;

struct EpiPlain {
    static constexpr bool PERM = true, AFTER_DRAIN = false;
    bf16_t* O; int ldc;
    __device__ __forceinline__ void operator()(const f32x4 (&acc)[2][2][4][2], const Unit& u, int wr, int wc, int fr, int fq) const {
        const int row0 = u.pm * BM + wr * 64 + fr, col0 = u.pn * BM + wc * 32 + 8 * fq;
#pragma unroll
        for (int ai = 0; ai < 2; ++ai)
#pragma unroll
            for (int m = 0; m < 4; ++m) { bf16_t* rowp = O + (size_t)(row0 + ai * HALF + m * 16) * ldc + col0;
#pragma unroll
                for (int bj = 0; bj < 2; ++bj) { const f32x4 v0 = acc[ai][bj][m][0], v1 = acc[ai][bj][m][1];
                    u32x4 w; w.x = cvt_pk_bf16(v0[0], v0[1]); w.y = cvt_pk_bf16(v0[2], v0[3]); w.z = cvt_pk_bf16(v1[0], v1[1]); w.w = cvt_pk_bf16(v1[2], v1[3]);
                    *(u32x4*)(rowp + bj * HALF) = w; } }
    }
};
struct EpiSwiglu {
    static constexpr bool PERM = true, AFTER_DRAIN = false;
    bf16_t* O; int ldc;
    __device__ __forceinline__ void operator()(const f32x4 (&acc)[2][2][4][2], const Unit& u, int wr, int wc, int fr, int fq) const {
        const int row0 = u.pm * BM + wr * 64 + fr, col0 = u.pn * HALF + wc * 32 + 8 * fq;
#pragma unroll
        for (int ai = 0; ai < 2; ++ai)
#pragma unroll
            for (int m = 0; m < 4; ++m) { bf16_t* rowp = O + (size_t)(row0 + ai * HALF + m * 16) * ldc + col0;
                float h[8];
#pragma unroll
                for (int n = 0; n < 2; ++n)
#pragma unroll
                    for (int k = 0; k < 4; ++k) { const float a = acc[ai][0][m][n][k], b = acc[ai][1][m][n][k]; h[n * 4 + k] = a * fsigmoid(a) * b; }
                u32x4 w; w.x = cvt_pk_bf16(h[0], h[1]); w.y = cvt_pk_bf16(h[2], h[3]); w.z = cvt_pk_bf16(h[4], h[5]); w.w = cvt_pk_bf16(h[6], h[7]);
                *(u32x4*)rowp = w; }
    }
};
template <int XNOUT, int GIDX, int HALFCOEF, int NSUB> struct EpiRes {
    static constexpr bool PERM = true, AFTER_DRAIN = false;
    const float* src_lat; const float* src_ctx; float* dst_lat; float* dst_ctx; const float* mod; const float* gnorm; bf16_t* xn; float* ssq;
    static constexpr int gidx = GIDX, nsub = NSUB; static constexpr float coef = HALFCOEF ? 0.5f : 1.0f;
    __device__ __forceinline__ void operator()(const f32x4 (&acc)[2][2][4][2], const Unit& u, int wr, int wc, int fr, int fq) const {
        asm volatile("" : "+v"(fr));
        const int b = u.pm / TPB, j = u.pm % TPB; const bool isctx = (j == TPB - 1);
        const float* src = isctx ? src_ctx + (size_t)b * 256 * 1024 : src_lat + (size_t)(b * 8192 + j * 256) * 1024;
        float* dst = isctx ? dst_ctx + (size_t)b * 256 * 1024 : dst_lat + (size_t)(b * 8192 + j * 256) * 1024;
        const float* mrow = mod + (size_t)(isctx ? 8 : b) * 9216;
        const float* g = mrow + gidx * 1024;
        const int col0 = u.pn * BM + wc * 32 + 8 * fq;
        f32x4 gv[2][2], gs[2][2];
#pragma unroll
        for (int bj = 0; bj < 2; ++bj)
#pragma unroll
            for (int n = 0; n < 2; ++n) { gv[bj][n] = *(const f32x4*)(g + col0 + bj * HALF + 4 * n) * coef;
                if (XNOUT) gs[bj][n] = *(const f32x4*)(gnorm + col0 + bj * HALF + 4 * n) * (*(const f32x4*)(mrow + (3 * nsub + 1) * 1024 + col0 + bj * HALF + 4 * n) + 1.f); }
#pragma unroll
        for (int ai = 0; ai < 2; ++ai)
#pragma unroll
            for (int m = 0; m < 4; ++m) { const int rl = ai * HALF + wr * 64 + m * 16 + fr; const size_t off = (size_t)rl * 1024 + col0; float sq = 0.f;
#pragma unroll
                for (int bj = 0; bj < 2; ++bj) { f32x4 o[2];
#pragma unroll
                    for (int n = 0; n < 2; ++n) { const f32x4 sv = *(const f32x4*)(src + off + bj * HALF + 4 * n); o[n] = sv + gv[bj][n] * acc[ai][bj][m][n];
                        if (!(XNOUT && isctx)) *(f32x4*)(dst + off + bj * HALF + 4 * n) = o[n]; }
                    if (XNOUT) { sq += (o[0][0] * o[0][0] + o[0][1] * o[0][1]) + (o[0][2] * o[0][2] + o[0][3] * o[0][3]) + (o[1][0] * o[1][0] + o[1][1] * o[1][1]) + (o[1][2] * o[1][2] + o[1][3] * o[1][3]);
                        const f32x4 x0 = o[0] * gs[bj][0], x1 = o[1] * gs[bj][1];
                        u32x4 w; w.x = cvt_pk_bf16(x0[0], x0[1]); w.y = cvt_pk_bf16(x0[2], x0[3]); w.z = cvt_pk_bf16(x1[0], x1[1]); w.w = cvt_pk_bf16(x1[2], x1[3]);
                        *(u32x4*)(xn + (size_t)(u.pm * BM + rl) * 1024 + col0 + bj * HALF) = w; } }
                if (XNOUT) { sq += __shfl_xor(sq, 16); sq += __shfl_xor(sq, 32); if (fq == 0) atomicAdd(ssq + u.pm * BM + rl, sq); }
                if (m & 1) asm volatile("" ::: "memory"); }
    }
};
struct EpiInproj {
    static constexpr bool PERM = true, AFTER_DRAIN = false;
    bf16_t* O; int ldc; const float* ssq; const float* sw; int swld;
    __device__ __forceinline__ void operator()(const f32x4 (&acc)[2][2][4][2], const Unit& u, int wr, int wc, int fr, int fq) const {
        const int row0 = u.pm * BM + wr * 64 + fr, col0 = u.pn * BM + wc * 32 + 8 * fq;
        const float* swr = sw + (size_t)((u.pm % TPB == TPB - 1) ? 8 : u.pm / TPB) * swld + col0;
        f32x4 sv[2][2];
#pragma unroll
        for (int bj = 0; bj < 2; ++bj)
#pragma unroll
            for (int n = 0; n < 2; ++n) sv[bj][n] = *(const f32x4*)(swr + bj * HALF + 4 * n);
#pragma unroll
        for (int ai = 0; ai < 2; ++ai)
#pragma unroll
            for (int m = 0; m < 4; ++m) { const int row = row0 + ai * HALF + m * 16; bf16_t* rowp = O + (size_t)row * ldc + col0;
                const float rstd = 1.f / sqrtf(ssq[row] * (1.f / 1024.f) + 1e-6f);
#pragma unroll
                for (int bj = 0; bj < 2; ++bj) { const f32x4 v0 = acc[ai][bj][m][0] * rstd + sv[bj][0], v1 = acc[ai][bj][m][1] * rstd + sv[bj][1];
                    u32x4 w; w.x = cvt_pk_bf16(v0[0], v0[1]); w.y = cvt_pk_bf16(v0[2], v0[3]); w.z = cvt_pk_bf16(v1[0], v1[1]); w.w = cvt_pk_bf16(v1[2], v1[3]);
                    *(u32x4*)(rowp + bj * HALF) = w; } }
    }
};
struct EpiSwigluN {
    static constexpr bool PERM = true, AFTER_DRAIN = false;
    bf16_t* O; int ldc; const float* ssq; const float* sw; int swld;
    __device__ __forceinline__ void operator()(const f32x4 (&acc)[2][2][4][2], const Unit& u, int wr, int wc, int fr, int fq) const {
        const int row0 = u.pm * BM + wr * 64 + fr, col0 = u.pn * HALF + wc * 32 + 8 * fq;
        const float* swr = sw + (size_t)((u.pm % TPB == TPB - 1) ? 8 : u.pm / TPB) * swld + u.pn * BM + wc * 32 + 8 * fq;
        f32x4 sv[2][2];
#pragma unroll
        for (int bj = 0; bj < 2; ++bj)
#pragma unroll
            for (int n = 0; n < 2; ++n) sv[bj][n] = *(const f32x4*)(swr + bj * HALF + 4 * n);
#pragma unroll
        for (int ai = 0; ai < 2; ++ai)
#pragma unroll
            for (int m = 0; m < 4; ++m) { const int row = row0 + ai * HALF + m * 16; bf16_t* rowp = O + (size_t)row * ldc + col0;
                const float rstd = 1.f / sqrtf(ssq[row] * (1.f / 1024.f) + 1e-6f);
                float h[8];
#pragma unroll
                for (int n = 0; n < 2; ++n)
#pragma unroll
                    for (int k = 0; k < 4; ++k) { const float a = acc[ai][0][m][n][k] * rstd + sv[0][n][k], b = acc[ai][1][m][n][k] * rstd + sv[1][n][k]; h[n * 4 + k] = a * fsigmoid(a) * b; }
                u32x4 w; w.x = cvt_pk_bf16(h[0], h[1]); w.y = cvt_pk_bf16(h[2], h[3]); w.z = cvt_pk_bf16(h[4], h[5]); w.w = cvt_pk_bf16(h[6], h[7]);
                *(u32x4*)rowp = w; }
    }
};
template <int SECOND> struct EpiGate {
    static constexpr bool PERM = true, AFTER_DRAIN = false;
    const bf16_t* P; const float* bgate; bf16_t* Z;
    __device__ __forceinline__ void operator()(const f32x4 (&acc)[2][2][4][2], const Unit& u, int wr, int wc, int fr, int fq) const {
        const int row0 = u.pm * BM + wr * 64 + fr, col0 = u.pn * BM + wc * 32 + 8 * fq;
        f32x4 bg[2][2];
#pragma unroll
        for (int bj = 0; bj < 2; ++bj)
#pragma unroll
            for (int n = 0; n < 2; ++n) bg[bj][n] = *(const f32x4*)(bgate + 1024 * SECOND + col0 + bj * HALF + 4 * n);
#pragma unroll
        for (int ai = 0; ai < 2; ++ai)
#pragma unroll
            for (int m = 0; m < 4; ++m) { const size_t row = (size_t)(row0 + ai * HALF + m * 16);
#pragma unroll
                for (int bj = 0; bj < 2; ++bj) { const int c = col0 + bj * HALF;
                    const u32x4 gr = *(const u32x4*)(P + row * PWID + 2304 + 1024 * SECOND + c);
                    float v[8];
                    v[0] = fsigmoid(bflo(gr.x) + bg[bj][0][0]) * acc[ai][bj][m][0][0]; v[1] = fsigmoid(bfhi(gr.x) + bg[bj][0][1]) * acc[ai][bj][m][0][1];
                    v[2] = fsigmoid(bflo(gr.y) + bg[bj][0][2]) * acc[ai][bj][m][0][2]; v[3] = fsigmoid(bfhi(gr.y) + bg[bj][0][3]) * acc[ai][bj][m][0][3];
                    v[4] = fsigmoid(bflo(gr.z) + bg[bj][1][0]) * acc[ai][bj][m][1][0]; v[5] = fsigmoid(bfhi(gr.z) + bg[bj][1][1]) * acc[ai][bj][m][1][1];
                    v[6] = fsigmoid(bflo(gr.w) + bg[bj][1][2]) * acc[ai][bj][m][1][2]; v[7] = fsigmoid(bfhi(gr.w) + bg[bj][1][3]) * acc[ai][bj][m][1][3];
                    bf16_t* zp = Z + row * 1024 + c;
                    if (SECOND) { const u32x4 zr = *(const u32x4*)zp;
                        v[0] += bflo(zr.x); v[1] += bfhi(zr.x); v[2] += bflo(zr.y); v[3] += bfhi(zr.y); v[4] += bflo(zr.z); v[5] += bfhi(zr.z); v[6] += bflo(zr.w); v[7] += bfhi(zr.w); }
                    u32x4 w; w.x = cvt_pk_bf16(v[0], v[1]); w.y = cvt_pk_bf16(v[2], v[3]); w.z = cvt_pk_bf16(v[4], v[5]); w.w = cvt_pk_bf16(v[6], v[7]);
                    *(u32x4*)zp = w; } }
    }
};
template <class Epi, class Sched, bool ALIGN_EPI = false, bool SP2 = false>
__device__ __forceinline__ void gemm_phase(PG8_LAS unsigned char* lds, const Gemm g, const Sched& S, const Epi& E) {
    const int tid = opaque_tid(), wid = __builtin_amdgcn_readfirstlane(tid >> 6), lane = tid & 63, wr = wid >> 2, wc = wid & 3, fr = lane & 15, fq = lane >> 4;
    const int K = g.K, nt = K / BK;
    unsigned voffA[2], voffB[2];
#pragma unroll
    for (int i = 0; i < 2; ++i) { int R, C; stage_rc(tid * 16 + i * 8192, R, C); const int Rb = Epi::PERM ? ((R & ~31) + perm32(R & 31)) : R;
        voffA[i] = (unsigned)(R * g.lda + C) * 2u; voffB[i] = (unsigned)(Rb * g.ldb + C) * 2u; }
    const size_t kstep = (size_t)(BK * 2);
    const size_t hstepA = (size_t)HALF * g.lda * 2, hstepB = (size_t)HALF * g.ldb * 2;
    const size_t tstepA = 2 * hstepA, tstepB = 2 * hstepB;
    const unsigned ldsw = (unsigned)wid * 1024u;
    const int aoff = lds_byte(wr * 64 + fr, fq * 8), boff = lds_byte(wc * 32 + fr, fq * 8);
#define PG8_SA(b, h) (((b) * 2 + (h)) * HTB)
#define PG8_SB(b, h) ((4 + (b) * 2 + (h)) * HTB)
#define PG8_STAGE(bufoff, gbase, voff) do { _Pragma("unroll") for (int _i = 0; _i < 2; ++_i) \
        __builtin_amdgcn_global_load_lds((const unsigned*)((const char*)(gbase) + (voff)[_i]), (PG8_LAS unsigned*)(lds + (bufoff) + ldsw + _i * 8192), 16, 0, 0); } while (0)
#define PG8_LDA(dst, b, h) do { _Pragma("unroll") for (int m = 0; m < 4; ++m) _Pragma("unroll") for (int k = 0; k < 2; ++k) dst[m][k] = *(const PG8_LAS bf16x8*)(lds + PG8_SA(b, h) + aoff + m * 2048 + k * 1024); } while (0)
#define PG8_LDB(dst, b, h) do { _Pragma("unroll") for (int n = 0; n < 2; ++n) _Pragma("unroll") for (int k = 0; k < 2; ++k) dst[n][k] = *(const PG8_LAS bf16x8*)(lds + PG8_SB(b, h) + boff + n * 2048 + k * 1024); } while (0)
#define PG8_MMA(ai, bj, At, Bt) do { __builtin_amdgcn_s_setprio(1); _Pragma("unroll") for (int m = 0; m < 4; ++m) _Pragma("unroll") for (int n = 0; n < 2; ++n) _Pragma("unroll") for (int k = 0; k < 2; ++k) \
        acc[ai][bj][m][n] = __builtin_amdgcn_mfma_f32_16x16x32_bf16(Bt[n][k], At[m][k], acc[ai][bj][m][n], 0, 0, 0); __builtin_amdgcn_s_setprio(0); } while (0)
#define PG8_WAIT_V(n) asm volatile("s_waitcnt vmcnt(" #n ")" ::: "memory")
#define PG8_WAIT_L(n) asm volatile("s_waitcnt lgkmcnt(" #n ")" ::: "memory")
#define PG8_BAR __builtin_amdgcn_s_barrier()
#define PG8_SCHED __builtin_amdgcn_sched_barrier(0)
    Unit cur, nxt; int ui = 0;
    if (!S.next(0, cur)) return;
    f32x4 acc[2][2][4][2];
#pragma unroll
    for (int a = 0; a < 2; ++a)
#pragma unroll
        for (int b = 0; b < 2; ++b)
#pragma unroll
            for (int m = 0; m < 4; ++m)
#pragma unroll
                for (int n = 0; n < 2; ++n) acc[a][b][m][n] = (f32x4){0.f, 0.f, 0.f, 0.f};
    bf16x8 At[4][2], B0[2][2], B1[2][2];
    const char* cA = (const char*)g.A + (size_t)cur.pm * tstepA; const char* cB = (const char*)g.Bt + (size_t)cur.pn * tstepB;
    S.a_ready(cur);
    if constexpr (SP2) {
        PG8_STAGE(PG8_SB(0, 0), cB, voffB); PG8_STAGE(PG8_SB(0, 1), cB + hstepB, voffB); PG8_STAGE(PG8_SA(0, 0), cA, voffA); PG8_STAGE(PG8_SA(0, 1), cA + hstepA, voffA);
        if (wr == 1) PG8_BAR;
        PG8_WAIT_V(2); PG8_BAR;
        PG8_STAGE(PG8_SB(1, 0), cB + kstep, voffB); PG8_STAGE(PG8_SA(1, 0), cA + kstep, voffA); PG8_STAGE(PG8_SB(1, 1), cB + hstepB + kstep, voffB);
        PG8_WAIT_V(6); PG8_BAR;
    } else {
        PG8_STAGE(PG8_SB(0, 0), cB, voffB); PG8_STAGE(PG8_SA(0, 0), cA, voffA); PG8_STAGE(PG8_SB(0, 1), cB + hstepB, voffB); PG8_STAGE(PG8_SA(0, 1), cA + hstepA, voffA);
        if (wr == 1) PG8_BAR;
        PG8_WAIT_V(4); PG8_BAR;
        PG8_STAGE(PG8_SB(1, 0), cB + kstep, voffB); PG8_STAGE(PG8_SA(1, 0), cA + kstep, voffA); PG8_STAGE(PG8_SB(1, 1), cB + hstepB + kstep, voffB);
        PG8_WAIT_V(6); PG8_BAR;
    }
    for (;;) {
        const bool has_next = S.next(ui + 1, nxt);
        const char* nA = has_next ? (const char*)g.A + (size_t)nxt.pm * tstepA : cA; const char* nB = has_next ? (const char*)g.Bt + (size_t)nxt.pn * tstepB : cB;
        for (int t = 0; t < nt; t += 2) {
            const bool last = (t == nt - 2);
            const char* a1 = cA + (size_t)(t + 1) * kstep;
            const char* a2 = last ? nA : cA + (size_t)(t + 2) * kstep; const char* b2 = last ? nB : cB + (size_t)(t + 2) * kstep;
            const char* a3 = a2 + kstep; const char* b3 = b2 + kstep;
            if (last && has_next) S.a_ready(nxt);
            if constexpr (SP2) {
            PG8_LDB(B0, 0, 0); PG8_LDB(B1, 0, 1); PG8_SCHED; PG8_LDA(At, 0, 0); PG8_STAGE(PG8_SA(1, 1), a1 + hstepA, voffA);
            PG8_WAIT_V(8); PG8_WAIT_L(0); PG8_BAR; PG8_MMA(0, 0, At, B0); PG8_MMA(0, 1, At, B1); PG8_BAR; PG8_SCHED;
            PG8_LDA(At, 0, 1); PG8_STAGE(PG8_SB(0, 0), b2, voffB); PG8_STAGE(PG8_SB(0, 1), b2 + hstepB, voffB); PG8_STAGE(PG8_SA(0, 0), a2, voffA);
            PG8_WAIT_V(8); PG8_WAIT_L(0); PG8_BAR; PG8_MMA(1, 0, At, B0); PG8_MMA(1, 1, At, B1); PG8_BAR; PG8_SCHED;
            PG8_LDB(B0, 1, 0); PG8_LDB(B1, 1, 1); PG8_SCHED; PG8_LDA(At, 1, 0); PG8_STAGE(PG8_SA(0, 1), a2 + hstepA, voffA);
            PG8_WAIT_V(8); PG8_WAIT_L(0); PG8_BAR; PG8_MMA(0, 0, At, B0); PG8_MMA(0, 1, At, B1); PG8_BAR; PG8_SCHED;
            PG8_LDA(At, 1, 1); PG8_STAGE(PG8_SB(1, 0), b3, voffB); PG8_STAGE(PG8_SB(1, 1), b3 + hstepB, voffB); PG8_STAGE(PG8_SA(1, 0), a3, voffA);
            PG8_WAIT_V(8); PG8_WAIT_L(0); PG8_BAR; PG8_MMA(1, 0, At, B0); PG8_MMA(1, 1, At, B1); PG8_BAR; PG8_SCHED;
            } else {
            PG8_LDB(B0, 0, 0); PG8_SCHED; PG8_LDA(At, 0, 0); PG8_STAGE(PG8_SA(1, 1), a1 + hstepA, voffA);
            PG8_WAIT_L(8); PG8_BAR; PG8_WAIT_L(0); PG8_MMA(0, 0, At, B0); PG8_BAR; PG8_SCHED;
            PG8_LDB(B1, 0, 1); PG8_STAGE(PG8_SB(0, 0), b2, voffB);
            PG8_BAR; PG8_WAIT_L(0); PG8_MMA(0, 1, At, B1); PG8_BAR;
            PG8_LDA(At, 0, 1); PG8_STAGE(PG8_SA(0, 0), a2, voffA);
            PG8_BAR; PG8_WAIT_L(0); PG8_MMA(1, 0, At, B0); PG8_BAR; PG8_SCHED;
            PG8_STAGE(PG8_SB(0, 1), b2 + hstepB, voffB);
            PG8_WAIT_V(6); PG8_BAR; PG8_MMA(1, 1, At, B1); PG8_BAR;
            PG8_LDB(B0, 1, 0); PG8_SCHED; PG8_LDA(At, 1, 0); PG8_STAGE(PG8_SA(0, 1), a2 + hstepA, voffA);
            PG8_WAIT_L(8); PG8_BAR; PG8_WAIT_L(0); PG8_MMA(0, 0, At, B0); PG8_BAR; PG8_SCHED;
            PG8_LDB(B1, 1, 1); PG8_STAGE(PG8_SB(1, 0), b3, voffB);
            PG8_BAR; PG8_WAIT_L(0); PG8_MMA(0, 1, At, B1); PG8_BAR;
            PG8_LDA(At, 1, 1); PG8_STAGE(PG8_SA(1, 0), a3, voffA);
            PG8_BAR; PG8_WAIT_L(0); PG8_MMA(1, 0, At, B0); PG8_BAR; PG8_SCHED;
            PG8_STAGE(PG8_SB(1, 1), b3 + hstepB, voffB);
            PG8_WAIT_V(6); PG8_BAR; PG8_MMA(1, 1, At, B1); PG8_BAR;
            }
        }
        if constexpr (ALIGN_EPI) { if (wr == 0) PG8_BAR; }
        if constexpr (!Epi::AFTER_DRAIN) { E(acc, cur, wr, wc, fr, fq); S.done(cur); }
        if (!has_next) break;
#pragma unroll
        for (int a = 0; a < 2; ++a)
#pragma unroll
            for (int b = 0; b < 2; ++b)
#pragma unroll
                for (int m = 0; m < 4; ++m)
#pragma unroll
                    for (int n = 0; n < 2; ++n) acc[a][b][m][n] = (f32x4){0.f, 0.f, 0.f, 0.f};
        cur = nxt; cA = nA; cB = nB; ++ui;
        if constexpr (ALIGN_EPI) { if (wr == 1) PG8_BAR; }
    }
    PG8_WAIT_V(0);
    if constexpr (!ALIGN_EPI) { if (wr == 0) PG8_BAR; }
    PG8_BAR;
    if constexpr (Epi::AFTER_DRAIN) { E.fused(acc, cur, wr, wc, fr, fq, lds, wid, lane); S.done(cur); }
#undef PG8_SA
#undef PG8_SB
#undef PG8_STAGE
#undef PG8_LDA
#undef PG8_LDB
#undef PG8_MMA
#undef PG8_WAIT_V
#undef PG8_WAIT_L
#undef PG8_BAR
#undef PG8_SCHED
}
}
#include <hip/hip_bf16.h>
#include <cmath>
namespace attn_body {
using bf16=__hip_bfloat16;
using bf16x8=__attribute__((ext_vector_type(8)))short;
using s16x4=__attribute__((ext_vector_type(4)))short;
using f32x16=__attribute__((ext_vector_type(16)))float;
using u32x4=__attribute__((ext_vector_type(4)))unsigned;
constexpr int SEQ=8448,D=64,DM=4608,NTILES=132;
constexpr int NW=8,QBLK=32,QB=QBLK*NW,KVBLK=64;
constexpr int ATTN_PITCH=DM, ATTN_UNIT_ROWS=QB;
__device__ __forceinline__ int crow(int r,int hi){return (r&3)+8*(r>>2)+4*hi;}
#define SBAR() __builtin_amdgcn_sched_barrier(0)
__device__ __forceinline__ void cmask(f32x16&p0,f32x16&p1,int jb,int qrel,int hi){
  const float NEG=-INFINITY; int kb=64*jb+4*hi;
  #pragma unroll
  for(int r=0;r<16;++r){int kv=kb+(r&3)+8*(r>>2); if(kv>qrel)p0[r]=NEG; if(kv+32>qrel)p1[r]=NEG;}
}

constexpr int NSLOT=3, SLOTB=8192;
constexpr int LDS_K=0, LDS_V=NSLOT*SLOTB, LDS_WS=2*NSLOT*SLOTB, LDS_OST=LDS_WS+NW*64*4, LDS_BYTES=LDS_OST+NW*4096;
constexpr float C2=0.125f*1.4426950408889634f;
__device__ __forceinline__ void glds16(const void*gsrc,unsigned lds_dst){unsigned keep;
  asm volatile("s_mov_b32 %0, m0\n\ts_mov_b32 m0, %2\n\ts_nop 0\n\tglobal_load_lds_dwordx4 %1, off\n\ts_mov_b32 m0, %0":"=&s"(keep):"v"(gsrc),"s"(lds_dst):"memory");}
__device__ __forceinline__ float max3f(float a,float b,float c){float r;asm("v_max3_f32 %0, %1, %2, %3":"=v"(r):"v"(a),"v"(b),"v"(c));return r;}
__device__ __forceinline__ float max2f(float a,float b){float r;asm("v_max_f32_e32 %0, %1, %2":"=v"(r):"v"(a),"v"(b));return r;}
__device__ __forceinline__ float fadd_s(float a,float b){float r;asm("v_add_f32_e32 %0, %1, %2":"=v"(r):"v"(a),"v"(b));return r;}
__device__ __forceinline__ float fsub_s(float a,float b){float r;asm("v_sub_f32_e32 %0, %1, %2":"=v"(r):"v"(a),"v"(b));return r;}
typedef float f32x2_t __attribute__((ext_vector_type(2))); typedef __bf16 bf16x2_t __attribute__((ext_vector_type(2)));
__device__ __forceinline__ unsigned cvtpk_s(float lo,float hi){f32x2_t v={lo,hi};bf16x2_t b=__builtin_convertvector(v,bf16x2_t);return __builtin_bit_cast(unsigned,b);}
#define WAIT_BAR(N) asm volatile("s_waitcnt vmcnt(" #N ") lgkmcnt(0)\n\ts_barrier":::"memory")

__device__ __forceinline__ void qkt(f32x16&p0,f32x16&p1,const char*Kslot,const bf16x8*qr,const f32x16&negm,int r32,int hi){
  const char*kb=Kslot+hi*1024+r32*16;
  #pragma unroll
  for(int d0=0;d0<4;++d0){
    const bf16x8 b0=*reinterpret_cast<const bf16x8*>(kb+d0*2048);
    const bf16x8 b1=*reinterpret_cast<const bf16x8*>(kb+d0*2048+512);
    if(d0==0){p0=__builtin_amdgcn_mfma_f32_32x32x16_bf16(b0,qr[0],negm,0,0,0);p1=__builtin_amdgcn_mfma_f32_32x32x16_bf16(b1,qr[0],negm,0,0,0);}
    else{p0=__builtin_amdgcn_mfma_f32_32x32x16_bf16(b0,qr[d0],p0,0,0,0);p1=__builtin_amdgcn_mfma_f32_32x32x16_bf16(b1,qr[d0],p1,0,0,0);}}
}
typedef __attribute__((address_space(3))) const char* lds_cptr;
typedef short v4i16_t __attribute__((ext_vector_type(4)));
__device__ __forceinline__ void kload8(bf16x8*kf,lds_cptr kp){
  kf[0]=*(const __attribute__((address_space(3))) bf16x8*)(kp);      kf[1]=*(const __attribute__((address_space(3))) bf16x8*)(kp+512);
  kf[2]=*(const __attribute__((address_space(3))) bf16x8*)(kp+2048); kf[3]=*(const __attribute__((address_space(3))) bf16x8*)(kp+2560);
  kf[4]=*(const __attribute__((address_space(3))) bf16x8*)(kp+4096); kf[5]=*(const __attribute__((address_space(3))) bf16x8*)(kp+4608);
  kf[6]=*(const __attribute__((address_space(3))) bf16x8*)(kp+6144); kf[7]=*(const __attribute__((address_space(3))) bf16x8*)(kp+6656);
}
__device__ __forceinline__ void kload2(bf16x8*kf,lds_cptr kp,int j){ kf[2*j]=*(const __attribute__((address_space(3))) bf16x8*)(kp+j*2048); kf[2*j+1]=*(const __attribute__((address_space(3))) bf16x8*)(kp+j*2048+512); }
__device__ __forceinline__ s16x4 vtr(lds_cptr p){ return __builtin_bit_cast(s16x4,__builtin_amdgcn_ds_read_tr16_b64_v4i16((__attribute__((address_space(3))) v4i16_t*)p)); }
__device__ __forceinline__ float rowmax(const f32x16&p0,const f32x16&p1){
  float a=max3f(p0[0],p0[1],p1[0]),b=max3f(p0[2],p0[3],p1[1]);a=max3f(a,p1[2],p1[3]);
  #pragma unroll
  for(int r=4;r<16;r+=4){a=max3f(a,p0[r],p0[r+1]);b=max3f(b,p0[r+2],p0[r+3]);a=max3f(a,p1[r],p1[r+1]);b=max3f(b,p1[r+2],p1[r+3]);}
  const float m=max2f(a,b);
  auto rr=__builtin_amdgcn_permlane32_swap(__float_as_uint(m),__float_as_uint(m),false,false);
  return max2f(__uint_as_float(rr[0]),__uint_as_float(rr[1]));
}
__device__ __forceinline__ void pv(f32x16*o,int vb,bf16x8 pa0,bf16x8 pa1,bf16x8 pa2,bf16x8 pa3){
  #pragma unroll
  for(int d0=0;d0<2;++d0){s16x4 lo[4],hi[4];
    #pragma unroll
    for(int ks=0;ks<4;++ks){
      asm volatile("ds_read_b64_tr_b16 %0,%1 offset:%c2":"=&v"(lo[ks]):"v"(vb),"i"(d0*4096+ks*1024):"memory");
      asm volatile("ds_read_b64_tr_b16 %0,%1 offset:%c2":"=&v"(hi[ks]):"v"(vb),"i"(d0*4096+ks*1024+512):"memory");}
    asm volatile("s_waitcnt lgkmcnt(0)":::"memory");SBAR();
    #define PK(k) (bf16x8){lo[k][0],lo[k][1],lo[k][2],lo[k][3],hi[k][0],hi[k][1],hi[k][2],hi[k][3]}
    o[d0]=__builtin_amdgcn_mfma_f32_32x32x16_bf16(pa0,PK(0),o[d0],0,0,0);
    o[d0]=__builtin_amdgcn_mfma_f32_32x32x16_bf16(pa1,PK(1),o[d0],0,0,0);
    o[d0]=__builtin_amdgcn_mfma_f32_32x32x16_bf16(pa2,PK(2),o[d0],0,0,0);
    o[d0]=__builtin_amdgcn_mfma_f32_32x32x16_bf16(pa3,PK(3),o[d0],0,0,0);
    #undef PK
  }
}

#ifndef ATTN_STORE16
#define ATTN_STORE16(p,v) (*(u32x4*)(p)=(v))
#endif
template<int THRL,bool NOMAX> __device__ __forceinline__ void attn_unit(int b,int h,int hk,int qb,const bf16*Q,const bf16*__restrict__ K,const bf16*__restrict__ V,bf16*O,char*shm){
  const int tid=opaque_tid(),lane=tid&63,r32=lane&31,hi=lane>>5; const int wid=__builtin_amdgcn_readfirstlane(tid>>6);
  const long rowbase=(long)b*SEQ; const int q0=qb*QB;
  const bf16*Qw=Q+(rowbase+q0+wid*QBLK)*DM+h*D;
  const bf16*Kh=K+rowbase*DM+hk*D,*Vh=V+rowbase*DM+hk*D;
  const unsigned lds0=(unsigned)(uintptr_t)shm;
  float*wsf=(float*)(shm+LDS_WS)+wid*64;
  const bf16*ksrc=Kh+(long)lane*DM+wid*8;
  const bf16*vsrc=Vh+(long)(16*(wid&3)+(lane>>2))*DM+(wid>>2)*32+(lane&3)*8;
  const unsigned kdst=lds0+LDS_K+wid*1024, vdst=lds0+LDS_V+wid*1024;
  #define DMA_K(t,slot) glds16(ksrc+(long)(t)*KVBLK*DM,(unsigned)__builtin_amdgcn_readfirstlane(kdst+(slot)))
  #define DMA_V(t,slot) glds16(vsrc+(long)(t)*KVBLK*DM,(unsigned)__builtin_amdgcn_readfirstlane(vdst+(slot)))
  const int vb0=(int)(lds0+LDS_V)+((lane>>4)&1)*32+(lane&3)*8+(4*hi+((lane&15)>>2))*64;
  const char*Kbase=shm+LDS_K; bf16x8 kf[8];
  const lds_cptr shm3=(lds_cptr)shm; const lds_cptr kp0=shm3+LDS_K+hi*1024+r32*16; const lds_cptr vp0=shm3+LDS_V+((lane>>4)&1)*32+(lane&3)*8+(4*hi+((lane&15)>>2))*64;
  constexpr int NT=NTILES;
  DMA_K(0,0);DMA_V(0,0);DMA_K(1,SLOTB);
  bf16x8 qr[4];
  #pragma unroll
  for(int d0=0;d0<4;++d0)qr[d0]=*reinterpret_cast<const bf16x8*>(&Qw[(long)r32*DM+d0*16+hi*8]);
  float mhat=0.f,l_reg=0.f;f32x16 o[2];o[0]=f32x16{};o[1]=f32x16{};f32x16 negm=f32x16{};asm volatile("":"+v"(negm));
  #define CMASK(P0,P1,t) do{}while(0)
  bool resc=false;
  #define START(P0,P1) do{ const float rm=rowmax(P0,P1); resc=false; \
    { const float dl=rm; mhat=fadd_s(mhat,dl); \
      _Pragma("unroll") for(int r=0;r<16;++r){P0[r]=fsub_s(P0[r],dl);P1[r]=fsub_s(P1[r],dl);} \
      _Pragma("unroll") for(int r=0;r<16;++r)negm[r]=-mhat; asm volatile("":"+v"(negm)); } \
    _Pragma("unroll") for(int r=0;r<16;++r)P0[r]=__builtin_amdgcn_exp2f(P0[r]); }while(0)
  #define RESC() do{ if(resc){ asm volatile("s_waitcnt lgkmcnt(0)":::"memory"); \
      _Pragma("unroll") for(int d_=0;d_<2;++d_) _Pragma("unroll") for(int r=0;r<16;++r)o[d_][r]*=wsf[crow(r,hi)]; } }while(0)
  f32x16 pA0,pA1,pB0,pB1;
  int sl_prev=0,sl_cur=0,sl_next=SLOTB;
  #define ROT() do{sl_prev=sl_cur;sl_cur=sl_next;sl_next=(sl_next==(NSLOT-1)*SLOTB)?0:sl_next+SLOTB;}while(0)
  DMA_K(2,2*SLOTB);
  WAIT_BAR(3);
  qkt(pA0,pA1,Kbase,qr,negm,r32,hi);asm volatile("s_nop 15\n\ts_nop 7":"+v"(pA0),"+v"(pA1));CMASK(pA0,pA1,0);
  START(pA0,pA1);
  _Pragma("unroll") for(int r=0;r<16;++r)pA1[r]=__builtin_amdgcn_exp2f(pA1[r]);
  WAIT_BAR(0);
  DMA_K(3,0);DMA_V(1,SLOTB);
  ROT();
  kload8(kf,kp0+sl_cur);
  WAIT_BAR(2);
  s16x4 vlo[8],vhi[8]; u32x4 pw0,pw1,pw2,pw3;
  #define PKW(P,B) cvtpk_s(P[B],P[B+1])
  #define PAF(k) __builtin_bit_cast(bf16x8,pw##k)
  #define VFR(i) (bf16x8){vlo[i][0],vlo[i][1],vlo[i][2],vlo[i][3],vhi[i][0],vhi[i][1],vhi[i][2],vhi[i][3]}
  #define PIN(x) asm volatile("":"+v"(x))
  #define MX3(a,b,c) __builtin_fmaxf(__builtin_fmaxf((a),(b)),(c))
  #define GAPA(MF,A0,A1,A2,A3,W0,W1,PW) do{ MF; sacc+=(f32x2_t){A0,A1}; sacc+=(f32x2_t){A2,A3}; PIN(sacc); W0; W1; PIN(PW); SBAR(); }while(0)
  #define EX(v) __builtin_amdgcn_exp2f(v)
  #define GAPB(MF,X,B) do{ MF; X[B]=EX(X[B]); X[B+1]=EX(X[B+1]); X[B+2]=EX(X[B+2]); X[B+3]=EX(X[B+3]); PIN(X); SBAR(); }while(0)
  #define VRD(i) do{ vlo[i]=vtr(vp_+(((i)>>2)*4096+((i)&3)*1024)); vhi[i]=vtr(vp_+(((i)>>2)*4096+((i)&3)*1024+512)); }while(0)
  #define KRD(G,j) do{ if(G){ kload2(kf,kp0+sl_next,j); SBAR(); } }while(0)
  #define STEP(C0,C1,P0,P1,t,GK,GV,GL) do{ SBAR(); \
    const lds_cptr vp_=vp0+sl_prev; \
    VRD(0); SBAR(); f32x2_t sacc={P0[0],P0[1]}; \
    GAPA(C0=__builtin_amdgcn_mfma_f32_32x32x16_bf16(kf[0],qr[0],negm,0,0,0), P0[2],P0[3],P0[4],P0[5],     pw0[0]=PKW(P0,0), pw0[1]=PKW(P0,2), pw0); \
    VRD(4); SBAR(); GAPA(C1=__builtin_amdgcn_mfma_f32_32x32x16_bf16(kf[1],qr[0],negm,0,0,0), P0[6],P0[7],P0[8],P0[9],     pw0[2]=PKW(P0,4), pw0[3]=PKW(P0,6), pw0); \
    VRD(1); SBAR(); GAPA(C0=__builtin_amdgcn_mfma_f32_32x32x16_bf16(kf[2],qr[1],C0,0,0,0),   P0[10],P0[11],P0[12],P0[13], pw1[0]=PKW(P0,8), pw1[1]=PKW(P0,10), pw1); \
    VRD(5); SBAR(); GAPA(C1=__builtin_amdgcn_mfma_f32_32x32x16_bf16(kf[3],qr[1],C1,0,0,0),   P0[14],P0[15],P1[0],P1[1],   pw1[2]=PKW(P0,12),pw1[3]=PKW(P0,14), pw1); \
    VRD(2); SBAR(); GAPA(C0=__builtin_amdgcn_mfma_f32_32x32x16_bf16(kf[4],qr[2],C0,0,0,0),   P1[2],P1[3],P1[4],P1[5],     pw2[0]=PKW(P1,0), pw2[1]=PKW(P1,2), pw2); \
    VRD(6); SBAR(); GAPA(C1=__builtin_amdgcn_mfma_f32_32x32x16_bf16(kf[5],qr[2],C1,0,0,0),   P1[6],P1[7],P1[8],P1[9],     pw2[2]=PKW(P1,4), pw2[3]=PKW(P1,6), pw2); \
    VRD(3); SBAR(); GAPA(C0=__builtin_amdgcn_mfma_f32_32x32x16_bf16(kf[6],qr[3],C0,0,0,0),   P1[10],P1[11],P1[12],P1[13], pw3[0]=PKW(P1,8), pw3[1]=PKW(P1,10), pw3); \
    VRD(7); SBAR(); GAPA(C1=__builtin_amdgcn_mfma_f32_32x32x16_bf16(kf[7],qr[3],C1,0,0,0),   P1[14],P1[15],0.f,0.f,       pw3[2]=PKW(P1,12),pw3[3]=PKW(P1,14), pw3); \
    l_reg+=(sacc.x+sacc.y); \
    if(GK){DMA_K((t)+3,sl_cur);} if(GV){DMA_V((t)+1,sl_next);} \
    CMASK(C0,C1,t); \
    if constexpr(!NOMAX){ float a=MX3(C0[0],C0[1],C1[0]),b=MX3(C0[2],C0[3],C1[1]); a=MX3(a,C1[2],C1[3]); \
      _Pragma("unroll") for(int r=4;r<16;r+=4){a=MX3(a,C0[r],C0[r+1]);b=MX3(b,C0[r+2],C0[r+3]);a=MX3(a,C1[r],C1[r+1]);b=MX3(b,C1[r+2],C1[r+3]);} \
      float rm=__builtin_fmaxf(a,b); { auto rr=__builtin_amdgcn_permlane32_swap(__float_as_uint(rm),__float_as_uint(rm),false,false); rm=__builtin_fmaxf(__uint_as_float(rr[0]),__uint_as_float(rr[1])); } \
      resc=false; \
      if(__builtin_expect(__any(rm>(float)THRL),0)){ const float dl=__builtin_fmaxf(rm,0.f); mhat+=dl; \
        _Pragma("unroll") for(int r=0;r<16;++r){C0[r]-=dl;C1[r]-=dl;} \
        _Pragma("unroll") for(int r=0;r<16;++r)negm[r]=-mhat; asm volatile("":"+v"(negm)); \
        const float f=__builtin_amdgcn_exp2f(-dl); l_reg*=f; if(hi==0)wsf[r32]=f; resc=true; } } \
    SBAR(); \
    GAPB(o[0]=__builtin_amdgcn_mfma_f32_32x32x16_bf16(PAF(0),VFR(0),o[0],0,0,0), C0,0); \
    GAPB(o[1]=__builtin_amdgcn_mfma_f32_32x32x16_bf16(PAF(0),VFR(4),o[1],0,0,0), C0,4); \
    KRD(GL,0); GAPB(o[0]=__builtin_amdgcn_mfma_f32_32x32x16_bf16(PAF(1),VFR(1),o[0],0,0,0), C0,8); \
    KRD(GL,1); GAPB(o[1]=__builtin_amdgcn_mfma_f32_32x32x16_bf16(PAF(1),VFR(5),o[1],0,0,0), C0,12); \
    KRD(GL,2); GAPB(o[0]=__builtin_amdgcn_mfma_f32_32x32x16_bf16(PAF(2),VFR(2),o[0],0,0,0), C1,0); \
    KRD(GL,3); GAPB(o[1]=__builtin_amdgcn_mfma_f32_32x32x16_bf16(PAF(2),VFR(6),o[1],0,0,0), C1,4); \
    GAPB(o[0]=__builtin_amdgcn_mfma_f32_32x32x16_bf16(PAF(3),VFR(3),o[0],0,0,0), C1,8); \
    GAPB(o[1]=__builtin_amdgcn_mfma_f32_32x32x16_bf16(PAF(3),VFR(7),o[1],0,0,0), C1,12); \
    }while(0)
  int t=1;
  #undef CMASK
  #define CMASK(P0,P1,t) do{}while(0)
  for(;t+5<NT;t+=2){
    STEP(pB0,pB1,pA0,pA1,t,true,true,true);     WAIT_BAR(2); RESC(); ROT();
    STEP(pA0,pA1,pB0,pB1,t+1,true,true,true);   WAIT_BAR(2); RESC(); ROT();
  }
  #undef CMASK
  #define CMASK(P0,P1,t) do{}while(0)
  #define ENDW(tt) do{ if((tt)+3<NT){WAIT_BAR(2);} else if((tt)+2<NT){WAIT_BAR(1);} else {WAIT_BAR(0);} }while(0)
  for(;t+1<NT;t+=2){
    STEP(pB0,pB1,pA0,pA1,t,(t+3<NT),(t+1<NT),(t+1<NT));       ENDW(t);   RESC(); ROT();
    STEP(pA0,pA1,pB0,pB1,t+1,(t+4<NT),(t+2<NT),(t+2<NT));     ENDW(t+1); RESC(); ROT();
  }
  STEP(pB0,pB1,pA0,pA1,NT-1,false,false,false); RESC();
  { float sacc=pB0[0]+pB0[1]; _Pragma("unroll") for(int r=2;r<16;++r)sacc+=pB0[r]; _Pragma("unroll") for(int r=0;r<16;++r)sacc+=pB1[r]; l_reg+=sacc;
    pw0=(u32x4){PKW(pB0,0),PKW(pB0,2),PKW(pB0,4),PKW(pB0,6)};pw1=(u32x4){PKW(pB0,8),PKW(pB0,10),PKW(pB0,12),PKW(pB0,14)};pw2=(u32x4){PKW(pB1,0),PKW(pB1,2),PKW(pB1,4),PKW(pB1,6)};pw3=(u32x4){PKW(pB1,8),PKW(pB1,10),PKW(pB1,12),PKW(pB1,14)};
    SBAR(); pv(o,vb0+sl_cur,PAF(0),PAF(1),PAF(2),PAF(3)); }
  #undef PKW
  #undef PAF
  #undef VFR
  #undef PIN
  #undef MX3
  #undef GAPA
  #undef GAPB
  #undef EX
  #undef VRD
  #undef KRD
  #undef STEP
  #undef ENDW
  {auto rr=__builtin_amdgcn_permlane32_swap(__float_as_uint(l_reg),__float_as_uint(l_reg),false,false);l_reg=__uint_as_float(rr[0])+__uint_as_float(rr[1]);}
  if(hi==0)wsf[32+r32]=l_reg;asm volatile("s_waitcnt lgkmcnt(0)":::"memory");
  float rli[16];
  #pragma unroll
  for(int r=0;r<16;++r)rli[r]=__builtin_amdgcn_rcpf(wsf[32+crow(r,hi)]);
  bf16*Ow=O+(rowbase+q0+wid*QBLK)*DM+h*D;
  { bf16*stg=(bf16*)(shm+LDS_OST)+wid*2048;
    #pragma unroll
    for(int r=0;r<16;++r){const int orow=crow(r,hi);
      #pragma unroll
      for(int d0=0;d0<2;++d0)stg[orow*64+d0*32+r32]=__float2bfloat16(o[d0][r]*rli[r]);}
    asm volatile("s_waitcnt lgkmcnt(0)":::"memory");
    #pragma unroll
    for(int i=0;i<4;++i){const int row=i*8+(lane>>3),ch=lane&7; const u32x4 v=*(const u32x4*)(stg+row*64+ch*8); ATTN_STORE16(Ow+(long)row*DM+ch*8,v);} }
  asm volatile("s_waitcnt lgkmcnt(0)\n\ts_barrier":::"memory");
  #undef DMA_K
  #undef DMA_V
  #undef CMASK
  #undef START
  #undef RESC
  #undef ROT
}
constexpr int ATTN_LDS_BYTES=LDS_BYTES;
#undef SBAR
#undef WAIT_BAR
}
#include <hip/hip_cooperative_groups.h>
namespace cg = cooperative_groups;
#define LAS __attribute__((address_space(3)))
typedef unsigned short bf16;
typedef unsigned v4u __attribute__((ext_vector_type(4)));
typedef unsigned v2u __attribute__((ext_vector_type(2)));
typedef float f32x4 __attribute__((ext_vector_type(4)));
typedef short bf16x8 __attribute__((ext_vector_type(8)));

#define XB_TMO      128
#define XB_XCNT(j)  (256  + 64 * (j))
#define XB_XSUB(j)  (1280 + 64 * (j))
#define XB_XGEN(j)  (2304 + 64 * (j))
#define XB_TOP      3328
#define XB_TOPGEN   3392
#define XCD_BAR_WORDS 3456
#define XB_SPIN_CAP (1u << 18)

__device__ __forceinline__ unsigned xb_ld(unsigned* p)              { return __hip_atomic_load(p, __ATOMIC_RELAXED, __HIP_MEMORY_SCOPE_AGENT); }
__device__ __forceinline__ unsigned xb_add(unsigned* p, unsigned v) { return __hip_atomic_fetch_add(p, v, __ATOMIC_RELAXED, __HIP_MEMORY_SCOPE_AGENT); }
__device__ __forceinline__ unsigned xb_xcc_id() { return (unsigned)__builtin_amdgcn_s_getreg((3 << 11) | 20) & 0xFu; }
#define XB_SPIN(cond, bar) do { unsigned _sp = 0; while (cond) { __builtin_amdgcn_s_sleep(1); \
    if ((++_sp & 255u) == 0u) { if (xb_ld(&(bar)[XB_TMO])) break; if (_sp > XB_SPIN_CAP) { atomicAdd(&(bar)[XB_TMO], 1u); break; } } } } while (0)

struct XcdBarrier {
    unsigned* bar; unsigned x;
    volatile LAS unsigned* st;
};

__device__ __forceinline__ XcdBarrier xcd_barrier_post(unsigned* bar, volatile LAS unsigned* st) {
    XcdBarrier b; b.bar = bar; b.x = xb_xcc_id(); b.st = st;
    if (threadIdx.x == 0) (void)xb_add(&bar[XB_XCNT(b.x)], 1u);
    return b;
}
__device__ __forceinline__ void xcd_barrier_complete(unsigned* bar, unsigned x, unsigned& nloc, unsigned& nx) {
    const unsigned G = gridDim.x * gridDim.y * gridDim.z;
    unsigned sum, cnt, mine, sp = 0u;
    for (;;) {
        sum = 0u; cnt = 0u; mine = 0u;
#pragma unroll
        for (unsigned j = 0; j < 16; ++j) { const unsigned c = xb_ld(&bar[XB_XCNT(j)]); sum += c; cnt += (c > 0u) ? 1u : 0u; mine = (j == x) ? c : mine; }
        if (sum == G) break;
        __builtin_amdgcn_s_sleep(1);
        if ((++sp & 255u) == 0u) { if (xb_ld(&bar[XB_TMO])) break; if (sp > XB_SPIN_CAP) { atomicAdd(&bar[XB_TMO], 1u); break; } }
    }
    nloc = mine > 0u ? mine : 1u; nx = cnt > 0u ? cnt : 1u;
}

__device__ __forceinline__ void xcd_barrier(const XcdBarrier& b) {
    asm volatile("s_waitcnt vmcnt(0)" ::: "memory");
    __syncthreads();
    if (threadIdx.x == 0) {
        unsigned* bar = b.bar;
        __builtin_amdgcn_s_waitcnt(0);
        unsigned nloc = b.st[0], nx = b.st[1];
        if (nloc == 0u) { xcd_barrier_complete(bar, b.x, nloc, nx); b.st[0] = nloc; b.st[1] = nx; }
        const unsigned old = xb_add(&bar[XB_XSUB(b.x)], 1u);
        const unsigned gen = old / nloc;
        if (old + 1u == (gen + 1u) * nloc) {
            __builtin_amdgcn_fence(__ATOMIC_RELEASE, "agent");
            asm volatile("s_waitcnt vmcnt(0)" ::: "memory");
            const unsigned og = xb_add(&bar[XB_TOP], 1u);
            const unsigned tg = og / nx;
            if (og + 1u == (tg + 1u) * nx) xb_add(&bar[XB_TOPGEN], 1u);
            else XB_SPIN(xb_ld(&bar[XB_TOPGEN]) == tg, bar);
            __builtin_amdgcn_fence(__ATOMIC_ACQUIRE, "agent");
            xb_add(&bar[XB_XGEN(b.x)], 1u);
            asm volatile("s_waitcnt vmcnt(0)" ::: "memory");
        } else {
            XB_SPIN(xb_ld(&bar[XB_XGEN(b.x)]) == gen, bar);
            __builtin_amdgcn_fence(__ATOMIC_ACQUIRE, "agent");
            asm volatile("s_waitcnt vmcnt(0)" ::: "memory");
        }
    }
    __syncthreads();
}

constexpr int NB = 8, TL = 8192, TC = 256, TB = TL + TC  , MR = NB * TB  , DM = 1024, DFF = 2816, PW = 4608, NMOD = 9216;
constexpr float EPS = 1e-6f;
constexpr int LDS_BYTES = 147456, NTHR = 512, NWAVES = 8;
constexpr int PC_Q = 0, PC_K = 512, PC_V = 640, PC_GQ = 768, PC_GK = 1024, PC_GV = 1280, PC_G6 = 1792, PC_GATE = 2304, PC_LOW = 4352;
constexpr int GLA_S = 132, GLA_ITEMS = 64 * GLA_S;
constexpr size_t MiB = 1u << 20;
constexpr size_t WS_SSQ1 = 5 * MiB, WS_SSQ2 = 5 * MiB + 512 * 1024, WS_SW1 = 6 * MiB, WS_SW2 = 6 * MiB + 512 * 1024;
constexpr size_t WS_MOD = 1 * MiB, WS_DN = 2 * MiB, WS_WUP1 = 8 * MiB, WS_WUP2 = 20 * MiB, WS_WDN1 = 32 * MiB, WS_WDN2 = 38 * MiB, WS_WIN = 44 * MiB, WS_WBR0 = 54 * MiB, WS_WBR1 = 55 * MiB, WS_WOUT = 56 * MiB,
                 WS_HCTX = 64 * MiB, WS_XN = 72 * MiB, WS_OF = 204 * MiB, WS_OB = 270 * MiB, WS_A = 336 * MiB, WS_END = 932 * MiB;
static_assert(WS_XN + (size_t)MR * DM * 2 <= WS_OF && WS_OF + (size_t)MR * 512 * 2 <= WS_OB && WS_OB + (size_t)MR * 512 * 2 <= WS_A && WS_A + (size_t)MR * PW * 2 <= WS_END, "ws map");
static_assert((size_t)GLA_ITEMS * 8192 * 2 <= (size_t)MR * DM * 2 && WS_DN + (size_t)GLA_ITEMS * 64 * 4 <= WS_WUP1, "gla ws");

__device__ __forceinline__ unsigned f2bf(float f) { unsigned u = __builtin_bit_cast(unsigned, f); return (u + 0x7fffu + ((u >> 16) & 1u)) >> 16; }
__device__ __forceinline__ unsigned pk2(float lo, float hi) { return f2bf(lo) | (f2bf(hi) << 16); }
__device__ __forceinline__ float bf2f(unsigned short h) { return __uint_as_float(((unsigned)h) << 16); }
__device__ __forceinline__ float wave_sum(float v) {
#pragma unroll
    for (int o = 1; o < 64; o <<= 1) v += __shfl_xor(v, o);
    return v;
}
__device__ __forceinline__ float silu_f(float v) { return v / (1.f + __expf(-v)); }

__device__ __forceinline__ void transpose_item(const float* W, int K, int N, bf16* WT, int k0, int n0, int drow0, LAS float* scr, int lane) {
#pragma unroll 8
    for (int i = 0; i < 32; ++i) { const int kk = 2 * i + (lane >> 5); scr[kk * 33 + (lane & 31)] = W[(size_t)(k0 + kk) * N + n0 + (lane & 31)]; }
    asm volatile("s_waitcnt lgkmcnt(0)" ::: "memory");
    const int c = lane & 7;
#pragma unroll
    for (int j = 0; j < 4; ++j) { const int n = (lane >> 3) + 8 * j; const LAS float* s = scr + (8 * c) * 33 + n;
        v4u o; o.x = pk2(s[0 * 33], s[1 * 33]); o.y = pk2(s[2 * 33], s[3 * 33]); o.z = pk2(s[4 * 33], s[5 * 33]); o.w = pk2(s[6 * 33], s[7 * 33]);
        *(v4u*)(WT + (size_t)(drow0 + n) * K + k0 + 8 * c) = o; }
    asm volatile("s_waitcnt lgkmcnt(0)" ::: "memory");
}
__device__ __forceinline__ int up_dest(int n0) { return n0 < DFF ? 256 * (n0 / 128) + (n0 % 128) : 256 * ((n0 - DFF) / 128) + 128 + ((n0 - DFF) % 128); }
__device__ __forceinline__ int win_dest(int n0) { return n0 < 2304 ? n0 : (n0 < 2336 ? n0 + 2048 : n0 - 32); }

__device__ __forceinline__ void norm_mod_rows(const float* lat, const float* ctxp, const float* mod, const float* g, int sub, bf16* XN, bool with_ctx, int gw, int NGW, int lane) {
    f32x4 gv[4];
#pragma unroll
    for (int j = 0; j < 4; ++j) gv[j] = *((const f32x4*)g + lane + 64 * j);
    for (int r0 = gw * 2; r0 < MR; r0 += NGW * 2) {
        const int b = r0 / TB, t = r0 % TB; const bool isctx = t >= TL;
        if (isctx && !with_ctx) continue;
        const float* src = isctx ? ctxp + (size_t)(b * TC + t - TL) * DM : lat + (size_t)(b * TL + t) * DM;
        const float* sh = mod + (size_t)(isctx ? 8 : b) * NMOD + (3 * sub) * DM; const float* sc = sh + DM;
        f32x4 v[2][4]; float s[2] = {0.f, 0.f};
#pragma unroll
        for (int u = 0; u < 2; ++u)
#pragma unroll
            for (int j = 0; j < 4; ++j) { v[u][j] = *((const f32x4*)(src + (size_t)u * DM) + lane + 64 * j); }
#pragma unroll
        for (int u = 0; u < 2; ++u)
#pragma unroll
            for (int j = 0; j < 4; ++j) s[u] += (v[u][j].x * v[u][j].x + v[u][j].y * v[u][j].y) + (v[u][j].z * v[u][j].z + v[u][j].w * v[u][j].w);
#pragma unroll
        for (int u = 0; u < 2; ++u) {
            const float rstd = 1.f / sqrtf(wave_sum(s[u]) * (1.f / DM) + EPS);
            unsigned long long* o8 = (unsigned long long*)(XN + (size_t)(r0 + u) * DM) + lane;
#pragma unroll
            for (int j = 0; j < 4; ++j) { const f32x4 scv = *((const f32x4*)sc + lane + 64 * j), shv = *((const f32x4*)sh + lane + 64 * j);
                const f32x4 y = (v[u][j] * rstd * gv[j]) * (scv + 1.f) + shv;
                o8[64 * j] = (unsigned long long)pk2(y.x, y.y) | ((unsigned long long)pk2(y.z, y.w) << 32); } }
    }
}

constexpr int GS = 72, VS = 136;
constexpr int GL_QE = 0, GL_KE = 9216, GL_KL = 18432, GL_A = 27648, GL_V = 36864, GL_B = 54272, GL_BT = 71680, GL_SEG = 71936, BS = 68;
typedef short v4i16_t __attribute__((ext_vector_type(4)));
__device__ __forceinline__ bf16x8 tr_frag(const LAS bf16* base, int rs  , int col0, int ks, int q4, int qq, int p) {
    const LAS bf16* a0 = base + (32 * ks + 8 * q4 + qq) * rs + col0 + 4 * p;
    const v4i16_t t0 = __builtin_amdgcn_ds_read_tr16_b64_v4i16((LAS v4i16_t*)a0), t1 = __builtin_amdgcn_ds_read_tr16_b64_v4i16((LAS v4i16_t*)(a0 + 4 * rs));
    return (bf16x8){t0[0], t0[1], t0[2], t0[3], t1[0], t1[1], t1[2], t1[3]};
}
#define GLA_ROWOF(c) (rowbase + (dir ? 63 - (c) : (c)))
template <int PASS> __device__ __forceinline__ void gla_pass(LAS unsigned char* lds, const bf16* P, const float* w_decay, const float* b_decay, bf16* Ubuf, float* dn, bf16* OF, bf16* OB, int bx, int G, unsigned* ctr) {
    const int tid = opaque_tid(), lane = tid & 63, w = __builtin_amdgcn_readfirstlane(tid >> 6), l15 = lane & 15, q4 = lane >> 4, qq = (lane & 15) >> 2, p3 = lane & 3;
    constexpr int NV = PASS == 1 ? 64 * 131 : 64 * 128;
    LAS bf16* qeL = (LAS bf16*)(lds + GL_QE); LAS bf16* keL = (LAS bf16*)(lds + GL_KE); LAS bf16* klL = (LAS bf16*)(lds + GL_KL); LAS bf16* AL = (LAS bf16*)(lds + GL_A); LAS bf16* vL = (LAS bf16*)(lds + GL_V);
    LAS float* bL = (LAS float*)(lds + GL_B); LAS float* btL = (LAS float*)(lds + GL_BT); LAS float* segT = (LAS float*)(lds + GL_SEG);
    const int c = tid >> 3, ch = tid & 7, dt = w & 3, half = w >> 2;
    v4u vraw[2], kraw, qraw, lowf[2]; float wdr[8]; float bdr = 0.f; bf16x8 xsn[2];
    vraw[0] = vraw[1] = kraw = qraw = lowf[0] = lowf[1] = (v4u){0u, 0u, 0u, 0u}; xsn[0] = xsn[1] = (bf16x8){0, 0, 0, 0, 0, 0, 0, 0};
#pragma unroll
    for (int j = 0; j < 8; ++j) wdr[j] = 0.f;
#define GLA_DEC(idx_) const int chain = PASS == 1 ? (idx_) / 131 : (idx_) >> 7, s = PASS == 1 ? (idx_) % 131 : 4 + ((idx_) & 127), dir = chain & 1, h = (chain >> 1) & 3, b = chain >> 3; \
    const int rowbase = b * TB + (s < 4 ? TL + (dir ? 3 - s : s) * 64 : (dir ? 127 - (s - 4) : s - 4) * 64); const int item = chain * GLA_S + s; (void)item
#define GLA_LOAD(idx_) do { GLA_DEC(idx_); \
        _Pragma("unroll") for (int i = 0; i < 2; ++i) { const int n = tid + 512 * i; vraw[i] = *(const v4u*)(P + (size_t)GLA_ROWOF(n >> 4) * PW + PC_GV + h * 128 + (n & 15) * 8); } \
        { const size_t ro = (size_t)GLA_ROWOF(c) * PW + h * 64 + ch * 8; kraw = *(const v4u*)(P + ro + PC_GK); if (PASS == 3) qraw = *(const v4u*)(P + ro + PC_GQ); } \
        _Pragma("unroll") for (int i = 0; i < 2; ++i) lowf[i] = *(const v4u*)(P + (size_t)GLA_ROWOF(16 * (2 * half + i) + l15) * PW + PC_LOW + dir * 16 + (q4 & 1) * 8); \
        _Pragma("unroll") for (int j = 0; j < 8; ++j) wdr[j] = w_decay[(dir * 16 + 8 * (q4 & 1) + j) * 256 + h * 64 + 16 * dt + l15]; \
        bdr = b_decay[dir * 256 + h * 64 + 16 * dt + l15]; \
        if (PASS == 3) { _Pragma("unroll") for (int ks = 0; ks < 2; ++ks) xsn[ks] = *(const bf16x8*)(Ubuf + (size_t)item * 8192 + (16 * w + l15) * 64 + 8 * q4 + 32 * ks); } } while (0)
    volatile LAS unsigned* nxtL = (volatile LAS unsigned*)(lds + GL_SEG + 1024);
    int idx = bx;
    if (ctr) { if (tid == 0) nxtL[0] = __hip_atomic_fetch_add(ctr, 1u, __ATOMIC_RELAXED, __HIP_MEMORY_SCOPE_AGENT); __syncthreads(); idx = (int)nxtL[0]; __syncthreads(); }
    if (idx < NV) GLA_LOAD(idx);
    for (; idx < NV;) {
        int nidx = idx + G;
        if (ctr && tid == 0) nxtL[0] = __hip_atomic_fetch_add(ctr, 1u, __ATOMIC_RELAXED, __HIP_MEMORY_SCOPE_AGENT);
        GLA_DEC(idx);
#pragma unroll
        for (int i = 0; i < 2; ++i) { const int n = tid + 512 * i; *(LAS v4u*)(vL + (n >> 4) * VS + (n & 15) * 8) = vraw[i]; }
        float kf[8], qf[8];
        kf[0] = pg8::bflo(kraw.x); kf[1] = pg8::bfhi(kraw.x); kf[2] = pg8::bflo(kraw.y); kf[3] = pg8::bfhi(kraw.y); kf[4] = pg8::bflo(kraw.z); kf[5] = pg8::bfhi(kraw.z); kf[6] = pg8::bflo(kraw.w); kf[7] = pg8::bfhi(kraw.w);
        if (PASS == 3) { qf[0] = pg8::bflo(qraw.x); qf[1] = pg8::bfhi(qraw.x); qf[2] = pg8::bflo(qraw.y); qf[3] = pg8::bfhi(qraw.y); qf[4] = pg8::bflo(qraw.z); qf[5] = pg8::bfhi(qraw.z); qf[6] = pg8::bflo(qraw.w); qf[7] = pg8::bfhi(qraw.w); }
        float bv[2][4], tot[2];
        { bf16x8 yv;
#pragma unroll
          for (int j = 0; j < 8; ++j) { const unsigned hb = f2bf(wdr[j]); const unsigned lb = f2bf(wdr[j] - __uint_as_float(hb << 16)); yv[j] = (short)(q4 < 2 ? hb : lb); }
#pragma unroll
          for (int i = 0; i < 2; ++i) { f32x4 z = {0.f, 0.f, 0.f, 0.f}; z = __builtin_amdgcn_mfma_f32_16x16x32_bf16(__builtin_bit_cast(bf16x8, lowf[i]), yv, z, 0, 0, 0);
              float run = 0.f;
#pragma unroll
              for (int r = 0; r < 4; ++r) { const float zz = z[r] + bdr; run += (fminf(zz, 0.f) - __logf(1.f + __expf(-fabsf(zz)))) * (1.f / 16.f); bv[i][r] = run; }
              float sc = run; float t = __shfl_up(sc, 16); if (q4 >= 1) sc += t; t = __shfl_up(sc, 32); if (q4 >= 2) sc += t;
              const float excl = sc - run; tot[i] = __shfl(sc, 48 + l15);
#pragma unroll
              for (int r = 0; r < 4; ++r) bv[i][r] += excl + (i ? tot[0] : 0.f); }
          if (q4 == 0) segT[half * 64 + 16 * dt + l15] = tot[0] + tot[1]; }
        __syncthreads();
        { const float other = segT[(1 - half) * 64 + 16 * dt + l15]; const float add = half ? other : 0.f;
#pragma unroll
          for (int i = 0; i < 2; ++i)
#pragma unroll
              for (int r = 0; r < 4; ++r) bL[(16 * (2 * half + i) + 4 * q4 + r) * BS + 16 * dt + l15] = bv[i][r] + add;
          if (half == 0 && q4 == 0) btL[16 * dt + l15] = tot[0] + tot[1] + other; }
        __syncthreads();
        float bl[8], btot[8];
        { const f32x4 b0 = *(const LAS f32x4*)(bL + c * BS + 8 * ch), b1 = *(const LAS f32x4*)(bL + c * BS + 8 * ch + 4), t0 = *(const LAS f32x4*)(btL + 8 * ch), t1 = *(const LAS f32x4*)(btL + 8 * ch + 4);
          bl[0] = b0[0]; bl[1] = b0[1]; bl[2] = b0[2]; bl[3] = b0[3]; bl[4] = b1[0]; bl[5] = b1[1]; bl[6] = b1[2]; bl[7] = b1[3];
          btot[0] = t0[0]; btot[1] = t0[1]; btot[2] = t0[2]; btot[3] = t0[3]; btot[4] = t1[0]; btot[5] = t1[1]; btot[6] = t1[2]; btot[7] = t1[3]; }
        if (PASS == 1) {
            float kl[8];
#pragma unroll
            for (int k = 0; k < 8; ++k) kl[k] = kf[k] * __expf(btot[k] - bl[k]);
            v4u o; o.x = pk2(kl[0], kl[1]); o.y = pk2(kl[2], kl[3]); o.z = pk2(kl[4], kl[5]); o.w = pk2(kl[6], kl[7]);
            *(LAS v4u*)(klL + c * GS + 8 * ch) = o;
            if (tid < 8) { f32x4* dp = (f32x4*)(dn + (size_t)item * 64 + 8 * ch); dp[0] = (f32x4){__expf(btot[0]), __expf(btot[1]), __expf(btot[2]), __expf(btot[3])}; dp[1] = (f32x4){__expf(btot[4]), __expf(btot[5]), __expf(btot[6]), __expf(btot[7])}; }
        } else {
            float qe[8], ke[8];
#pragma unroll
            for (int k = 0; k < 8; ++k) { qe[k] = qf[k] * __expf(bl[k]) * 0.125f; ke[k] = kf[k] * __expf(-bl[k]); }
            v4u o; o.x = pk2(qe[0], qe[1]); o.y = pk2(qe[2], qe[3]); o.z = pk2(qe[4], qe[5]); o.w = pk2(qe[6], qe[7]);
            *(LAS v4u*)(qeL + c * GS + 8 * ch) = o;
            o.x = pk2(ke[0], ke[1]); o.y = pk2(ke[2], ke[3]); o.z = pk2(ke[4], ke[5]); o.w = pk2(ke[6], ke[7]);
            *(LAS v4u*)(keL + c * GS + 8 * ch) = o;
        }
        bf16x8 xs[2]; xs[0] = xsn[0]; xs[1] = xsn[1];
        if (ctr) nidx = (int)nxtL[0];
        if (nidx < NV) GLA_LOAD(nidx);
        __syncthreads();
        if (PASS == 1) {
            bf16x8 y[2];
#pragma unroll
            for (int ks = 0; ks < 2; ++ks) y[ks] = tr_frag(vL, VS, 16 * w, ks, q4, qq, p3);
#pragma unroll
            for (int dt = 0; dt < 4; ++dt) { f32x4 acc = {0.f, 0.f, 0.f, 0.f};
#pragma unroll
                for (int ks = 0; ks < 2; ++ks) { const bf16x8 x = tr_frag(klL, GS, 16 * dt, ks, q4, qq, p3); acc = __builtin_amdgcn_mfma_f32_16x16x32_bf16(x, y[ks], acc, 0, 0, 0); }
                v2u o; o.x = pk2(acc[0], acc[1]); o.y = pk2(acc[2], acc[3]);
                *(v2u*)(Ubuf + (size_t)item * 8192 + (16 * w + l15) * 64 + 16 * dt + 4 * q4) = o; }
        } else {
            { const int it = w >> 1;
#pragma unroll
              for (int jj = 0; jj < 2; ++jj) { const int jt = (w & 1) * 2 + jj; f32x4 acc = {0.f, 0.f, 0.f, 0.f};
                  if (jt <= it) {
#pragma unroll
                      for (int ks = 0; ks < 2; ++ks) { const bf16x8 x = *(const LAS bf16x8*)(keL + (16 * jt + l15) * GS + 8 * q4 + 32 * ks), y = *(const LAS bf16x8*)(qeL + (16 * it + l15) * GS + 8 * q4 + 32 * ks);
                          acc = __builtin_amdgcn_mfma_f32_16x16x32_bf16(x, y, acc, 0, 0, 0); }
                      const int i = 16 * it + l15, j0 = 16 * jt + 4 * q4;
#pragma unroll
                      for (int r = 0; r < 4; ++r) if (j0 + r > i) acc[r] = 0.f;
                  }
                  v2u o; o.x = pk2(acc[0], acc[1]); o.y = pk2(acc[2], acc[3]);
                  *(LAS v2u*)(AL + (16 * it + l15) * GS + 16 * jt + 4 * q4) = o; } }
            bf16x8 xv[2];
#pragma unroll
            for (int ks = 0; ks < 2; ++ks) xv[ks] = tr_frag(vL, VS, 16 * w, ks, q4, qq, p3);
            __syncthreads();
            bf16* Ob = dir ? OB : OF;
#pragma unroll
            for (int it = 0; it < 4; ++it) { f32x4 acc = {0.f, 0.f, 0.f, 0.f};
#pragma unroll
                for (int ks = 0; ks < 2; ++ks) { const bf16x8 y = *(const LAS bf16x8*)(AL + (16 * it + l15) * GS + 8 * q4 + 32 * ks); acc = __builtin_amdgcn_mfma_f32_16x16x32_bf16(xv[ks], y, acc, 0, 0, 0); }
#pragma unroll
                for (int ks = 0; ks < 2; ++ks) { const bf16x8 y = *(const LAS bf16x8*)(qeL + (16 * it + l15) * GS + 8 * q4 + 32 * ks); acc = __builtin_amdgcn_mfma_f32_16x16x32_bf16(xs[ks], y, acc, 0, 0, 0); }
                v2u o; o.x = pk2(acc[0], acc[1]); o.y = pk2(acc[2], acc[3]);
                *(v2u*)(Ob + (size_t)GLA_ROWOF(16 * it + l15) * 512 + h * 128 + 16 * w + 4 * q4) = o; }
        }
        __syncthreads();
        idx = nidx;
    }
#undef GLA_DEC
#undef GLA_LOAD
}

struct Args { const float* in[19]; float* out; unsigned char* ws; };
__global__ void __launch_bounds__(NTHR, 2) mk_fwd(Args args) {
    extern __shared__ __attribute__((aligned(16))) unsigned char lds_raw[];
    cg::grid_group grid = cg::this_grid();
    LAS unsigned char* lds = (LAS unsigned char*)lds_raw;
    const int G = gridDim.x, bx = blockIdx.x, NGW = G * NWAVES;
    unsigned long long pacc = 0ull, pt0 = 0ull; (void)pt0;
#define PB(k) do { if ((PROBE_MASK >> (k)) & 1ull) pt0 = __builtin_amdgcn_s_memrealtime(); } while (0)
#define PE(k) do { if ((PROBE_MASK >> (k)) & 1ull) pacc += __builtin_amdgcn_s_memrealtime() - pt0; } while (0)
#define GSYNC() do { xcd_barrier(xbar); if (PROBE_SYNC) { const unsigned long long t_ = __builtin_amdgcn_s_memrealtime(); xcd_barrier(xbar); pacc += __builtin_amdgcn_s_memrealtime() - t_; } } while (0)
#define PH_IDS const int tid = opaque_tid(), lane = tid & 63, wave = __builtin_amdgcn_readfirstlane(tid >> 6), gw = bx * NWAVES + wave; (void)lane; (void)gw
    unsigned char* ws = args.ws;
    const float* x = args.in[0]; const float* cvec = args.in[1]; const float* ctx = args.in[2]; const float* c_ctx = args.in[3]; const float* w_mod = args.in[4]; const float* b_mod = args.in[5];
    const float* g_norm = args.in[6]; const float* w_up = args.in[7]; const float* w_down = args.in[8]; const float* w_in = args.in[9]; const float* g_q = args.in[10]; const float* g_k = args.in[11];
    const float* w_decay = args.in[12]; const float* b_decay = args.in[13]; const float* g_gla = args.in[14]; const float* w_branch = args.in[15]; const float* b_gate = args.in[16]; const float* w_out = args.in[17]; const float* g_final = args.in[18];
    float* H = args.out;
    float* HC = (float*)(ws + WS_HCTX);
    float* mod = (float*)(ws + WS_MOD); float* dn = (float*)(ws + WS_DN);
    bf16* Wup1 = (bf16*)(ws + WS_WUP1); bf16* Wup2 = (bf16*)(ws + WS_WUP2); bf16* Wdn1 = (bf16*)(ws + WS_WDN1); bf16* Wdn2 = (bf16*)(ws + WS_WDN2); bf16* Win = (bf16*)(ws + WS_WIN);
    bf16* Wbr0 = (bf16*)(ws + WS_WBR0); bf16* Wbr1 = (bf16*)(ws + WS_WBR1); bf16* Wout = (bf16*)(ws + WS_WOUT);
    bf16* XN = (bf16*)(ws + WS_XN); bf16* OF = (bf16*)(ws + WS_OF); bf16* OB = (bf16*)(ws + WS_OB); bf16* PA = (bf16*)(ws + WS_A);
    bf16* HID = PA; bf16* Ubuf = XN; bf16* Z = XN;
    float* ssq1 = (float*)(ws + WS_SSQ1); float* ssq2 = (float*)(ws + WS_SSQ2); float* sW1 = (float*)(ws + WS_SW1); float* sW2 = (float*)(ws + WS_SW2);
    bf16* XN2 = OF;

    volatile LAS unsigned* xst = (volatile LAS unsigned*)(lds + LDS_BYTES - 64);
    if (threadIdx.x < 2) xst[threadIdx.x] = 0u;
    unsigned* barw = (unsigned*)ws;
    if (bx == 0) for (int i = threadIdx.x; i < XCD_BAR_WORDS + 128; i += NTHR) __hip_atomic_store(barw + i, 0u, __ATOMIC_RELAXED, __HIP_MEMORY_SCOPE_AGENT);
    XcdBarrier xbar; xbar.bar = barw; xbar.x = 0; xbar.st = xst;
    PB(0);
    {
        PH_IDS;
        LAS float* sc = (LAS float*)lds; LAS float* red = sc + 9 * 1024;
        for (int idx = tid; idx < 9 * 1024; idx += NTHR) { const int j = idx >> 10, k = idx & 1023; const float v = j < 8 ? cvec[j * 1024 + k] : c_ctx[k]; sc[idx] = silu_f(v); }
        __syncthreads();
        for (int it = bx; it < NMOD / 32; it += G) {
            const int cc = tid & 31, ks = tid >> 5, col = it * 32 + cc;
            float a[9];
#pragma unroll
            for (int j = 0; j < 9; ++j) a[j] = 0.f;
#pragma unroll 4
            for (int kk = 0; kk < 64; ++kk) { const int k = ks * 64 + kk; const float wv = w_mod[(size_t)k * NMOD + col];
#pragma unroll
                for (int j = 0; j < 9; ++j) a[j] += sc[j * 1024 + k] * wv; }
#pragma unroll
            for (int j = 0; j < 9; ++j) red[(ks * 9 + j) * 32 + cc] = a[j];
            __syncthreads();
            if (tid < 288) { const int j = tid >> 5, c2 = tid & 31; float s = b_mod[it * 32 + c2];
#pragma unroll
                for (int k2 = 0; k2 < 16; ++k2) s += red[(k2 * 9 + j) * 32 + c2];
                mod[(size_t)j * NMOD + it * 32 + c2] = s; }
            __syncthreads();
        }
        LAS float* scr = (LAS float*)(lds + 65536) + wave * 2176;
        constexpr int I_UP = 16 * 176, I_DN = 44 * 32;
        for (int it = gw; it < I_UP + I_DN; it += NGW) {
            int r = it;
            if (r < I_UP) { const int kb = r / 176, nb = r % 176; transpose_item(w_up, 1024, 5632, Wup1, 64 * kb, 32 * nb, up_dest(32 * nb), scr, lane); continue; } r -= I_UP;
            { const int kb = r / 32, nb = r % 32; transpose_item(w_down, DFF, 1024, Wdn1, 64 * kb, 32 * nb, 32 * nb, scr, lane); }
        }
        for (int i = bx * NTHR + tid; i < 224 * 1024 / 8; i += G * NTHR) ((v4u*)(Win + (size_t)4384 * 1024))[i] = (v4u){0u, 0u, 0u, 0u};
        for (int i = bx * NTHR + tid; i < MR; i += G * NTHR) { ssq1[i] = 0.f; ssq2[i] = 0.f; }
    }
    grid.sync();
    xbar.x = xb_xcc_id(); if (threadIdx.x == 0) xst[2] = xb_add(&barw[XB_XCNT(xbar.x)], 1u);
    PE(0); PB(1);
    { PH_IDS; norm_mod_rows(x, ctx, mod, g_norm + 0 * DM, 0, XN, true, gw, NGW, lane);
      LAS float* sc = (LAS float*)lds; LAS float* red = sc + 9 * 1024;
      for (int it = bx; it < 144 + 176; it += G) {
          const bool second = it >= 144; const int n0 = (second ? it - 144 : it) * 32; const int sub = second ? 2 : 1;
          __syncthreads();
          for (int idx = tid; idx < 9 * 1024; idx += NTHR) sc[idx] = mod[(size_t)(idx >> 10) * NMOD + (3 * sub) * DM + (idx & 1023)];
          __syncthreads();
          const int cc = tid & 31, ks = tid >> 5, nd = n0 + cc; int nsrc; const float* Wp; int ldw;
          if (!second) { Wp = w_in; ldw = 4384; nsrc = nd < 2304 ? nd : (nd < 4352 ? nd + 32 : (nd < 4384 ? nd - 2048 : -1)); }
          else { Wp = w_up + (size_t)1024 * 5632; ldw = 5632; const int tile = nd >> 8, within = nd & 255; nsrc = within < 128 ? 128 * tile + within : DFF + 128 * tile + (within - 128); }
          float a[9];
#pragma unroll
          for (int j = 0; j < 9; ++j) a[j] = 0.f;
          if (nsrc >= 0) {
#pragma unroll 4
              for (int kk = 0; kk < 64; ++kk) { const int k = ks * 64 + kk; const float wv = Wp[(size_t)k * ldw + nsrc];
#pragma unroll
                  for (int j = 0; j < 9; ++j) a[j] += sc[j * 1024 + k] * wv; } }
#pragma unroll
          for (int j = 0; j < 9; ++j) red[(ks * 9 + j) * 32 + cc] = a[j];
          __syncthreads();
          if (tid < 288) { const int j = tid >> 5, c2 = tid & 31; float sum = 0.f;
#pragma unroll
              for (int k2 = 0; k2 < 16; ++k2) sum += red[(k2 * 9 + j) * 32 + c2];
              (second ? sW2 + (size_t)j * 5632 : sW1 + (size_t)j * PW)[n0 + c2] = sum; }
      }
      __syncthreads(); }
    GSYNC(); PE(1); PB(2);
    if (threadIdx.x == 0) { bool uni = (xbar.x < 8u) && ((G & 7) == 0);
        for (unsigned j = 0; j < 16; ++j) { const unsigned cnt_ = xb_ld(&barw[XB_XCNT(j)]); uni = uni && (cnt_ == (j < 8u ? (unsigned)(G >> 3) : 0u)); }
        xst[3] = uni ? (xst[2] * 8u + xbar.x) : (unsigned)bx; }
    __syncthreads();
    const int vb = (int)xst[3];
    { pg8::Gemm g{XN, Wup1, MR, 5632, 1024, 1024, 1024}; pg8::StaticOrder S; S.init(MR, 5632, G, vb);
      pg8::EpiSwiglu E{HID, DFF}; pg8::gemm_phase<pg8::EpiSwiglu, pg8::StaticOrder, true, true>(lds, g, S, E); }
    GSYNC(); PE(2); PB(3);
    { pg8::Gemm g{HID, Wdn1, MR, 1024, DFF, DFF, DFF}; pg8::StaticOrder S; S.init(MR, 1024, G, vb);
      pg8::EpiRes<1, 2, 1, 1> E{x, ctx, H, HC, mod, g_norm + 1 * DM, XN, ssq1}; pg8::gemm_phase<pg8::EpiRes<1, 2, 1, 1>, pg8::StaticOrder, true, true>(lds, g, S, E); }
    { PH_IDS;
      const int rem = (264 * 4) % G, ir = rem ? vb - rem : vb, ni = rem ? G - rem : G;
      if (ir >= 0) {
          LAS float* scr = (LAS float*)(lds + 65536) + wave * 2176;
          constexpr int I_UP = 16 * 176, I_DN = 44 * 32, I_IN = 16 * 137, I_BR = 8 * 32, I_OUT = 16 * 32;
          constexpr int NITEMS = I_UP + I_DN + I_IN + 2 * I_BR + I_OUT;
          for (int it = ir * NWAVES + wave; it < NITEMS; it += ni * NWAVES) {
              int r = it;
              if (r < I_UP) { const int kb = r / 176, nb = r % 176; transpose_item(w_up + (size_t)1024 * 5632, 1024, 5632, Wup2, 64 * kb, 32 * nb, up_dest(32 * nb), scr, lane); continue; } r -= I_UP;
              if (r < I_DN) { const int kb = r / 32, nb = r % 32; transpose_item(w_down + (size_t)DFF * 1024, DFF, 1024, Wdn2, 64 * kb, 32 * nb, 32 * nb, scr, lane); continue; } r -= I_DN;
              if (r < I_IN) { const int kb = r / 137, nb = r % 137; transpose_item(w_in, 1024, 4384, Win, 64 * kb, 32 * nb, win_dest(32 * nb), scr, lane); continue; } r -= I_IN;
              if (r < 2 * I_BR) { const int l = r / I_BR; r %= I_BR; const int kb = r / 32, nb = r % 32; transpose_item(w_branch + (size_t)l * 512 * 1024, 512, 1024, l ? Wbr1 : Wbr0, 64 * kb, 32 * nb, 32 * nb, scr, lane); continue; } r -= 2 * I_BR;
              { const int kb = r / 32, nb = r % 32; transpose_item(w_out, 1024, 1024, Wout, 64 * kb, 32 * nb, 32 * nb, scr, lane); }
          }
      } }
    GSYNC(); PE(3); PB(4);
#if MK_STAGE >= 2
    { pg8::Gemm g{XN, Win, MR, PW, 1024, 1024, 1024}; pg8::StaticOrder S; S.init(MR, PW, G, vb);
      pg8::EpiInproj E{PA, PW, ssq1, sW1, PW}; pg8::gemm_phase<pg8::EpiInproj, pg8::StaticOrder, true, true>(lds, g, S, E); }
    GSYNC(); PE(4); PB(5);
    { PH_IDS;
      const int l7 = lane & 7, l3 = lane & 3; const bool is_hi = (lane & 4) != 0;
      float frq[8], gq8[8], gk8[8];
#pragma unroll
      for (int k = 0; k < 8; ++k) { frq[k] = __builtin_amdgcn_exp2f(-(float)(8 * (l3 & 1) + k) * (13.287712379549449f / 16.f)); gq8[k] = g_q[8 * l7 + k] * attn_body::C2; gk8[k] = g_k[8 * l7 + k]; }
      for (int r0 = gw * 4; r0 < MR; r0 += NGW * 4) {
          const int t0 = r0 % TB; const bool isctx = t0 >= TL;
          v4u qv[4], kv[4];
#pragma unroll
          for (int u = 0; u < 4; ++u) { bf16* rp = PA + (size_t)(r0 + u) * PW; qv[u] = (v4u){0u, 0u, 0u, 0u}; if (!isctx) qv[u] = *(const v4u*)(rp + lane * 8); kv[u] = *(const v4u*)(rp + PC_K + (lane & 15) * 8); }
#pragma unroll
          for (int u = 0; u < 4; ++u) { bf16* rp = PA + (size_t)(r0 + u) * PW; const int t = t0 + u;
              const float pos = (l3 < 2) ? (float)(t >> 6) : (float)(t & 63);
              float cs8[8], sn8[8];
#pragma unroll
              for (int k = 0; k < 8; ++k) { const float ang = pos * frq[k]; cs8[k] = isctx ? 1.f : __cosf(ang); sn8[k] = isctx ? 0.f : __sinf(ang); }
#pragma unroll
              for (int part = 0; part < 2; ++part) { const v4u raw = part ? kv[u] : qv[u];
                  float xv[8]; xv[0] = pg8::bflo(raw.x); xv[1] = pg8::bfhi(raw.x); xv[2] = pg8::bflo(raw.y); xv[3] = pg8::bfhi(raw.y); xv[4] = pg8::bflo(raw.z); xv[5] = pg8::bfhi(raw.z); xv[6] = pg8::bflo(raw.w); xv[7] = pg8::bfhi(raw.w);
                  float ss = 0.f;
#pragma unroll
                  for (int k = 0; k < 8; ++k) ss += xv[k] * xv[k];
                  ss += __shfl_xor(ss, 1); ss += __shfl_xor(ss, 2); ss += __shfl_xor(ss, 4);
                  const float rstd = 1.f / sqrtf(ss * (1.f / 64.f) + EPS);
                  float o[8];
#pragma unroll
                  for (int k = 0; k < 8; ++k) { const float y = xv[k] * rstd * (part ? gk8[k] : gq8[k]); const float py = __shfl_xor(y, 4);
                      o[k] = is_hi ? (py * sn8[k] + y * cs8[k]) : (y * cs8[k] - py * sn8[k]); }
                  v4u w4; w4.x = pk2(o[0], o[1]); w4.y = pk2(o[2], o[3]); w4.z = pk2(o[4], o[5]); w4.w = pk2(o[6], o[7]);
                  if (part == 0) { if (!isctx) *(v4u*)(rp + lane * 8) = w4; } else { if (lane < 16) *(v4u*)(rp + PC_K + lane * 8) = w4; } } } } }
    gla_pass<1>(lds, PA, w_decay, b_decay, Ubuf, dn, OF, OB, vb, G, nullptr);
    GSYNC(); PE(5); PB(6);
    { PH_IDS; const int tg = bx * NTHR + tid;
      for (int q = tg; q < 64 * 2048; q += G * NTHR) { const int chain = q >> 11, e4 = q & 2047; const int d0 = (4 * e4) & 63;
          f32x4 S = {0.f, 0.f, 0.f, 0.f};
          for (int s0 = 0; s0 < GLA_S; s0 += 12) { v2u ur[12]; f32x4 dv[12];
#pragma unroll
              for (int j = 0; j < 12; ++j) { const size_t item = (size_t)chain * GLA_S + s0 + j; ur[j] = (v2u){0u, 0u}; dv[j] = (f32x4){0.f, 0.f, 0.f, 0.f};
                  if (s0 + j < GLA_S - 1) { ur[j] = *(const v2u*)(Ubuf + item * 8192 + 4 * e4); dv[j] = *(const f32x4*)(dn + item * 64 + d0); } }
#pragma unroll
              for (int j = 0; j < 12; ++j) { const size_t item = (size_t)chain * GLA_S + s0 + j;
                  v2u o; o.x = pk2(S[0], S[1]); o.y = pk2(S[2], S[3]); *(v2u*)(Ubuf + item * 8192 + 4 * e4) = o;
                  S[0] = dv[j][0] * S[0] + __uint_as_float(ur[j].x << 16); S[1] = dv[j][1] * S[1] + __uint_as_float(ur[j].x & 0xffff0000u);
                  S[2] = dv[j][2] * S[2] + __uint_as_float(ur[j].y << 16); S[3] = dv[j][3] * S[3] + __uint_as_float(ur[j].y & 0xffff0000u); } } } }
    GSYNC(); PE(6); PB(7);
    bool fastsm;
    { const int l_ = opaque_tid() & 63; float gqm = fabsf(g_q[l_]), gkm = fabsf(g_k[l_]);
#pragma unroll
      for (int o = 1; o < 64; o <<= 1) { gqm = fmaxf(gqm, __shfl_xor(gqm, o)); gkm = fmaxf(gkm, __shfl_xor(gkm, o)); }
      fastsm = __builtin_amdgcn_readfirstlane((2.f * 11.5416f * gqm * gkm + 14.f < 100.f) ? 1 : 0) != 0; }
    { const attn_body::bf16* Qp = (const attn_body::bf16*)(PA + PC_Q); const attn_body::bf16* Kp = (const attn_body::bf16*)(PA + PC_K); const attn_body::bf16* Vp = (const attn_body::bf16*)(PA + PC_V);
      if ((G & 7) == 0) { const int b = vb & 7, ci = vb >> 3, nper = G >> 3;
          for (int idx = ci; idx < 256; idx += nper) { const int h = idx >> 5, qb = idx & 31;
              if (fastsm) attn_body::attn_unit<8, true>(b, h, h >> 2, qb, Qp, Kp, Vp, (attn_body::bf16*)(PA + PC_Q), (char*)lds_raw);
              else attn_body::attn_unit<8, false>(b, h, h >> 2, qb, Qp, Kp, Vp, (attn_body::bf16*)(PA + PC_Q), (char*)lds_raw); } }
      else { for (int u = vb; u < 2048; u += G) { const int b = u >> 8, h = (u >> 5) & 7, qb = u & 31; attn_body::attn_unit<8, false>(b, h, h >> 2, qb, Qp, Kp, Vp, (attn_body::bf16*)(PA + PC_Q), (char*)lds_raw); } }
    }
    __syncthreads();
    PE(7); PB(21);
    gla_pass<3>(lds, PA, w_decay, b_decay, Ubuf, dn, OF, OB, vb, G, barw + XCD_BAR_WORDS + 64);
    GSYNC(); PE(21); PB(8);
    { PH_IDS;
      const int col = lane * 8, e0 = col & 127; float gg8[8];
#pragma unroll
      for (int k = 0; k < 8; ++k) gg8[k] = g_gla[e0 + k];
      for (int r0 = gw * 4; r0 < MR; r0 += NGW * 4) {
          if (r0 % TB >= TL) continue;
          v4u a[4], bq[4], gq[4];
#pragma unroll
          for (int u = 0; u < 4; ++u) { const size_t r = r0 + u; a[u] = *(const v4u*)(OF + r * 512 + col); bq[u] = *(const v4u*)(OB + r * 512 + col); gq[u] = *(const v4u*)(PA + r * PW + PC_G6 + col); }
#pragma unroll
          for (int u = 0; u < 4; ++u) { const size_t r = r0 + u; float o[8], gg[8];
              o[0] = pg8::bflo(a[u].x) + pg8::bflo(bq[u].x); o[1] = pg8::bfhi(a[u].x) + pg8::bfhi(bq[u].x); o[2] = pg8::bflo(a[u].y) + pg8::bflo(bq[u].y); o[3] = pg8::bfhi(a[u].y) + pg8::bfhi(bq[u].y);
              o[4] = pg8::bflo(a[u].z) + pg8::bflo(bq[u].z); o[5] = pg8::bfhi(a[u].z) + pg8::bfhi(bq[u].z); o[6] = pg8::bflo(a[u].w) + pg8::bflo(bq[u].w); o[7] = pg8::bfhi(a[u].w) + pg8::bfhi(bq[u].w);
              gg[0] = pg8::bflo(gq[u].x); gg[1] = pg8::bfhi(gq[u].x); gg[2] = pg8::bflo(gq[u].y); gg[3] = pg8::bfhi(gq[u].y); gg[4] = pg8::bflo(gq[u].z); gg[5] = pg8::bfhi(gq[u].z); gg[6] = pg8::bflo(gq[u].w); gg[7] = pg8::bfhi(gq[u].w);
              float ss = 0.f;
#pragma unroll
              for (int k = 0; k < 8; ++k) ss += o[k] * o[k];
#pragma unroll
              for (int of = 1; of < 16; of <<= 1) ss += __shfl_xor(ss, of);
              const float rstd = 1.f / sqrtf(ss * (1.f / 128.f) + EPS); float y[8];
#pragma unroll
              for (int k = 0; k < 8; ++k) y[k] = o[k] * rstd * gg8[k] * silu_f(gg[k]);
              v4u w4; w4.x = pk2(y[0], y[1]); w4.y = pk2(y[2], y[3]); w4.z = pk2(y[4], y[5]); w4.w = pk2(y[6], y[7]);
              *(v4u*)(OF + r * 512 + col) = w4; } } }
    GSYNC(); PE(8); PB(9);
    { pg8::Gemm g{PA + PC_Q, Wbr0, MR, 1024, 512, PW, 512}; pg8::StaticOrder S; S.init(NB * TL, 1024, G, vb, 1);
      pg8::EpiGate<0> E{PA, b_gate, Z}; pg8::gemm_phase<pg8::EpiGate<0>, pg8::StaticOrder, true, true>(lds, g, S, E); }
    __syncthreads();
    { pg8::Gemm g{OF, Wbr1, MR, 1024, 512, 512, 512}; pg8::StaticOrder S; S.init(NB * TL, 1024, G, vb, 1);
      pg8::EpiGate<1> E{PA, b_gate, Z}; pg8::gemm_phase<pg8::EpiGate<1>, pg8::StaticOrder, true, true>(lds, g, S, E); }
    GSYNC(); PE(9); PB(10);
    { pg8::Gemm g{Z, Wout, MR, 1024, 1024, 1024, 1024}; pg8::StaticOrder S; S.init(NB * TL, 1024, G, vb, 1);
      pg8::EpiRes<1, 5, 0, 2> E{H, HC, H, HC, mod, g_norm + 2 * DM, XN2, ssq2}; pg8::gemm_phase<pg8::EpiRes<1, 5, 0, 2>, pg8::StaticOrder, true, true>(lds, g, S, E); }
    GSYNC(); PE(10); PB(11);
#endif
#if MK_STAGE >= 3
    { pg8::Gemm g{XN2, Wup2, MR, 5632, 1024, 1024, 1024}; pg8::StaticOrder S; S.init(NB * TL, 5632, G, vb, 1);
      pg8::EpiSwigluN E{HID, DFF, ssq2, sW2, 5632}; pg8::gemm_phase<pg8::EpiSwigluN, pg8::StaticOrder, true, true>(lds, g, S, E); }
    GSYNC(); PE(11); PB(12);
    { pg8::Gemm g{HID, Wdn2, MR, 1024, DFF, DFF, DFF}; pg8::StaticOrder S; S.init(NB * TL, 1024, G, vb, 1);
      pg8::EpiRes<0, 8, 1, 0> E{H, HC, H, HC, mod, nullptr, nullptr, nullptr}; pg8::gemm_phase<pg8::EpiRes<0, 8, 1, 0>, pg8::StaticOrder, true, true>(lds, g, S, E); }
    GSYNC(); PE(12); PB(13);
#endif
    { PH_IDS; f32x4 gv[4];
#pragma unroll
      for (int j = 0; j < 4; ++j) gv[j] = *((const f32x4*)g_final + lane + 64 * j);
      for (int r0 = gw * 2; r0 < NB * TL; r0 += NGW * 2) { f32x4* p = (f32x4*)(H + (size_t)r0 * DM) + lane; f32x4 v[2][4]; float s[2] = {0.f, 0.f};
#pragma unroll
          for (int u = 0; u < 2; ++u)
#pragma unroll
              for (int j = 0; j < 4; ++j) v[u][j] = p[u * 256 + 64 * j];
#pragma unroll
          for (int u = 0; u < 2; ++u)
#pragma unroll
              for (int j = 0; j < 4; ++j) s[u] += (v[u][j].x * v[u][j].x + v[u][j].y * v[u][j].y) + (v[u][j].z * v[u][j].z + v[u][j].w * v[u][j].w);
#pragma unroll
          for (int u = 0; u < 2; ++u) { const float rstd = 1.f / sqrtf(wave_sum(s[u]) * (1.f / DM) + EPS);
#pragma unroll
              for (int j = 0; j < 4; ++j) p[u * 256 + 64 * j] = v[u][j] * rstd * gv[j]; } } }
    PE(13);
    if (PROBE_MASK != 0ull || PROBE_SYNC) { const unsigned long long te = __builtin_amdgcn_s_memrealtime() + (unsigned long long)PROBE_MULT * pacc; while (__builtin_amdgcn_s_memrealtime() < te) __builtin_amdgcn_s_sleep(32); }
}

extern "C" void kernel_launch(void* const* d_in, const int* in_sizes, int n_in, void* d_out, int out_size, void* d_ws, size_t ws_size, hipStream_t stream) {
    static int grid = 0;
    if (grid == 0) {
        int dev = 0, cus = 0, per_cu = 0;
        hipGetDevice(&dev); hipDeviceGetAttribute(&cus, hipDeviceAttributeMultiprocessorCount, dev);
        hipFuncSetAttribute((const void*)mk_fwd, hipFuncAttributeMaxDynamicSharedMemorySize, LDS_BYTES);
        hipOccupancyMaxActiveBlocksPerMultiprocessor(&per_cu, (const void*)mk_fwd, NTHR, LDS_BYTES);
        if (per_cu < 1) per_cu = 1;
        grid = cus * per_cu;
        if (n_in != 19 || ws_size < WS_END) { fprintf(stderr, "kernel_launch: unexpected n_in %d or ws_size %zu\n", n_in, ws_size); }
    }
    Args a{};
    for (int i = 0; i < 19; ++i) a.in[i] = (const float*)d_in[i];
    a.out = (float*)d_out; a.ws = (unsigned char*)d_ws;
    void* kargs[] = {&a};
    hipError_t e = hipLaunchCooperativeKernel((const void*)mk_fwd, dim3(grid), dim3(NTHR), kargs, LDS_BYTES, stream);
    if (e != hipSuccess) fprintf(stderr, "cooperative launch failed: %s (grid %d)\n", hipGetErrorString(e), grid);
}
```

```cpp
#include <hip/hip_runtime.h>
#include <cstdio>
#include <cstdint>
#ifndef MK_STAGE
#define MK_STAGE 3
#endif
#define PROBE_MASK 0ull
#define PROBE_SYNC 0
#define PROBE_MULT 4
__device__ __forceinline__ int opaque_tid() { int t; asm volatile("v_mov_b32 %0, %1" : "=v"(t) : "v"((int)threadIdx.x)); return t; }
namespace pg8 {
#define PG8_LAS __attribute__((address_space(3)))
typedef unsigned short bf16_t;
typedef short bf16x8 __attribute__((ext_vector_type(8)));
typedef float f32x4 __attribute__((ext_vector_type(4)));
typedef unsigned u32x4 __attribute__((ext_vector_type(4)));
constexpr int BM = 256, BK = 64, HALF = 128, HTB = HALF * BK * 2  , STAGE_BYTES = 8 * HTB, NXCD = 8, WGM = 4;

__host__ __device__ __forceinline__ int lds_byte(int r, int c) { const int st = (r >> 4) * 2 + (c >> 5), rr = r & 15, cc = c & 31, ob = rr * 64 + cc * 2; return st * 1024 + (ob ^ (((ob >> 9) & 1) << 5)); }
__host__ __device__ __forceinline__ void stage_rc(int b, int& R, int& C) { const int st = b / 1024, sb = b % 1024, swz = sb ^ (((sb >> 9) & 1) << 5); R = (st >> 1) * 16 + swz / 64; C = (st & 1) * 32 + (swz % 64) / 2; }
__host__ __device__ __forceinline__ int perm32(int rho) { const int n = rho >> 4, i = rho & 15; return 8 * (i >> 2) + 4 * n + (i & 3); }

struct Unit { int pm, pn; };
struct Gemm { const bf16_t* A; const bf16_t* Bt; int M, N, K, lda, ldb; };

struct StaticOrder {
    int nM, nN, nwg, G, c, skip;
    __host__ __device__ void init(int M, int N, int G_, int c_, int skip_ = 0) { nM = M / BM; nN = N / BM; nwg = nM * nN; G = G_; c = c_; skip = skip_; }
    __host__ __device__ bool next(int i, Unit& u) const {
        const long L = (long)i * G + c; if (L >= nwg) return false;
        int wgid = (int)L; { const int q = nwg / NXCD, r = nwg % NXCD, xcd = wgid % NXCD, off = wgid / NXCD; wgid = (xcd < r ? xcd * (q + 1) : r * (q + 1) + (xcd - r) * q) + off; }
        const int nig = WGM * nN, gid = wgid / nig, fm = gid * WGM, gsz = (nM - fm) < WGM ? (nM - fm) : WGM;
        u.pm = fm + ((wgid % nig) % gsz); u.pn = (wgid % nig) / gsz; if (skip) u.pm += u.pm / 32; return true;
    }
    __device__ __forceinline__ void a_ready(const Unit&) const {}
    __device__ __forceinline__ void done(const Unit&) const {}
};

__device__ __forceinline__ unsigned cvt_pk_bf16(float lo, float hi) { unsigned r; asm volatile("v_cvt_pk_bf16_f32 %0, %1, %2" : "=v"(r) : "v"(lo), "v"(hi)); return r; }
__device__ __forceinline__ float fsigmoid(float x) { return __builtin_amdgcn_rcpf(1.f + __builtin_amdgcn_exp2f(-1.4426950408889634f * x)); }
__device__ __forceinline__ float bflo(unsigned w) { return __uint_as_float(w << 16); }
__device__ __forceinline__ float bfhi(unsigned w) { return __uint_as_float(w & 0xffff0000u); }
constexpr int TPB = 33;
constexpr int PWID = 4608;

struct EpiPlain {
    static constexpr bool PERM = true, AFTER_DRAIN = false;
    bf16_t* O; int ldc;
    __device__ __forceinline__ void operator()(const f32x4 (&acc)[2][2][4][2], const Unit& u, int wr, int wc, int fr, int fq) const {
        const int row0 = u.pm * BM + wr * 64 + fr, col0 = u.pn * BM + wc * 32 + 8 * fq;
#pragma unroll
        for (int ai = 0; ai < 2; ++ai)
#pragma unroll
            for (int m = 0; m < 4; ++m) { bf16_t* rowp = O + (size_t)(row0 + ai * HALF + m * 16) * ldc + col0;
#pragma unroll
                for (int bj = 0; bj < 2; ++bj) { const f32x4 v0 = acc[ai][bj][m][0], v1 = acc[ai][bj][m][1];
                    u32x4 w; w.x = cvt_pk_bf16(v0[0], v0[1]); w.y = cvt_pk_bf16(v0[2], v0[3]); w.z = cvt_pk_bf16(v1[0], v1[1]); w.w = cvt_pk_bf16(v1[2], v1[3]);
                    *(u32x4*)(rowp + bj * HALF) = w; } }
    }
};
struct EpiSwiglu {
    static constexpr bool PERM = true, AFTER_DRAIN = false;
    bf16_t* O; int ldc;
    __device__ __forceinline__ void operator()(const f32x4 (&acc)[2][2][4][2], const Unit& u, int wr, int wc, int fr, int fq) const {
        const int row0 = u.pm * BM + wr * 64 + fr, col0 = u.pn * HALF + wc * 32 + 8 * fq;
#pragma unroll
        for (int ai = 0; ai < 2; ++ai)
#pragma unroll
            for (int m = 0; m < 4; ++m) { bf16_t* rowp = O + (size_t)(row0 + ai * HALF + m * 16) * ldc + col0;
                float h[8];
#pragma unroll
                for (int n = 0; n < 2; ++n)
#pragma unroll
                    for (int k = 0; k < 4; ++k) { const float a = acc[ai][0][m][n][k], b = acc[ai][1][m][n][k]; h[n * 4 + k] = a * fsigmoid(a) * b; }
                u32x4 w; w.x = cvt_pk_bf16(h[0], h[1]); w.y = cvt_pk_bf16(h[2], h[3]); w.z = cvt_pk_bf16(h[4], h[5]); w.w = cvt_pk_bf16(h[6], h[7]);
                *(u32x4*)rowp = w; }
    }
};
template <int XNOUT, int GIDX, int HALFCOEF, int NSUB> struct EpiRes {
    static constexpr bool PERM = true, AFTER_DRAIN = false;
    const float* src_lat; const float* src_ctx; float* dst_lat; float* dst_ctx; const float* mod; const float* gnorm; bf16_t* xn; float* ssq;
    static constexpr int gidx = GIDX, nsub = NSUB; static constexpr float coef = HALFCOEF ? 0.5f : 1.0f;
    __device__ __forceinline__ void operator()(const f32x4 (&acc)[2][2][4][2], const Unit& u, int wr, int wc, int fr, int fq) const {
        asm volatile("" : "+v"(fr));
        const int b = u.pm / TPB, j = u.pm % TPB; const bool isctx = (j == TPB - 1);
        const float* src = isctx ? src_ctx + (size_t)b * 256 * 1024 : src_lat + (size_t)(b * 8192 + j * 256) * 1024;
        float* dst = isctx ? dst_ctx + (size_t)b * 256 * 1024 : dst_lat + (size_t)(b * 8192 + j * 256) * 1024;
        const float* mrow = mod + (size_t)(isctx ? 8 : b) * 9216;
        const float* g = mrow + gidx * 1024;
        const int col0 = u.pn * BM + wc * 32 + 8 * fq;
        f32x4 gv[2][2], gs[2][2];
#pragma unroll
        for (int bj = 0; bj < 2; ++bj)
#pragma unroll
            for (int n = 0; n < 2; ++n) { gv[bj][n] = *(const f32x4*)(g + col0 + bj * HALF + 4 * n) * coef;
                if (XNOUT) gs[bj][n] = *(const f32x4*)(gnorm + col0 + bj * HALF + 4 * n) * (*(const f32x4*)(mrow + (3 * nsub + 1) * 1024 + col0 + bj * HALF + 4 * n) + 1.f); }
#pragma unroll
        for (int ai = 0; ai < 2; ++ai)
#pragma unroll
            for (int m = 0; m < 4; ++m) { const int rl = ai * HALF + wr * 64 + m * 16 + fr; const size_t off = (size_t)rl * 1024 + col0; float sq = 0.f;
#pragma unroll
                for (int bj = 0; bj < 2; ++bj) { f32x4 o[2];
#pragma unroll
                    for (int n = 0; n < 2; ++n) { const f32x4 sv = *(const f32x4*)(src + off + bj * HALF + 4 * n); o[n] = sv + gv[bj][n] * acc[ai][bj][m][n];
                        if (!(XNOUT && isctx)) *(f32x4*)(dst + off + bj * HALF + 4 * n) = o[n]; }
                    if (XNOUT) { sq += (o[0][0] * o[0][0] + o[0][1] * o[0][1]) + (o[0][2] * o[0][2] + o[0][3] * o[0][3]) + (o[1][0] * o[1][0] + o[1][1] * o[1][1]) + (o[1][2] * o[1][2] + o[1][3] * o[1][3]);
                        const f32x4 x0 = o[0] * gs[bj][0], x1 = o[1] * gs[bj][1];
                        u32x4 w; w.x = cvt_pk_bf16(x0[0], x0[1]); w.y = cvt_pk_bf16(x0[2], x0[3]); w.z = cvt_pk_bf16(x1[0], x1[1]); w.w = cvt_pk_bf16(x1[2], x1[3]);
                        *(u32x4*)(xn + (size_t)(u.pm * BM + rl) * 1024 + col0 + bj * HALF) = w; } }
                if (XNOUT) { sq += __shfl_xor(sq, 16); sq += __shfl_xor(sq, 32); if (fq == 0) atomicAdd(ssq + u.pm * BM + rl, sq); }
                if (m & 1) asm volatile("" ::: "memory"); }
    }
};
struct EpiInproj {
    static constexpr bool PERM = true, AFTER_DRAIN = false;
    bf16_t* O; int ldc; const float* ssq; const float* sw; int swld;
    __device__ __forceinline__ void operator()(const f32x4 (&acc)[2][2][4][2], const Unit& u, int wr, int wc, int fr, int fq) const {
        const int row0 = u.pm * BM + wr * 64 + fr, col0 = u.pn * BM + wc * 32 + 8 * fq;
        const float* swr = sw + (size_t)((u.pm % TPB == TPB - 1) ? 8 : u.pm / TPB) * swld + col0;
        f32x4 sv[2][2];
#pragma unroll
        for (int bj = 0; bj < 2; ++bj)
#pragma unroll
            for (int n = 0; n < 2; ++n) sv[bj][n] = *(const f32x4*)(swr + bj * HALF + 4 * n);
#pragma unroll
        for (int ai = 0; ai < 2; ++ai)
#pragma unroll
            for (int m = 0; m < 4; ++m) { const int row = row0 + ai * HALF + m * 16; bf16_t* rowp = O + (size_t)row * ldc + col0;
                const float rstd = 1.f / sqrtf(ssq[row] * (1.f / 1024.f) + 1e-6f);
#pragma unroll
                for (int bj = 0; bj < 2; ++bj) { const f32x4 v0 = acc[ai][bj][m][0] * rstd + sv[bj][0], v1 = acc[ai][bj][m][1] * rstd + sv[bj][1];
                    u32x4 w; w.x = cvt_pk_bf16(v0[0], v0[1]); w.y = cvt_pk_bf16(v0[2], v0[3]); w.z = cvt_pk_bf16(v1[0], v1[1]); w.w = cvt_pk_bf16(v1[2], v1[3]);
                    *(u32x4*)(rowp + bj * HALF) = w; } }
    }
};
struct EpiSwigluN {
    static constexpr bool PERM = true, AFTER_DRAIN = false;
    bf16_t* O; int ldc; const float* ssq; const float* sw; int swld;
    __device__ __forceinline__ void operator()(const f32x4 (&acc)[2][2][4][2], const Unit& u, int wr, int wc, int fr, int fq) const {
        const int row0 = u.pm * BM + wr * 64 + fr, col0 = u.pn * HALF + wc * 32 + 8 * fq;
        const float* swr = sw + (size_t)((u.pm % TPB == TPB - 1) ? 8 : u.pm / TPB) * swld + u.pn * BM + wc * 32 + 8 * fq;
        f32x4 sv[2][2];
#pragma unroll
        for (int bj = 0; bj < 2; ++bj)
#pragma unroll
            for (int n = 0; n < 2; ++n) sv[bj][n] = *(const f32x4*)(swr + bj * HALF + 4 * n);
#pragma unroll
        for (int ai = 0; ai < 2; ++ai)
#pragma unroll
            for (int m = 0; m < 4; ++m) { const int row = row0 + ai * HALF + m * 16; bf16_t* rowp = O + (size_t)row * ldc + col0;
                const float rstd = 1.f / sqrtf(ssq[row] * (1.f / 1024.f) + 1e-6f);
                float h[8];
#pragma unroll
                for (int n = 0; n < 2; ++n)
#pragma unroll
                    for (int k = 0; k < 4; ++k) { const float a = acc[ai][0][m][n][k] * rstd + sv[0][n][k], b = acc[ai][1][m][n][k] * rstd + sv[1][n][k]; h[n * 4 + k] = a * fsigmoid(a) * b; }
                u32x4 w; w.x = cvt_pk_bf16(h[0], h[1]); w.y = cvt_pk_bf16(h[2], h[3]); w.z = cvt_pk_bf16(h[4], h[5]); w.w = cvt_pk_bf16(h[6], h[7]);
                *(u32x4*)rowp = w; }
    }
};
template <int SECOND> struct EpiGate {
    static constexpr bool PERM = true, AFTER_DRAIN = false;
    const bf16_t* P; const float* bgate; bf16_t* Z;
    __device__ __forceinline__ void operator()(const f32x4 (&acc)[2][2][4][2], const Unit& u, int wr, int wc, int fr, int fq) const {
        const int row0 = u.pm * BM + wr * 64 + fr, col0 = u.pn * BM + wc * 32 + 8 * fq;
        f32x4 bg[2][2];
#pragma unroll
        for (int bj = 0; bj < 2; ++bj)
#pragma unroll
            for (int n = 0; n < 2; ++n) bg[bj][n] = *(const f32x4*)(bgate + 1024 * SECOND + col0 + bj * HALF + 4 * n);
#pragma unroll
        for (int ai = 0; ai < 2; ++ai)
#pragma unroll
            for (int m = 0; m < 4; ++m) { const size_t row = (size_t)(row0 + ai * HALF + m * 16);
#pragma unroll
                for (int bj = 0; bj < 2; ++bj) { const int c = col0 + bj * HALF;
                    const u32x4 gr = *(const u32x4*)(P + row * PWID + 2304 + 1024 * SECOND + c);
                    float v[8];
                    v[0] = fsigmoid(bflo(gr.x) + bg[bj][0][0]) * acc[ai][bj][m][0][0]; v[1] = fsigmoid(bfhi(gr.x) + bg[bj][0][1]) * acc[ai][bj][m][0][1];
                    v[2] = fsigmoid(bflo(gr.y) + bg[bj][0][2]) * acc[ai][bj][m][0][2]; v[3] = fsigmoid(bfhi(gr.y) + bg[bj][0][3]) * acc[ai][bj][m][0][3];
                    v[4] = fsigmoid(bflo(gr.z) + bg[bj][1][0]) * acc[ai][bj][m][1][0]; v[5] = fsigmoid(bfhi(gr.z) + bg[bj][1][1]) * acc[ai][bj][m][1][1];
                    v[6] = fsigmoid(bflo(gr.w) + bg[bj][1][2]) * acc[ai][bj][m][1][2]; v[7] = fsigmoid(bfhi(gr.w) + bg[bj][1][3]) * acc[ai][bj][m][1][3];
                    bf16_t* zp = Z + row * 1024 + c;
                    if (SECOND) { const u32x4 zr = *(const u32x4*)zp;
                        v[0] += bflo(zr.x); v[1] += bfhi(zr.x); v[2] += bflo(zr.y); v[3] += bfhi(zr.y); v[4] += bflo(zr.z); v[5] += bfhi(zr.z); v[6] += bflo(zr.w); v[7] += bfhi(zr.w); }
                    u32x4 w; w.x = cvt_pk_bf16(v[0], v[1]); w.y = cvt_pk_bf16(v[2], v[3]); w.z = cvt_pk_bf16(v[4], v[5]); w.w = cvt_pk_bf16(v[6], v[7]);
                    *(u32x4*)zp = w; } }
    }
};
template <class Epi, class Sched, bool ALIGN_EPI = false, bool SP2 = false>
__device__ __forceinline__ void gemm_phase(PG8_LAS unsigned char* lds, const Gemm g, const Sched& S, const Epi& E) {
    const int tid = opaque_tid(), wid = __builtin_amdgcn_readfirstlane(tid >> 6), lane = tid & 63, wr = wid >> 2, wc = wid & 3, fr = lane & 15, fq = lane >> 4;
    const int K = g.K, nt = K / BK;
    unsigned voffA[2], voffB[2];
#pragma unroll
    for (int i = 0; i < 2; ++i) { int R, C; stage_rc(tid * 16 + i * 8192, R, C); const int Rb = Epi::PERM ? ((R & ~31) + perm32(R & 31)) : R;
        voffA[i] = (unsigned)(R * g.lda + C) * 2u; voffB[i] = (unsigned)(Rb * g.ldb + C) * 2u; }
    const size_t kstep = (size_t)(BK * 2);
    const size_t hstepA = (size_t)HALF * g.lda * 2, hstepB = (size_t)HALF * g.ldb * 2;
    const size_t tstepA = 2 * hstepA, tstepB = 2 * hstepB;
    const unsigned ldsw = (unsigned)wid * 1024u;
    const int aoff = lds_byte(wr * 64 + fr, fq * 8), boff = lds_byte(wc * 32 + fr, fq * 8);
#define PG8_SA(b, h) (((b) * 2 + (h)) * HTB)
#define PG8_SB(b, h) ((4 + (b) * 2 + (h)) * HTB)
#define PG8_STAGE(bufoff, gbase, voff) do { _Pragma("unroll") for (int _i = 0; _i < 2; ++_i) \
        __builtin_amdgcn_global_load_lds((const unsigned*)((const char*)(gbase) + (voff)[_i]), (PG8_LAS unsigned*)(lds + (bufoff) + ldsw + _i * 8192), 16, 0, 0); } while (0)
#define PG8_LDA(dst, b, h) do { _Pragma("unroll") for (int m = 0; m < 4; ++m) _Pragma("unroll") for (int k = 0; k < 2; ++k) dst[m][k] = *(const PG8_LAS bf16x8*)(lds + PG8_SA(b, h) + aoff + m * 2048 + k * 1024); } while (0)
#define PG8_LDB(dst, b, h) do { _Pragma("unroll") for (int n = 0; n < 2; ++n) _Pragma("unroll") for (int k = 0; k < 2; ++k) dst[n][k] = *(const PG8_LAS bf16x8*)(lds + PG8_SB(b, h) + boff + n * 2048 + k * 1024); } while (0)
#define PG8_MMA(ai, bj, At, Bt) do { __builtin_amdgcn_s_setprio(1); _Pragma("unroll") for (int m = 0; m < 4; ++m) _Pragma("unroll") for (int n = 0; n < 2; ++n) _Pragma("unroll") for (int k = 0; k < 2; ++k) \
        acc[ai][bj][m][n] = __builtin_amdgcn_mfma_f32_16x16x32_bf16(Bt[n][k], At[m][k], acc[ai][bj][m][n], 0, 0, 0); __builtin_amdgcn_s_setprio(0); } while (0)
#define PG8_WAIT_V(n) asm volatile("s_waitcnt vmcnt(" #n ")" ::: "memory")
#define PG8_WAIT_L(n) asm volatile("s_waitcnt lgkmcnt(" #n ")" ::: "memory")
#define PG8_BAR __builtin_amdgcn_s_barrier()
#define PG8_SCHED __builtin_amdgcn_sched_barrier(0)
    Unit cur, nxt; int ui = 0;
    if (!S.next(0, cur)) return;
    f32x4 acc[2][2][4][2];
#pragma unroll
    for (int a = 0; a < 2; ++a)
#pragma unroll
        for (int b = 0; b < 2; ++b)
#pragma unroll
            for (int m = 0; m < 4; ++m)
#pragma unroll
                for (int n = 0; n < 2; ++n) acc[a][b][m][n] = (f32x4){0.f, 0.f, 0.f, 0.f};
    bf16x8 At[4][2], B0[2][2], B1[2][2];
    const char* cA = (const char*)g.A + (size_t)cur.pm * tstepA; const char* cB = (const char*)g.Bt + (size_t)cur.pn * tstepB;
    S.a_ready(cur);
    if constexpr (SP2) {
        PG8_STAGE(PG8_SB(0, 0), cB, voffB); PG8_STAGE(PG8_SB(0, 1), cB + hstepB, voffB); PG8_STAGE(PG8_SA(0, 0), cA, voffA); PG8_STAGE(PG8_SA(0, 1), cA + hstepA, voffA);
        if (wr == 1) PG8_BAR;
        PG8_WAIT_V(2); PG8_BAR;
        PG8_STAGE(PG8_SB(1, 0), cB + kstep, voffB); PG8_STAGE(PG8_SA(1, 0), cA + kstep, voffA); PG8_STAGE(PG8_SB(1, 1), cB + hstepB + kstep, voffB);
        PG8_WAIT_V(6); PG8_BAR;
    } else {
        PG8_STAGE(PG8_SB(0, 0), cB, voffB); PG8_STAGE(PG8_SA(0, 0), cA, voffA); PG8_STAGE(PG8_SB(0, 1), cB + hstepB, voffB); PG8_STAGE(PG8_SA(0, 1), cA + hstepA, voffA);
        if (wr == 1) PG8_BAR;
        PG8_WAIT_V(4); PG8_BAR;
        PG8_STAGE(PG8_SB(1, 0), cB + kstep, voffB); PG8_STAGE(PG8_SA(1, 0), cA + kstep, voffA); PG8_STAGE(PG8_SB(1, 1), cB + hstepB + kstep, voffB);
        PG8_WAIT_V(6); PG8_BAR;
    }
    for (;;) {
        const bool has_next = S.next(ui + 1, nxt);
        const char* nA = has_next ? (const char*)g.A + (size_t)nxt.pm * tstepA : cA; const char* nB = has_next ? (const char*)g.Bt + (size_t)nxt.pn * tstepB : cB;
        for (int t = 0; t < nt; t += 2) {
            const bool last = (t == nt - 2);
            const char* a1 = cA + (size_t)(t + 1) * kstep;
            const char* a2 = last ? nA : cA + (size_t)(t + 2) * kstep; const char* b2 = last ? nB : cB + (size_t)(t + 2) * kstep;
            const char* a3 = a2 + kstep; const char* b3 = b2 + kstep;
            if (last && has_next) S.a_ready(nxt);
            if constexpr (SP2) {
            PG8_LDB(B0, 0, 0); PG8_LDB(B1, 0, 1); PG8_SCHED; PG8_LDA(At, 0, 0); PG8_STAGE(PG8_SA(1, 1), a1 + hstepA, voffA);
            PG8_WAIT_V(8); PG8_WAIT_L(0); PG8_BAR; PG8_MMA(0, 0, At, B0); PG8_MMA(0, 1, At, B1); PG8_BAR; PG8_SCHED;
            PG8_LDA(At, 0, 1); PG8_STAGE(PG8_SB(0, 0), b2, voffB); PG8_STAGE(PG8_SB(0, 1), b2 + hstepB, voffB); PG8_STAGE(PG8_SA(0, 0), a2, voffA);
            PG8_WAIT_V(8); PG8_WAIT_L(0); PG8_BAR; PG8_MMA(1, 0, At, B0); PG8_MMA(1, 1, At, B1); PG8_BAR; PG8_SCHED;
            PG8_LDB(B0, 1, 0); PG8_LDB(B1, 1, 1); PG8_SCHED; PG8_LDA(At, 1, 0); PG8_STAGE(PG8_SA(0, 1), a2 + hstepA, voffA);
            PG8_WAIT_V(8); PG8_WAIT_L(0); PG8_BAR; PG8_MMA(0, 0, At, B0); PG8_MMA(0, 1, At, B1); PG8_BAR; PG8_SCHED;
            PG8_LDA(At, 1, 1); PG8_STAGE(PG8_SB(1, 0), b3, voffB); PG8_STAGE(PG8_SB(1, 1), b3 + hstepB, voffB); PG8_STAGE(PG8_SA(1, 0), a3, voffA);
            PG8_WAIT_V(8); PG8_WAIT_L(0); PG8_BAR; PG8_MMA(1, 0, At, B0); PG8_MMA(1, 1, At, B1); PG8_BAR; PG8_SCHED;
            } else {
            PG8_LDB(B0, 0, 0); PG8_SCHED; PG8_LDA(At, 0, 0); PG8_STAGE(PG8_SA(1, 1), a1 + hstepA, voffA);
            PG8_WAIT_L(8); PG8_BAR; PG8_WAIT_L(0); PG8_MMA(0, 0, At, B0); PG8_BAR; PG8_SCHED;
            PG8_LDB(B1, 0, 1); PG8_STAGE(PG8_SB(0, 0), b2, voffB);
            PG8_BAR; PG8_WAIT_L(0); PG8_MMA(0, 1, At, B1); PG8_BAR;
            PG8_LDA(At, 0, 1); PG8_STAGE(PG8_SA(0, 0), a2, voffA);
            PG8_BAR; PG8_WAIT_L(0); PG8_MMA(1, 0, At, B0); PG8_BAR; PG8_SCHED;
            PG8_STAGE(PG8_SB(0, 1), b2 + hstepB, voffB);
            PG8_WAIT_V(6); PG8_BAR; PG8_MMA(1, 1, At, B1); PG8_BAR;
            PG8_LDB(B0, 1, 0); PG8_SCHED; PG8_LDA(At, 1, 0); PG8_STAGE(PG8_SA(0, 1), a2 + hstepA, voffA);
            PG8_WAIT_L(8); PG8_BAR; PG8_WAIT_L(0); PG8_MMA(0, 0, At, B0); PG8_BAR; PG8_SCHED;
            PG8_LDB(B1, 1, 1); PG8_STAGE(PG8_SB(1, 0), b3, voffB);
            PG8_BAR; PG8_WAIT_L(0); PG8_MMA(0, 1, At, B1); PG8_BAR;
            PG8_LDA(At, 1, 1); PG8_STAGE(PG8_SA(1, 0), a3, voffA);
            PG8_BAR; PG8_WAIT_L(0); PG8_MMA(1, 0, At, B0); PG8_BAR; PG8_SCHED;
            PG8_STAGE(PG8_SB(1, 1), b3 + hstepB, voffB);
            PG8_WAIT_V(6); PG8_BAR; PG8_MMA(1, 1, At, B1); PG8_BAR;
            }
        }
        if constexpr (ALIGN_EPI) { if (wr == 0) PG8_BAR; }
        if constexpr (!Epi::AFTER_DRAIN) { E(acc, cur, wr, wc, fr, fq); S.done(cur); }
        if (!has_next) break;
#pragma unroll
        for (int a = 0; a < 2; ++a)
#pragma unroll
            for (int b = 0; b < 2; ++b)
#pragma unroll
                for (int m = 0; m < 4; ++m)
#pragma unroll
                    for (int n = 0; n < 2; ++n) acc[a][b][m][n] = (f32x4){0.f, 0.f, 0.f, 0.f};
        cur = nxt; cA = nA; cB = nB; ++ui;
        if constexpr (ALIGN_EPI) { if (wr == 1) PG8_BAR; }
    }
    PG8_WAIT_V(0);
    if constexpr (!ALIGN_EPI) { if (wr == 0) PG8_BAR; }
    PG8_BAR;
    if constexpr (Epi::AFTER_DRAIN) { E.fused(acc, cur, wr, wc, fr, fq, lds, wid, lane); S.done(cur); }
#undef PG8_SA
#undef PG8_SB
#undef PG8_STAGE
#undef PG8_LDA
#undef PG8_LDB
#undef PG8_MMA
#undef PG8_WAIT_V
#undef PG8_WAIT_L
#undef PG8_BAR
#undef PG8_SCHED
}
}
#include <hip/hip_bf16.h>
#include <cmath>
namespace attn_body {
using bf16=__hip_bfloat16;
using bf16x8=__attribute__((ext_vector_type(8)))short;
using s16x4=__attribute__((ext_vector_type(4)))short;
using f32x16=__attribute__((ext_vector_type(16)))float;
using u32x4=__attribute__((ext_vector_type(4)))unsigned;
constexpr int SEQ=8448,D=64,DM=4608,NTILES=132;
constexpr int NW=8,QBLK=32,QB=QBLK*NW,KVBLK=64;
constexpr int ATTN_PITCH=DM, ATTN_UNIT_ROWS=QB;
__device__ __forceinline__ int crow(int r,int hi){return (r&3)+8*(r>>2)+4*hi;}
#define SBAR() __builtin_amdgcn_sched_barrier(0)
__device__ __forceinline__ void cmask(f32x16&p0,f32x16&p1,int jb,int qrel,int hi){
  const float NEG=-INFINITY; int kb=64*jb+4*hi;
  #pragma unroll
  for(int r=0;r<16;++r){int kv=kb+(r&3)+8*(r>>2); if(kv>qrel)p0[r]=NEG; if(kv+32>qrel)p1[r]=NEG;}
}

constexpr int NSLOT=3, SLOTB=8192;
constexpr int LDS_K=0, LDS_V=NSLOT*SLOTB, LDS_WS=2*NSLOT*SLOTB, LDS_OST=LDS_WS+NW*64*4, LDS_BYTES=LDS_OST+NW*4096;
constexpr float C2=0.125f*1.4426950408889634f;
__device__ __forceinline__ void glds16(const void*gsrc,unsigned lds_dst){unsigned keep;
  asm volatile("s_mov_b32 %0, m0\n\ts_mov_b32 m0, %2\n\ts_nop 0\n\tglobal_load_lds_dwordx4 %1, off\n\ts_mov_b32 m0, %0":"=&s"(keep):"v"(gsrc),"s"(lds_dst):"memory");}
__device__ __forceinline__ float max3f(float a,float b,float c){float r;asm("v_max3_f32 %0, %1, %2, %3":"=v"(r):"v"(a),"v"(b),"v"(c));return r;}
__device__ __forceinline__ float max2f(float a,float b){float r;asm("v_max_f32_e32 %0, %1, %2":"=v"(r):"v"(a),"v"(b));return r;}
__device__ __forceinline__ float fadd_s(float a,float b){float r;asm("v_add_f32_e32 %0, %1, %2":"=v"(r):"v"(a),"v"(b));return r;}
__device__ __forceinline__ float fsub_s(float a,float b){float r;asm("v_sub_f32_e32 %0, %1, %2":"=v"(r):"v"(a),"v"(b));return r;}
typedef float f32x2_t __attribute__((ext_vector_type(2))); typedef __bf16 bf16x2_t __attribute__((ext_vector_type(2)));
__device__ __forceinline__ unsigned cvtpk_s(float lo,float hi){f32x2_t v={lo,hi};bf16x2_t b=__builtin_convertvector(v,bf16x2_t);return __builtin_bit_cast(unsigned,b);}
#define WAIT_BAR(N) asm volatile("s_waitcnt vmcnt(" #N ") lgkmcnt(0)\n\ts_barrier":::"memory")

__device__ __forceinline__ void qkt(f32x16&p0,f32x16&p1,const char*Kslot,const bf16x8*qr,const f32x16&negm,int r32,int hi){
  const char*kb=Kslot+hi*1024+r32*16;
  #pragma unroll
  for(int d0=0;d0<4;++d0){
    const bf16x8 b0=*reinterpret_cast<const bf16x8*>(kb+d0*2048);
    const bf16x8 b1=*reinterpret_cast<const bf16x8*>(kb+d0*2048+512);
    if(d0==0){p0=__builtin_amdgcn_mfma_f32_32x32x16_bf16(b0,qr[0],negm,0,0,0);p1=__builtin_amdgcn_mfma_f32_32x32x16_bf16(b1,qr[0],negm,0,0,0);}
    else{p0=__builtin_amdgcn_mfma_f32_32x32x16_bf16(b0,qr[d0],p0,0,0,0);p1=__builtin_amdgcn_mfma_f32_32x32x16_bf16(b1,qr[d0],p1,0,0,0);}}
}
typedef __attribute__((address_space(3))) const char* lds_cptr;
typedef short v4i16_t __attribute__((ext_vector_type(4)));
__device__ __forceinline__ void kload8(bf16x8*kf,lds_cptr kp){
  kf[0]=*(const __attribute__((address_space(3))) bf16x8*)(kp);      kf[1]=*(const __attribute__((address_space(3))) bf16x8*)(kp+512);
  kf[2]=*(const __attribute__((address_space(3))) bf16x8*)(kp+2048); kf[3]=*(const __attribute__((address_space(3))) bf16x8*)(kp+2560);
  kf[4]=*(const __attribute__((address_space(3))) bf16x8*)(kp+4096); kf[5]=*(const __attribute__((address_space(3))) bf16x8*)(kp+4608);
  kf[6]=*(const __attribute__((address_space(3))) bf16x8*)(kp+6144); kf[7]=*(const __attribute__((address_space(3))) bf16x8*)(kp+6656);
}
__device__ __forceinline__ void kload2(bf16x8*kf,lds_cptr kp,int j){ kf[2*j]=*(const __attribute__((address_space(3))) bf16x8*)(kp+j*2048); kf[2*j+1]=*(const __attribute__((address_space(3))) bf16x8*)(kp+j*2048+512); }
__device__ __forceinline__ s16x4 vtr(lds_cptr p){ return __builtin_bit_cast(s16x4,__builtin_amdgcn_ds_read_tr16_b64_v4i16((__attribute__((address_space(3))) v4i16_t*)p)); }
__device__ __forceinline__ float rowmax(const f32x16&p0,const f32x16&p1){
  float a=max3f(p0[0],p0[1],p1[0]),b=max3f(p0[2],p0[3],p1[1]);a=max3f(a,p1[2],p1[3]);
  #pragma unroll
  for(int r=4;r<16;r+=4){a=max3f(a,p0[r],p0[r+1]);b=max3f(b,p0[r+2],p0[r+3]);a=max3f(a,p1[r],p1[r+1]);b=max3f(b,p1[r+2],p1[r+3]);}
  const float m=max2f(a,b);
  auto rr=__builtin_amdgcn_permlane32_swap(__float_as_uint(m),__float_as_uint(m),false,false);
  return max2f(__uint_as_float(rr[0]),__uint_as_float(rr[1]));
}
__device__ __forceinline__ void pv(f32x16*o,int vb,bf16x8 pa0,bf16x8 pa1,bf16x8 pa2,bf16x8 pa3){
  #pragma unroll
  for(int d0=0;d0<2;++d0){s16x4 lo[4],hi[4];
    #pragma unroll
    for(int ks=0;ks<4;++ks){
      asm volatile("ds_read_b64_tr_b16 %0,%1 offset:%c2":"=&v"(lo[ks]):"v"(vb),"i"(d0*4096+ks*1024):"memory");
      asm volatile("ds_read_b64_tr_b16 %0,%1 offset:%c2":"=&v"(hi[ks]):"v"(vb),"i"(d0*4096+ks*1024+512):"memory");}
    asm volatile("s_waitcnt lgkmcnt(0)":::"memory");SBAR();
    #define PK(k) (bf16x8){lo[k][0],lo[k][1],lo[k][2],lo[k][3],hi[k][0],hi[k][1],hi[k][2],hi[k][3]}
    o[d0]=__builtin_amdgcn_mfma_f32_32x32x16_bf16(pa0,PK(0),o[d0],0,0,0);
    o[d0]=__builtin_amdgcn_mfma_f32_32x32x16_bf16(pa1,PK(1),o[d0],0,0,0);
    o[d0]=__builtin_amdgcn_mfma_f32_32x32x16_bf16(pa2,PK(2),o[d0],0,0,0);
    o[d0]=__builtin_amdgcn_mfma_f32_32x32x16_bf16(pa3,PK(3),o[d0],0,0,0);
    #undef PK
  }
}

#ifndef ATTN_STORE16
#define ATTN_STORE16(p,v) (*(u32x4*)(p)=(v))
#endif
template<int THRL,bool NOMAX> __device__ __forceinline__ void attn_unit(int b,int h,int hk,int qb,const bf16*Q,const bf16*__restrict__ K,const bf16*__restrict__ V,bf16*O,char*shm){
  const int tid=opaque_tid(),lane=tid&63,r32=lane&31,hi=lane>>5; const int wid=__builtin_amdgcn_readfirstlane(tid>>6);
  const long rowbase=(long)b*SEQ; const int q0=qb*QB;
  const bf16*Qw=Q+(rowbase+q0+wid*QBLK)*DM+h*D;
  const bf16*Kh=K+rowbase*DM+hk*D,*Vh=V+rowbase*DM+hk*D;
  const unsigned lds0=(unsigned)(uintptr_t)shm;
  float*wsf=(float*)(shm+LDS_WS)+wid*64;
  const bf16*ksrc=Kh+(long)lane*DM+wid*8;
  const bf16*vsrc=Vh+(long)(16*(wid&3)+(lane>>2))*DM+(wid>>2)*32+(lane&3)*8;
  const unsigned kdst=lds0+LDS_K+wid*1024, vdst=lds0+LDS_V+wid*1024;
  #define DMA_K(t,slot) glds16(ksrc+(long)(t)*KVBLK*DM,(unsigned)__builtin_amdgcn_readfirstlane(kdst+(slot)))
  #define DMA_V(t,slot) glds16(vsrc+(long)(t)*KVBLK*DM,(unsigned)__builtin_amdgcn_readfirstlane(vdst+(slot)))
  const int vb0=(int)(lds0+LDS_V)+((lane>>4)&1)*32+(lane&3)*8+(4*hi+((lane&15)>>2))*64;
  const char*Kbase=shm+LDS_K; bf16x8 kf[8];
  const lds_cptr shm3=(lds_cptr)shm; const lds_cptr kp0=shm3+LDS_K+hi*1024+r32*16; const lds_cptr vp0=shm3+LDS_V+((lane>>4)&1)*32+(lane&3)*8+(4*hi+((lane&15)>>2))*64;
  constexpr int NT=NTILES;
  DMA_K(0,0);DMA_V(0,0);DMA_K(1,SLOTB);
  bf16x8 qr[4];
  #pragma unroll
  for(int d0=0;d0<4;++d0)qr[d0]=*reinterpret_cast<const bf16x8*>(&Qw[(long)r32*DM+d0*16+hi*8]);
  float mhat=0.f,l_reg=0.f;f32x16 o[2];o[0]=f32x16{};o[1]=f32x16{};f32x16 negm=f32x16{};asm volatile("":"+v"(negm));
  #define CMASK(P0,P1,t) do{}while(0)
  bool resc=false;
  #define START(P0,P1) do{ const float rm=rowmax(P0,P1); resc=false; \
    { const float dl=rm; mhat=fadd_s(mhat,dl); \
      _Pragma("unroll") for(int r=0;r<16;++r){P0[r]=fsub_s(P0[r],dl);P1[r]=fsub_s(P1[r],dl);} \
      _Pragma("unroll") for(int r=0;r<16;++r)negm[r]=-mhat; asm volatile("":"+v"(negm)); } \
    _Pragma("unroll") for(int r=0;r<16;++r)P0[r]=__builtin_amdgcn_exp2f(P0[r]); }while(0)
  #define RESC() do{ if(resc){ asm volatile("s_waitcnt lgkmcnt(0)":::"memory"); \
      _Pragma("unroll") for(int d_=0;d_<2;++d_) _Pragma("unroll") for(int r=0;r<16;++r)o[d_][r]*=wsf[crow(r,hi)]; } }while(0)
  f32x16 pA0,pA1,pB0,pB1;
  int sl_prev=0,sl_cur=0,sl_next=SLOTB;
  #define ROT() do{sl_prev=sl_cur;sl_cur=sl_next;sl_next=(sl_next==(NSLOT-1)*SLOTB)?0:sl_next+SLOTB;}while(0)
  DMA_K(2,2*SLOTB);
  WAIT_BAR(3);
  qkt(pA0,pA1,Kbase,qr,negm,r32,hi);asm volatile("s_nop 15\n\ts_nop 7":"+v"(pA0),"+v"(pA1));CMASK(pA0,pA1,0);
  START(pA0,pA1);
  _Pragma("unroll") for(int r=0;r<16;++r)pA1[r]=__builtin_amdgcn_exp2f(pA1[r]);
  WAIT_BAR(0);
  DMA_K(3,0);DMA_V(1,SLOTB);
  ROT();
  kload8(kf,kp0+sl_cur);
  WAIT_BAR(2);
  s16x4 vlo[8],vhi[8]; u32x4 pw0,pw1,pw2,pw3;
  #define PKW(P,B) cvtpk_s(P[B],P[B+1])
  #define PAF(k) __builtin_bit_cast(bf16x8,pw##k)
  #define VFR(i) (bf16x8){vlo[i][0],vlo[i][1],vlo[i][2],vlo[i][3],vhi[i][0],vhi[i][1],vhi[i][2],vhi[i][3]}
  #define PIN(x) asm volatile("":"+v"(x))
  #define MX3(a,b,c) __builtin_fmaxf(__builtin_fmaxf((a),(b)),(c))
  #define GAPA(MF,A0,A1,A2,A3,W0,W1,PW) do{ MF; sacc+=A0; sacc+=A1; sacc+=A2; sacc+=A3; PIN(sacc); W0; W1; PIN(PW); SBAR(); }while(0)
  #define EX(v) __builtin_amdgcn_exp2f(v)
  #define GAPB(MF,X,B) do{ MF; X[B]=EX(X[B]); X[B+1]=EX(X[B+1]); X[B+2]=EX(X[B+2]); X[B+3]=EX(X[B+3]); PIN(X); SBAR(); }while(0)
  #define VRD(i) do{ vlo[i]=vtr(vp_+(((i)>>2)*4096+((i)&3)*1024)); vhi[i]=vtr(vp_+(((i)>>2)*4096+((i)&3)*1024+512)); }while(0)
  #define KRD(G,j) do{ if(G){ kload2(kf,kp0+sl_next,j); SBAR(); } }while(0)
  #define STEP(C0,C1,P0,P1,t,GK,GV,GL) do{ SBAR(); \
    const lds_cptr vp_=vp0+sl_prev; \
    VRD(0); SBAR(); float sacc=(P0[0]+P0[1]); \
    GAPA(C0=__builtin_amdgcn_mfma_f32_32x32x16_bf16(kf[0],qr[0],negm,0,0,0), P0[2],P0[3],P0[4],P0[5],     pw0[0]=PKW(P0,0), pw0[1]=PKW(P0,2), pw0); \
    VRD(4); SBAR(); GAPA(C1=__builtin_amdgcn_mfma_f32_32x32x16_bf16(kf[1],qr[0],negm,0,0,0), P0[6],P0[7],P0[8],P0[9],     pw0[2]=PKW(P0,4), pw0[3]=PKW(P0,6), pw0); \
    VRD(1); SBAR(); GAPA(C0=__builtin_amdgcn_mfma_f32_32x32x16_bf16(kf[2],qr[1],C0,0,0,0),   P0[10],P0[11],P0[12],P0[13], pw1[0]=PKW(P0,8), pw1[1]=PKW(P0,10), pw1); \
    VRD(5); SBAR(); GAPA(C1=__builtin_amdgcn_mfma_f32_32x32x16_bf16(kf[3],qr[1],C1,0,0,0),   P0[14],P0[15],P1[0],P1[1],   pw1[2]=PKW(P0,12),pw1[3]=PKW(P0,14), pw1); \
    VRD(2); SBAR(); GAPA(C0=__builtin_amdgcn_mfma_f32_32x32x16_bf16(kf[4],qr[2],C0,0,0,0),   P1[2],P1[3],P1[4],P1[5],     pw2[0]=PKW(P1,0), pw2[1]=PKW(P1,2), pw2); \
    VRD(6); SBAR(); GAPA(C1=__builtin_amdgcn_mfma_f32_32x32x16_bf16(kf[5],qr[2],C1,0,0,0),   P1[6],P1[7],P1[8],P1[9],     pw2[2]=PKW(P1,4), pw2[3]=PKW(P1,6), pw2); \
    VRD(3); SBAR(); GAPA(C0=__builtin_amdgcn_mfma_f32_32x32x16_bf16(kf[6],qr[3],C0,0,0,0),   P1[10],P1[11],P1[12],P1[13], pw3[0]=PKW(P1,8), pw3[1]=PKW(P1,10), pw3); \
    VRD(7); SBAR(); GAPA(C1=__builtin_amdgcn_mfma_f32_32x32x16_bf16(kf[7],qr[3],C1,0,0,0),   P1[14],P1[15],0.f,0.f,       pw3[2]=PKW(P1,12),pw3[3]=PKW(P1,14), pw3); \
    l_reg+=sacc; \
    if(GK){DMA_K((t)+3,sl_cur);} if(GV){DMA_V((t)+1,sl_next);} \
    CMASK(C0,C1,t); \
    if constexpr(!NOMAX){ float a=MX3(C0[0],C0[1],C1[0]),b=MX3(C0[2],C0[3],C1[1]); a=MX3(a,C1[2],C1[3]); \
      _Pragma("unroll") for(int r=4;r<16;r+=4){a=MX3(a,C0[r],C0[r+1]);b=MX3(b,C0[r+2],C0[r+3]);a=MX3(a,C1[r],C1[r+1]);b=MX3(b,C1[r+2],C1[r+3]);} \
      float rm=__builtin_fmaxf(a,b); { auto rr=__builtin_amdgcn_permlane32_swap(__float_as_uint(rm),__float_as_uint(rm),false,false); rm=__builtin_fmaxf(__uint_as_float(rr[0]),__uint_as_float(rr[1])); } \
      resc=false; \
      if(__builtin_expect(__any(rm>(float)THRL),0)){ const float dl=__builtin_fmaxf(rm,0.f); mhat+=dl; \
        _Pragma("unroll") for(int r=0;r<16;++r){C0[r]-=dl;C1[r]-=dl;} \
        _Pragma("unroll") for(int r=0;r<16;++r)negm[r]=-mhat; asm volatile("":"+v"(negm)); \
        const float f=__builtin_amdgcn_exp2f(-dl); l_reg*=f; if(hi==0)wsf[r32]=f; resc=true; } } \
    SBAR(); \
    GAPB(o[0]=__builtin_amdgcn_mfma_f32_32x32x16_bf16(PAF(0),VFR(0),o[0],0,0,0), C0,0); \
    GAPB(o[1]=__builtin_amdgcn_mfma_f32_32x32x16_bf16(PAF(0),VFR(4),o[1],0,0,0), C0,4); \
    KRD(GL,0); GAPB(o[0]=__builtin_amdgcn_mfma_f32_32x32x16_bf16(PAF(1),VFR(1),o[0],0,0,0), C0,8); \
    KRD(GL,1); GAPB(o[1]=__builtin_amdgcn_mfma_f32_32x32x16_bf16(PAF(1),VFR(5),o[1],0,0,0), C0,12); \
    KRD(GL,2); GAPB(o[0]=__builtin_amdgcn_mfma_f32_32x32x16_bf16(PAF(2),VFR(2),o[0],0,0,0), C1,0); \
    KRD(GL,3); GAPB(o[1]=__builtin_amdgcn_mfma_f32_32x32x16_bf16(PAF(2),VFR(6),o[1],0,0,0), C1,4); \
    GAPB(o[0]=__builtin_amdgcn_mfma_f32_32x32x16_bf16(PAF(3),VFR(3),o[0],0,0,0), C1,8); \
    GAPB(o[1]=__builtin_amdgcn_mfma_f32_32x32x16_bf16(PAF(3),VFR(7),o[1],0,0,0), C1,12); \
    }while(0)
  int t=1;
  #undef CMASK
  #define CMASK(P0,P1,t) do{}while(0)
  for(;t+5<NT;t+=2){
    STEP(pB0,pB1,pA0,pA1,t,true,true,true);     WAIT_BAR(2); RESC(); ROT();
    STEP(pA0,pA1,pB0,pB1,t+1,true,true,true);   WAIT_BAR(2); RESC(); ROT();
  }
  #undef CMASK
  #define CMASK(P0,P1,t) do{}while(0)
  #define ENDW(tt) do{ if((tt)+3<NT){WAIT_BAR(2);} else if((tt)+2<NT){WAIT_BAR(1);} else {WAIT_BAR(0);} }while(0)
  for(;t+1<NT;t+=2){
    STEP(pB0,pB1,pA0,pA1,t,(t+3<NT),(t+1<NT),(t+1<NT));       ENDW(t);   RESC(); ROT();
    STEP(pA0,pA1,pB0,pB1,t+1,(t+4<NT),(t+2<NT),(t+2<NT));     ENDW(t+1); RESC(); ROT();
  }
  STEP(pB0,pB1,pA0,pA1,NT-1,false,false,false); RESC();
  { float sacc=pB0[0]+pB0[1]; _Pragma("unroll") for(int r=2;r<16;++r)sacc+=pB0[r]; _Pragma("unroll") for(int r=0;r<16;++r)sacc+=pB1[r]; l_reg+=sacc;
    pw0=(u32x4){PKW(pB0,0),PKW(pB0,2),PKW(pB0,4),PKW(pB0,6)};pw1=(u32x4){PKW(pB0,8),PKW(pB0,10),PKW(pB0,12),PKW(pB0,14)};pw2=(u32x4){PKW(pB1,0),PKW(pB1,2),PKW(pB1,4),PKW(pB1,6)};pw3=(u32x4){PKW(pB1,8),PKW(pB1,10),PKW(pB1,12),PKW(pB1,14)};
    SBAR(); pv(o,vb0+sl_cur,PAF(0),PAF(1),PAF(2),PAF(3)); }
  #undef PKW
  #undef PAF
  #undef VFR
  #undef PIN
  #undef MX3
  #undef GAPA
  #undef GAPB
  #undef EX
  #undef VRD
  #undef KRD
  #undef STEP
  #undef ENDW
  {auto rr=__builtin_amdgcn_permlane32_swap(__float_as_uint(l_reg),__float_as_uint(l_reg),false,false);l_reg=__uint_as_float(rr[0])+__uint_as_float(rr[1]);}
  if(hi==0)wsf[32+r32]=l_reg;asm volatile("s_waitcnt lgkmcnt(0)":::"memory");
  float rli[16];
  #pragma unroll
  for(int r=0;r<16;++r)rli[r]=__builtin_amdgcn_rcpf(wsf[32+crow(r,hi)]);
  bf16*Ow=O+(rowbase+q0+wid*QBLK)*DM+h*D;
  { bf16*stg=(bf16*)(shm+LDS_OST)+wid*2048;
    #pragma unroll
    for(int r=0;r<16;++r){const int orow=crow(r,hi);
      #pragma unroll
      for(int d0=0;d0<2;++d0)stg[orow*64+d0*32+r32]=__float2bfloat16(o[d0][r]*rli[r]);}
    asm volatile("s_waitcnt lgkmcnt(0)":::"memory");
    #pragma unroll
    for(int i=0;i<4;++i){const int row=i*8+(lane>>3),ch=lane&7; const u32x4 v=*(const u32x4*)(stg+row*64+ch*8); ATTN_STORE16(Ow+(long)row*DM+ch*8,v);} }
  asm volatile("s_waitcnt lgkmcnt(0)\n\ts_barrier":::"memory");
  #undef DMA_K
  #undef DMA_V
  #undef CMASK
  #undef START
  #undef RESC
  #undef ROT
}
constexpr int ATTN_LDS_BYTES=LDS_BYTES;
#undef SBAR
#undef WAIT_BAR
}
#include <hip/hip_cooperative_groups.h>
namespace cg = cooperative_groups;
#define LAS __attribute__((address_space(3)))
typedef unsigned short bf16;
typedef unsigned v4u __attribute__((ext_vector_type(4)));
typedef unsigned v2u __attribute__((ext_vector_type(2)));
typedef float f32x4 __attribute__((ext_vector_type(4)));
typedef short bf16x8 __attribute__((ext_vector_type(8)));

#define XB_TMO      128
#define XB_XCNT(j)  (256  + 64 * (j))
#define XB_XSUB(j)  (1280 + 64 * (j))
#define XB_XGEN(j)  (2304 + 64 * (j))
#define XB_TOP      3328
#define XB_TOPGEN   3392
#define XCD_BAR_WORDS 3456
#define XB_SPIN_CAP (1u << 18)

__device__ __forceinline__ unsigned xb_ld(unsigned* p)              { return __hip_atomic_load(p, __ATOMIC_RELAXED, __HIP_MEMORY_SCOPE_AGENT); }
__device__ __forceinline__ unsigned xb_add(unsigned* p, unsigned v) { return __hip_atomic_fetch_add(p, v, __ATOMIC_RELAXED, __HIP_MEMORY_SCOPE_AGENT); }
__device__ __forceinline__ unsigned xb_xcc_id() { return (unsigned)__builtin_amdgcn_s_getreg((3 << 11) | 20) & 0xFu; }
#define XB_SPIN(cond, bar) do { unsigned _sp = 0; while (cond) { __builtin_amdgcn_s_sleep(1); \
    if ((++_sp & 255u) == 0u) { if (xb_ld(&(bar)[XB_TMO])) break; if (_sp > XB_SPIN_CAP) { atomicAdd(&(bar)[XB_TMO], 1u); break; } } } } while (0)

struct XcdBarrier {
    unsigned* bar; unsigned x;
    volatile LAS unsigned* st;
};

__device__ __forceinline__ XcdBarrier xcd_barrier_post(unsigned* bar, volatile LAS unsigned* st) {
    XcdBarrier b; b.bar = bar; b.x = xb_xcc_id(); b.st = st;
    if (threadIdx.x == 0) (void)xb_add(&bar[XB_XCNT(b.x)], 1u);
    return b;
}
__device__ __forceinline__ void xcd_barrier_complete(unsigned* bar, unsigned x, unsigned& nloc, unsigned& nx) {
    const unsigned G = gridDim.x * gridDim.y * gridDim.z;
    unsigned sum, cnt, mine, sp = 0u;
    for (;;) {
        sum = 0u; cnt = 0u; mine = 0u;
#pragma unroll
        for (unsigned j = 0; j < 16; ++j) { const unsigned c = xb_ld(&bar[XB_XCNT(j)]); sum += c; cnt += (c > 0u) ? 1u : 0u; mine = (j == x) ? c : mine; }
        if (sum == G) break;
        __builtin_amdgcn_s_sleep(1);
        if ((++sp & 255u) == 0u) { if (xb_ld(&bar[XB_TMO])) break; if (sp > XB_SPIN_CAP) { atomicAdd(&bar[XB_TMO], 1u); break; } }
    }
    nloc = mine > 0u ? mine : 1u; nx = cnt > 0u ? cnt : 1u;
}

__device__ __forceinline__ void xcd_barrier(const XcdBarrier& b) {
    asm volatile("s_waitcnt vmcnt(0)" ::: "memory");
    __syncthreads();
    if (threadIdx.x == 0) {
        unsigned* bar = b.bar;
        __builtin_amdgcn_s_waitcnt(0);
        unsigned nloc = b.st[0], nx = b.st[1];
        if (nloc == 0u) { xcd_barrier_complete(bar, b.x, nloc, nx); b.st[0] = nloc; b.st[1] = nx; }
        const unsigned old = xb_add(&bar[XB_XSUB(b.x)], 1u);
        const unsigned gen = old / nloc;
        if (old + 1u == (gen + 1u) * nloc) {
            __builtin_amdgcn_fence(__ATOMIC_RELEASE, "agent");
            asm volatile("s_waitcnt vmcnt(0)" ::: "memory");
            const unsigned og = xb_add(&bar[XB_TOP], 1u);
            const unsigned tg = og / nx;
            if (og + 1u == (tg + 1u) * nx) xb_add(&bar[XB_TOPGEN], 1u);
            else XB_SPIN(xb_ld(&bar[XB_TOPGEN]) == tg, bar);
            __builtin_amdgcn_fence(__ATOMIC_ACQUIRE, "agent");
            xb_add(&bar[XB_XGEN(b.x)], 1u);
            asm volatile("s_waitcnt vmcnt(0)" ::: "memory");
        } else {
            XB_SPIN(xb_ld(&bar[XB_XGEN(b.x)]) == gen, bar);
            __builtin_amdgcn_fence(__ATOMIC_ACQUIRE, "agent");
            asm volatile("s_waitcnt vmcnt(0)" ::: "memory");
        }
    }
    __syncthreads();
}

constexpr int NB = 8, TL = 8192, TC = 256, TB = TL + TC  , MR = NB * TB  , DM = 1024, DFF = 2816, PW = 4608, NMOD = 9216;
constexpr float EPS = 1e-6f;
constexpr int LDS_BYTES = 147456, NTHR = 512, NWAVES = 8;
constexpr int PC_Q = 0, PC_K = 512, PC_V = 640, PC_GQ = 768, PC_GK = 1024, PC_GV = 1280, PC_G6 = 1792, PC_GATE = 2304, PC_LOW = 4352;
constexpr int GLA_S = 132, GLA_ITEMS = 64 * GLA_S;
constexpr size_t MiB = 1u << 20;
constexpr size_t WS_SSQ1 = 5 * MiB, WS_SSQ2 = 5 * MiB + 512 * 1024, WS_SW1 = 6 * MiB, WS_SW2 = 6 * MiB + 512 * 1024;
constexpr size_t WS_MOD = 1 * MiB, WS_DN = 2 * MiB, WS_WUP1 = 8 * MiB, WS_WUP2 = 20 * MiB, WS_WDN1 = 32 * MiB, WS_WDN2 = 38 * MiB, WS_WIN = 44 * MiB, WS_WBR0 = 54 * MiB, WS_WBR1 = 55 * MiB, WS_WOUT = 56 * MiB,
                 WS_HCTX = 64 * MiB, WS_XN = 72 * MiB, WS_OF = 204 * MiB, WS_OB = 270 * MiB, WS_A = 336 * MiB, WS_END = 932 * MiB;
static_assert(WS_XN + (size_t)MR * DM * 2 <= WS_OF && WS_OF + (size_t)MR * 512 * 2 <= WS_OB && WS_OB + (size_t)MR * 512 * 2 <= WS_A && WS_A + (size_t)MR * PW * 2 <= WS_END, "ws map");
static_assert((size_t)GLA_ITEMS * 8192 * 2 <= (size_t)MR * DM * 2 && WS_DN + (size_t)GLA_ITEMS * 64 * 4 <= WS_WUP1, "gla ws");

__device__ __forceinline__ unsigned f2bf(float f) { unsigned u = __builtin_bit_cast(unsigned, f); return (u + 0x7fffu + ((u >> 16) & 1u)) >> 16; }
__device__ __forceinline__ unsigned pk2(float lo, float hi) { return f2bf(lo) | (f2bf(hi) << 16); }
__device__ __forceinline__ float bf2f(unsigned short h) { return __uint_as_float(((unsigned)h) << 16); }
__device__ __forceinline__ float wave_sum(float v) {
#pragma unroll
    for (int o = 1; o < 64; o <<= 1) v += __shfl_xor(v, o);
    return v;
}
__device__ __forceinline__ float silu_f(float v) { return v / (1.f + __expf(-v)); }

__device__ __forceinline__ void transpose_item(const float* W, int K, int N, bf16* WT, int k0, int n0, int drow0, LAS float* scr, int lane) {
#pragma unroll 8
    for (int i = 0; i < 32; ++i) { const int kk = 2 * i + (lane >> 5); scr[kk * 33 + (lane & 31)] = W[(size_t)(k0 + kk) * N + n0 + (lane & 31)]; }
    asm volatile("s_waitcnt lgkmcnt(0)" ::: "memory");
    const int c = lane & 7;
#pragma unroll
    for (int j = 0; j < 4; ++j) { const int n = (lane >> 3) + 8 * j; const LAS float* s = scr + (8 * c) * 33 + n;
        v4u o; o.x = pk2(s[0 * 33], s[1 * 33]); o.y = pk2(s[2 * 33], s[3 * 33]); o.z = pk2(s[4 * 33], s[5 * 33]); o.w = pk2(s[6 * 33], s[7 * 33]);
        *(v4u*)(WT + (size_t)(drow0 + n) * K + k0 + 8 * c) = o; }
    asm volatile("s_waitcnt lgkmcnt(0)" ::: "memory");
}
__device__ __forceinline__ int up_dest(int n0) { return n0 < DFF ? 256 * (n0 / 128) + (n0 % 128) : 256 * ((n0 - DFF) / 128) + 128 + ((n0 - DFF) % 128); }
__device__ __forceinline__ int win_dest(int n0) { return n0 < 2304 ? n0 : (n0 < 2336 ? n0 + 2048 : n0 - 32); }

__device__ __forceinline__ void norm_mod_rows(const float* lat, const float* ctxp, const float* mod, const float* g, int sub, bf16* XN, bool with_ctx, int gw, int NGW, int lane) {
    f32x4 gv[4];
#pragma unroll
    for (int j = 0; j < 4; ++j) gv[j] = *((const f32x4*)g + lane + 64 * j);
    for (int r0 = gw * 4; r0 < MR; r0 += NGW * 4) {
        const int b = r0 / TB, t = r0 % TB; const bool isctx = t >= TL;
        if (isctx && !with_ctx) continue;
        const float* src = isctx ? ctxp + (size_t)(b * TC + t - TL) * DM : lat + (size_t)(b * TL + t) * DM;
        const float* sh = mod + (size_t)(isctx ? 8 : b) * NMOD + (3 * sub) * DM; const float* sc = sh + DM;
        f32x4 v[4][4]; float s[4] = {0.f, 0.f, 0.f, 0.f};
#pragma unroll
        for (int u = 0; u < 4; ++u)
#pragma unroll
            for (int j = 0; j < 4; ++j) { v[u][j] = *((const f32x4*)(src + (size_t)u * DM) + lane + 64 * j); }
#pragma unroll
        for (int u = 0; u < 4; ++u)
#pragma unroll
            for (int j = 0; j < 4; ++j) s[u] += (v[u][j].x * v[u][j].x + v[u][j].y * v[u][j].y) + (v[u][j].z * v[u][j].z + v[u][j].w * v[u][j].w);
#pragma unroll
        for (int u = 0; u < 4; ++u) {
            const float rstd = 1.f / sqrtf(wave_sum(s[u]) * (1.f / DM) + EPS);
            unsigned long long* o8 = (unsigned long long*)(XN + (size_t)(r0 + u) * DM) + lane;
#pragma unroll
            for (int j = 0; j < 4; ++j) { const f32x4 scv = *((const f32x4*)sc + lane + 64 * j), shv = *((const f32x4*)sh + lane + 64 * j);
                const f32x4 y = (v[u][j] * rstd * gv[j]) * (scv + 1.f) + shv;
                o8[64 * j] = (unsigned long long)pk2(y.x, y.y) | ((unsigned long long)pk2(y.z, y.w) << 32); } }
    }
}

constexpr int GS = 72, VS = 136;
constexpr int GL_QE = 0, GL_KE = 9216, GL_KL = 18432, GL_A = 27648, GL_V = 36864, GL_B = 54272, GL_BT = 71680, GL_SEG = 71936, BS = 68;
typedef short v4i16_t __attribute__((ext_vector_type(4)));
__device__ __forceinline__ bf16x8 tr_frag(const LAS bf16* base, int rs  , int col0, int ks, int q4, int qq, int p) {
    const LAS bf16* a0 = base + (32 * ks + 8 * q4 + qq) * rs + col0 + 4 * p;
    const v4i16_t t0 = __builtin_amdgcn_ds_read_tr16_b64_v4i16((LAS v4i16_t*)a0), t1 = __builtin_amdgcn_ds_read_tr16_b64_v4i16((LAS v4i16_t*)(a0 + 4 * rs));
    return (bf16x8){t0[0], t0[1], t0[2], t0[3], t1[0], t1[1], t1[2], t1[3]};
}
#define GLA_ROWOF(c) (rowbase + (dir ? 63 - (c) : (c)))
template <int PASS> __device__ __forceinline__ void gla_pass(LAS unsigned char* lds, const bf16* P, const float* w_decay, const float* b_decay, bf16* Ubuf, float* dn, bf16* OF, bf16* OB, int bx, int G, unsigned* ctr) {
    const int tid = opaque_tid(), lane = tid & 63, w = __builtin_amdgcn_readfirstlane(tid >> 6), l15 = lane & 15, q4 = lane >> 4, qq = (lane & 15) >> 2, p3 = lane & 3;
    constexpr int NV = PASS == 1 ? 64 * 131 : 64 * 128;
    LAS bf16* qeL = (LAS bf16*)(lds + GL_QE); LAS bf16* keL = (LAS bf16*)(lds + GL_KE); LAS bf16* klL = (LAS bf16*)(lds + GL_KL); LAS bf16* AL = (LAS bf16*)(lds + GL_A); LAS bf16* vL = (LAS bf16*)(lds + GL_V);
    LAS float* bL = (LAS float*)(lds + GL_B); LAS float* btL = (LAS float*)(lds + GL_BT); LAS float* segT = (LAS float*)(lds + GL_SEG);
    const int c = tid >> 3, ch = tid & 7, dt = w & 3, half = w >> 2;
    v4u vraw[2], kraw, qraw, lowf[2]; float wdr[8]; float bdr = 0.f; bf16x8 xsn[2];
    vraw[0] = vraw[1] = kraw = qraw = lowf[0] = lowf[1] = (v4u){0u, 0u, 0u, 0u}; xsn[0] = xsn[1] = (bf16x8){0, 0, 0, 0, 0, 0, 0, 0};
#pragma unroll
    for (int j = 0; j < 8; ++j) wdr[j] = 0.f;
#define GLA_DEC(idx_) const int chain = PASS == 1 ? (idx_) / 131 : (idx_) >> 7, s = PASS == 1 ? (idx_) % 131 : 4 + ((idx_) & 127), dir = chain & 1, h = (chain >> 1) & 3, b = chain >> 3; \
    const int rowbase = b * TB + (s < 4 ? TL + (dir ? 3 - s : s) * 64 : (dir ? 127 - (s - 4) : s - 4) * 64); const int item = chain * GLA_S + s; (void)item
#define GLA_LOAD(idx_) do { GLA_DEC(idx_); \
        _Pragma("unroll") for (int i = 0; i < 2; ++i) { const int n = tid + 512 * i; vraw[i] = *(const v4u*)(P + (size_t)GLA_ROWOF(n >> 4) * PW + PC_GV + h * 128 + (n & 15) * 8); } \
        { const size_t ro = (size_t)GLA_ROWOF(c) * PW + h * 64 + ch * 8; kraw = *(const v4u*)(P + ro + PC_GK); if (PASS == 3) qraw = *(const v4u*)(P + ro + PC_GQ); } \
        _Pragma("unroll") for (int i = 0; i < 2; ++i) lowf[i] = *(const v4u*)(P + (size_t)GLA_ROWOF(16 * (2 * half + i) + l15) * PW + PC_LOW + dir * 16 + (q4 & 1) * 8); \
        _Pragma("unroll") for (int j = 0; j < 8; ++j) wdr[j] = w_decay[(dir * 16 + 8 * (q4 & 1) + j) * 256 + h * 64 + 16 * dt + l15]; \
        bdr = b_decay[dir * 256 + h * 64 + 16 * dt + l15]; \
        if (PASS == 3) { _Pragma("unroll") for (int ks = 0; ks < 2; ++ks) xsn[ks] = *(const bf16x8*)(Ubuf + (size_t)item * 8192 + (16 * w + l15) * 64 + 8 * q4 + 32 * ks); } } while (0)
    volatile LAS unsigned* nxtL = (volatile LAS unsigned*)(lds + GL_SEG + 1024);
    int idx = bx;
    if (ctr) { if (tid == 0) nxtL[0] = __hip_atomic_fetch_add(ctr, 1u, __ATOMIC_RELAXED, __HIP_MEMORY_SCOPE_AGENT); __syncthreads(); idx = (int)nxtL[0]; __syncthreads(); }
    if (idx < NV) GLA_LOAD(idx);
    for (; idx < NV;) {
        int nidx = idx + G;
        if (ctr && tid == 0) nxtL[0] = __hip_atomic_fetch_add(ctr, 1u, __ATOMIC_RELAXED, __HIP_MEMORY_SCOPE_AGENT);
        GLA_DEC(idx);
#pragma unroll
        for (int i = 0; i < 2; ++i) { const int n = tid + 512 * i; *(LAS v4u*)(vL + (n >> 4) * VS + (n & 15) * 8) = vraw[i]; }
        float kf[8], qf[8];
        kf[0] = pg8::bflo(kraw.x); kf[1] = pg8::bfhi(kraw.x); kf[2] = pg8::bflo(kraw.y); kf[3] = pg8::bfhi(kraw.y); kf[4] = pg8::bflo(kraw.z); kf[5] = pg8::bfhi(kraw.z); kf[6] = pg8::bflo(kraw.w); kf[7] = pg8::bfhi(kraw.w);
        if (PASS == 3) { qf[0] = pg8::bflo(qraw.x); qf[1] = pg8::bfhi(qraw.x); qf[2] = pg8::bflo(qraw.y); qf[3] = pg8::bfhi(qraw.y); qf[4] = pg8::bflo(qraw.z); qf[5] = pg8::bfhi(qraw.z); qf[6] = pg8::bflo(qraw.w); qf[7] = pg8::bfhi(qraw.w); }
        float bv[2][4], tot[2];
        { bf16x8 yv;
#pragma unroll
          for (int j = 0; j < 8; ++j) { const unsigned hb = f2bf(wdr[j]); const unsigned lb = f2bf(wdr[j] - __uint_as_float(hb << 16)); yv[j] = (short)(q4 < 2 ? hb : lb); }
#pragma unroll
          for (int i = 0; i < 2; ++i) { f32x4 z = {0.f, 0.f, 0.f, 0.f}; z = __builtin_amdgcn_mfma_f32_16x16x32_bf16(__builtin_bit_cast(bf16x8, lowf[i]), yv, z, 0, 0, 0);
              float run = 0.f;
#pragma unroll
              for (int r = 0; r < 4; ++r) { const float zz = z[r] + bdr; run += (fminf(zz, 0.f) - __logf(1.f + __expf(-fabsf(zz)))) * (1.f / 16.f); bv[i][r] = run; }
              float sc = run; float t = __shfl_up(sc, 16); if (q4 >= 1) sc += t; t = __shfl_up(sc, 32); if (q4 >= 2) sc += t;
              const float excl = sc - run; tot[i] = __shfl(sc, 48 + l15);
#pragma unroll
              for (int r = 0; r < 4; ++r) bv[i][r] += excl + (i ? tot[0] : 0.f); }
          if (q4 == 0) segT[half * 64 + 16 * dt + l15] = tot[0] + tot[1]; }
        __syncthreads();
        { const float other = segT[(1 - half) * 64 + 16 * dt + l15]; const float add = half ? other : 0.f;
#pragma unroll
          for (int i = 0; i < 2; ++i)
#pragma unroll
              for (int r = 0; r < 4; ++r) bL[(16 * (2 * half + i) + 4 * q4 + r) * BS + 16 * dt + l15] = bv[i][r] + add;
          if (half == 0 && q4 == 0) btL[16 * dt + l15] = tot[0] + tot[1] + other; }
        __syncthreads();
        float bl[8], btot[8];
        { const f32x4 b0 = *(const LAS f32x4*)(bL + c * BS + 8 * ch), b1 = *(const LAS f32x4*)(bL + c * BS + 8 * ch + 4), t0 = *(const LAS f32x4*)(btL + 8 * ch), t1 = *(const LAS f32x4*)(btL + 8 * ch + 4);
          bl[0] = b0[0]; bl[1] = b0[1]; bl[2] = b0[2]; bl[3] = b0[3]; bl[4] = b1[0]; bl[5] = b1[1]; bl[6] = b1[2]; bl[7] = b1[3];
          btot[0] = t0[0]; btot[1] = t0[1]; btot[2] = t0[2]; btot[3] = t0[3]; btot[4] = t1[0]; btot[5] = t1[1]; btot[6] = t1[2]; btot[7] = t1[3]; }
        if (PASS == 1) {
            float kl[8];
#pragma unroll
            for (int k = 0; k < 8; ++k) kl[k] = kf[k] * __expf(btot[k] - bl[k]);
            v4u o; o.x = pk2(kl[0], kl[1]); o.y = pk2(kl[2], kl[3]); o.z = pk2(kl[4], kl[5]); o.w = pk2(kl[6], kl[7]);
            *(LAS v4u*)(klL + c * GS + 8 * ch) = o;
            if (tid < 8) { f32x4* dp = (f32x4*)(dn + (size_t)item * 64 + 8 * ch); dp[0] = (f32x4){__expf(btot[0]), __expf(btot[1]), __expf(btot[2]), __expf(btot[3])}; dp[1] = (f32x4){__expf(btot[4]), __expf(btot[5]), __expf(btot[6]), __expf(btot[7])}; }
        } else {
            float qe[8], ke[8];
#pragma unroll
            for (int k = 0; k < 8; ++k) { qe[k] = qf[k] * __expf(bl[k]) * 0.125f; ke[k] = kf[k] * __expf(-bl[k]); }
            v4u o; o.x = pk2(qe[0], qe[1]); o.y = pk2(qe[2], qe[3]); o.z = pk2(qe[4], qe[5]); o.w = pk2(qe[6], qe[7]);
            *(LAS v4u*)(qeL + c * GS + 8 * ch) = o;
            o.x = pk2(ke[0], ke[1]); o.y = pk2(ke[2], ke[3]); o.z = pk2(ke[4], ke[5]); o.w = pk2(ke[6], ke[7]);
            *(LAS v4u*)(keL + c * GS + 8 * ch) = o;
        }
        bf16x8 xs[2]; xs[0] = xsn[0]; xs[1] = xsn[1];
        if (ctr) nidx = (int)nxtL[0];
        if (nidx < NV) GLA_LOAD(nidx);
        __syncthreads();
        if (PASS == 1) {
            bf16x8 y[2];
#pragma unroll
            for (int ks = 0; ks < 2; ++ks) y[ks] = tr_frag(vL, VS, 16 * w, ks, q4, qq, p3);
#pragma unroll
            for (int dt = 0; dt < 4; ++dt) { f32x4 acc = {0.f, 0.f, 0.f, 0.f};
#pragma unroll
                for (int ks = 0; ks < 2; ++ks) { const bf16x8 x = tr_frag(klL, GS, 16 * dt, ks, q4, qq, p3); acc = __builtin_amdgcn_mfma_f32_16x16x32_bf16(x, y[ks], acc, 0, 0, 0); }
                v2u o; o.x = pk2(acc[0], acc[1]); o.y = pk2(acc[2], acc[3]);
                *(v2u*)(Ubuf + (size_t)item * 8192 + (16 * w + l15) * 64 + 16 * dt + 4 * q4) = o; }
        } else {
            { const int it = w >> 1;
#pragma unroll
              for (int jj = 0; jj < 2; ++jj) { const int jt = (w & 1) * 2 + jj; f32x4 acc = {0.f, 0.f, 0.f, 0.f};
                  if (jt <= it) {
#pragma unroll
                      for (int ks = 0; ks < 2; ++ks) { const bf16x8 x = *(const LAS bf16x8*)(keL + (16 * jt + l15) * GS + 8 * q4 + 32 * ks), y = *(const LAS bf16x8*)(qeL + (16 * it + l15) * GS + 8 * q4 + 32 * ks);
                          acc = __builtin_amdgcn_mfma_f32_16x16x32_bf16(x, y, acc, 0, 0, 0); }
                      const int i = 16 * it + l15, j0 = 16 * jt + 4 * q4;
#pragma unroll
                      for (int r = 0; r < 4; ++r) if (j0 + r > i) acc[r] = 0.f;
                  }
                  v2u o; o.x = pk2(acc[0], acc[1]); o.y = pk2(acc[2], acc[3]);
                  *(LAS v2u*)(AL + (16 * it + l15) * GS + 16 * jt + 4 * q4) = o; } }
            bf16x8 xv[2];
#pragma unroll
            for (int ks = 0; ks < 2; ++ks) xv[ks] = tr_frag(vL, VS, 16 * w, ks, q4, qq, p3);
            __syncthreads();
            bf16* Ob = dir ? OB : OF;
#pragma unroll
            for (int it = 0; it < 4; ++it) { f32x4 acc = {0.f, 0.f, 0.f, 0.f};
#pragma unroll
                for (int ks = 0; ks < 2; ++ks) { const bf16x8 y = *(const LAS bf16x8*)(AL + (16 * it + l15) * GS + 8 * q4 + 32 * ks); acc = __builtin_amdgcn_mfma_f32_16x16x32_bf16(xv[ks], y, acc, 0, 0, 0); }
#pragma unroll
                for (int ks = 0; ks < 2; ++ks) { const bf16x8 y = *(const LAS bf16x8*)(qeL + (16 * it + l15) * GS + 8 * q4 + 32 * ks); acc = __builtin_amdgcn_mfma_f32_16x16x32_bf16(xs[ks], y, acc, 0, 0, 0); }
                v2u o; o.x = pk2(acc[0], acc[1]); o.y = pk2(acc[2], acc[3]);
                *(v2u*)(Ob + (size_t)GLA_ROWOF(16 * it + l15) * 512 + h * 128 + 16 * w + 4 * q4) = o; }
        }
        __syncthreads();
        idx = nidx;
    }
#undef GLA_DEC
#undef GLA_LOAD
}

struct Args { const float* in[19]; float* out; unsigned char* ws; };
__global__ void __launch_bounds__(NTHR, 2) mk_fwd(Args args) {
    extern __shared__ __attribute__((aligned(16))) unsigned char lds_raw[];
    cg::grid_group grid = cg::this_grid();
    LAS unsigned char* lds = (LAS unsigned char*)lds_raw;
    const int G = gridDim.x, bx = blockIdx.x, NGW = G * NWAVES;
    unsigned long long pacc = 0ull, pt0 = 0ull; (void)pt0;
#define PB(k) do { if ((PROBE_MASK >> (k)) & 1ull) pt0 = __builtin_amdgcn_s_memrealtime(); } while (0)
#define PE(k) do { if ((PROBE_MASK >> (k)) & 1ull) pacc += __builtin_amdgcn_s_memrealtime() - pt0; } while (0)
#define GSYNC() do { xcd_barrier(xbar); if (PROBE_SYNC) { const unsigned long long t_ = __builtin_amdgcn_s_memrealtime(); xcd_barrier(xbar); pacc += __builtin_amdgcn_s_memrealtime() - t_; } } while (0)
#define PH_IDS const int tid = opaque_tid(), lane = tid & 63, wave = __builtin_amdgcn_readfirstlane(tid >> 6), gw = bx * NWAVES + wave; (void)lane; (void)gw
    unsigned char* ws = args.ws;
    const float* x = args.in[0]; const float* cvec = args.in[1]; const float* ctx = args.in[2]; const float* c_ctx = args.in[3]; const float* w_mod = args.in[4]; const float* b_mod = args.in[5];
    const float* g_norm = args.in[6]; const float* w_up = args.in[7]; const float* w_down = args.in[8]; const float* w_in = args.in[9]; const float* g_q = args.in[10]; const float* g_k = args.in[11];
    const float* w_decay = args.in[12]; const float* b_decay = args.in[13]; const float* g_gla = args.in[14]; const float* w_branch = args.in[15]; const float* b_gate = args.in[16]; const float* w_out = args.in[17]; const float* g_final = args.in[18];
    float* H = args.out;
    float* HC = (float*)(ws + WS_HCTX);
    float* mod = (float*)(ws + WS_MOD); float* dn = (float*)(ws + WS_DN);
    bf16* Wup1 = (bf16*)(ws + WS_WUP1); bf16* Wup2 = (bf16*)(ws + WS_WUP2); bf16* Wdn1 = (bf16*)(ws + WS_WDN1); bf16* Wdn2 = (bf16*)(ws + WS_WDN2); bf16* Win = (bf16*)(ws + WS_WIN);
    bf16* Wbr0 = (bf16*)(ws + WS_WBR0); bf16* Wbr1 = (bf16*)(ws + WS_WBR1); bf16* Wout = (bf16*)(ws + WS_WOUT);
    bf16* XN = (bf16*)(ws + WS_XN); bf16* OF = (bf16*)(ws + WS_OF); bf16* OB = (bf16*)(ws + WS_OB); bf16* PA = (bf16*)(ws + WS_A);
    bf16* HID = PA; bf16* Ubuf = XN; bf16* Z = XN;
    float* ssq1 = (float*)(ws + WS_SSQ1); float* ssq2 = (float*)(ws + WS_SSQ2); float* sW1 = (float*)(ws + WS_SW1); float* sW2 = (float*)(ws + WS_SW2);
    bf16* XN2 = OF;

    volatile LAS unsigned* xst = (volatile LAS unsigned*)(lds + LDS_BYTES - 64);
    if (threadIdx.x < 2) xst[threadIdx.x] = 0u;
    unsigned* barw = (unsigned*)ws;
    if (bx == 0) for (int i = threadIdx.x; i < XCD_BAR_WORDS + 128; i += NTHR) __hip_atomic_store(barw + i, 0u, __ATOMIC_RELAXED, __HIP_MEMORY_SCOPE_AGENT);
    XcdBarrier xbar; xbar.bar = barw; xbar.x = 0; xbar.st = xst;
    PB(0);
    {
        PH_IDS;
        LAS float* sc = (LAS float*)lds; LAS float* red = sc + 9 * 1024;
        for (int idx = tid; idx < 9 * 1024; idx += NTHR) { const int j = idx >> 10, k = idx & 1023; const float v = j < 8 ? cvec[j * 1024 + k] : c_ctx[k]; sc[idx] = silu_f(v); }
        __syncthreads();
        for (int it = bx; it < NMOD / 32; it += G) {
            const int cc = tid & 31, ks = tid >> 5, col = it * 32 + cc;
            float a[9];
#pragma unroll
            for (int j = 0; j < 9; ++j) a[j] = 0.f;
#pragma unroll 4
            for (int kk = 0; kk < 64; ++kk) { const int k = ks * 64 + kk; const float wv = w_mod[(size_t)k * NMOD + col];
#pragma unroll
                for (int j = 0; j < 9; ++j) a[j] += sc[j * 1024 + k] * wv; }
#pragma unroll
            for (int j = 0; j < 9; ++j) red[(ks * 9 + j) * 32 + cc] = a[j];
            __syncthreads();
            if (tid < 288) { const int j = tid >> 5, c2 = tid & 31; float s = b_mod[it * 32 + c2];
#pragma unroll
                for (int k2 = 0; k2 < 16; ++k2) s += red[(k2 * 9 + j) * 32 + c2];
                mod[(size_t)j * NMOD + it * 32 + c2] = s; }
            __syncthreads();
        }
        LAS float* scr = (LAS float*)(lds + 65536) + wave * 2176;
        constexpr int I_UP = 16 * 176, I_DN = 44 * 32;
        for (int it = gw; it < I_UP + I_DN; it += NGW) {
            int r = it;
            if (r < I_UP) { const int kb = r / 176, nb = r % 176; transpose_item(w_up, 1024, 5632, Wup1, 64 * kb, 32 * nb, up_dest(32 * nb), scr, lane); continue; } r -= I_UP;
            { const int kb = r / 32, nb = r % 32; transpose_item(w_down, DFF, 1024, Wdn1, 64 * kb, 32 * nb, 32 * nb, scr, lane); }
        }
        for (int i = bx * NTHR + tid; i < 224 * 1024 / 8; i += G * NTHR) ((v4u*)(Win + (size_t)4384 * 1024))[i] = (v4u){0u, 0u, 0u, 0u};
        for (int i = bx * NTHR + tid; i < MR; i += G * NTHR) { ssq1[i] = 0.f; ssq2[i] = 0.f; }
    }
    grid.sync();
    xbar.x = xb_xcc_id(); if (threadIdx.x == 0) xst[2] = xb_add(&barw[XB_XCNT(xbar.x)], 1u);
    PE(0); PB(1);
    { PH_IDS; norm_mod_rows(x, ctx, mod, g_norm + 0 * DM, 0, XN, true, gw, NGW, lane);
      LAS float* sc = (LAS float*)lds; LAS float* red = sc + 9 * 1024;
      for (int it = bx; it < 144 + 176; it += G) {
          const bool second = it >= 144; const int n0 = (second ? it - 144 : it) * 32; const int sub = second ? 2 : 1;
          __syncthreads();
          for (int idx = tid; idx < 9 * 1024; idx += NTHR) sc[idx] = mod[(size_t)(idx >> 10) * NMOD + (3 * sub) * DM + (idx & 1023)];
          __syncthreads();
          const int cc = tid & 31, ks = tid >> 5, nd = n0 + cc; int nsrc; const float* Wp; int ldw;
          if (!second) { Wp = w_in; ldw = 4384; nsrc = nd < 2304 ? nd : (nd < 4352 ? nd + 32 : (nd < 4384 ? nd - 2048 : -1)); }
          else { Wp = w_up + (size_t)1024 * 5632; ldw = 5632; const int tile = nd >> 8, within = nd & 255; nsrc = within < 128 ? 128 * tile + within : DFF + 128 * tile + (within - 128); }
          float a[9];
#pragma unroll
          for (int j = 0; j < 9; ++j) a[j] = 0.f;
          if (nsrc >= 0) {
#pragma unroll 4
              for (int kk = 0; kk < 64; ++kk) { const int k = ks * 64 + kk; const float wv = Wp[(size_t)k * ldw + nsrc];
#pragma unroll
                  for (int j = 0; j < 9; ++j) a[j] += sc[j * 1024 + k] * wv; } }
#pragma unroll
          for (int j = 0; j < 9; ++j) red[(ks * 9 + j) * 32 + cc] = a[j];
          __syncthreads();
          if (tid < 288) { const int j = tid >> 5, c2 = tid & 31; float sum = 0.f;
#pragma unroll
              for (int k2 = 0; k2 < 16; ++k2) sum += red[(k2 * 9 + j) * 32 + c2];
              (second ? sW2 + (size_t)j * 5632 : sW1 + (size_t)j * PW)[n0 + c2] = sum; }
      }
      __syncthreads(); }
    GSYNC(); PE(1); PB(2);
    if (threadIdx.x == 0) { bool uni = (xbar.x < 8u) && ((G & 7) == 0);
        for (unsigned j = 0; j < 16; ++j) { const unsigned cnt_ = xb_ld(&barw[XB_XCNT(j)]); uni = uni && (cnt_ == (j < 8u ? (unsigned)(G >> 3) : 0u)); }
        xst[3] = uni ? (xst[2] * 8u + xbar.x) : (unsigned)bx; }
    __syncthreads();
    const int vb = (int)xst[3];
    { pg8::Gemm g{XN, Wup1, MR, 5632, 1024, 1024, 1024}; pg8::StaticOrder S; S.init(MR, 5632, G, vb);
      pg8::EpiSwiglu E{HID, DFF}; pg8::gemm_phase<pg8::EpiSwiglu, pg8::StaticOrder, true, true>(lds, g, S, E); }
    GSYNC(); PE(2); PB(3);
    { pg8::Gemm g{HID, Wdn1, MR, 1024, DFF, DFF, DFF}; pg8::StaticOrder S; S.init(MR, 1024, G, vb);
      pg8::EpiRes<1, 2, 1, 1> E{x, ctx, H, HC, mod, g_norm + 1 * DM, XN, ssq1}; pg8::gemm_phase<pg8::EpiRes<1, 2, 1, 1>, pg8::StaticOrder, true, true>(lds, g, S, E); }
    { PH_IDS;
      const int rem = (264 * 4) % G, ir = rem ? vb - rem : vb, ni = rem ? G - rem : G;
      if (ir >= 0) {
          LAS float* scr = (LAS float*)(lds + 65536) + wave * 2176;
          constexpr int I_UP = 16 * 176, I_DN = 44 * 32, I_IN = 16 * 137, I_BR = 8 * 32, I_OUT = 16 * 32;
          constexpr int NITEMS = I_UP + I_DN + I_IN + 2 * I_BR + I_OUT;
          for (int it = ir * NWAVES + wave; it < NITEMS; it += ni * NWAVES) {
              int r = it;
              if (r < I_UP) { const int kb = r / 176, nb = r % 176; transpose_item(w_up + (size_t)1024 * 5632, 1024, 5632, Wup2, 64 * kb, 32 * nb, up_dest(32 * nb), scr, lane); continue; } r -= I_UP;
              if (r < I_DN) { const int kb = r / 32, nb = r % 32; transpose_item(w_down + (size_t)DFF * 1024, DFF, 1024, Wdn2, 64 * kb, 32 * nb, 32 * nb, scr, lane); continue; } r -= I_DN;
              if (r < I_IN) { const int kb = r / 137, nb = r % 137; transpose_item(w_in, 1024, 4384, Win, 64 * kb, 32 * nb, win_dest(32 * nb), scr, lane); continue; } r -= I_IN;
              if (r < 2 * I_BR) { const int l = r / I_BR; r %= I_BR; const int kb = r / 32, nb = r % 32; transpose_item(w_branch + (size_t)l * 512 * 1024, 512, 1024, l ? Wbr1 : Wbr0, 64 * kb, 32 * nb, 32 * nb, scr, lane); continue; } r -= 2 * I_BR;
              { const int kb = r / 32, nb = r % 32; transpose_item(w_out, 1024, 1024, Wout, 64 * kb, 32 * nb, 32 * nb, scr, lane); }
          }
      } }
    GSYNC(); PE(3); PB(4);
#if MK_STAGE >= 2
    { pg8::Gemm g{XN, Win, MR, PW, 1024, 1024, 1024}; pg8::StaticOrder S; S.init(MR, PW, G, vb);
      pg8::EpiInproj E{PA, PW, ssq1, sW1, PW}; pg8::gemm_phase<pg8::EpiInproj, pg8::StaticOrder, true, true>(lds, g, S, E); }
    GSYNC(); PE(4); PB(5);
    { PH_IDS;
      const int l7 = lane & 7, l3 = lane & 3; const bool is_hi = (lane & 4) != 0;
      float frq[8], gq8[8], gk8[8];
#pragma unroll
      for (int k = 0; k < 8; ++k) { frq[k] = __builtin_amdgcn_exp2f(-(float)(8 * (l3 & 1) + k) * (13.287712379549449f / 16.f)); gq8[k] = g_q[8 * l7 + k] * attn_body::C2; gk8[k] = g_k[8 * l7 + k]; }
      for (int r0 = gw * 4; r0 < MR; r0 += NGW * 4) {
          const int t0 = r0 % TB; const bool isctx = t0 >= TL;
          v4u qv[4], kv[4];
#pragma unroll
          for (int u = 0; u < 4; ++u) { bf16* rp = PA + (size_t)(r0 + u) * PW; qv[u] = (v4u){0u, 0u, 0u, 0u}; if (!isctx) qv[u] = *(const v4u*)(rp + lane * 8); kv[u] = *(const v4u*)(rp + PC_K + (lane & 15) * 8); }
#pragma unroll
          for (int u = 0; u < 4; ++u) { bf16* rp = PA + (size_t)(r0 + u) * PW; const int t = t0 + u;
              const float pos = (l3 < 2) ? (float)(t >> 6) : (float)(t & 63);
              float cs8[8], sn8[8];
#pragma unroll
              for (int k = 0; k < 8; ++k) { const float ang = pos * frq[k]; cs8[k] = isctx ? 1.f : __cosf(ang); sn8[k] = isctx ? 0.f : __sinf(ang); }
#pragma unroll
              for (int part = 0; part < 2; ++part) { const v4u raw = part ? kv[u] : qv[u];
                  float xv[8]; xv[0] = pg8::bflo(raw.x); xv[1] = pg8::bfhi(raw.x); xv[2] = pg8::bflo(raw.y); xv[3] = pg8::bfhi(raw.y); xv[4] = pg8::bflo(raw.z); xv[5] = pg8::bfhi(raw.z); xv[6] = pg8::bflo(raw.w); xv[7] = pg8::bfhi(raw.w);
                  float ss = 0.f;
#pragma unroll
                  for (int k = 0; k < 8; ++k) ss += xv[k] * xv[k];
                  ss += __shfl_xor(ss, 1); ss += __shfl_xor(ss, 2); ss += __shfl_xor(ss, 4);
                  const float rstd = 1.f / sqrtf(ss * (1.f / 64.f) + EPS);
                  float o[8];
#pragma unroll
                  for (int k = 0; k < 8; ++k) { const float y = xv[k] * rstd * (part ? gk8[k] : gq8[k]); const float py = __shfl_xor(y, 4);
                      o[k] = is_hi ? (py * sn8[k] + y * cs8[k]) : (y * cs8[k] - py * sn8[k]); }
                  v4u w4; w4.x = pk2(o[0], o[1]); w4.y = pk2(o[2], o[3]); w4.z = pk2(o[4], o[5]); w4.w = pk2(o[6], o[7]);
                  if (part == 0) { if (!isctx) *(v4u*)(rp + lane * 8) = w4; } else { if (lane < 16) *(v4u*)(rp + PC_K + lane * 8) = w4; } } } } }
    gla_pass<1>(lds, PA, w_decay, b_decay, Ubuf, dn, OF, OB, vb, G, nullptr);
    GSYNC(); PE(5); PB(6);
    { PH_IDS; const int tg = bx * NTHR + tid;
      for (int q = tg; q < 64 * 2048; q += G * NTHR) { const int chain = q >> 11, e4 = q & 2047; const int d0 = (4 * e4) & 63;
          f32x4 S = {0.f, 0.f, 0.f, 0.f};
          for (int s0 = 0; s0 < GLA_S; s0 += 12) { v2u ur[12]; f32x4 dv[12];
#pragma unroll
              for (int j = 0; j < 12; ++j) { const size_t item = (size_t)chain * GLA_S + s0 + j; ur[j] = (v2u){0u, 0u}; dv[j] = (f32x4){0.f, 0.f, 0.f, 0.f};
                  if (s0 + j < GLA_S - 1) { ur[j] = *(const v2u*)(Ubuf + item * 8192 + 4 * e4); dv[j] = *(const f32x4*)(dn + item * 64 + d0); } }
#pragma unroll
              for (int j = 0; j < 12; ++j) { const size_t item = (size_t)chain * GLA_S + s0 + j;
                  v2u o; o.x = pk2(S[0], S[1]); o.y = pk2(S[2], S[3]); *(v2u*)(Ubuf + item * 8192 + 4 * e4) = o;
                  S[0] = dv[j][0] * S[0] + __uint_as_float(ur[j].x << 16); S[1] = dv[j][1] * S[1] + __uint_as_float(ur[j].x & 0xffff0000u);
                  S[2] = dv[j][2] * S[2] + __uint_as_float(ur[j].y << 16); S[3] = dv[j][3] * S[3] + __uint_as_float(ur[j].y & 0xffff0000u); } } } }
    GSYNC(); PE(6); PB(7);
    bool fastsm;
    { const int l_ = opaque_tid() & 63; float gqm = fabsf(g_q[l_]), gkm = fabsf(g_k[l_]);
#pragma unroll
      for (int o = 1; o < 64; o <<= 1) { gqm = fmaxf(gqm, __shfl_xor(gqm, o)); gkm = fmaxf(gkm, __shfl_xor(gkm, o)); }
      fastsm = __builtin_amdgcn_readfirstlane((2.f * 11.5416f * gqm * gkm + 14.f < 100.f) ? 1 : 0) != 0; }
    { const attn_body::bf16* Qp = (const attn_body::bf16*)(PA + PC_Q); const attn_body::bf16* Kp = (const attn_body::bf16*)(PA + PC_K); const attn_body::bf16* Vp = (const attn_body::bf16*)(PA + PC_V);
      if ((G & 7) == 0) { const int b = vb & 7, ci = vb >> 3, nper = G >> 3;
          for (int idx = ci; idx < 256; idx += nper) { const int h = idx >> 5, qb = idx & 31;
              if (fastsm) attn_body::attn_unit<8, true>(b, h, h >> 2, qb, Qp, Kp, Vp, (attn_body::bf16*)(PA + PC_Q), (char*)lds_raw);
              else attn_body::attn_unit<8, false>(b, h, h >> 2, qb, Qp, Kp, Vp, (attn_body::bf16*)(PA + PC_Q), (char*)lds_raw); } }
      else { for (int u = vb; u < 2048; u += G) { const int b = u >> 8, h = (u >> 5) & 7, qb = u & 31; attn_body::attn_unit<8, false>(b, h, h >> 2, qb, Qp, Kp, Vp, (attn_body::bf16*)(PA + PC_Q), (char*)lds_raw); } }
    }
    __syncthreads();
    PE(7); PB(21);
    gla_pass<3>(lds, PA, w_decay, b_decay, Ubuf, dn, OF, OB, vb, G, barw + XCD_BAR_WORDS + 64);
    GSYNC(); PE(21); PB(8);
    { PH_IDS;
      const int col = lane * 8, e0 = col & 127; float gg8[8];
#pragma unroll
      for (int k = 0; k < 8; ++k) gg8[k] = g_gla[e0 + k];
      for (int r0 = gw * 4; r0 < MR; r0 += NGW * 4) {
          if (r0 % TB >= TL) continue;
          v4u a[4], bq[4], gq[4];
#pragma unroll
          for (int u = 0; u < 4; ++u) { const size_t r = r0 + u; a[u] = *(const v4u*)(OF + r * 512 + col); bq[u] = *(const v4u*)(OB + r * 512 + col); gq[u] = *(const v4u*)(PA + r * PW + PC_G6 + col); }
#pragma unroll
          for (int u = 0; u < 4; ++u) { const size_t r = r0 + u; float o[8], gg[8];
              o[0] = pg8::bflo(a[u].x) + pg8::bflo(bq[u].x); o[1] = pg8::bfhi(a[u].x) + pg8::bfhi(bq[u].x); o[2] = pg8::bflo(a[u].y) + pg8::bflo(bq[u].y); o[3] = pg8::bfhi(a[u].y) + pg8::bfhi(bq[u].y);
              o[4] = pg8::bflo(a[u].z) + pg8::bflo(bq[u].z); o[5] = pg8::bfhi(a[u].z) + pg8::bfhi(bq[u].z); o[6] = pg8::bflo(a[u].w) + pg8::bflo(bq[u].w); o[7] = pg8::bfhi(a[u].w) + pg8::bfhi(bq[u].w);
              gg[0] = pg8::bflo(gq[u].x); gg[1] = pg8::bfhi(gq[u].x); gg[2] = pg8::bflo(gq[u].y); gg[3] = pg8::bfhi(gq[u].y); gg[4] = pg8::bflo(gq[u].z); gg[5] = pg8::bfhi(gq[u].z); gg[6] = pg8::bflo(gq[u].w); gg[7] = pg8::bfhi(gq[u].w);
              float ss = 0.f;
#pragma unroll
              for (int k = 0; k < 8; ++k) ss += o[k] * o[k];
#pragma unroll
              for (int of = 1; of < 16; of <<= 1) ss += __shfl_xor(ss, of);
              const float rstd = 1.f / sqrtf(ss * (1.f / 128.f) + EPS); float y[8];
#pragma unroll
              for (int k = 0; k < 8; ++k) y[k] = o[k] * rstd * gg8[k] * silu_f(gg[k]);
              v4u w4; w4.x = pk2(y[0], y[1]); w4.y = pk2(y[2], y[3]); w4.z = pk2(y[4], y[5]); w4.w = pk2(y[6], y[7]);
              *(v4u*)(OF + r * 512 + col) = w4; } } }
    GSYNC(); PE(8); PB(9);
    { pg8::Gemm g{PA + PC_Q, Wbr0, MR, 1024, 512, PW, 512}; pg8::StaticOrder S; S.init(NB * TL, 1024, G, vb, 1);
      pg8::EpiGate<0> E{PA, b_gate, Z}; pg8::gemm_phase<pg8::EpiGate<0>, pg8::StaticOrder, true, true>(lds, g, S, E); }
    __syncthreads();
    { pg8::Gemm g{OF, Wbr1, MR, 1024, 512, 512, 512}; pg8::StaticOrder S; S.init(NB * TL, 1024, G, vb, 1);
      pg8::EpiGate<1> E{PA, b_gate, Z}; pg8::gemm_phase<pg8::EpiGate<1>, pg8::StaticOrder, true, true>(lds, g, S, E); }
    GSYNC(); PE(9); PB(10);
    { pg8::Gemm g{Z, Wout, MR, 1024, 1024, 1024, 1024}; pg8::StaticOrder S; S.init(NB * TL, 1024, G, vb, 1);
      pg8::EpiRes<1, 5, 0, 2> E{H, HC, H, HC, mod, g_norm + 2 * DM, XN2, ssq2}; pg8::gemm_phase<pg8::EpiRes<1, 5, 0, 2>, pg8::StaticOrder, true, true>(lds, g, S, E); }
    GSYNC(); PE(10); PB(11);
#endif
#if MK_STAGE >= 3
    { pg8::Gemm g{XN2, Wup2, MR, 5632, 1024, 1024, 1024}; pg8::StaticOrder S; S.init(NB * TL, 5632, G, vb, 1);
      pg8::EpiSwigluN E{HID, DFF, ssq2, sW2, 5632}; pg8::gemm_phase<pg8::EpiSwigluN, pg8::StaticOrder, true, true>(lds, g, S, E); }
    GSYNC(); PE(11); PB(12);
    { pg8::Gemm g{HID, Wdn2, MR, 1024, DFF, DFF, DFF}; pg8::StaticOrder S; S.init(NB * TL, 1024, G, vb, 1);
      pg8::EpiRes<0, 8, 1, 0> E{H, HC, H, HC, mod, nullptr, nullptr, nullptr}; pg8::gemm_phase<pg8::EpiRes<0, 8, 1, 0>, pg8::StaticOrder, true, true>(lds, g, S, E); }
    GSYNC(); PE(12); PB(13);
#endif
    { PH_IDS; f32x4 gv[4];
#pragma unroll
      for (int j = 0; j < 4; ++j) gv[j] = *((const f32x4*)g_final + lane + 64 * j);
      for (int r0 = gw * 4; r0 < NB * TL; r0 += NGW * 4) { f32x4* p = (f32x4*)(H + (size_t)r0 * DM) + lane; f32x4 v[4][4]; float s[4] = {0.f, 0.f, 0.f, 0.f};
#pragma unroll
          for (int u = 0; u < 4; ++u)
#pragma unroll
              for (int j = 0; j < 4; ++j) v[u][j] = p[u * 256 + 64 * j];
#pragma unroll
          for (int u = 0; u < 4; ++u)
#pragma unroll
              for (int j = 0; j < 4; ++j) s[u] += (v[u][j].x * v[u][j].x + v[u][j].y * v[u][j].y) + (v[u][j].z * v[u][j].z + v[u][j].w * v[u][j].w);
#pragma unroll
          for (int u = 0; u < 4; ++u) { const float rstd = 1.f / sqrtf(wave_sum(s[u]) * (1.f / DM) + EPS);
#pragma unroll
              for (int j = 0; j < 4; ++j) p[u * 256 + 64 * j] = v[u][j] * rstd * gv[j]; } } }
    PE(13);
    if (PROBE_MASK != 0ull || PROBE_SYNC) { const unsigned long long te = __builtin_amdgcn_s_memrealtime() + (unsigned long long)PROBE_MULT * pacc; while (__builtin_amdgcn_s_memrealtime() < te) __builtin_amdgcn_s_sleep(32); }
}

extern "C" void kernel_launch(void* const* d_in, const int* in_sizes, int n_in, void* d_out, int out_size, void* d_ws, size_t ws_size, hipStream_t stream) {
    static int grid = 0;
    if (grid == 0) {
        int dev = 0, cus = 0, per_cu = 0;
        hipGetDevice(&dev); hipDeviceGetAttribute(&cus, hipDeviceAttributeMultiprocessorCount, dev);
        hipFuncSetAttribute((const void*)mk_fwd, hipFuncAttributeMaxDynamicSharedMemorySize, LDS_BYTES);
        hipOccupancyMaxActiveBlocksPerMultiprocessor(&per_cu, (const void*)mk_fwd, NTHR, LDS_BYTES);
        if (per_cu < 1) per_cu = 1;
        grid = cus * per_cu;
        if (n_in != 19 || ws_size < WS_END) { fprintf(stderr, "kernel_launch: unexpected n_in %d or ws_size %zu\n", n_in, ws_size); }
    }
    Args a{};
    for (int i = 0; i < 19; ++i) a.in[i] = (const float*)d_in[i];
    a.out = (float*)d_out; a.ws = (unsigned char*)d_ws;
    void* kargs[] = {&a};
    hipError_t e = hipLaunchCooperativeKernel((const void*)mk_fwd, dim3(grid), dim3(NTHR), kargs, LDS_BYTES, stream);
    if (e != hipSuccess) fprintf(stderr, "cooperative launch failed: %s (grid %d)\n", hipGetErrorString(e), grid);
}
```

```cpp
#include <hip/hip_runtime.h>
#include <cstdio>
#include <cstdint>
#ifndef MK_STAGE
#define MK_STAGE 3
#endif
#define PROBE_MASK 0ull
#define PROBE_SYNC 0
#define PROBE_MULT 4
__device__ __forceinline__ int opaque_tid() { int t; asm volatile("v_mov_b32 %0, %1" : "=v"(t) : "v"((int)threadIdx.x)); return t; }
namespace pg8 {
#define PG8_LAS __attribute__((address_space(3)))
typedef unsigned short bf16_t;
typedef short bf16x8 __attribute__((ext_vector_type(8)));
typedef float f32x4 __attribute__((ext_vector_type(4)));
typedef unsigned u32x4 __attribute__((ext_vector_type(4)));
constexpr int BM = 256, BK = 64, HALF = 128, HTB = HALF * BK * 2  , STAGE_BYTES = 8 * HTB, NXCD = 8, WGM = 4;

__host__ __device__ __forceinline__ int lds_byte(int r, int c) { const int st = (r >> 4) * 2 + (c >> 5), rr = r & 15, cc = c & 31, ob = rr * 64 + cc * 2; return st * 1024 + (ob ^ (((ob >> 9) & 1) << 5)); }
__host__ __device__ __forceinline__ void stage_rc(int b, int& R, int& C) { const int st = b / 1024, sb = b % 1024, swz = sb ^ (((sb >> 9) & 1) << 5); R = (st >> 1) * 16 + swz / 64; C = (st & 1) * 32 + (swz % 64) / 2; }
__host__ __device__ __forceinline__ int perm32(int rho) { const int n = rho >> 4, i = rho & 15; return 8 * (i >> 2) + 4 * n + (i & 3); }

struct Unit { int pm, pn; };
struct Gemm { const bf16_t* A; const bf16_t* Bt; int M, N, K, lda, ldb; };

struct StaticOrder {
    int nM, nN, nwg, G, c, skip;
    __host__ __device__ void init(int M, int N, int G_, int c_, int skip_ = 0) { nM = M / BM; nN = N / BM; nwg = nM * nN; G = G_; c = c_; skip = skip_; }
    __host__ __device__ bool next(int i, Unit& u) const {
        const long L = (long)i * G + c; if (L >= nwg) return false;
        int wgid = (int)L; { const int q = nwg / NXCD, r = nwg % NXCD, xcd = wgid % NXCD, off = wgid / NXCD; wgid = (xcd < r ? xcd * (q + 1) : r * (q + 1) + (xcd - r) * q) + off; }
        const int nig = WGM * nN, gid = wgid / nig, fm = gid * WGM, gsz = (nM - fm) < WGM ? (nM - fm) : WGM;
        u.pm = fm + ((wgid % nig) % gsz); u.pn = (wgid % nig) / gsz; if (skip) u.pm += u.pm / 32; return true;
    }
    __device__ __forceinline__ void a_ready(const Unit&) const {}
    __device__ __forceinline__ void done(const Unit&) const {}
};

__device__ __forceinline__ unsigned cvt_pk_bf16(float lo, float hi) { unsigned r; asm volatile("v_cvt_pk_bf16_f32 %0, %1, %2" : "=v"(r) : "v"(lo), "v"(hi)); return r; }
__device__ __forceinline__ float fsigmoid(float x) { return __builtin_amdgcn_rcpf(1.f + __builtin_amdgcn_exp2f(-1.4426950408889634f * x)); }
__device__ __forceinline__ float bflo(unsigned w) { return __uint_as_float(w << 16); }
__device__ __forceinline__ float bfhi(unsigned w) { return __uint_as_float(w & 0xffff0000u); }
constexpr int TPB = 33;
constexpr int PWID = 4608;

struct EpiPlain {
    static constexpr bool PERM = true, AFTER_DRAIN = false;
    bf16_t* O; int ldc;
    __device__ __forceinline__ void operator()(const f32x4 (&acc)[2][2][4][2], const Unit& u, int wr, int wc, int fr, int fq) const {
        const int row0 = u.pm * BM + wr * 64 + fr, col0 = u.pn * BM + wc * 32 + 8 * fq;
#pragma unroll
        for (int ai = 0; ai < 2; ++ai)
#pragma unroll
            for (int m = 0; m < 4; ++m) { bf16_t* rowp = O + (size_t)(row0 + ai * HALF + m * 16) * ldc + col0;
#pragma unroll
                for (int bj = 0; bj < 2; ++bj) { const f32x4 v0 = acc[ai][bj][m][0], v1 = acc[ai][bj][m][1];
                    u32x4 w; w.x = cvt_pk_bf16(v0[0], v0[1]); w.y = cvt_pk_bf16(v0[2], v0[3]); w.z = cvt_pk_bf16(v1[0], v1[1]); w.w = cvt_pk_bf16(v1[2], v1[3]);
                    *(u32x4*)(rowp + bj * HALF) = w; } }
    }
};
struct EpiSwiglu {
    static constexpr bool PERM = true, AFTER_DRAIN = false;
    bf16_t* O; int ldc;
    __device__ __forceinline__ void operator()(const f32x4 (&acc)[2][2][4][2], const Unit& u, int wr, int wc, int fr, int fq) const {
        const int row0 = u.pm * BM + wr * 64 + fr, col0 = u.pn * HALF + wc * 32 + 8 * fq;
#pragma unroll
        for (int ai = 0; ai < 2; ++ai)
#pragma unroll
            for (int m = 0; m < 4; ++m) { bf16_t* rowp = O + (size_t)(row0 + ai * HALF + m * 16) * ldc + col0;
                float h[8];
#pragma unroll
                for (int n = 0; n < 2; ++n)
#pragma unroll
                    for (int k = 0; k < 4; ++k) { const float a = acc[ai][0][m][n][k], b = acc[ai][1][m][n][k]; h[n * 4 + k] = a * fsigmoid(a) * b; }
                u32x4 w; w.x = cvt_pk_bf16(h[0], h[1]); w.y = cvt_pk_bf16(h[2], h[3]); w.z = cvt_pk_bf16(h[4], h[5]); w.w = cvt_pk_bf16(h[6], h[7]);
                *(u32x4*)rowp = w; }
    }
};
template <int XNOUT, int GIDX, int HALFCOEF, int NSUB> struct EpiRes {
    static constexpr bool PERM = true, AFTER_DRAIN = false;
    const float* src_lat; const float* src_ctx; float* dst_lat; float* dst_ctx; const float* mod; const float* gnorm; bf16_t* xn; float* ssq;
    static constexpr int gidx = GIDX, nsub = NSUB; static constexpr float coef = HALFCOEF ? 0.5f : 1.0f;
    __device__ __forceinline__ void operator()(const f32x4 (&acc)[2][2][4][2], const Unit& u, int wr, int wc, int fr, int fq) const {
        asm volatile("" : "+v"(fr));
        const int b = u.pm / TPB, j = u.pm % TPB; const bool isctx = (j == TPB - 1);
        const float* src = isctx ? src_ctx + (size_t)b * 256 * 1024 : src_lat + (size_t)(b * 8192 + j * 256) * 1024;
        float* dst = isctx ? dst_ctx + (size_t)b * 256 * 1024 : dst_lat + (size_t)(b * 8192 + j * 256) * 1024;
        const float* mrow = mod + (size_t)(isctx ? 8 : b) * 9216;
        const float* g = mrow + gidx * 1024;
        const int col0 = u.pn * BM + wc * 32 + 8 * fq;
        f32x4 gv[2][2], gs[2][2];
#pragma unroll
        for (int bj = 0; bj < 2; ++bj)
#pragma unroll
            for (int n = 0; n < 2; ++n) { gv[bj][n] = *(const f32x4*)(g + col0 + bj * HALF + 4 * n) * coef;
                if (XNOUT) gs[bj][n] = *(const f32x4*)(gnorm + col0 + bj * HALF + 4 * n) * (*(const f32x4*)(mrow + (3 * nsub + 1) * 1024 + col0 + bj * HALF + 4 * n) + 1.f); }
#pragma unroll
        for (int ai = 0; ai < 2; ++ai)
#pragma unroll
            for (int m = 0; m < 4; ++m) { const int rl = ai * HALF + wr * 64 + m * 16 + fr; const size_t off = (size_t)rl * 1024 + col0; float sq = 0.f;
#pragma unroll
                for (int bj = 0; bj < 2; ++bj) { f32x4 o[2];
#pragma unroll
                    for (int n = 0; n < 2; ++n) { const f32x4 sv = *(const f32x4*)(src + off + bj * HALF + 4 * n); o[n] = sv + gv[bj][n] * acc[ai][bj][m][n];
                        if (!(XNOUT && isctx)) *(f32x4*)(dst + off + bj * HALF + 4 * n) = o[n]; }
                    if (XNOUT) { sq += (o[0][0] * o[0][0] + o[0][1] * o[0][1]) + (o[0][2] * o[0][2] + o[0][3] * o[0][3]) + (o[1][0] * o[1][0] + o[1][1] * o[1][1]) + (o[1][2] * o[1][2] + o[1][3] * o[1][3]);
                        const f32x4 x0 = o[0] * gs[bj][0], x1 = o[1] * gs[bj][1];
                        u32x4 w; w.x = cvt_pk_bf16(x0[0], x0[1]); w.y = cvt_pk_bf16(x0[2], x0[3]); w.z = cvt_pk_bf16(x1[0], x1[1]); w.w = cvt_pk_bf16(x1[2], x1[3]);
                        *(u32x4*)(xn + (size_t)(u.pm * BM + rl) * 1024 + col0 + bj * HALF) = w; } }
                if (XNOUT) { sq += __shfl_xor(sq, 16); sq += __shfl_xor(sq, 32); if (fq == 0) atomicAdd(ssq + u.pm * BM + rl, sq); }
                if (m & 1) asm volatile("" ::: "memory"); }
    }
};
struct EpiInproj {
    static constexpr bool PERM = true, AFTER_DRAIN = false;
    bf16_t* O; int ldc; const float* ssq; const float* sw; int swld;
    __device__ __forceinline__ void operator()(const f32x4 (&acc)[2][2][4][2], const Unit& u, int wr, int wc, int fr, int fq) const {
        const int row0 = u.pm * BM + wr * 64 + fr, col0 = u.pn * BM + wc * 32 + 8 * fq;
        const float* swr = sw + (size_t)((u.pm % TPB == TPB - 1) ? 8 : u.pm / TPB) * swld + col0;
        f32x4 sv[2][2];
#pragma unroll
        for (int bj = 0; bj < 2; ++bj)
#pragma unroll
            for (int n = 0; n < 2; ++n) sv[bj][n] = *(const f32x4*)(swr + bj * HALF + 4 * n);
#pragma unroll
        for (int ai = 0; ai < 2; ++ai)
#pragma unroll
            for (int m = 0; m < 4; ++m) { const int row = row0 + ai * HALF + m * 16; bf16_t* rowp = O + (size_t)row * ldc + col0;
                const float rstd = 1.f / sqrtf(ssq[row] * (1.f / 1024.f) + 1e-6f);
#pragma unroll
                for (int bj = 0; bj < 2; ++bj) { const f32x4 v0 = acc[ai][bj][m][0] * rstd + sv[bj][0], v1 = acc[ai][bj][m][1] * rstd + sv[bj][1];
                    u32x4 w; w.x = cvt_pk_bf16(v0[0], v0[1]); w.y = cvt_pk_bf16(v0[2], v0[3]); w.z = cvt_pk_bf16(v1[0], v1[1]); w.w = cvt_pk_bf16(v1[2], v1[3]);
                    *(u32x4*)(rowp + bj * HALF) = w; } }
    }
};
struct EpiSwigluN {
    static constexpr bool PERM = true, AFTER_DRAIN = false;
    bf16_t* O; int ldc; const float* ssq; const float* sw; int swld;
    __device__ __forceinline__ void operator()(const f32x4 (&acc)[2][2][4][2], const Unit& u, int wr, int wc, int fr, int fq) const {
        const int row0 = u.pm * BM + wr * 64 + fr, col0 = u.pn * HALF + wc * 32 + 8 * fq;
        const float* swr = sw + (size_t)((u.pm % TPB == TPB - 1) ? 8 : u.pm / TPB) * swld + u.pn * BM + wc * 32 + 8 * fq;
        f32x4 sv[2][2];
#pragma unroll
        for (int bj = 0; bj < 2; ++bj)
#pragma unroll
            for (int n = 0; n < 2; ++n) sv[bj][n] = *(const f32x4*)(swr + bj * HALF + 4 * n);
#pragma unroll
        for (int ai = 0; ai < 2; ++ai)
#pragma unroll
            for (int m = 0; m < 4; ++m) { const int row = row0 + ai * HALF + m * 16; bf16_t* rowp = O + (size_t)row * ldc + col0;
                const float rstd = 1.f / sqrtf(ssq[row] * (1.f / 1024.f) + 1e-6f);
                float h[8];
#pragma unroll
                for (int n = 0; n < 2; ++n)
#pragma unroll
                    for (int k = 0; k < 4; ++k) { const float a = acc[ai][0][m][n][k] * rstd + sv[0][n][k], b = acc[ai][1][m][n][k] * rstd + sv[1][n][k]; h[n * 4 + k] = a * fsigmoid(a) * b; }
                u32x4 w; w.x = cvt_pk_bf16(h[0], h[1]); w.y = cvt_pk_bf16(h[2], h[3]); w.z = cvt_pk_bf16(h[4], h[5]); w.w = cvt_pk_bf16(h[6], h[7]);
                *(u32x4*)rowp = w; }
    }
};
template <int SECOND> struct EpiGate {
    static constexpr bool PERM = true, AFTER_DRAIN = false;
    const bf16_t* P; const float* bgate; bf16_t* Z;
    __device__ __forceinline__ void operator()(const f32x4 (&acc)[2][2][4][2], const Unit& u, int wr, int wc, int fr, int fq) const {
        const int row0 = u.pm * BM + wr * 64 + fr, col0 = u.pn * BM + wc * 32 + 8 * fq;
        f32x4 bg[2][2];
#pragma unroll
        for (int bj = 0; bj < 2; ++bj)
#pragma unroll
            for (int n = 0; n < 2; ++n) bg[bj][n] = *(const f32x4*)(bgate + 1024 * SECOND + col0 + bj * HALF + 4 * n);
#pragma unroll
        for (int ai = 0; ai < 2; ++ai)
#pragma unroll
            for (int m = 0; m < 4; ++m) { const size_t row = (size_t)(row0 + ai * HALF + m * 16);
#pragma unroll
                for (int bj = 0; bj < 2; ++bj) { const int c = col0 + bj * HALF;
                    const u32x4 gr = *(const u32x4*)(P + row * PWID + 2304 + 1024 * SECOND + c);
                    float v[8];
                    v[0] = fsigmoid(bflo(gr.x) + bg[bj][0][0]) * acc[ai][bj][m][0][0]; v[1] = fsigmoid(bfhi(gr.x) + bg[bj][0][1]) * acc[ai][bj][m][0][1];
                    v[2] = fsigmoid(bflo(gr.y) + bg[bj][0][2]) * acc[ai][bj][m][0][2]; v[3] = fsigmoid(bfhi(gr.y) + bg[bj][0][3]) * acc[ai][bj][m][0][3];
                    v[4] = fsigmoid(bflo(gr.z) + bg[bj][1][0]) * acc[ai][bj][m][1][0]; v[5] = fsigmoid(bfhi(gr.z) + bg[bj][1][1]) * acc[ai][bj][m][1][1];
                    v[6] = fsigmoid(bflo(gr.w) + bg[bj][1][2]) * acc[ai][bj][m][1][2]; v[7] = fsigmoid(bfhi(gr.w) + bg[bj][1][3]) * acc[ai][bj][m][1][3];
                    bf16_t* zp = Z + row * 1024 + c;
                    if (SECOND) { const u32x4 zr = *(const u32x4*)zp;
                        v[0] += bflo(zr.x); v[1] += bfhi(zr.x); v[2] += bflo(zr.y); v[3] += bfhi(zr.y); v[4] += bflo(zr.z); v[5] += bfhi(zr.z); v[6] += bflo(zr.w); v[7] += bfhi(zr.w); }
                    u32x4 w; w.x = cvt_pk_bf16(v[0], v[1]); w.y = cvt_pk_bf16(v[2], v[3]); w.z = cvt_pk_bf16(v[4], v[5]); w.w = cvt_pk_bf16(v[6], v[7]);
                    *(u32x4*)zp = w; } }
    }
};
template <class Epi, class Sched, bool ALIGN_EPI = false, bool SP2 = false>
__device__ __forceinline__ void gemm_phase(PG8_LAS unsigned char* lds, const Gemm g, const Sched& S, const Epi& E) {
    const int tid = opaque_tid(), wid = __builtin_amdgcn_readfirstlane(tid >> 6), lane = tid & 63, wr = wid >> 2, wc = wid & 3, fr = lane & 15, fq = lane >> 4;
    const int K = g.K, nt = K / BK;
    unsigned voffA[2], voffB[2];
#pragma unroll
    for (int i = 0; i < 2; ++i) { int R, C; stage_rc(tid * 16 + i * 8192, R, C); const int Rb = Epi::PERM ? ((R & ~31) + perm32(R & 31)) : R;
        voffA[i] = (unsigned)(R * g.lda + C) * 2u; voffB[i] = (unsigned)(Rb * g.ldb + C) * 2u; }
    const size_t kstep = (size_t)(BK * 2);
    const size_t hstepA = (size_t)HALF * g.lda * 2, hstepB = (size_t)HALF * g.ldb * 2;
    const size_t tstepA = 2 * hstepA, tstepB = 2 * hstepB;
    const unsigned ldsw = (unsigned)wid * 1024u;
    const int aoff = lds_byte(wr * 64 + fr, fq * 8), boff = lds_byte(wc * 32 + fr, fq * 8);
#define PG8_SA(b, h) (((b) * 2 + (h)) * HTB)
#define PG8_SB(b, h) ((4 + (b) * 2 + (h)) * HTB)
#define PG8_STAGE(bufoff, gbase, voff) do { _Pragma("unroll") for (int _i = 0; _i < 2; ++_i) \
        __builtin_amdgcn_global_load_lds((const unsigned*)((const char*)(gbase) + (voff)[_i]), (PG8_LAS unsigned*)(lds + (bufoff) + ldsw + _i * 8192), 16, 0, 0); } while (0)
#define PG8_LDA(dst, b, h) do { _Pragma("unroll") for (int m = 0; m < 4; ++m) _Pragma("unroll") for (int k = 0; k < 2; ++k) dst[m][k] = *(const PG8_LAS bf16x8*)(lds + PG8_SA(b, h) + aoff + m * 2048 + k * 1024); } while (0)
#define PG8_LDB(dst, b, h) do { _Pragma("unroll") for (int n = 0; n < 2; ++n) _Pragma("unroll") for (int k = 0; k < 2; ++k) dst[n][k] = *(const PG8_LAS bf16x8*)(lds + PG8_SB(b, h) + boff + n * 2048 + k * 1024); } while (0)
#define PG8_MMA(ai, bj, At, Bt) do { __builtin_amdgcn_s_setprio(1); _Pragma("unroll") for (int m = 0; m < 4; ++m) _Pragma("unroll") for (int n = 0; n < 2; ++n) _Pragma("unroll") for (int k = 0; k < 2; ++k) \
        acc[ai][bj][m][n] = __builtin_amdgcn_mfma_f32_16x16x32_bf16(Bt[n][k], At[m][k], acc[ai][bj][m][n], 0, 0, 0); __builtin_amdgcn_s_setprio(0); } while (0)
#define PG8_WAIT_V(n) asm volatile("s_waitcnt vmcnt(" #n ")" ::: "memory")
#define PG8_WAIT_L(n) asm volatile("s_waitcnt lgkmcnt(" #n ")" ::: "memory")
#define PG8_BAR __builtin_amdgcn_s_barrier()
#define PG8_SCHED __builtin_amdgcn_sched_barrier(0)
    Unit cur, nxt; int ui = 0;
    if (!S.next(0, cur)) return;
    f32x4 acc[2][2][4][2];
#pragma unroll
    for (int a = 0; a < 2; ++a)
#pragma unroll
        for (int b = 0; b < 2; ++b)
#pragma unroll
            for (int m = 0; m < 4; ++m)
#pragma unroll
                for (int n = 0; n < 2; ++n) acc[a][b][m][n] = (f32x4){0.f, 0.f, 0.f, 0.f};
    bf16x8 At[4][2], B0[2][2], B1[2][2];
    const char* cA = (const char*)g.A + (size_t)cur.pm * tstepA; const char* cB = (const char*)g.Bt + (size_t)cur.pn * tstepB;
    S.a_ready(cur);
    if constexpr (SP2) {
        PG8_STAGE(PG8_SB(0, 0), cB, voffB); PG8_STAGE(PG8_SB(0, 1), cB + hstepB, voffB); PG8_STAGE(PG8_SA(0, 0), cA, voffA); PG8_STAGE(PG8_SA(0, 1), cA + hstepA, voffA);
        if (wr == 1) PG8_BAR;
        PG8_WAIT_V(2); PG8_BAR;
        PG8_STAGE(PG8_SB(1, 0), cB + kstep, voffB); PG8_STAGE(PG8_SA(1, 0), cA + kstep, voffA); PG8_STAGE(PG8_SB(1, 1), cB + hstepB + kstep, voffB);
        PG8_WAIT_V(6); PG8_BAR;
    } else {
        PG8_STAGE(PG8_SB(0, 0), cB, voffB); PG8_STAGE(PG8_SA(0, 0), cA, voffA); PG8_STAGE(PG8_SB(0, 1), cB + hstepB, voffB); PG8_STAGE(PG8_SA(0, 1), cA + hstepA, voffA);
        if (wr == 1) PG8_BAR;
        PG8_WAIT_V(4); PG8_BAR;
        PG8_STAGE(PG8_SB(1, 0), cB + kstep, voffB); PG8_STAGE(PG8_SA(1, 0), cA + kstep, voffA); PG8_STAGE(PG8_SB(1, 1), cB + hstepB + kstep, voffB);
        PG8_WAIT_V(6); PG8_BAR;
    }
    for (;;) {
        const bool has_next = S.next(ui + 1, nxt);
        const char* nA = has_next ? (const char*)g.A + (size_t)nxt.pm * tstepA : cA; const char* nB = has_next ? (const char*)g.Bt + (size_t)nxt.pn * tstepB : cB;
        for (int t = 0; t < nt; t += 2) {
            const bool last = (t == nt - 2);
            const char* a1 = cA + (size_t)(t + 1) * kstep;
            const char* a2 = last ? nA : cA + (size_t)(t + 2) * kstep; const char* b2 = last ? nB : cB + (size_t)(t + 2) * kstep;
            const char* a3 = a2 + kstep; const char* b3 = b2 + kstep;
            if (last && has_next) S.a_ready(nxt);
            if constexpr (SP2) {
            PG8_LDB(B0, 0, 0); PG8_LDB(B1, 0, 1); PG8_SCHED; PG8_LDA(At, 0, 0); PG8_STAGE(PG8_SA(1, 1), a1 + hstepA, voffA);
            PG8_WAIT_V(8); PG8_WAIT_L(0); PG8_BAR; PG8_MMA(0, 0, At, B0); PG8_MMA(0, 1, At, B1); PG8_BAR; PG8_SCHED;
            PG8_LDA(At, 0, 1); PG8_STAGE(PG8_SB(0, 0), b2, voffB); PG8_STAGE(PG8_SB(0, 1), b2 + hstepB, voffB); PG8_STAGE(PG8_SA(0, 0), a2, voffA);
            PG8_WAIT_V(8); PG8_WAIT_L(0); PG8_BAR; PG8_MMA(1, 0, At, B0); PG8_MMA(1, 1, At, B1); PG8_BAR; PG8_SCHED;
            PG8_LDB(B0, 1, 0); PG8_LDB(B1, 1, 1); PG8_SCHED; PG8_LDA(At, 1, 0); PG8_STAGE(PG8_SA(0, 1), a2 + hstepA, voffA);
            PG8_WAIT_V(8); PG8_WAIT_L(0); PG8_BAR; PG8_MMA(0, 0, At, B0); PG8_MMA(0, 1, At, B1); PG8_BAR; PG8_SCHED;
            PG8_LDA(At, 1, 1); PG8_STAGE(PG8_SB(1, 0), b3, voffB); PG8_STAGE(PG8_SB(1, 1), b3 + hstepB, voffB); PG8_STAGE(PG8_SA(1, 0), a3, voffA);
            PG8_WAIT_V(8); PG8_WAIT_L(0); PG8_BAR; PG8_MMA(1, 0, At, B0); PG8_MMA(1, 1, At, B1); PG8_BAR; PG8_SCHED;
            } else {
            PG8_LDB(B0, 0, 0); PG8_SCHED; PG8_LDA(At, 0, 0); PG8_STAGE(PG8_SA(1, 1), a1 + hstepA, voffA);
            PG8_WAIT_L(8); PG8_BAR; PG8_WAIT_L(0); PG8_MMA(0, 0, At, B0); PG8_BAR; PG8_SCHED;
            PG8_LDB(B1, 0, 1); PG8_STAGE(PG8_SB(0, 0), b2, voffB);
            PG8_BAR; PG8_WAIT_L(0); PG8_MMA(0, 1, At, B1); PG8_BAR;
            PG8_LDA(At, 0, 1); PG8_STAGE(PG8_SA(0, 0), a2, voffA);
            PG8_BAR; PG8_WAIT_L(0); PG8_MMA(1, 0, At, B0); PG8_BAR; PG8_SCHED;
            PG8_STAGE(PG8_SB(0, 1), b2 + hstepB, voffB);
            PG8_WAIT_V(6); PG8_BAR; PG8_MMA(1, 1, At, B1); PG8_BAR;
            PG8_LDB(B0, 1, 0); PG8_SCHED; PG8_LDA(At, 1, 0); PG8_STAGE(PG8_SA(0, 1), a2 + hstepA, voffA);
            PG8_WAIT_L(8); PG8_BAR; PG8_WAIT_L(0); PG8_MMA(0, 0, At, B0); PG8_BAR; PG8_SCHED;
            PG8_LDB(B1, 1, 1); PG8_STAGE(PG8_SB(1, 0), b3, voffB);
            PG8_BAR; PG8_WAIT_L(0); PG8_MMA(0, 1, At, B1); PG8_BAR;
            PG8_LDA(At, 1, 1); PG8_STAGE(PG8_SA(1, 0), a3, voffA);
            PG8_BAR; PG8_WAIT_L(0); PG8_MMA(1, 0, At, B0); PG8_BAR; PG8_SCHED;
            PG8_STAGE(PG8_SB(1, 1), b3 + hstepB, voffB);
            PG8_WAIT_V(6); PG8_BAR; PG8_MMA(1, 1, At, B1); PG8_BAR;
            }
        }
        if constexpr (ALIGN_EPI) { if (wr == 0) PG8_BAR; }
        if constexpr (!Epi::AFTER_DRAIN) { E(acc, cur, wr, wc, fr, fq); S.done(cur); }
        if (!has_next) break;
#pragma unroll
        for (int a = 0; a < 2; ++a)
#pragma unroll
            for (int b = 0; b < 2; ++b)
#pragma unroll
                for (int m = 0; m < 4; ++m)
#pragma unroll
                    for (int n = 0; n < 2; ++n) acc[a][b][m][n] = (f32x4){0.f, 0.f, 0.f, 0.f};
        cur = nxt; cA = nA; cB = nB; ++ui;
        if constexpr (ALIGN_EPI) { if (wr == 1) PG8_BAR; }
    }
    PG8_WAIT_V(0);
    if constexpr (!ALIGN_EPI) { if (wr == 0) PG8_BAR; }
    PG8_BAR;
    if constexpr (Epi::AFTER_DRAIN) { E.fused(acc, cur, wr, wc, fr, fq, lds, wid, lane); S.done(cur); }
#undef PG8_SA
#undef PG8_SB
#undef PG8_STAGE
#undef PG8_LDA
#undef PG8_LDB
#undef PG8_MMA
#undef PG8_WAIT_V
#undef PG8_WAIT_L
#undef PG8_BAR
#undef PG8_SCHED
}
}
#include <hip/hip_bf16.h>
#include <cmath>
namespace attn_body {
using bf16=__hip_bfloat16;
using bf16x8=__attribute__((ext_vector_type(8)))short;
using s16x4=__attribute__((ext_vector_type(4)))short;
using f32x16=__attribute__((ext_vector_type(16)))float;
using u32x4=__attribute__((ext_vector_type(4)))unsigned;
constexpr int SEQ=8448,D=64,DM=4608,NTILES=132;
constexpr int NW=8,QBLK=32,QB=QBLK*NW,KVBLK=64;
constexpr int ATTN_PITCH=DM, ATTN_UNIT_ROWS=QB;
__device__ __forceinline__ int crow(int r,int hi){return (r&3)+8*(r>>2)+4*hi;}
#define SBAR() __builtin_amdgcn_sched_barrier(0)
__device__ __forceinline__ void cmask(f32x16&p0,f32x16&p1,int jb,int qrel,int hi){
  const float NEG=-INFINITY; int kb=64*jb+4*hi;
  #pragma unroll
  for(int r=0;r<16;++r){int kv=kb+(r&3)+8*(r>>2); if(kv>qrel)p0[r]=NEG; if(kv+32>qrel)p1[r]=NEG;}
}

constexpr int NSLOT=3, SLOTB=8192;
constexpr int LDS_K=0, LDS_V=NSLOT*SLOTB, LDS_WS=2*NSLOT*SLOTB, LDS_OST=LDS_WS+NW*64*4, LDS_BYTES=LDS_OST+NW*4096;
constexpr float C2=0.125f*1.4426950408889634f;
__device__ __forceinline__ void glds16(const void*gsrc,unsigned lds_dst){unsigned keep;
  asm volatile("s_mov_b32 %0, m0\n\ts_mov_b32 m0, %2\n\ts_nop 0\n\tglobal_load_lds_dwordx4 %1, off\n\ts_mov_b32 m0, %0":"=&s"(keep):"v"(gsrc),"s"(lds_dst):"memory");}
__device__ __forceinline__ float max3f(float a,float b,float c){float r;asm("v_max3_f32 %0, %1, %2, %3":"=v"(r):"v"(a),"v"(b),"v"(c));return r;}
__device__ __forceinline__ float max2f(float a,float b){float r;asm("v_max_f32_e32 %0, %1, %2":"=v"(r):"v"(a),"v"(b));return r;}
__device__ __forceinline__ float fadd_s(float a,float b){float r;asm("v_add_f32_e32 %0, %1, %2":"=v"(r):"v"(a),"v"(b));return r;}
__device__ __forceinline__ float fsub_s(float a,float b){float r;asm("v_sub_f32_e32 %0, %1, %2":"=v"(r):"v"(a),"v"(b));return r;}
typedef float f32x2_t __attribute__((ext_vector_type(2))); typedef __bf16 bf16x2_t __attribute__((ext_vector_type(2)));
__device__ __forceinline__ unsigned cvtpk_s(float lo,float hi){f32x2_t v={lo,hi};bf16x2_t b=__builtin_convertvector(v,bf16x2_t);return __builtin_bit_cast(unsigned,b);}
#define WAIT_BAR(N) asm volatile("s_waitcnt vmcnt(" #N ") lgkmcnt(0)\n\ts_barrier":::"memory")

__device__ __forceinline__ void qkt(f32x16&p0,f32x16&p1,const char*Kslot,const bf16x8*qr,const f32x16&negm,int r32,int hi){
  const char*kb=Kslot+hi*1024+r32*16;
  #pragma unroll
  for(int d0=0;d0<4;++d0){
    const bf16x8 b0=*reinterpret_cast<const bf16x8*>(kb+d0*2048);
    const bf16x8 b1=*reinterpret_cast<const bf16x8*>(kb+d0*2048+512);
    if(d0==0){p0=__builtin_amdgcn_mfma_f32_32x32x16_bf16(b0,qr[0],negm,0,0,0);p1=__builtin_amdgcn_mfma_f32_32x32x16_bf16(b1,qr[0],negm,0,0,0);}
    else{p0=__builtin_amdgcn_mfma_f32_32x32x16_bf16(b0,qr[d0],p0,0,0,0);p1=__builtin_amdgcn_mfma_f32_32x32x16_bf16(b1,qr[d0],p1,0,0,0);}}
}
typedef __attribute__((address_space(3))) const char* lds_cptr;
typedef short v4i16_t __attribute__((ext_vector_type(4)));
__device__ __forceinline__ void kload8(bf16x8*kf,lds_cptr kp){
  kf[0]=*(const __attribute__((address_space(3))) bf16x8*)(kp);      kf[1]=*(const __attribute__((address_space(3))) bf16x8*)(kp+512);
  kf[2]=*(const __attribute__((address_space(3))) bf16x8*)(kp+2048); kf[3]=*(const __attribute__((address_space(3))) bf16x8*)(kp+2560);
  kf[4]=*(const __attribute__((address_space(3))) bf16x8*)(kp+4096); kf[5]=*(const __attribute__((address_space(3))) bf16x8*)(kp+4608);
  kf[6]=*(const __attribute__((address_space(3))) bf16x8*)(kp+6144); kf[7]=*(const __attribute__((address_space(3))) bf16x8*)(kp+6656);
}
__device__ __forceinline__ void kload2(bf16x8*kf,lds_cptr kp,int j){ kf[2*j]=*(const __attribute__((address_space(3))) bf16x8*)(kp+j*2048); kf[2*j+1]=*(const __attribute__((address_space(3))) bf16x8*)(kp+j*2048+512); }
__device__ __forceinline__ s16x4 vtr(lds_cptr p){ return __builtin_bit_cast(s16x4,__builtin_amdgcn_ds_read_tr16_b64_v4i16((__attribute__((address_space(3))) v4i16_t*)p)); }
__device__ __forceinline__ float rowmax(const f32x16&p0,const f32x16&p1){
  float a=max3f(p0[0],p0[1],p1[0]),b=max3f(p0[2],p0[3],p1[1]);a=max3f(a,p1[2],p1[3]);
  #pragma unroll
  for(int r=4;r<16;r+=4){a=max3f(a,p0[r],p0[r+1]);b=max3f(b,p0[r+2],p0[r+3]);a=max3f(a,p1[r],p1[r+1]);b=max3f(b,p1[r+2],p1[r+3]);}
  const float m=max2f(a,b);
  auto rr=__builtin_amdgcn_permlane32_swap(__float_as_uint(m),__float_as_uint(m),false,false);
  return max2f(__uint_as_float(rr[0]),__uint_as_float(rr[1]));
}
__device__ __forceinline__ void pv(f32x16*o,int vb,bf16x8 pa0,bf16x8 pa1,bf16x8 pa2,bf16x8 pa3){
  #pragma unroll
  for(int d0=0;d0<2;++d0){s16x4 lo[4],hi[4];
    #pragma unroll
    for(int ks=0;ks<4;++ks){
      asm volatile("ds_read_b64_tr_b16 %0,%1 offset:%c2":"=&v"(lo[ks]):"v"(vb),"i"(d0*4096+ks*1024):"memory");
      asm volatile("ds_read_b64_tr_b16 %0,%1 offset:%c2":"=&v"(hi[ks]):"v"(vb),"i"(d0*4096+ks*1024+512):"memory");}
    asm volatile("s_waitcnt lgkmcnt(0)":::"memory");SBAR();
    #define PK(k) (bf16x8){lo[k][0],lo[k][1],lo[k][2],lo[k][3],hi[k][0],hi[k][1],hi[k][2],hi[k][3]}
    o[d0]=__builtin_amdgcn_mfma_f32_32x32x16_bf16(pa0,PK(0),o[d0],0,0,0);
    o[d0]=__builtin_amdgcn_mfma_f32_32x32x16_bf16(pa1,PK(1),o[d0],0,0,0);
    o[d0]=__builtin_amdgcn_mfma_f32_32x32x16_bf16(pa2,PK(2),o[d0],0,0,0);
    o[d0]=__builtin_amdgcn_mfma_f32_32x32x16_bf16(pa3,PK(3),o[d0],0,0,0);
    #undef PK
  }
}

#ifndef ATTN_STORE16
#define ATTN_STORE16(p,v) (*(u32x4*)(p)=(v))
#endif
template<int THRL,bool NOMAX> __device__ __forceinline__ void attn_unit(int b,int h,int hk,int qb,const bf16*Q,const bf16*__restrict__ K,const bf16*__restrict__ V,bf16*O,char*shm){
  const int tid=opaque_tid(),lane=tid&63,r32=lane&31,hi=lane>>5; const int wid=__builtin_amdgcn_readfirstlane(tid>>6);
  const long rowbase=(long)b*SEQ; const int q0=qb*QB;
  const bf16*Qw=Q+(rowbase+q0+wid*QBLK)*DM+h*D;
  const bf16*Kh=K+rowbase*DM+hk*D,*Vh=V+rowbase*DM+hk*D;
  const unsigned lds0=(unsigned)(uintptr_t)shm;
  float*wsf=(float*)(shm+LDS_WS)+wid*64;
  const bf16*ksrc=Kh+(long)lane*DM+wid*8;
  const bf16*vsrc=Vh+(long)(16*(wid&3)+(lane>>2))*DM+(wid>>2)*32+(lane&3)*8;
  const unsigned kdst=lds0+LDS_K+wid*1024, vdst=lds0+LDS_V+wid*1024;
  #define DMA_K(t,slot) glds16(ksrc+(long)(t)*KVBLK*DM,(unsigned)__builtin_amdgcn_readfirstlane(kdst+(slot)))
  #define DMA_V(t,slot) glds16(vsrc+(long)(t)*KVBLK*DM,(unsigned)__builtin_amdgcn_readfirstlane(vdst+(slot)))
  const int vb0=(int)(lds0+LDS_V)+((lane>>4)&1)*32+(lane&3)*8+(4*hi+((lane&15)>>2))*64;
  const char*Kbase=shm+LDS_K; bf16x8 kf[8];
  const lds_cptr shm3=(lds_cptr)shm; const lds_cptr kp0=shm3+LDS_K+hi*1024+r32*16; const lds_cptr vp0=shm3+LDS_V+((lane>>4)&1)*32+(lane&3)*8+(4*hi+((lane&15)>>2))*64;
  constexpr int NT=NTILES;
  DMA_K(0,0);DMA_V(0,0);DMA_K(1,SLOTB);
  bf16x8 qr[4];
  #pragma unroll
  for(int d0=0;d0<4;++d0)qr[d0]=*reinterpret_cast<const bf16x8*>(&Qw[(long)r32*DM+d0*16+hi*8]);
  float mhat=0.f,l_reg=0.f;f32x16 o[2];o[0]=f32x16{};o[1]=f32x16{};f32x16 negm=f32x16{};asm volatile("":"+v"(negm));
  #define CMASK(P0,P1,t) do{}while(0)
  bool resc=false;
  #define START(P0,P1) do{ const float rm=rowmax(P0,P1); resc=false; \
    { const float dl=rm; mhat=fadd_s(mhat,dl); \
      _Pragma("unroll") for(int r=0;r<16;++r){P0[r]=fsub_s(P0[r],dl);P1[r]=fsub_s(P1[r],dl);} \
      _Pragma("unroll") for(int r=0;r<16;++r)negm[r]=-mhat; asm volatile("":"+v"(negm)); } \
    _Pragma("unroll") for(int r=0;r<16;++r)P0[r]=__builtin_amdgcn_exp2f(P0[r]); }while(0)
  #define RESC() do{ if(resc){ asm volatile("s_waitcnt lgkmcnt(0)":::"memory"); \
      _Pragma("unroll") for(int d_=0;d_<2;++d_) _Pragma("unroll") for(int r=0;r<16;++r)o[d_][r]*=wsf[crow(r,hi)]; } }while(0)
  f32x16 pA0,pA1,pB0,pB1;
  int sl_prev=0,sl_cur=0,sl_next=SLOTB;
  #define ROT() do{sl_prev=sl_cur;sl_cur=sl_next;sl_next=(sl_next==(NSLOT-1)*SLOTB)?0:sl_next+SLOTB;}while(0)
  DMA_K(2,2*SLOTB);
  WAIT_BAR(3);
  qkt(pA0,pA1,Kbase,qr,negm,r32,hi);asm volatile("s_nop 15\n\ts_nop 7":"+v"(pA0),"+v"(pA1));CMASK(pA0,pA1,0);
  START(pA0,pA1);
  _Pragma("unroll") for(int r=0;r<16;++r)pA1[r]=__builtin_amdgcn_exp2f(pA1[r]);
  WAIT_BAR(0);
  DMA_K(3,0);DMA_V(1,SLOTB);
  ROT();
  kload8(kf,kp0+sl_cur);
  WAIT_BAR(2);
  s16x4 vlo[8],vhi[8]; u32x4 pw0,pw1,pw2,pw3;
  #define PKW(P,B) cvtpk_s(P[B],P[B+1])
  #define PAF(k) __builtin_bit_cast(bf16x8,pw##k)
  #define VFR(i) (bf16x8){vlo[i][0],vlo[i][1],vlo[i][2],vlo[i][3],vhi[i][0],vhi[i][1],vhi[i][2],vhi[i][3]}
  #define PIN(x) asm volatile("":"+v"(x))
  #define MX3(a,b,c) __builtin_fmaxf(__builtin_fmaxf((a),(b)),(c))
  #define GAPA(MF,A0,A1,A2,A3,W0,W1,PW) do{ MF; sacc+=A0; sacc+=A1; sacc+=A2; sacc+=A3; PIN(sacc); W0; W1; PIN(PW); SBAR(); }while(0)
  #define EX(v) __builtin_amdgcn_exp2f(v)
  #define GAPB(MF,X,B) do{ MF; X[B]=EX(X[B]); X[B+1]=EX(X[B+1]); X[B+2]=EX(X[B+2]); X[B+3]=EX(X[B+3]); PIN(X); SBAR(); }while(0)
  #define VRD(i) do{ vlo[i]=vtr(vp_+(((i)>>2)*4096+((i)&3)*1024)); vhi[i]=vtr(vp_+(((i)>>2)*4096+((i)&3)*1024+512)); }while(0)
  #define KRD(G,j) do{ if(G){ kload2(kf,kp0+sl_next,j); SBAR(); } }while(0)
  #define STEP(C0,C1,P0,P1,t,GK,GV,GL) do{ SBAR(); \
    const lds_cptr vp_=vp0+sl_prev; \
    VRD(0); SBAR(); float sacc=(P0[0]+P0[1]); \
    GAPA(C0=__builtin_amdgcn_mfma_f32_32x32x16_bf16(kf[0],qr[0],negm,0,0,0), P0[2],P0[3],P0[4],P0[5],     pw0[0]=PKW(P0,0), pw0[1]=PKW(P0,2), pw0); \
    VRD(4); SBAR(); GAPA(C1=__builtin_amdgcn_mfma_f32_32x32x16_bf16(kf[1],qr[0],negm,0,0,0), P0[6],P0[7],P0[8],P0[9],     pw0[2]=PKW(P0,4), pw0[3]=PKW(P0,6), pw0); \
    VRD(1); SBAR(); GAPA(C0=__builtin_amdgcn_mfma_f32_32x32x16_bf16(kf[2],qr[1],C0,0,0,0),   P0[10],P0[11],P0[12],P0[13], pw1[0]=PKW(P0,8), pw1[1]=PKW(P0,10), pw1); \
    VRD(5); SBAR(); GAPA(C1=__builtin_amdgcn_mfma_f32_32x32x16_bf16(kf[3],qr[1],C1,0,0,0),   P0[14],P0[15],P1[0],P1[1],   pw1[2]=PKW(P0,12),pw1[3]=PKW(P0,14), pw1); \
    VRD(2); SBAR(); GAPA(C0=__builtin_amdgcn_mfma_f32_32x32x16_bf16(kf[4],qr[2],C0,0,0,0),   P1[2],P1[3],P1[4],P1[5],     pw2[0]=PKW(P1,0), pw2[1]=PKW(P1,2), pw2); \
    VRD(6); SBAR(); GAPA(C1=__builtin_amdgcn_mfma_f32_32x32x16_bf16(kf[5],qr[2],C1,0,0,0),   P1[6],P1[7],P1[8],P1[9],     pw2[2]=PKW(P1,4), pw2[3]=PKW(P1,6), pw2); \
    VRD(3); SBAR(); GAPA(C0=__builtin_amdgcn_mfma_f32_32x32x16_bf16(kf[6],qr[3],C0,0,0,0),   P1[10],P1[11],P1[12],P1[13], pw3[0]=PKW(P1,8), pw3[1]=PKW(P1,10), pw3); \
    VRD(7); SBAR(); GAPA(C1=__builtin_amdgcn_mfma_f32_32x32x16_bf16(kf[7],qr[3],C1,0,0,0),   P1[14],P1[15],0.f,0.f,       pw3[2]=PKW(P1,12),pw3[3]=PKW(P1,14), pw3); \
    l_reg+=sacc; \
    if(GK){DMA_K((t)+3,sl_cur);} if(GV){DMA_V((t)+1,sl_next);} \
    CMASK(C0,C1,t); \
    if constexpr(!NOMAX){ float a=MX3(C0[0],C0[1],C1[0]),b=MX3(C0[2],C0[3],C1[1]); a=MX3(a,C1[2],C1[3]); \
      _Pragma("unroll") for(int r=4;r<16;r+=4){a=MX3(a,C0[r],C0[r+1]);b=MX3(b,C0[r+2],C0[r+3]);a=MX3(a,C1[r],C1[r+1]);b=MX3(b,C1[r+2],C1[r+3]);} \
      float rm=__builtin_fmaxf(a,b); { auto rr=__builtin_amdgcn_permlane32_swap(__float_as_uint(rm),__float_as_uint(rm),false,false); rm=__builtin_fmaxf(__uint_as_float(rr[0]),__uint_as_float(rr[1])); } \
      resc=false; \
      if(__builtin_expect(__any(rm>(float)THRL),0)){ const float dl=__builtin_fmaxf(rm,0.f); mhat+=dl; \
        _Pragma("unroll") for(int r=0;r<16;++r){C0[r]-=dl;C1[r]-=dl;} \
        _Pragma("unroll") for(int r=0;r<16;++r)negm[r]=-mhat; asm volatile("":"+v"(negm)); \
        const float f=__builtin_amdgcn_exp2f(-dl); l_reg*=f; if(hi==0)wsf[r32]=f; resc=true; } } \
    SBAR(); \
    GAPB(o[0]=__builtin_amdgcn_mfma_f32_32x32x16_bf16(PAF(0),VFR(0),o[0],0,0,0), C0,0); \
    GAPB(o[1]=__builtin_amdgcn_mfma_f32_32x32x16_bf16(PAF(0),VFR(4),o[1],0,0,0), C0,4); \
    KRD(GL,0); GAPB(o[0]=__builtin_amdgcn_mfma_f32_32x32x16_bf16(PAF(1),VFR(1),o[0],0,0,0), C0,8); \
    KRD(GL,1); GAPB(o[1]=__builtin_amdgcn_mfma_f32_32x32x16_bf16(PAF(1),VFR(5),o[1],0,0,0), C0,12); \
    KRD(GL,2); GAPB(o[0]=__builtin_amdgcn_mfma_f32_32x32x16_bf16(PAF(2),VFR(2),o[0],0,0,0), C1,0); \
    KRD(GL,3); GAPB(o[1]=__builtin_amdgcn_mfma_f32_32x32x16_bf16(PAF(2),VFR(6),o[1],0,0,0), C1,4); \
    GAPB(o[0]=__builtin_amdgcn_mfma_f32_32x32x16_bf16(PAF(3),VFR(3),o[0],0,0,0), C1,8); \
    GAPB(o[1]=__builtin_amdgcn_mfma_f32_32x32x16_bf16(PAF(3),VFR(7),o[1],0,0,0), C1,12); \
    }while(0)
  int t=1;
  #undef CMASK
  #define CMASK(P0,P1,t) do{}while(0)
  for(;t+5<NT;t+=2){
    STEP(pB0,pB1,pA0,pA1,t,true,true,true);     WAIT_BAR(2); RESC(); ROT();
    STEP(pA0,pA1,pB0,pB1,t+1,true,true,true);   WAIT_BAR(2); RESC(); ROT();
  }
  #undef CMASK
  #define CMASK(P0,P1,t) do{}while(0)
  #define ENDW(tt) do{ if((tt)+3<NT){WAIT_BAR(2);} else if((tt)+2<NT){WAIT_BAR(1);} else {WAIT_BAR(0);} }while(0)
  for(;t+1<NT;t+=2){
    STEP(pB0,pB1,pA0,pA1,t,(t+3<NT),(t+1<NT),(t+1<NT));       ENDW(t);   RESC(); ROT();
    STEP(pA0,pA1,pB0,pB1,t+1,(t+4<NT),(t+2<NT),(t+2<NT));     ENDW(t+1); RESC(); ROT();
  }
  STEP(pB0,pB1,pA0,pA1,NT-1,false,false,false); RESC();
  { float sacc=pB0[0]+pB0[1]; _Pragma("unroll") for(int r=2;r<16;++r)sacc+=pB0[r]; _Pragma("unroll") for(int r=0;r<16;++r)sacc+=pB1[r]; l_reg+=sacc;
    pw0=(u32x4){PKW(pB0,0),PKW(pB0,2),PKW(pB0,4),PKW(pB0,6)};pw1=(u32x4){PKW(pB0,8),PKW(pB0,10),PKW(pB0,12),PKW(pB0,14)};pw2=(u32x4){PKW(pB1,0),PKW(pB1,2),PKW(pB1,4),PKW(pB1,6)};pw3=(u32x4){PKW(pB1,8),PKW(pB1,10),PKW(pB1,12),PKW(pB1,14)};
    SBAR(); pv(o,vb0+sl_cur,PAF(0),PAF(1),PAF(2),PAF(3)); }
  #undef PKW
  #undef PAF
  #undef VFR
  #undef PIN
  #undef MX3
  #undef GAPA
  #undef GAPB
  #undef EX
  #undef VRD
  #undef KRD
  #undef STEP
  #undef ENDW
  {auto rr=__builtin_amdgcn_permlane32_swap(__float_as_uint(l_reg),__float_as_uint(l_reg),false,false);l_reg=__uint_as_float(rr[0])+__uint_as_float(rr[1]);}
  if(hi==0)wsf[32+r32]=l_reg;asm volatile("s_waitcnt lgkmcnt(0)":::"memory");
  float rli[16];
  #pragma unroll
  for(int r=0;r<16;++r)rli[r]=__builtin_amdgcn_rcpf(wsf[32+crow(r,hi)]);
  bf16*Ow=O+(rowbase+q0+wid*QBLK)*DM+h*D;
  { bf16*stg=(bf16*)(shm+LDS_OST)+wid*2048;
    #pragma unroll
    for(int r=0;r<16;++r){const int orow=crow(r,hi);
      #pragma unroll
      for(int d0=0;d0<2;++d0)stg[orow*64+d0*32+r32]=__float2bfloat16(o[d0][r]*rli[r]);}
    asm volatile("s_waitcnt lgkmcnt(0)":::"memory");
    #pragma unroll
    for(int i=0;i<4;++i){const int row=i*8+(lane>>3),ch=lane&7; const u32x4 v=*(const u32x4*)(stg+row*64+ch*8); ATTN_STORE16(Ow+(long)row*DM+ch*8,v);} }
  asm volatile("s_waitcnt lgkmcnt(0)\n\ts_barrier":::"memory");
  #undef DMA_K
  #undef DMA_V
  #undef CMASK
  #undef START
  #undef RESC
  #undef ROT
}
constexpr int ATTN_LDS_BYTES=LDS_BYTES;
#undef SBAR
#undef WAIT_BAR
}
#include <hip/hip_cooperative_groups.h>
namespace cg = cooperative_groups;
#define LAS __attribute__((address_space(3)))
typedef unsigned short bf16;
typedef unsigned v4u __attribute__((ext_vector_type(4)));
typedef unsigned v2u __attribute__((ext_vector_type(2)));
typedef float f32x4 __attribute__((ext_vector_type(4)));
typedef short bf16x8 __attribute__((ext_vector_type(8)));

#define XB_TMO      128
#define XB_XCNT(j)  (256  + 64 * (j))
#define XB_XSUB(j)  (1280 + 64 * (j))
#define XB_XGEN(j)  (2304 + 64 * (j))
#define XB_TOP      3328
#define XB_TOPGEN   3392
#define XCD_BAR_WORDS 3456
#define XB_SPIN_CAP (1u << 18)

__device__ __forceinline__ unsigned xb_ld(unsigned* p)              { return __hip_atomic_load(p, __ATOMIC_RELAXED, __HIP_MEMORY_SCOPE_AGENT); }
__device__ __forceinline__ unsigned xb_add(unsigned* p, unsigned v) { return __hip_atomic_fetch_add(p, v, __ATOMIC_RELAXED, __HIP_MEMORY_SCOPE_AGENT); }
__device__ __forceinline__ unsigned xb_xcc_id() { return (unsigned)__builtin_amdgcn_s_getreg((3 << 11) | 20) & 0xFu; }
#define XB_SPIN(cond, bar) do { unsigned _sp = 0; while (cond) { __builtin_amdgcn_s_sleep(1); \
    if ((++_sp & 255u) == 0u) { if (xb_ld(&(bar)[XB_TMO])) break; if (_sp > XB_SPIN_CAP) { atomicAdd(&(bar)[XB_TMO], 1u); break; } } } } while (0)

struct XcdBarrier {
    unsigned* bar; unsigned x;
    volatile LAS unsigned* st;
};

__device__ __forceinline__ XcdBarrier xcd_barrier_post(unsigned* bar, volatile LAS unsigned* st) {
    XcdBarrier b; b.bar = bar; b.x = xb_xcc_id(); b.st = st;
    if (threadIdx.x == 0) (void)xb_add(&bar[XB_XCNT(b.x)], 1u);
    return b;
}
__device__ __forceinline__ void xcd_barrier_complete(unsigned* bar, unsigned x, unsigned& nloc, unsigned& nx) {
    const unsigned G = gridDim.x * gridDim.y * gridDim.z;
    unsigned sum, cnt, mine, sp = 0u;
    for (;;) {
        sum = 0u; cnt = 0u; mine = 0u;
#pragma unroll
        for (unsigned j = 0; j < 16; ++j) { const unsigned c = xb_ld(&bar[XB_XCNT(j)]); sum += c; cnt += (c > 0u) ? 1u : 0u; mine = (j == x) ? c : mine; }
        if (sum == G) break;
        __builtin_amdgcn_s_sleep(1);
        if ((++sp & 255u) == 0u) { if (xb_ld(&bar[XB_TMO])) break; if (sp > XB_SPIN_CAP) { atomicAdd(&bar[XB_TMO], 1u); break; } }
    }
    nloc = mine > 0u ? mine : 1u; nx = cnt > 0u ? cnt : 1u;
}

__device__ __forceinline__ void xcd_barrier(const XcdBarrier& b) {
    asm volatile("s_waitcnt vmcnt(0)" ::: "memory");
    __syncthreads();
    if (threadIdx.x == 0) {
        unsigned* bar = b.bar;
        __builtin_amdgcn_s_waitcnt(0);
        unsigned nloc = b.st[0], nx = b.st[1];
        if (nloc == 0u) { xcd_barrier_complete(bar, b.x, nloc, nx); b.st[0] = nloc; b.st[1] = nx; }
        const unsigned old = xb_add(&bar[XB_XSUB(b.x)], 1u);
        const unsigned gen = old / nloc;
        if (old + 1u == (gen + 1u) * nloc) {
            __builtin_amdgcn_fence(__ATOMIC_RELEASE, "agent");
            asm volatile("s_waitcnt vmcnt(0)" ::: "memory");
            const unsigned og = xb_add(&bar[XB_TOP], 1u);
            const unsigned tg = og / nx;
            if (og + 1u == (tg + 1u) * nx) xb_add(&bar[XB_TOPGEN], 1u);
            else XB_SPIN(xb_ld(&bar[XB_TOPGEN]) == tg, bar);
            __builtin_amdgcn_fence(__ATOMIC_ACQUIRE, "agent");
            xb_add(&bar[XB_XGEN(b.x)], 1u);
            asm volatile("s_waitcnt vmcnt(0)" ::: "memory");
        } else {
            XB_SPIN(xb_ld(&bar[XB_XGEN(b.x)]) == gen, bar);
            __builtin_amdgcn_fence(__ATOMIC_ACQUIRE, "agent");
            asm volatile("s_waitcnt vmcnt(0)" ::: "memory");
        }
    }
    __syncthreads();
}

constexpr int NB = 8, TL = 8192, TC = 256, TB = TL + TC  , MR = NB * TB  , DM = 1024, DFF = 2816, PW = 4608, NMOD = 9216;
constexpr float EPS = 1e-6f;
constexpr int LDS_BYTES = 147456, NTHR = 512, NWAVES = 8;
constexpr int PC_Q = 0, PC_K = 512, PC_V = 640, PC_GQ = 768, PC_GK = 1024, PC_GV = 1280, PC_G6 = 1792, PC_GATE = 2304, PC_LOW = 4352;
constexpr int GLA_S = 132, GLA_ITEMS = 64 * GLA_S;
constexpr size_t MiB = 1u << 20;
constexpr size_t WS_SSQ1 = 5 * MiB, WS_SSQ2 = 5 * MiB + 512 * 1024, WS_SW1 = 6 * MiB, WS_SW2 = 6 * MiB + 512 * 1024;
constexpr size_t WS_MOD = 1 * MiB, WS_DN = 2 * MiB, WS_WUP1 = 8 * MiB, WS_WUP2 = 20 * MiB, WS_WDN1 = 32 * MiB, WS_WDN2 = 38 * MiB, WS_WIN = 44 * MiB, WS_WBR0 = 54 * MiB, WS_WBR1 = 55 * MiB, WS_WOUT = 56 * MiB,
                 WS_HCTX = 64 * MiB, WS_XN = 72 * MiB, WS_OF = 204 * MiB, WS_OB = 270 * MiB, WS_A = 336 * MiB, WS_END = 932 * MiB;
static_assert(WS_XN + (size_t)MR * DM * 2 <= WS_OF && WS_OF + (size_t)MR * 512 * 2 <= WS_OB && WS_OB + (size_t)MR * 512 * 2 <= WS_A && WS_A + (size_t)MR * PW * 2 <= WS_END, "ws map");
static_assert((size_t)GLA_ITEMS * 8192 * 2 <= (size_t)MR * DM * 2 && WS_DN + (size_t)GLA_ITEMS * 64 * 4 <= WS_WUP1, "gla ws");

__device__ __forceinline__ unsigned f2bf(float f) { unsigned u = __builtin_bit_cast(unsigned, f); return (u + 0x7fffu + ((u >> 16) & 1u)) >> 16; }
typedef float pk_f32x2 __attribute__((ext_vector_type(2))); typedef __bf16 pk_bf16x2 __attribute__((ext_vector_type(2)));
__device__ __forceinline__ unsigned pk2(float lo, float hi) { const pk_f32x2 v = {lo, hi}; return __builtin_bit_cast(unsigned, __builtin_convertvector(v, pk_bf16x2)); }
__device__ __forceinline__ float bf2f(unsigned short h) { return __uint_as_float(((unsigned)h) << 16); }
__device__ __forceinline__ float wave_sum(float v) {
#pragma unroll
    for (int o = 1; o < 64; o <<= 1) v += __shfl_xor(v, o);
    return v;
}
__device__ __forceinline__ float silu_f(float v) { return v / (1.f + __expf(-v)); }

__device__ __forceinline__ void transpose_item(const float* W, int K, int N, bf16* WT, int k0, int n0, int drow0, LAS float* scr, int lane) {
#pragma unroll 8
    for (int i = 0; i < 32; ++i) { const int kk = 2 * i + (lane >> 5); scr[kk * 33 + (lane & 31)] = W[(size_t)(k0 + kk) * N + n0 + (lane & 31)]; }
    asm volatile("s_waitcnt lgkmcnt(0)" ::: "memory");
    const int c = lane & 7;
#pragma unroll
    for (int j = 0; j < 4; ++j) { const int n = (lane >> 3) + 8 * j; const LAS float* s = scr + (8 * c) * 33 + n;
        v4u o; o.x = pk2(s[0 * 33], s[1 * 33]); o.y = pk2(s[2 * 33], s[3 * 33]); o.z = pk2(s[4 * 33], s[5 * 33]); o.w = pk2(s[6 * 33], s[7 * 33]);
        *(v4u*)(WT + (size_t)(drow0 + n) * K + k0 + 8 * c) = o; }
    asm volatile("s_waitcnt lgkmcnt(0)" ::: "memory");
}
__device__ __forceinline__ int up_dest(int n0) { return n0 < DFF ? 256 * (n0 / 128) + (n0 % 128) : 256 * ((n0 - DFF) / 128) + 128 + ((n0 - DFF) % 128); }
__device__ __forceinline__ int win_dest(int n0) { return n0 < 2304 ? n0 : (n0 < 2336 ? n0 + 2048 : n0 - 32); }

__device__ __forceinline__ void norm_mod_rows(const float* lat, const float* ctxp, const float* mod, const float* g, int sub, bf16* XN, bool with_ctx, int gw, int NGW, int lane) {
    f32x4 gv[4];
#pragma unroll
    for (int j = 0; j < 4; ++j) gv[j] = *((const f32x4*)g + lane + 64 * j);
    for (int r0 = gw * 4; r0 < MR; r0 += NGW * 4) {
        const int b = r0 / TB, t = r0 % TB; const bool isctx = t >= TL;
        if (isctx && !with_ctx) continue;
        const float* src = isctx ? ctxp + (size_t)(b * TC + t - TL) * DM : lat + (size_t)(b * TL + t) * DM;
        const float* sh = mod + (size_t)(isctx ? 8 : b) * NMOD + (3 * sub) * DM; const float* sc = sh + DM;
        f32x4 v[4][4]; float s[4] = {0.f, 0.f, 0.f, 0.f}; f32x4 scv[4], shv[4];
#pragma unroll
        for (int u = 0; u < 4; ++u)
#pragma unroll
            for (int j = 0; j < 4; ++j) { v[u][j] = *((const f32x4*)(src + (size_t)u * DM) + lane + 64 * j); }
#pragma unroll
        for (int j = 0; j < 4; ++j) { scv[j] = *((const f32x4*)sc + lane + 64 * j) + 1.f; shv[j] = *((const f32x4*)sh + lane + 64 * j); }
#pragma unroll
        for (int u = 0; u < 4; ++u)
#pragma unroll
            for (int j = 0; j < 4; ++j) s[u] += (v[u][j].x * v[u][j].x + v[u][j].y * v[u][j].y) + (v[u][j].z * v[u][j].z + v[u][j].w * v[u][j].w);
#pragma unroll
        for (int u = 0; u < 4; ++u) {
            const float rstd = 1.f / sqrtf(wave_sum(s[u]) * (1.f / DM) + EPS);
            unsigned long long* o8 = (unsigned long long*)(XN + (size_t)(r0 + u) * DM) + lane;
#pragma unroll
            for (int j = 0; j < 4; ++j) {
                const f32x4 y = (v[u][j] * rstd * gv[j]) * scv[j] + shv[j];
                o8[64 * j] = (unsigned long long)pk2(y.x, y.y) | ((unsigned long long)pk2(y.z, y.w) << 32); } }
    }
}

constexpr int GS = 72, VS = 136;
constexpr int GL_QE = 0, GL_KE = 9216, GL_KL = 18432, GL_A = 27648, GL_V = 36864, GL_B = 54272, GL_BT = 71680, GL_SEG = 71936, BS = 68;
typedef short v4i16_t __attribute__((ext_vector_type(4)));
__device__ __forceinline__ bf16x8 tr_frag(const LAS bf16* base, int rs  , int col0, int ks, int q4, int qq, int p) {
    const LAS bf16* a0 = base + (32 * ks + 8 * q4 + qq) * rs + col0 + 4 * p;
    const v4i16_t t0 = __builtin_amdgcn_ds_read_tr16_b64_v4i16((LAS v4i16_t*)a0), t1 = __builtin_amdgcn_ds_read_tr16_b64_v4i16((LAS v4i16_t*)(a0 + 4 * rs));
    return (bf16x8){t0[0], t0[1], t0[2], t0[3], t1[0], t1[1], t1[2], t1[3]};
}
#define GLA_ROWOF(c) (rowbase + (dir ? 63 - (c) : (c)))
template <int PASS> __device__ __forceinline__ void gla_pass(LAS unsigned char* lds, const bf16* P, const float* w_decay, const float* b_decay, bf16* Ubuf, float* dn, bf16* OF, bf16* OB, int bx, int G, unsigned* ctr) {
    const int tid = opaque_tid(), lane = tid & 63, w = __builtin_amdgcn_readfirstlane(tid >> 6), l15 = lane & 15, q4 = lane >> 4, qq = (lane & 15) >> 2, p3 = lane & 3;
    constexpr int NV = PASS == 1 ? 64 * 131 : 64 * 128;
    LAS bf16* qeL = (LAS bf16*)(lds + GL_QE); LAS bf16* keL = (LAS bf16*)(lds + GL_KE); LAS bf16* klL = (LAS bf16*)(lds + GL_KL); LAS bf16* AL = (LAS bf16*)(lds + GL_A); LAS bf16* vL = (LAS bf16*)(lds + GL_V);
    LAS float* bL = (LAS float*)(lds + GL_B); LAS float* btL = (LAS float*)(lds + GL_BT); LAS float* segT = (LAS float*)(lds + GL_SEG);
    const int c = tid >> 3, ch = tid & 7, dt = w & 3, half = w >> 2;
    v4u vraw[2], kraw, qraw, lowf[2]; float wdr[8]; float bdr = 0.f; bf16x8 xsn[2];
    vraw[0] = vraw[1] = kraw = qraw = lowf[0] = lowf[1] = (v4u){0u, 0u, 0u, 0u}; xsn[0] = xsn[1] = (bf16x8){0, 0, 0, 0, 0, 0, 0, 0};
#pragma unroll
    for (int j = 0; j < 8; ++j) wdr[j] = 0.f;
#define GLA_DEC(idx_) const int chain = PASS == 1 ? (idx_) / 131 : (idx_) >> 7, s = PASS == 1 ? (idx_) % 131 : 4 + ((idx_) & 127), dir = chain & 1, h = (chain >> 1) & 3, b = chain >> 3; \
    const int rowbase = b * TB + (s < 4 ? TL + (dir ? 3 - s : s) * 64 : (dir ? 127 - (s - 4) : s - 4) * 64); const int item = chain * GLA_S + s; (void)item
#define GLA_LOAD(idx_) do { GLA_DEC(idx_); \
        _Pragma("unroll") for (int i = 0; i < 2; ++i) { const int n = tid + 512 * i; vraw[i] = *(const v4u*)(P + (size_t)GLA_ROWOF(n >> 4) * PW + PC_GV + h * 128 + (n & 15) * 8); } \
        { const size_t ro = (size_t)GLA_ROWOF(c) * PW + h * 64 + ch * 8; kraw = *(const v4u*)(P + ro + PC_GK); if (PASS == 3) qraw = *(const v4u*)(P + ro + PC_GQ); } \
        _Pragma("unroll") for (int i = 0; i < 2; ++i) lowf[i] = *(const v4u*)(P + (size_t)GLA_ROWOF(16 * (2 * half + i) + l15) * PW + PC_LOW + dir * 16 + (q4 & 1) * 8); \
        _Pragma("unroll") for (int j = 0; j < 8; ++j) wdr[j] = w_decay[(dir * 16 + 8 * (q4 & 1) + j) * 256 + h * 64 + 16 * dt + l15]; \
        bdr = b_decay[dir * 256 + h * 64 + 16 * dt + l15]; \
        if (PASS == 3) { _Pragma("unroll") for (int ks = 0; ks < 2; ++ks) xsn[ks] = *(const bf16x8*)(Ubuf + (size_t)item * 8192 + (16 * w + l15) * 64 + 8 * q4 + 32 * ks); } } while (0)
    volatile LAS unsigned* nxtL = (volatile LAS unsigned*)(lds + GL_SEG + 1024);
    int idx = bx;
    if (ctr) { if (tid == 0) nxtL[0] = __hip_atomic_fetch_add(ctr, 1u, __ATOMIC_RELAXED, __HIP_MEMORY_SCOPE_AGENT); __syncthreads(); idx = (int)nxtL[0]; __syncthreads(); }
    if (idx < NV) GLA_LOAD(idx);
    for (; idx < NV;) {
        int nidx = idx + G;
        if (ctr && tid == 0) nxtL[0] = __hip_atomic_fetch_add(ctr, 1u, __ATOMIC_RELAXED, __HIP_MEMORY_SCOPE_AGENT);
        GLA_DEC(idx);
#pragma unroll
        for (int i = 0; i < 2; ++i) { const int n = tid + 512 * i; *(LAS v4u*)(vL + (n >> 4) * VS + (n & 15) * 8) = vraw[i]; }
        float kf[8], qf[8];
        kf[0] = pg8::bflo(kraw.x); kf[1] = pg8::bfhi(kraw.x); kf[2] = pg8::bflo(kraw.y); kf[3] = pg8::bfhi(kraw.y); kf[4] = pg8::bflo(kraw.z); kf[5] = pg8::bfhi(kraw.z); kf[6] = pg8::bflo(kraw.w); kf[7] = pg8::bfhi(kraw.w);
        if (PASS == 3) { qf[0] = pg8::bflo(qraw.x); qf[1] = pg8::bfhi(qraw.x); qf[2] = pg8::bflo(qraw.y); qf[3] = pg8::bfhi(qraw.y); qf[4] = pg8::bflo(qraw.z); qf[5] = pg8::bfhi(qraw.z); qf[6] = pg8::bflo(qraw.w); qf[7] = pg8::bfhi(qraw.w); }
        float bv[2][4], tot[2];
        { bf16x8 yv;
#pragma unroll
          for (int j = 0; j < 8; ++j) { const unsigned hb = f2bf(wdr[j]); const unsigned lb = f2bf(wdr[j] - __uint_as_float(hb << 16)); yv[j] = (short)(q4 < 2 ? hb : lb); }
#pragma unroll
          for (int i = 0; i < 2; ++i) { f32x4 z = {0.f, 0.f, 0.f, 0.f}; z = __builtin_amdgcn_mfma_f32_16x16x32_bf16(__builtin_bit_cast(bf16x8, lowf[i]), yv, z, 0, 0, 0);
              float run = 0.f;
#pragma unroll
              for (int r = 0; r < 4; ++r) { const float zz = z[r] + bdr; run += (fminf(zz, 0.f) - __logf(1.f + __expf(-fabsf(zz)))) * (1.f / 16.f); bv[i][r] = run; }
              float sc = run; float t = __shfl_up(sc, 16); if (q4 >= 1) sc += t; t = __shfl_up(sc, 32); if (q4 >= 2) sc += t;
              const float excl = sc - run; tot[i] = __shfl(sc, 48 + l15);
#pragma unroll
              for (int r = 0; r < 4; ++r) bv[i][r] += excl + (i ? tot[0] : 0.f); }
          if (q4 == 0) segT[half * 64 + 16 * dt + l15] = tot[0] + tot[1]; }
        __syncthreads();
        { const float other = segT[(1 - half) * 64 + 16 * dt + l15]; const float add = half ? other : 0.f;
#pragma unroll
          for (int i = 0; i < 2; ++i)
#pragma unroll
              for (int r = 0; r < 4; ++r) bL[(16 * (2 * half + i) + 4 * q4 + r) * BS + 16 * dt + l15] = bv[i][r] + add;
          if (half == 0 && q4 == 0) btL[16 * dt + l15] = tot[0] + tot[1] + other; }
        __syncthreads();
        float bl[8], btot[8];
        { const f32x4 b0 = *(const LAS f32x4*)(bL + c * BS + 8 * ch), b1 = *(const LAS f32x4*)(bL + c * BS + 8 * ch + 4), t0 = *(const LAS f32x4*)(btL + 8 * ch), t1 = *(const LAS f32x4*)(btL + 8 * ch + 4);
          bl[0] = b0[0]; bl[1] = b0[1]; bl[2] = b0[2]; bl[3] = b0[3]; bl[4] = b1[0]; bl[5] = b1[1]; bl[6] = b1[2]; bl[7] = b1[3];
          btot[0] = t0[0]; btot[1] = t0[1]; btot[2] = t0[2]; btot[3] = t0[3]; btot[4] = t1[0]; btot[5] = t1[1]; btot[6] = t1[2]; btot[7] = t1[3]; }
        if (PASS == 1) {
            float kl[8];
#pragma unroll
            for (int k = 0; k < 8; ++k) kl[k] = kf[k] * __expf(btot[k] - bl[k]);
            v4u o; o.x = pk2(kl[0], kl[1]); o.y = pk2(kl[2], kl[3]); o.z = pk2(kl[4], kl[5]); o.w = pk2(kl[6], kl[7]);
            *(LAS v4u*)(klL + c * GS + 8 * ch) = o;
            if (tid < 8) { f32x4* dp = (f32x4*)(dn + (size_t)item * 64 + 8 * ch); dp[0] = (f32x4){__expf(btot[0]), __expf(btot[1]), __expf(btot[2]), __expf(btot[3])}; dp[1] = (f32x4){__expf(btot[4]), __expf(btot[5]), __expf(btot[6]), __expf(btot[7])}; }
        } else {
            float qe[8], ke[8];
#pragma unroll
            for (int k = 0; k < 8; ++k) { qe[k] = qf[k] * __expf(bl[k]) * 0.125f; ke[k] = kf[k] * __expf(-bl[k]); }
            v4u o; o.x = pk2(qe[0], qe[1]); o.y = pk2(qe[2], qe[3]); o.z = pk2(qe[4], qe[5]); o.w = pk2(qe[6], qe[7]);
            *(LAS v4u*)(qeL + c * GS + 8 * ch) = o;
            o.x = pk2(ke[0], ke[1]); o.y = pk2(ke[2], ke[3]); o.z = pk2(ke[4], ke[5]); o.w = pk2(ke[6], ke[7]);
            *(LAS v4u*)(keL + c * GS + 8 * ch) = o;
        }
        bf16x8 xs[2]; xs[0] = xsn[0]; xs[1] = xsn[1];
        if (ctr) nidx = (int)nxtL[0];
        if (nidx < NV) GLA_LOAD(nidx);
        __syncthreads();
        if (PASS == 1) {
            bf16x8 y[2];
#pragma unroll
            for (int ks = 0; ks < 2; ++ks) y[ks] = tr_frag(vL, VS, 16 * w, ks, q4, qq, p3);
#pragma unroll
            for (int dt = 0; dt < 4; ++dt) { f32x4 acc = {0.f, 0.f, 0.f, 0.f};
#pragma unroll
                for (int ks = 0; ks < 2; ++ks) { const bf16x8 x = tr_frag(klL, GS, 16 * dt, ks, q4, qq, p3); acc = __builtin_amdgcn_mfma_f32_16x16x32_bf16(x, y[ks], acc, 0, 0, 0); }
                v2u o; o.x = pk2(acc[0], acc[1]); o.y = pk2(acc[2], acc[3]);
                *(v2u*)(Ubuf + (size_t)item * 8192 + (16 * w + l15) * 64 + 16 * dt + 4 * q4) = o; }
        } else {
            { const int it = w >> 1;
#pragma unroll
              for (int jj = 0; jj < 2; ++jj) { const int jt = (w & 1) * 2 + jj; f32x4 acc = {0.f, 0.f, 0.f, 0.f};
                  if (jt <= it) {
#pragma unroll
                      for (int ks = 0; ks < 2; ++ks) { const bf16x8 x = *(const LAS bf16x8*)(keL + (16 * jt + l15) * GS + 8 * q4 + 32 * ks), y = *(const LAS bf16x8*)(qeL + (16 * it + l15) * GS + 8 * q4 + 32 * ks);
                          acc = __builtin_amdgcn_mfma_f32_16x16x32_bf16(x, y, acc, 0, 0, 0); }
                      const int i = 16 * it + l15, j0 = 16 * jt + 4 * q4;
#pragma unroll
                      for (int r = 0; r < 4; ++r) if (j0 + r > i) acc[r] = 0.f;
                  }
                  v2u o; o.x = pk2(acc[0], acc[1]); o.y = pk2(acc[2], acc[3]);
                  *(LAS v2u*)(AL + (16 * it + l15) * GS + 16 * jt + 4 * q4) = o; } }
            bf16x8 xv[2];
#pragma unroll
            for (int ks = 0; ks < 2; ++ks) xv[ks] = tr_frag(vL, VS, 16 * w, ks, q4, qq, p3);
            __syncthreads();
            bf16* Ob = dir ? OB : OF;
#pragma unroll
            for (int it = 0; it < 4; ++it) { f32x4 acc = {0.f, 0.f, 0.f, 0.f};
#pragma unroll
                for (int ks = 0; ks < 2; ++ks) { const bf16x8 y = *(const LAS bf16x8*)(AL + (16 * it + l15) * GS + 8 * q4 + 32 * ks); acc = __builtin_amdgcn_mfma_f32_16x16x32_bf16(xv[ks], y, acc, 0, 0, 0); }
#pragma unroll
                for (int ks = 0; ks < 2; ++ks) { const bf16x8 y = *(const LAS bf16x8*)(qeL + (16 * it + l15) * GS + 8 * q4 + 32 * ks); acc = __builtin_amdgcn_mfma_f32_16x16x32_bf16(xs[ks], y, acc, 0, 0, 0); }
                v2u o; o.x = pk2(acc[0], acc[1]); o.y = pk2(acc[2], acc[3]);
                *(v2u*)(Ob + (size_t)GLA_ROWOF(16 * it + l15) * 512 + h * 128 + 16 * w + 4 * q4) = o; }
        }
        __syncthreads();
        idx = nidx;
    }
#undef GLA_DEC
#undef GLA_LOAD
}

struct Args { const float* in[19]; float* out; unsigned char* ws; };
__global__ void __launch_bounds__(NTHR, 2) mk_fwd(Args args) {
    extern __shared__ __attribute__((aligned(16))) unsigned char lds_raw[];
    cg::grid_group grid = cg::this_grid();
    LAS unsigned char* lds = (LAS unsigned char*)lds_raw;
    const int G = gridDim.x, bx = blockIdx.x, NGW = G * NWAVES;
    unsigned long long pacc = 0ull, pt0 = 0ull; (void)pt0;
#define PB(k) do { if ((PROBE_MASK >> (k)) & 1ull) pt0 = __builtin_amdgcn_s_memrealtime(); } while (0)
#define PE(k) do { if ((PROBE_MASK >> (k)) & 1ull) pacc += __builtin_amdgcn_s_memrealtime() - pt0; } while (0)
#define GSYNC() do { xcd_barrier(xbar); if (PROBE_SYNC) { const unsigned long long t_ = __builtin_amdgcn_s_memrealtime(); xcd_barrier(xbar); pacc += __builtin_amdgcn_s_memrealtime() - t_; } } while (0)
#define PH_IDS const int tid = opaque_tid(), lane = tid & 63, wave = __builtin_amdgcn_readfirstlane(tid >> 6), gw = bx * NWAVES + wave; (void)lane; (void)gw
    unsigned char* ws = args.ws;
    const float* x = args.in[0]; const float* cvec = args.in[1]; const float* ctx = args.in[2]; const float* c_ctx = args.in[3]; const float* w_mod = args.in[4]; const float* b_mod = args.in[5];
    const float* g_norm = args.in[6]; const float* w_up = args.in[7]; const float* w_down = args.in[8]; const float* w_in = args.in[9]; const float* g_q = args.in[10]; const float* g_k = args.in[11];
    const float* w_decay = args.in[12]; const float* b_decay = args.in[13]; const float* g_gla = args.in[14]; const float* w_branch = args.in[15]; const float* b_gate = args.in[16]; const float* w_out = args.in[17]; const float* g_final = args.in[18];
    float* H = args.out;
    float* HC = (float*)(ws + WS_HCTX);
    float* mod = (float*)(ws + WS_MOD); float* dn = (float*)(ws + WS_DN);
    bf16* Wup1 = (bf16*)(ws + WS_WUP1); bf16* Wup2 = (bf16*)(ws + WS_WUP2); bf16* Wdn1 = (bf16*)(ws + WS_WDN1); bf16* Wdn2 = (bf16*)(ws + WS_WDN2); bf16* Win = (bf16*)(ws + WS_WIN);
    bf16* Wbr0 = (bf16*)(ws + WS_WBR0); bf16* Wbr1 = (bf16*)(ws + WS_WBR1); bf16* Wout = (bf16*)(ws + WS_WOUT);
    bf16* XN = (bf16*)(ws + WS_XN); bf16* OF = (bf16*)(ws + WS_OF); bf16* OB = (bf16*)(ws + WS_OB); bf16* PA = (bf16*)(ws + WS_A);
    bf16* HID = PA; bf16* Ubuf = XN; bf16* Z = XN;
    float* ssq1 = (float*)(ws + WS_SSQ1); float* ssq2 = (float*)(ws + WS_SSQ2); float* sW1 = (float*)(ws + WS_SW1); float* sW2 = (float*)(ws + WS_SW2);
    bf16* XN2 = OF;

    volatile LAS unsigned* xst = (volatile LAS unsigned*)(lds + LDS_BYTES - 64);
    if (threadIdx.x < 2) xst[threadIdx.x] = 0u;
    unsigned* barw = (unsigned*)ws;
    if (bx == 0) for (int i = threadIdx.x; i < XCD_BAR_WORDS + 128; i += NTHR) __hip_atomic_store(barw + i, 0u, __ATOMIC_RELAXED, __HIP_MEMORY_SCOPE_AGENT);
    XcdBarrier xbar; xbar.bar = barw; xbar.x = 0; xbar.st = xst;
    PB(0);
    {
        PH_IDS;
        LAS float* sc = (LAS float*)lds; LAS float* red = sc + 9 * 1024;
        for (int idx = tid; idx < 9 * 1024; idx += NTHR) { const int j = idx >> 10, k = idx & 1023; const float v = j < 8 ? cvec[j * 1024 + k] : c_ctx[k]; sc[idx] = silu_f(v); }
        __syncthreads();
        for (int it = bx; it < NMOD / 32; it += G) {
            const int cc = tid & 31, ks = tid >> 5, col = it * 32 + cc;
            float a[9];
#pragma unroll
            for (int j = 0; j < 9; ++j) a[j] = 0.f;
#pragma unroll 4
            for (int kk = 0; kk < 64; ++kk) { const int k = ks * 64 + kk; const float wv = w_mod[(size_t)k * NMOD + col];
#pragma unroll
                for (int j = 0; j < 9; ++j) a[j] += sc[j * 1024 + k] * wv; }
#pragma unroll
            for (int j = 0; j < 9; ++j) red[(ks * 9 + j) * 32 + cc] = a[j];
            __syncthreads();
            if (tid < 288) { const int j = tid >> 5, c2 = tid & 31; float s = b_mod[it * 32 + c2];
#pragma unroll
                for (int k2 = 0; k2 < 16; ++k2) s += red[(k2 * 9 + j) * 32 + c2];
                mod[(size_t)j * NMOD + it * 32 + c2] = s; }
            __syncthreads();
        }
        LAS float* scr = (LAS float*)(lds + 65536) + wave * 2176;
        constexpr int I_UP = 16 * 176, I_DN = 44 * 32;
        for (int it = gw; it < I_UP + I_DN; it += NGW) {
            int r = it;
            if (r < I_UP) { const int kb = r / 176, nb = r % 176; transpose_item(w_up, 1024, 5632, Wup1, 64 * kb, 32 * nb, up_dest(32 * nb), scr, lane); continue; } r -= I_UP;
            { const int kb = r / 32, nb = r % 32; transpose_item(w_down, DFF, 1024, Wdn1, 64 * kb, 32 * nb, 32 * nb, scr, lane); }
        }
        for (int i = bx * NTHR + tid; i < 224 * 1024 / 8; i += G * NTHR) ((v4u*)(Win + (size_t)4384 * 1024))[i] = (v4u){0u, 0u, 0u, 0u};
        for (int i = bx * NTHR + tid; i < MR; i += G * NTHR) { ssq1[i] = 0.f; ssq2[i] = 0.f; }
    }
    grid.sync();
    xbar.x = xb_xcc_id(); if (threadIdx.x == 0) xst[2] = xb_add(&barw[XB_XCNT(xbar.x)], 1u);
    PE(0); PB(1);
    { PH_IDS; norm_mod_rows(x, ctx, mod, g_norm + 0 * DM, 0, XN, true, gw, NGW, lane);
      LAS float* sc = (LAS float*)lds; LAS float* red = sc + 9 * 1024;
      for (int it = bx; it < 144 + 176; it += G) {
          const bool second = it >= 144; const int n0 = (second ? it - 144 : it) * 32; const int sub = second ? 2 : 1;
          __syncthreads();
          for (int idx = tid; idx < 9 * 1024; idx += NTHR) sc[idx] = mod[(size_t)(idx >> 10) * NMOD + (3 * sub) * DM + (idx & 1023)];
          __syncthreads();
          const int cc = tid & 31, ks = tid >> 5, nd = n0 + cc; int nsrc; const float* Wp; int ldw;
          if (!second) { Wp = w_in; ldw = 4384; nsrc = nd < 2304 ? nd : (nd < 4352 ? nd + 32 : (nd < 4384 ? nd - 2048 : -1)); }
          else { Wp = w_up + (size_t)1024 * 5632; ldw = 5632; const int tile = nd >> 8, within = nd & 255; nsrc = within < 128 ? 128 * tile + within : DFF + 128 * tile + (within - 128); }
          float a[9];
#pragma unroll
          for (int j = 0; j < 9; ++j) a[j] = 0.f;
          if (nsrc >= 0) {
#pragma unroll 4
              for (int kk = 0; kk < 64; ++kk) { const int k = ks * 64 + kk; const float wv = Wp[(size_t)k * ldw + nsrc];
#pragma unroll
                  for (int j = 0; j < 9; ++j) a[j] += sc[j * 1024 + k] * wv; } }
#pragma unroll
          for (int j = 0; j < 9; ++j) red[(ks * 9 + j) * 32 + cc] = a[j];
          __syncthreads();
          if (tid < 288) { const int j = tid >> 5, c2 = tid & 31; float sum = 0.f;
#pragma unroll
              for (int k2 = 0; k2 < 16; ++k2) sum += red[(k2 * 9 + j) * 32 + c2];
              (second ? sW2 + (size_t)j * 5632 : sW1 + (size_t)j * PW)[n0 + c2] = sum; }
      }
      __syncthreads(); }
    GSYNC(); PE(1); PB(2);
    if (threadIdx.x == 0) { bool uni = (xbar.x < 8u) && ((G & 7) == 0);
        for (unsigned j = 0; j < 16; ++j) { const unsigned cnt_ = xb_ld(&barw[XB_XCNT(j)]); uni = uni && (cnt_ == (j < 8u ? (unsigned)(G >> 3) : 0u)); }
        xst[3] = uni ? (xst[2] * 8u + xbar.x) : (unsigned)bx; }
    __syncthreads();
    const int vb = (int)xst[3];
    { pg8::Gemm g{XN, Wup1, MR, 5632, 1024, 1024, 1024}; pg8::StaticOrder S; S.init(MR, 5632, G, vb);
      pg8::EpiSwiglu E{HID, DFF}; pg8::gemm_phase<pg8::EpiSwiglu, pg8::StaticOrder, true, true>(lds, g, S, E); }
    GSYNC(); PE(2); PB(3);
    { pg8::Gemm g{HID, Wdn1, MR, 1024, DFF, DFF, DFF}; pg8::StaticOrder S; S.init(MR, 1024, G, vb);
      pg8::EpiRes<1, 2, 1, 1> E{x, ctx, H, HC, mod, g_norm + 1 * DM, XN, ssq1}; pg8::gemm_phase<pg8::EpiRes<1, 2, 1, 1>, pg8::StaticOrder, true, true>(lds, g, S, E); }
    { PH_IDS;
      const int rem = (264 * 4) % G, ir = rem ? vb - rem : vb, ni = rem ? G - rem : G;
      if (ir >= 0) {
          LAS float* scr = (LAS float*)(lds + 65536) + wave * 2176;
          constexpr int I_UP = 16 * 176, I_DN = 44 * 32, I_IN = 16 * 137, I_BR = 8 * 32, I_OUT = 16 * 32;
          constexpr int NITEMS = I_UP + I_DN + I_IN + 2 * I_BR + I_OUT;
          for (int it = ir * NWAVES + wave; it < NITEMS; it += ni * NWAVES) {
              int r = it;
              if (r < I_UP) { const int kb = r / 176, nb = r % 176; transpose_item(w_up + (size_t)1024 * 5632, 1024, 5632, Wup2, 64 * kb, 32 * nb, up_dest(32 * nb), scr, lane); continue; } r -= I_UP;
              if (r < I_DN) { const int kb = r / 32, nb = r % 32; transpose_item(w_down + (size_t)DFF * 1024, DFF, 1024, Wdn2, 64 * kb, 32 * nb, 32 * nb, scr, lane); continue; } r -= I_DN;
              if (r < I_IN) { const int kb = r / 137, nb = r % 137; transpose_item(w_in, 1024, 4384, Win, 64 * kb, 32 * nb, win_dest(32 * nb), scr, lane); continue; } r -= I_IN;
              if (r < 2 * I_BR) { const int l = r / I_BR; r %= I_BR; const int kb = r / 32, nb = r % 32; transpose_item(w_branch + (size_t)l * 512 * 1024, 512, 1024, l ? Wbr1 : Wbr0, 64 * kb, 32 * nb, 32 * nb, scr, lane); continue; } r -= 2 * I_BR;
              { const int kb = r / 32, nb = r % 32; transpose_item(w_out, 1024, 1024, Wout, 64 * kb, 32 * nb, 32 * nb, scr, lane); }
          }
      } }
    GSYNC(); PE(3); PB(4);
#if MK_STAGE >= 2
    { pg8::Gemm g{XN, Win, MR, PW, 1024, 1024, 1024}; pg8::StaticOrder S; S.init(MR, PW, G, vb);
      pg8::EpiInproj E{PA, PW, ssq1, sW1, PW}; pg8::gemm_phase<pg8::EpiInproj, pg8::StaticOrder, true, true>(lds, g, S, E); }
    GSYNC(); PE(4); PB(5);
    { PH_IDS;
      const int l7 = lane & 7, l3 = lane & 3; const bool is_hi = (lane & 4) != 0;
      float frq[8], gq8[8], gk8[8];
#pragma unroll
      for (int k = 0; k < 8; ++k) { frq[k] = __builtin_amdgcn_exp2f(-(float)(8 * (l3 & 1) + k) * (13.287712379549449f / 16.f)); gq8[k] = g_q[8 * l7 + k] * attn_body::C2; gk8[k] = g_k[8 * l7 + k]; }
      for (int r0 = gw * 4; r0 < MR; r0 += NGW * 4) {
          const int t0 = r0 % TB; const bool isctx = t0 >= TL;
          v4u qv[4], kv[4];
#pragma unroll
          for (int u = 0; u < 4; ++u) { bf16* rp = PA + (size_t)(r0 + u) * PW; qv[u] = (v4u){0u, 0u, 0u, 0u}; if (!isctx) qv[u] = *(const v4u*)(rp + lane * 8); kv[u] = *(const v4u*)(rp + PC_K + (lane & 15) * 8); }
#pragma unroll
          for (int u = 0; u < 4; ++u) { bf16* rp = PA + (size_t)(r0 + u) * PW; const int t = t0 + u;
              const float pos = (l3 < 2) ? (float)(t >> 6) : (float)(t & 63);
              float cs8[8], sn8[8];
#pragma unroll
              for (int k = 0; k < 8; ++k) { const float ang = pos * frq[k]; cs8[k] = isctx ? 1.f : __cosf(ang); sn8[k] = isctx ? 0.f : __sinf(ang); }
#pragma unroll
              for (int part = 0; part < 2; ++part) { const v4u raw = part ? kv[u] : qv[u];
                  float xv[8]; xv[0] = pg8::bflo(raw.x); xv[1] = pg8::bfhi(raw.x); xv[2] = pg8::bflo(raw.y); xv[3] = pg8::bfhi(raw.y); xv[4] = pg8::bflo(raw.z); xv[5] = pg8::bfhi(raw.z); xv[6] = pg8::bflo(raw.w); xv[7] = pg8::bfhi(raw.w);
                  float ss = 0.f;
#pragma unroll
                  for (int k = 0; k < 8; ++k) ss += xv[k] * xv[k];
                  ss += __shfl_xor(ss, 1); ss += __shfl_xor(ss, 2); ss += __shfl_xor(ss, 4);
                  const float rstd = 1.f / sqrtf(ss * (1.f / 64.f) + EPS);
                  float o[8];
#pragma unroll
                  for (int k = 0; k < 8; ++k) { const float y = xv[k] * rstd * (part ? gk8[k] : gq8[k]); const float py = __shfl_xor(y, 4);
                      o[k] = is_hi ? (py * sn8[k] + y * cs8[k]) : (y * cs8[k] - py * sn8[k]); }
                  v4u w4; w4.x = pk2(o[0], o[1]); w4.y = pk2(o[2], o[3]); w4.z = pk2(o[4], o[5]); w4.w = pk2(o[6], o[7]);
                  if (part == 0) { if (!isctx) *(v4u*)(rp + lane * 8) = w4; } else { if (lane < 16) *(v4u*)(rp + PC_K + lane * 8) = w4; } } } } }
    gla_pass<1>(lds, PA, w_decay, b_decay, Ubuf, dn, OF, OB, vb, G, nullptr);
    GSYNC(); PE(5); PB(6);
    { PH_IDS; const int tg = bx * NTHR + tid;
      for (int q = tg; q < 64 * 2048; q += G * NTHR) { const int chain = q >> 11, e4 = q & 2047; const int d0 = (4 * e4) & 63;
          f32x4 S = {0.f, 0.f, 0.f, 0.f};
          for (int s0 = 0; s0 < GLA_S; s0 += 12) { v2u ur[12]; f32x4 dv[12];
#pragma unroll
              for (int j = 0; j < 12; ++j) { const size_t item = (size_t)chain * GLA_S + s0 + j; ur[j] = (v2u){0u, 0u}; dv[j] = (f32x4){0.f, 0.f, 0.f, 0.f};
                  if (s0 + j < GLA_S - 1) { ur[j] = *(const v2u*)(Ubuf + item * 8192 + 4 * e4); dv[j] = *(const f32x4*)(dn + item * 64 + d0); } }
#pragma unroll
              for (int j = 0; j < 12; ++j) { const size_t item = (size_t)chain * GLA_S + s0 + j;
                  v2u o; o.x = pk2(S[0], S[1]); o.y = pk2(S[2], S[3]); *(v2u*)(Ubuf + item * 8192 + 4 * e4) = o;
                  S[0] = dv[j][0] * S[0] + __uint_as_float(ur[j].x << 16); S[1] = dv[j][1] * S[1] + __uint_as_float(ur[j].x & 0xffff0000u);
                  S[2] = dv[j][2] * S[2] + __uint_as_float(ur[j].y << 16); S[3] = dv[j][3] * S[3] + __uint_as_float(ur[j].y & 0xffff0000u); } } } }
    GSYNC(); PE(6); PB(7);
    bool fastsm;
    { const int l_ = opaque_tid() & 63; float gqm = fabsf(g_q[l_]), gkm = fabsf(g_k[l_]);
#pragma unroll
      for (int o = 1; o < 64; o <<= 1) { gqm = fmaxf(gqm, __shfl_xor(gqm, o)); gkm = fmaxf(gkm, __shfl_xor(gkm, o)); }
      fastsm = __builtin_amdgcn_readfirstlane((2.f * 11.5416f * gqm * gkm + 14.f < 100.f) ? 1 : 0) != 0; }
    { const attn_body::bf16* Qp = (const attn_body::bf16*)(PA + PC_Q); const attn_body::bf16* Kp = (const attn_body::bf16*)(PA + PC_K); const attn_body::bf16* Vp = (const attn_body::bf16*)(PA + PC_V);
      if ((G & 7) == 0) { const int b = vb & 7, ci = vb >> 3, nper = G >> 3;
          for (int idx = ci; idx < 256; idx += nper) { const int h = idx >> 5, qb = idx & 31;
              if (fastsm) attn_body::attn_unit<8, true>(b, h, h >> 2, qb, Qp, Kp, Vp, (attn_body::bf16*)(PA + PC_Q), (char*)lds_raw);
              else attn_body::attn_unit<8, false>(b, h, h >> 2, qb, Qp, Kp, Vp, (attn_body::bf16*)(PA + PC_Q), (char*)lds_raw); } }
      else { for (int u = vb; u < 2048; u += G) { const int b = u >> 8, h = (u >> 5) & 7, qb = u & 31; attn_body::attn_unit<8, false>(b, h, h >> 2, qb, Qp, Kp, Vp, (attn_body::bf16*)(PA + PC_Q), (char*)lds_raw); } }
    }
    __syncthreads();
    PE(7); PB(21);
    gla_pass<3>(lds, PA, w_decay, b_decay, Ubuf, dn, OF, OB, vb, G, barw + XCD_BAR_WORDS + 64);
    GSYNC(); PE(21); PB(8);
    { PH_IDS;
      const int col = lane * 8, e0 = col & 127; float gg8[8];
#pragma unroll
      for (int k = 0; k < 8; ++k) gg8[k] = g_gla[e0 + k];
      for (int r0 = gw * 4; r0 < MR; r0 += NGW * 4) {
          if (r0 % TB >= TL) continue;
          v4u a[4], bq[4], gq[4];
#pragma unroll
          for (int u = 0; u < 4; ++u) { const size_t r = r0 + u; a[u] = *(const v4u*)(OF + r * 512 + col); bq[u] = *(const v4u*)(OB + r * 512 + col); gq[u] = *(const v4u*)(PA + r * PW + PC_G6 + col); }
#pragma unroll
          for (int u = 0; u < 4; ++u) { const size_t r = r0 + u; float o[8], gg[8];
              o[0] = pg8::bflo(a[u].x) + pg8::bflo(bq[u].x); o[1] = pg8::bfhi(a[u].x) + pg8::bfhi(bq[u].x); o[2] = pg8::bflo(a[u].y) + pg8::bflo(bq[u].y); o[3] = pg8::bfhi(a[u].y) + pg8::bfhi(bq[u].y);
              o[4] = pg8::bflo(a[u].z) + pg8::bflo(bq[u].z); o[5] = pg8::bfhi(a[u].z) + pg8::bfhi(bq[u].z); o[6] = pg8::bflo(a[u].w) + pg8::bflo(bq[u].w); o[7] = pg8::bfhi(a[u].w) + pg8::bfhi(bq[u].w);
              gg[0] = pg8::bflo(gq[u].x); gg[1] = pg8::bfhi(gq[u].x); gg[2] = pg8::bflo(gq[u].y); gg[3] = pg8::bfhi(gq[u].y); gg[4] = pg8::bflo(gq[u].z); gg[5] = pg8::bfhi(gq[u].z); gg[6] = pg8::bflo(gq[u].w); gg[7] = pg8::bfhi(gq[u].w);
              float ss = 0.f;
#pragma unroll
              for (int k = 0; k < 8; ++k) ss += o[k] * o[k];
#pragma unroll
              for (int of = 1; of < 16; of <<= 1) ss += __shfl_xor(ss, of);
              const float rstd = 1.f / sqrtf(ss * (1.f / 128.f) + EPS); float y[8];
#pragma unroll
              for (int k = 0; k < 8; ++k) y[k] = o[k] * rstd * gg8[k] * silu_f(gg[k]);
              v4u w4; w4.x = pk2(y[0], y[1]); w4.y = pk2(y[2], y[3]); w4.z = pk2(y[4], y[5]); w4.w = pk2(y[6], y[7]);
              *(v4u*)(OF + r * 512 + col) = w4; } } }
    GSYNC(); PE(8); PB(9);
    { pg8::Gemm g{PA + PC_Q, Wbr0, MR, 1024, 512, PW, 512}; pg8::StaticOrder S; S.init(NB * TL, 1024, G, vb, 1);
      pg8::EpiGate<0> E{PA, b_gate, Z}; pg8::gemm_phase<pg8::EpiGate<0>, pg8::StaticOrder, true, true>(lds, g, S, E); }
    __syncthreads();
    { pg8::Gemm g{OF, Wbr1, MR, 1024, 512, 512, 512}; pg8::StaticOrder S; S.init(NB * TL, 1024, G, vb, 1);
      pg8::EpiGate<1> E{PA, b_gate, Z}; pg8::gemm_phase<pg8::EpiGate<1>, pg8::StaticOrder, true, true>(lds, g, S, E); }
    GSYNC(); PE(9); PB(10);
    { pg8::Gemm g{Z, Wout, MR, 1024, 1024, 1024, 1024}; pg8::StaticOrder S; S.init(NB * TL, 1024, G, vb, 1);
      pg8::EpiRes<1, 5, 0, 2> E{H, HC, H, HC, mod, g_norm + 2 * DM, XN2, ssq2}; pg8::gemm_phase<pg8::EpiRes<1, 5, 0, 2>, pg8::StaticOrder, true, true>(lds, g, S, E); }
    GSYNC(); PE(10); PB(11);
#endif
#if MK_STAGE >= 3
    { pg8::Gemm g{XN2, Wup2, MR, 5632, 1024, 1024, 1024}; pg8::StaticOrder S; S.init(NB * TL, 5632, G, vb, 1);
      pg8::EpiSwigluN E{HID, DFF, ssq2, sW2, 5632}; pg8::gemm_phase<pg8::EpiSwigluN, pg8::StaticOrder, true, true>(lds, g, S, E); }
    GSYNC(); PE(11); PB(12);
    { pg8::Gemm g{HID, Wdn2, MR, 1024, DFF, DFF, DFF}; pg8::StaticOrder S; S.init(NB * TL, 1024, G, vb, 1);
      pg8::EpiRes<0, 8, 1, 0> E{H, HC, H, HC, mod, nullptr, nullptr, nullptr}; pg8::gemm_phase<pg8::EpiRes<0, 8, 1, 0>, pg8::StaticOrder, true, true>(lds, g, S, E); }
    GSYNC(); PE(12); PB(13);
#endif
    { PH_IDS; f32x4 gv[4];
#pragma unroll
      for (int j = 0; j < 4; ++j) gv[j] = *((const f32x4*)g_final + lane + 64 * j);
      for (int r0 = gw * 4; r0 < NB * TL; r0 += NGW * 4) { f32x4* p = (f32x4*)(H + (size_t)r0 * DM) + lane; f32x4 v[4][4]; float s[4] = {0.f, 0.f, 0.f, 0.f};
#pragma unroll
          for (int u = 0; u < 4; ++u)
#pragma unroll
              for (int j = 0; j < 4; ++j) v[u][j] = p[u * 256 + 64 * j];
#pragma unroll
          for (int u = 0; u < 4; ++u)
#pragma unroll
              for (int j = 0; j < 4; ++j) s[u] += (v[u][j].x * v[u][j].x + v[u][j].y * v[u][j].y) + (v[u][j].z * v[u][j].z + v[u][j].w * v[u][j].w);
#pragma unroll
          for (int u = 0; u < 4; ++u) { const float rstd = 1.f / sqrtf(wave_sum(s[u]) * (1.f / DM) + EPS);
#pragma unroll
              for (int j = 0; j < 4; ++j) p[u * 256 + 64 * j] = v[u][j] * rstd * gv[j]; } } }
    PE(13);
    if (PROBE_MASK != 0ull || PROBE_SYNC) { const unsigned long long te = __builtin_amdgcn_s_memrealtime() + (unsigned long long)PROBE_MULT * pacc; while (__builtin_amdgcn_s_memrealtime() < te) __builtin_amdgcn_s_sleep(32); }
}

extern "C" void kernel_launch(void* const* d_in, const int* in_sizes, int n_in, void* d_out, int out_size, void* d_ws, size_t ws_size, hipStream_t stream) {
    static int grid = 0;
    if (grid == 0) {
        int dev = 0, cus = 0, per_cu = 0;
        hipGetDevice(&dev); hipDeviceGetAttribute(&cus, hipDeviceAttributeMultiprocessorCount, dev);
        hipFuncSetAttribute((const void*)mk_fwd, hipFuncAttributeMaxDynamicSharedMemorySize, LDS_BYTES);
        hipOccupancyMaxActiveBlocksPerMultiprocessor(&per_cu, (const void*)mk_fwd, NTHR, LDS_BYTES);
        if (per_cu < 1) per_cu = 1;
        grid = cus * per_cu;
        if (n_in != 19 || ws_size < WS_END) { fprintf(stderr, "kernel_launch: unexpected n_in %d or ws_size %zu\n", n_in, ws_size); }
    }
    Args a{};
    for (int i = 0; i < 19; ++i) a.in[i] = (const float*)d_in[i];
    a.out = (float*)d_out; a.ws = (unsigned char*)d_ws;
    void* kargs[] = {&a};
    hipError_t e = hipLaunchCooperativeKernel((const void*)mk_fwd, dim3(grid), dim3(NTHR), kargs, LDS_BYTES, stream);
    if (e != hipSuccess) fprintf(stderr, "cooperative launch failed: %s (grid %d)\n", hipGetErrorString(e), grid);
}
```

```cpp
#include <hip/hip_runtime.h>
#include <cstdio>
#include <cstdint>
#ifndef MK_STAGE
#define MK_STAGE 3
#endif
#define PROBE_MASK 0ull
#define PROBE_SYNC 0
#define PROBE_MULT 4
__device__ __forceinline__ int opaque_tid() { int t; asm volatile("v_mov_b32 %0, %1" : "=v"(t) : "v"((int)threadIdx.x)); return t; }
namespace pg8 {
#define PG8_LAS __attribute__((address_space(3)))
typedef unsigned short bf16_t;
typedef short bf16x8 __attribute__((ext_vector_type(8)));
typedef float f32x4 __attribute__((ext_vector_type(4)));
typedef unsigned u32x4 __attribute__((ext_vector_type(4)));
constexpr int BM = 256, BK = 64, HALF = 128, HTB = HALF * BK * 2  , STAGE_BYTES = 8 * HTB, NXCD = 8, WGM = 4;

__host__ __device__ __forceinline__ int lds_byte(int r, int c) { const int st = (r >> 4) * 2 + (c >> 5), rr = r & 15, cc = c & 31, ob = rr * 64 + cc * 2; return st * 1024 + (ob ^ (((ob >> 9) & 1) << 5)); }
__host__ __device__ __forceinline__ void stage_rc(int b, int& R, int& C) { const int st = b / 1024, sb = b % 1024, swz = sb ^ (((sb >> 9) & 1) << 5); R = (st >> 1) * 16 + swz / 64; C = (st & 1) * 32 + (swz % 64) / 2; }
__host__ __device__ __forceinline__ int perm32(int rho) { const int n = rho >> 4, i = rho & 15; return 8 * (i >> 2) + 4 * n + (i & 3); }

struct Unit { int pm, pn; };
struct Gemm { const bf16_t* A; const bf16_t* Bt; int M, N, K, lda, ldb; };

struct StaticOrder {
    int nM, nN, nwg, G, c, skip;
    __host__ __device__ void init(int M, int N, int G_, int c_, int skip_ = 0) { nM = M / BM; nN = N / BM; nwg = nM * nN; G = G_; c = c_; skip = skip_; }
    __host__ __device__ bool next(int i, Unit& u) const {
        const long L = (long)i * G + c; if (L >= nwg) return false;
        int wgid = (int)L; { const int q = nwg / NXCD, r = nwg % NXCD, xcd = wgid % NXCD, off = wgid / NXCD; wgid = (xcd < r ? xcd * (q + 1) : r * (q + 1) + (xcd - r) * q) + off; }
        const int nig = WGM * nN, gid = wgid / nig, fm = gid * WGM, gsz = (nM - fm) < WGM ? (nM - fm) : WGM;
        u.pm = fm + ((wgid % nig) % gsz); u.pn = (wgid % nig) / gsz; if (skip) u.pm += u.pm / 32; return true;
    }
    __device__ __forceinline__ void a_ready(const Unit&) const {}
    __device__ __forceinline__ void done(const Unit&) const {}
};

__device__ __forceinline__ unsigned cvt_pk_bf16(float lo, float hi) { unsigned r; asm volatile("v_cvt_pk_bf16_f32 %0, %1, %2" : "=v"(r) : "v"(lo), "v"(hi)); return r; }
__device__ __forceinline__ float fsigmoid(float x) { return __builtin_amdgcn_rcpf(1.f + __builtin_amdgcn_exp2f(-1.4426950408889634f * x)); }
__device__ __forceinline__ float bflo(unsigned w) { return __uint_as_float(w << 16); }
__device__ __forceinline__ float bfhi(unsigned w) { return __uint_as_float(w & 0xffff0000u); }
constexpr int TPB = 33;
constexpr int PWID = 4608;

struct EpiPlain {
    static constexpr bool PERM = true, AFTER_DRAIN = false;
    bf16_t* O; int ldc;
    __device__ __forceinline__ void operator()(const f32x4 (&acc)[2][2][4][2], const Unit& u, int wr, int wc, int fr, int fq) const {
        const int row0 = u.pm * BM + wr * 64 + fr, col0 = u.pn * BM + wc * 32 + 8 * fq;
#pragma unroll
        for (int ai = 0; ai < 2; ++ai)
#pragma unroll
            for (int m = 0; m < 4; ++m) { bf16_t* rowp = O + (size_t)(row0 + ai * HALF + m * 16) * ldc + col0;
#pragma unroll
                for (int bj = 0; bj < 2; ++bj) { const f32x4 v0 = acc[ai][bj][m][0], v1 = acc[ai][bj][m][1];
                    u32x4 w; w.x = cvt_pk_bf16(v0[0], v0[1]); w.y = cvt_pk_bf16(v0[2], v0[3]); w.z = cvt_pk_bf16(v1[0], v1[1]); w.w = cvt_pk_bf16(v1[2], v1[3]);
                    *(u32x4*)(rowp + bj * HALF) = w; } }
    }
};
struct EpiSwiglu {
    static constexpr bool PERM = true, AFTER_DRAIN = false;
    bf16_t* O; int ldc;
    __device__ __forceinline__ void operator()(const f32x4 (&acc)[2][2][4][2], const Unit& u, int wr, int wc, int fr, int fq) const {
        const int row0 = u.pm * BM + wr * 64 + fr, col0 = u.pn * HALF + wc * 32 + 8 * fq;
#pragma unroll
        for (int ai = 0; ai < 2; ++ai)
#pragma unroll
            for (int m = 0; m < 4; ++m) { bf16_t* rowp = O + (size_t)(row0 + ai * HALF + m * 16) * ldc + col0;
                float h[8];
#pragma unroll
                for (int n = 0; n < 2; ++n)
#pragma unroll
                    for (int k = 0; k < 4; ++k) { const float a = acc[ai][0][m][n][k], b = acc[ai][1][m][n][k]; h[n * 4 + k] = a * fsigmoid(a) * b; }
                u32x4 w; w.x = cvt_pk_bf16(h[0], h[1]); w.y = cvt_pk_bf16(h[2], h[3]); w.z = cvt_pk_bf16(h[4], h[5]); w.w = cvt_pk_bf16(h[6], h[7]);
                *(u32x4*)rowp = w; }
    }
};
template <int XNOUT, int GIDX, int HALFCOEF, int NSUB> struct EpiRes {
    static constexpr bool PERM = true, AFTER_DRAIN = false;
    const float* src_lat; const float* src_ctx; float* dst_lat; float* dst_ctx; const float* mod; const float* gnorm; bf16_t* xn; float* ssq;
    static constexpr int gidx = GIDX, nsub = NSUB; static constexpr float coef = HALFCOEF ? 0.5f : 1.0f;
    __device__ __forceinline__ void operator()(const f32x4 (&acc)[2][2][4][2], const Unit& u, int wr, int wc, int fr, int fq) const {
        asm volatile("" : "+v"(fr));
        const int b = u.pm / TPB, j = u.pm % TPB; const bool isctx = (j == TPB - 1);
        const float* src = isctx ? src_ctx + (size_t)b * 256 * 1024 : src_lat + (size_t)(b * 8192 + j * 256) * 1024;
        float* dst = isctx ? dst_ctx + (size_t)b * 256 * 1024 : dst_lat + (size_t)(b * 8192 + j * 256) * 1024;
        const float* mrow = mod + (size_t)(isctx ? 8 : b) * 9216;
        const float* g = mrow + gidx * 1024;
        const int col0 = u.pn * BM + wc * 32 + 8 * fq;
        f32x4 gv[2][2], gs[2][2];
#pragma unroll
        for (int bj = 0; bj < 2; ++bj)
#pragma unroll
            for (int n = 0; n < 2; ++n) { gv[bj][n] = *(const f32x4*)(g + col0 + bj * HALF + 4 * n) * coef;
                if (XNOUT) gs[bj][n] = *(const f32x4*)(gnorm + col0 + bj * HALF + 4 * n) * (*(const f32x4*)(mrow + (3 * nsub + 1) * 1024 + col0 + bj * HALF + 4 * n) + 1.f); }
#pragma unroll
        for (int ai = 0; ai < 2; ++ai)
#pragma unroll
            for (int m = 0; m < 4; ++m) { const int rl = ai * HALF + wr * 64 + m * 16 + fr; const size_t off = (size_t)rl * 1024 + col0; float sq = 0.f;
#pragma unroll
                for (int bj = 0; bj < 2; ++bj) { f32x4 o[2];
#pragma unroll
                    for (int n = 0; n < 2; ++n) { const f32x4 sv = *(const f32x4*)(src + off + bj * HALF + 4 * n); o[n] = sv + gv[bj][n] * acc[ai][bj][m][n];
                        if (!(XNOUT && isctx)) *(f32x4*)(dst + off + bj * HALF + 4 * n) = o[n]; }
                    if (XNOUT) { sq += (o[0][0] * o[0][0] + o[0][1] * o[0][1]) + (o[0][2] * o[0][2] + o[0][3] * o[0][3]) + (o[1][0] * o[1][0] + o[1][1] * o[1][1]) + (o[1][2] * o[1][2] + o[1][3] * o[1][3]);
                        const f32x4 x0 = o[0] * gs[bj][0], x1 = o[1] * gs[bj][1];
                        u32x4 w; w.x = cvt_pk_bf16(x0[0], x0[1]); w.y = cvt_pk_bf16(x0[2], x0[3]); w.z = cvt_pk_bf16(x1[0], x1[1]); w.w = cvt_pk_bf16(x1[2], x1[3]);
                        *(u32x4*)(xn + (size_t)(u.pm * BM + rl) * 1024 + col0 + bj * HALF) = w; } }
                if (XNOUT) { sq += __shfl_xor(sq, 16); sq += __shfl_xor(sq, 32); if (fq == 0) atomicAdd(ssq + u.pm * BM + rl, sq); }
                if (m & 1) asm volatile("" ::: "memory"); }
    }
};
struct EpiInproj {
    static constexpr bool PERM = true, AFTER_DRAIN = false;
    bf16_t* O; int ldc; const float* ssq; const float* sw; int swld;
    __device__ __forceinline__ void operator()(const f32x4 (&acc)[2][2][4][2], const Unit& u, int wr, int wc, int fr, int fq) const {
        const int row0 = u.pm * BM + wr * 64 + fr, col0 = u.pn * BM + wc * 32 + 8 * fq;
        const float* swr = sw + (size_t)((u.pm % TPB == TPB - 1) ? 8 : u.pm / TPB) * swld + col0;
        f32x4 sv[2][2];
#pragma unroll
        for (int bj = 0; bj < 2; ++bj)
#pragma unroll
            for (int n = 0; n < 2; ++n) sv[bj][n] = *(const f32x4*)(swr + bj * HALF + 4 * n);
#pragma unroll
        for (int ai = 0; ai < 2; ++ai)
#pragma unroll
            for (int m = 0; m < 4; ++m) { const int row = row0 + ai * HALF + m * 16; bf16_t* rowp = O + (size_t)row * ldc + col0;
                const float rstd = 1.f / sqrtf(ssq[row] * (1.f / 1024.f) + 1e-6f);
#pragma unroll
                for (int bj = 0; bj < 2; ++bj) { const f32x4 v0 = acc[ai][bj][m][0] * rstd + sv[bj][0], v1 = acc[ai][bj][m][1] * rstd + sv[bj][1];
                    u32x4 w; w.x = cvt_pk_bf16(v0[0], v0[1]); w.y = cvt_pk_bf16(v0[2], v0[3]); w.z = cvt_pk_bf16(v1[0], v1[1]); w.w = cvt_pk_bf16(v1[2], v1[3]);
                    *(u32x4*)(rowp + bj * HALF) = w; } }
    }
};
struct EpiSwigluN {
    static constexpr bool PERM = true, AFTER_DRAIN = false;
    bf16_t* O; int ldc; const float* ssq; const float* sw; int swld;
    __device__ __forceinline__ void operator()(const f32x4 (&acc)[2][2][4][2], const Unit& u, int wr, int wc, int fr, int fq) const {
        const int row0 = u.pm * BM + wr * 64 + fr, col0 = u.pn * HALF + wc * 32 + 8 * fq;
        const float* swr = sw + (size_t)((u.pm % TPB == TPB - 1) ? 8 : u.pm / TPB) * swld + u.pn * BM + wc * 32 + 8 * fq;
        f32x4 sv[2][2];
#pragma unroll
        for (int bj = 0; bj < 2; ++bj)
#pragma unroll
            for (int n = 0; n < 2; ++n) sv[bj][n] = *(const f32x4*)(swr + bj * HALF + 4 * n);
#pragma unroll
        for (int ai = 0; ai < 2; ++ai)
#pragma unroll
            for (int m = 0; m < 4; ++m) { const int row = row0 + ai * HALF + m * 16; bf16_t* rowp = O + (size_t)row * ldc + col0;
                const float rstd = 1.f / sqrtf(ssq[row] * (1.f / 1024.f) + 1e-6f);
                float h[8];
#pragma unroll
                for (int n = 0; n < 2; ++n)
#pragma unroll
                    for (int k = 0; k < 4; ++k) { const float a = acc[ai][0][m][n][k] * rstd + sv[0][n][k], b = acc[ai][1][m][n][k] * rstd + sv[1][n][k]; h[n * 4 + k] = a * fsigmoid(a) * b; }
                u32x4 w; w.x = cvt_pk_bf16(h[0], h[1]); w.y = cvt_pk_bf16(h[2], h[3]); w.z = cvt_pk_bf16(h[4], h[5]); w.w = cvt_pk_bf16(h[6], h[7]);
                *(u32x4*)rowp = w; }
    }
};
template <int SECOND> struct EpiGate {
    static constexpr bool PERM = true, AFTER_DRAIN = false;
    const bf16_t* P; const float* bgate; bf16_t* Z;
    __device__ __forceinline__ void operator()(const f32x4 (&acc)[2][2][4][2], const Unit& u, int wr, int wc, int fr, int fq) const {
        const int row0 = u.pm * BM + wr * 64 + fr, col0 = u.pn * BM + wc * 32 + 8 * fq;
        f32x4 bg[2][2];
#pragma unroll
        for (int bj = 0; bj < 2; ++bj)
#pragma unroll
            for (int n = 0; n < 2; ++n) bg[bj][n] = *(const f32x4*)(bgate + 1024 * SECOND + col0 + bj * HALF + 4 * n);
#pragma unroll
        for (int ai = 0; ai < 2; ++ai)
#pragma unroll
            for (int m = 0; m < 4; ++m) { const size_t row = (size_t)(row0 + ai * HALF + m * 16);
#pragma unroll
                for (int bj = 0; bj < 2; ++bj) { const int c = col0 + bj * HALF;
                    const u32x4 gr = *(const u32x4*)(P + row * PWID + 2304 + 1024 * SECOND + c);
                    float v[8];
                    v[0] = fsigmoid(bflo(gr.x) + bg[bj][0][0]) * acc[ai][bj][m][0][0]; v[1] = fsigmoid(bfhi(gr.x) + bg[bj][0][1]) * acc[ai][bj][m][0][1];
                    v[2] = fsigmoid(bflo(gr.y) + bg[bj][0][2]) * acc[ai][bj][m][0][2]; v[3] = fsigmoid(bfhi(gr.y) + bg[bj][0][3]) * acc[ai][bj][m][0][3];
                    v[4] = fsigmoid(bflo(gr.z) + bg[bj][1][0]) * acc[ai][bj][m][1][0]; v[5] = fsigmoid(bfhi(gr.z) + bg[bj][1][1]) * acc[ai][bj][m][1][1];
                    v[6] = fsigmoid(bflo(gr.w) + bg[bj][1][2]) * acc[ai][bj][m][1][2]; v[7] = fsigmoid(bfhi(gr.w) + bg[bj][1][3]) * acc[ai][bj][m][1][3];
                    bf16_t* zp = Z + row * 1024 + c;
                    if (SECOND) { const u32x4 zr = *(const u32x4*)zp;
                        v[0] += bflo(zr.x); v[1] += bfhi(zr.x); v[2] += bflo(zr.y); v[3] += bfhi(zr.y); v[4] += bflo(zr.z); v[5] += bfhi(zr.z); v[6] += bflo(zr.w); v[7] += bfhi(zr.w); }
                    u32x4 w; w.x = cvt_pk_bf16(v[0], v[1]); w.y = cvt_pk_bf16(v[2], v[3]); w.z = cvt_pk_bf16(v[4], v[5]); w.w = cvt_pk_bf16(v[6], v[7]);
                    *(u32x4*)zp = w; } }
    }
};
template <class Epi, class Sched, bool ALIGN_EPI = false, bool SP2 = false>
__device__ __forceinline__ void gemm_phase(PG8_LAS unsigned char* lds, const Gemm g, const Sched& S, const Epi& E) {
    const int tid = opaque_tid(), wid = __builtin_amdgcn_readfirstlane(tid >> 6), lane = tid & 63, wr = wid >> 2, wc = wid & 3, fr = lane & 15, fq = lane >> 4;
    const int K = g.K, nt = K / BK;
    unsigned voffA[2], voffB[2];
#pragma unroll
    for (int i = 0; i < 2; ++i) { int R, C; stage_rc(tid * 16 + i * 8192, R, C); const int Rb = Epi::PERM ? ((R & ~31) + perm32(R & 31)) : R;
        voffA[i] = (unsigned)(R * g.lda + C) * 2u; voffB[i] = (unsigned)(Rb * g.ldb + C) * 2u; }
    const size_t kstep = (size_t)(BK * 2);
    const size_t hstepA = (size_t)HALF * g.lda * 2, hstepB = (size_t)HALF * g.ldb * 2;
    const size_t tstepA = 2 * hstepA, tstepB = 2 * hstepB;
    const unsigned ldsw = (unsigned)wid * 1024u;
    const int aoff = lds_byte(wr * 64 + fr, fq * 8), boff = lds_byte(wc * 32 + fr, fq * 8);
#define PG8_SA(b, h) (((b) * 2 + (h)) * HTB)
#define PG8_SB(b, h) ((4 + (b) * 2 + (h)) * HTB)
#define PG8_STAGE(bufoff, gbase, voff) do { _Pragma("unroll") for (int _i = 0; _i < 2; ++_i) \
        __builtin_amdgcn_global_load_lds((const unsigned*)((const char*)(gbase) + (voff)[_i]), (PG8_LAS unsigned*)(lds + (bufoff) + ldsw + _i * 8192), 16, 0, 0); } while (0)
#define PG8_LDA(dst, b, h) do { _Pragma("unroll") for (int m = 0; m < 4; ++m) _Pragma("unroll") for (int k = 0; k < 2; ++k) dst[m][k] = *(const PG8_LAS bf16x8*)(lds + PG8_SA(b, h) + aoff + m * 2048 + k * 1024); } while (0)
#define PG8_LDB(dst, b, h) do { _Pragma("unroll") for (int n = 0; n < 2; ++n) _Pragma("unroll") for (int k = 0; k < 2; ++k) dst[n][k] = *(const PG8_LAS bf16x8*)(lds + PG8_SB(b, h) + boff + n * 2048 + k * 1024); } while (0)
#define PG8_MMA(ai, bj, At, Bt) do { __builtin_amdgcn_s_setprio(1); _Pragma("unroll") for (int m = 0; m < 4; ++m) _Pragma("unroll") for (int n = 0; n < 2; ++n) _Pragma("unroll") for (int k = 0; k < 2; ++k) \
        acc[ai][bj][m][n] = __builtin_amdgcn_mfma_f32_16x16x32_bf16(Bt[n][k], At[m][k], acc[ai][bj][m][n], 0, 0, 0); __builtin_amdgcn_s_setprio(0); } while (0)
#define PG8_WAIT_V(n) asm volatile("s_waitcnt vmcnt(" #n ")" ::: "memory")
#define PG8_WAIT_L(n) asm volatile("s_waitcnt lgkmcnt(" #n ")" ::: "memory")
#define PG8_BAR __builtin_amdgcn_s_barrier()
#define PG8_SCHED __builtin_amdgcn_sched_barrier(0)
    Unit cur, nxt; int ui = 0;
    if (!S.next(0, cur)) return;
    f32x4 acc[2][2][4][2];
#pragma unroll
    for (int a = 0; a < 2; ++a)
#pragma unroll
        for (int b = 0; b < 2; ++b)
#pragma unroll
            for (int m = 0; m < 4; ++m)
#pragma unroll
                for (int n = 0; n < 2; ++n) acc[a][b][m][n] = (f32x4){0.f, 0.f, 0.f, 0.f};
    bf16x8 At[4][2], B0[2][2], B1[2][2];
    const char* cA = (const char*)g.A + (size_t)cur.pm * tstepA; const char* cB = (const char*)g.Bt + (size_t)cur.pn * tstepB;
    S.a_ready(cur);
    if constexpr (SP2) {
        PG8_STAGE(PG8_SB(0, 0), cB, voffB); PG8_STAGE(PG8_SB(0, 1), cB + hstepB, voffB); PG8_STAGE(PG8_SA(0, 0), cA, voffA); PG8_STAGE(PG8_SA(0, 1), cA + hstepA, voffA);
        if (wr == 1) PG8_BAR;
        PG8_WAIT_V(2); PG8_BAR;
        PG8_STAGE(PG8_SB(1, 0), cB + kstep, voffB); PG8_STAGE(PG8_SA(1, 0), cA + kstep, voffA); PG8_STAGE(PG8_SB(1, 1), cB + hstepB + kstep, voffB);
        PG8_WAIT_V(6); PG8_BAR;
    } else {
        PG8_STAGE(PG8_SB(0, 0), cB, voffB); PG8_STAGE(PG8_SA(0, 0), cA, voffA); PG8_STAGE(PG8_SB(0, 1), cB + hstepB, voffB); PG8_STAGE(PG8_SA(0, 1), cA + hstepA, voffA);
        if (wr == 1) PG8_BAR;
        PG8_WAIT_V(4); PG8_BAR;
        PG8_STAGE(PG8_SB(1, 0), cB + kstep, voffB); PG8_STAGE(PG8_SA(1, 0), cA + kstep, voffA); PG8_STAGE(PG8_SB(1, 1), cB + hstepB + kstep, voffB);
        PG8_WAIT_V(6); PG8_BAR;
    }
    for (;;) {
        const bool has_next = S.next(ui + 1, nxt);
        const char* nA = has_next ? (const char*)g.A + (size_t)nxt.pm * tstepA : cA; const char* nB = has_next ? (const char*)g.Bt + (size_t)nxt.pn * tstepB : cB;
        for (int t = 0; t < nt; t += 2) {
            const bool last = (t == nt - 2);
            const char* a1 = cA + (size_t)(t + 1) * kstep;
            const char* a2 = last ? nA : cA + (size_t)(t + 2) * kstep; const char* b2 = last ? nB : cB + (size_t)(t + 2) * kstep;
            const char* a3 = a2 + kstep; const char* b3 = b2 + kstep;
            if (last && has_next) S.a_ready(nxt);
            if constexpr (SP2) {
            PG8_LDB(B0, 0, 0); PG8_LDB(B1, 0, 1); PG8_SCHED; PG8_LDA(At, 0, 0); PG8_STAGE(PG8_SA(1, 1), a1 + hstepA, voffA);
            PG8_WAIT_V(8); PG8_WAIT_L(0); PG8_BAR; PG8_MMA(0, 0, At, B0); PG8_MMA(0, 1, At, B1); PG8_BAR; PG8_SCHED;
            PG8_LDA(At, 0, 1); PG8_STAGE(PG8_SB(0, 0), b2, voffB); PG8_STAGE(PG8_SB(0, 1), b2 + hstepB, voffB); PG8_STAGE(PG8_SA(0, 0), a2, voffA);
            PG8_WAIT_V(8); PG8_WAIT_L(0); PG8_BAR; PG8_MMA(1, 0, At, B0); PG8_MMA(1, 1, At, B1); PG8_BAR; PG8_SCHED;
            PG8_LDB(B0, 1, 0); PG8_LDB(B1, 1, 1); PG8_SCHED; PG8_LDA(At, 1, 0); PG8_STAGE(PG8_SA(0, 1), a2 + hstepA, voffA);
            PG8_WAIT_V(8); PG8_WAIT_L(0); PG8_BAR; PG8_MMA(0, 0, At, B0); PG8_MMA(0, 1, At, B1); PG8_BAR; PG8_SCHED;
            PG8_LDA(At, 1, 1); PG8_STAGE(PG8_SB(1, 0), b3, voffB); PG8_STAGE(PG8_SB(1, 1), b3 + hstepB, voffB); PG8_STAGE(PG8_SA(1, 0), a3, voffA);
            PG8_WAIT_V(8); PG8_WAIT_L(0); PG8_BAR; PG8_MMA(1, 0, At, B0); PG8_MMA(1, 1, At, B1); PG8_BAR; PG8_SCHED;
            } else {
            PG8_LDB(B0, 0, 0); PG8_SCHED; PG8_LDA(At, 0, 0); PG8_STAGE(PG8_SA(1, 1), a1 + hstepA, voffA);
            PG8_WAIT_L(8); PG8_BAR; PG8_WAIT_L(0); PG8_MMA(0, 0, At, B0); PG8_BAR; PG8_SCHED;
            PG8_LDB(B1, 0, 1); PG8_STAGE(PG8_SB(0, 0), b2, voffB);
            PG8_BAR; PG8_WAIT_L(0); PG8_MMA(0, 1, At, B1); PG8_BAR;
            PG8_LDA(At, 0, 1); PG8_STAGE(PG8_SA(0, 0), a2, voffA);
            PG8_BAR; PG8_WAIT_L(0); PG8_MMA(1, 0, At, B0); PG8_BAR; PG8_SCHED;
            PG8_STAGE(PG8_SB(0, 1), b2 + hstepB, voffB);
            PG8_WAIT_V(6); PG8_BAR; PG8_MMA(1, 1, At, B1); PG8_BAR;
            PG8_LDB(B0, 1, 0); PG8_SCHED; PG8_LDA(At, 1, 0); PG8_STAGE(PG8_SA(0, 1), a2 + hstepA, voffA);
            PG8_WAIT_L(8); PG8_BAR; PG8_WAIT_L(0); PG8_MMA(0, 0, At, B0); PG8_BAR; PG8_SCHED;
            PG8_LDB(B1, 1, 1); PG8_STAGE(PG8_SB(1, 0), b3, voffB);
            PG8_BAR; PG8_WAIT_L(0); PG8_MMA(0, 1, At, B1); PG8_BAR;
            PG8_LDA(At, 1, 1); PG8_STAGE(PG8_SA(1, 0), a3, voffA);
            PG8_BAR; PG8_WAIT_L(0); PG8_MMA(1, 0, At, B0); PG8_BAR; PG8_SCHED;
            PG8_STAGE(PG8_SB(1, 1), b3 + hstepB, voffB);
            PG8_WAIT_V(6); PG8_BAR; PG8_MMA(1, 1, At, B1); PG8_BAR;
            }
        }
        if constexpr (ALIGN_EPI) { if (wr == 0) PG8_BAR; }
        if constexpr (!Epi::AFTER_DRAIN) { E(acc, cur, wr, wc, fr, fq); S.done(cur); }
        if (!has_next) break;
#pragma unroll
        for (int a = 0; a < 2; ++a)
#pragma unroll
            for (int b = 0; b < 2; ++b)
#pragma unroll
                for (int m = 0; m < 4; ++m)
#pragma unroll
                    for (int n = 0; n < 2; ++n) acc[a][b][m][n] = (f32x4){0.f, 0.f, 0.f, 0.f};
        cur = nxt; cA = nA; cB = nB; ++ui;
        if constexpr (ALIGN_EPI) { if (wr == 1) PG8_BAR; }
    }
    PG8_WAIT_V(0);
    if constexpr (!ALIGN_EPI) { if (wr == 0) PG8_BAR; }
    PG8_BAR;
    if constexpr (Epi::AFTER_DRAIN) { E.fused(acc, cur, wr, wc, fr, fq, lds, wid, lane); S.done(cur); }
#undef PG8_SA
#undef PG8_SB
#undef PG8_STAGE
#undef PG8_LDA
#undef PG8_LDB
#undef PG8_MMA
#undef PG8_WAIT_V
#undef PG8_WAIT_L
#undef PG8_BAR
#undef PG8_SCHED
}
}
#include <hip/hip_bf16.h>
#include <cmath>
namespace attn_body {
using bf16=__hip_bfloat16;
using bf16x8=__attribute__((ext_vector_type(8)))short;
using s16x4=__attribute__((ext_vector_type(4)))short;
using f32x16=__attribute__((ext_vector_type(16)))float;
using u32x4=__attribute__((ext_vector_type(4)))unsigned;
constexpr int SEQ=8448,D=64,DM=4608,NTILES=132;
constexpr int NW=8,QBLK=32,QB=QBLK*NW,KVBLK=64;
constexpr int ATTN_PITCH=DM, ATTN_UNIT_ROWS=QB;
__device__ __forceinline__ int crow(int r,int hi){return (r&3)+8*(r>>2)+4*hi;}
#define SBAR() __builtin_amdgcn_sched_barrier(0)
__device__ __forceinline__ void cmask(f32x16&p0,f32x16&p1,int jb,int qrel,int hi){
  const float NEG=-INFINITY; int kb=64*jb+4*hi;
  #pragma unroll
  for(int r=0;r<16;++r){int kv=kb+(r&3)+8*(r>>2); if(kv>qrel)p0[r]=NEG; if(kv+32>qrel)p1[r]=NEG;}
}

constexpr int NSLOT=3, SLOTB=8192;
constexpr int LDS_K=0, LDS_V=NSLOT*SLOTB, LDS_WS=2*NSLOT*SLOTB, LDS_OST=LDS_WS+NW*64*4, LDS_BYTES=LDS_OST+NW*4096;
constexpr float C2=0.125f*1.4426950408889634f;
__device__ __forceinline__ void glds16(const void*gsrc,unsigned lds_dst){unsigned keep;
  asm volatile("s_mov_b32 %0, m0\n\ts_mov_b32 m0, %2\n\ts_nop 0\n\tglobal_load_lds_dwordx4 %1, off\n\ts_mov_b32 m0, %0":"=&s"(keep):"v"(gsrc),"s"(lds_dst):"memory");}
__device__ __forceinline__ float max3f(float a,float b,float c){float r;asm("v_max3_f32 %0, %1, %2, %3":"=v"(r):"v"(a),"v"(b),"v"(c));return r;}
__device__ __forceinline__ float max2f(float a,float b){float r;asm("v_max_f32_e32 %0, %1, %2":"=v"(r):"v"(a),"v"(b));return r;}
__device__ __forceinline__ float fadd_s(float a,float b){float r;asm("v_add_f32_e32 %0, %1, %2":"=v"(r):"v"(a),"v"(b));return r;}
__device__ __forceinline__ float fsub_s(float a,float b){float r;asm("v_sub_f32_e32 %0, %1, %2":"=v"(r):"v"(a),"v"(b));return r;}
typedef float f32x2_t __attribute__((ext_vector_type(2))); typedef __bf16 bf16x2_t __attribute__((ext_vector_type(2)));
__device__ __forceinline__ unsigned cvtpk_s(float lo,float hi){f32x2_t v={lo,hi};bf16x2_t b=__builtin_convertvector(v,bf16x2_t);return __builtin_bit_cast(unsigned,b);}
#define WAIT_BAR(N) asm volatile("s_waitcnt vmcnt(" #N ") lgkmcnt(0)\n\ts_barrier":::"memory")

__device__ __forceinline__ void qkt(f32x16&p0,f32x16&p1,const char*Kslot,const bf16x8*qr,const f32x16&negm,int r32,int hi){
  const char*kb=Kslot+hi*1024+r32*16;
  #pragma unroll
  for(int d0=0;d0<4;++d0){
    const bf16x8 b0=*reinterpret_cast<const bf16x8*>(kb+d0*2048);
    const bf16x8 b1=*reinterpret_cast<const bf16x8*>(kb+d0*2048+512);
    if(d0==0){p0=__builtin_amdgcn_mfma_f32_32x32x16_bf16(b0,qr[0],negm,0,0,0);p1=__builtin_amdgcn_mfma_f32_32x32x16_bf16(b1,qr[0],negm,0,0,0);}
    else{p0=__builtin_amdgcn_mfma_f32_32x32x16_bf16(b0,qr[d0],p0,0,0,0);p1=__builtin_amdgcn_mfma_f32_32x32x16_bf16(b1,qr[d0],p1,0,0,0);}}
}
typedef __attribute__((address_space(3))) const char* lds_cptr;
typedef short v4i16_t __attribute__((ext_vector_type(4)));
__device__ __forceinline__ void kload8(bf16x8*kf,lds_cptr kp){
  kf[0]=*(const __attribute__((address_space(3))) bf16x8*)(kp);      kf[1]=*(const __attribute__((address_space(3))) bf16x8*)(kp+512);
  kf[2]=*(const __attribute__((address_space(3))) bf16x8*)(kp+2048); kf[3]=*(const __attribute__((address_space(3))) bf16x8*)(kp+2560);
  kf[4]=*(const __attribute__((address_space(3))) bf16x8*)(kp+4096); kf[5]=*(const __attribute__((address_space(3))) bf16x8*)(kp+4608);
  kf[6]=*(const __attribute__((address_space(3))) bf16x8*)(kp+6144); kf[7]=*(const __attribute__((address_space(3))) bf16x8*)(kp+6656);
}
__device__ __forceinline__ void kload2(bf16x8*kf,lds_cptr kp,int j){ kf[2*j]=*(const __attribute__((address_space(3))) bf16x8*)(kp+j*2048); kf[2*j+1]=*(const __attribute__((address_space(3))) bf16x8*)(kp+j*2048+512); }
__device__ __forceinline__ s16x4 vtr(lds_cptr p){ return __builtin_bit_cast(s16x4,__builtin_amdgcn_ds_read_tr16_b64_v4i16((__attribute__((address_space(3))) v4i16_t*)p)); }
__device__ __forceinline__ float rowmax(const f32x16&p0,const f32x16&p1){
  float a=max3f(p0[0],p0[1],p1[0]),b=max3f(p0[2],p0[3],p1[1]);a=max3f(a,p1[2],p1[3]);
  #pragma unroll
  for(int r=4;r<16;r+=4){a=max3f(a,p0[r],p0[r+1]);b=max3f(b,p0[r+2],p0[r+3]);a=max3f(a,p1[r],p1[r+1]);b=max3f(b,p1[r+2],p1[r+3]);}
  const float m=max2f(a,b);
  auto rr=__builtin_amdgcn_permlane32_swap(__float_as_uint(m),__float_as_uint(m),false,false);
  return max2f(__uint_as_float(rr[0]),__uint_as_float(rr[1]));
}
__device__ __forceinline__ void pv(f32x16*o,int vb,bf16x8 pa0,bf16x8 pa1,bf16x8 pa2,bf16x8 pa3){
  #pragma unroll
  for(int d0=0;d0<2;++d0){s16x4 lo[4],hi[4];
    #pragma unroll
    for(int ks=0;ks<4;++ks){
      asm volatile("ds_read_b64_tr_b16 %0,%1 offset:%c2":"=&v"(lo[ks]):"v"(vb),"i"(d0*4096+ks*1024):"memory");
      asm volatile("ds_read_b64_tr_b16 %0,%1 offset:%c2":"=&v"(hi[ks]):"v"(vb),"i"(d0*4096+ks*1024+512):"memory");}
    asm volatile("s_waitcnt lgkmcnt(0)":::"memory");SBAR();
    #define PK(k) (bf16x8){lo[k][0],lo[k][1],lo[k][2],lo[k][3],hi[k][0],hi[k][1],hi[k][2],hi[k][3]}
    o[d0]=__builtin_amdgcn_mfma_f32_32x32x16_bf16(pa0,PK(0),o[d0],0,0,0);
    o[d0]=__builtin_amdgcn_mfma_f32_32x32x16_bf16(pa1,PK(1),o[d0],0,0,0);
    o[d0]=__builtin_amdgcn_mfma_f32_32x32x16_bf16(pa2,PK(2),o[d0],0,0,0);
    o[d0]=__builtin_amdgcn_mfma_f32_32x32x16_bf16(pa3,PK(3),o[d0],0,0,0);
    #undef PK
  }
}

#ifndef ATTN_STORE16
#define ATTN_STORE16(p,v) (*(u32x4*)(p)=(v))
#endif
template<int THRL,bool NOMAX> __device__ __forceinline__ void attn_unit(int b,int h,int hk,int qb,const bf16*Q,const bf16*__restrict__ K,const bf16*__restrict__ V,bf16*O,char*shm){
  const int tid=opaque_tid(),lane=tid&63,r32=lane&31,hi=lane>>5; const int wid=__builtin_amdgcn_readfirstlane(tid>>6);
  const long rowbase=(long)b*SEQ; const int q0=qb*QB;
  const bf16*Qw=Q+(rowbase+q0+wid*QBLK)*DM+h*D;
  const bf16*Kh=K+rowbase*DM+hk*D,*Vh=V+rowbase*DM+hk*D;
  const unsigned lds0=(unsigned)(uintptr_t)shm;
  float*wsf=(float*)(shm+LDS_WS)+wid*64;
  const bf16*ksrc=Kh+(long)lane*DM+wid*8;
  const bf16*vsrc=Vh+(long)(16*(wid&3)+(lane>>2))*DM+(wid>>2)*32+(lane&3)*8;
  const unsigned kdst=lds0+LDS_K+wid*1024, vdst=lds0+LDS_V+wid*1024;
  #define DMA_K(t,slot) glds16(ksrc+(long)(t)*KVBLK*DM,(unsigned)__builtin_amdgcn_readfirstlane(kdst+(slot)))
  #define DMA_V(t,slot) glds16(vsrc+(long)(t)*KVBLK*DM,(unsigned)__builtin_amdgcn_readfirstlane(vdst+(slot)))
  const int vb0=(int)(lds0+LDS_V)+((lane>>4)&1)*32+(lane&3)*8+(4*hi+((lane&15)>>2))*64;
  const char*Kbase=shm+LDS_K; bf16x8 kf[8];
  const lds_cptr shm3=(lds_cptr)shm; const lds_cptr kp0=shm3+LDS_K+hi*1024+r32*16; const lds_cptr vp0=shm3+LDS_V+((lane>>4)&1)*32+(lane&3)*8+(4*hi+((lane&15)>>2))*64;
  constexpr int NT=NTILES;
  DMA_K(0,0);DMA_V(0,0);DMA_K(1,SLOTB);
  bf16x8 qr[4];
  #pragma unroll
  for(int d0=0;d0<4;++d0)qr[d0]=*reinterpret_cast<const bf16x8*>(&Qw[(long)r32*DM+d0*16+hi*8]);
  float mhat=0.f,l_reg=0.f;f32x16 o[2];o[0]=f32x16{};o[1]=f32x16{};f32x16 negm=f32x16{};asm volatile("":"+v"(negm));
  #define CMASK(P0,P1,t) do{}while(0)
  bool resc=false;
  #define START(P0,P1) do{ const float rm=rowmax(P0,P1); resc=false; \
    { const float dl=rm; mhat=fadd_s(mhat,dl); \
      _Pragma("unroll") for(int r=0;r<16;++r){P0[r]=fsub_s(P0[r],dl);P1[r]=fsub_s(P1[r],dl);} \
      _Pragma("unroll") for(int r=0;r<16;++r)negm[r]=-mhat; asm volatile("":"+v"(negm)); } \
    _Pragma("unroll") for(int r=0;r<16;++r)P0[r]=__builtin_amdgcn_exp2f(P0[r]); }while(0)
  #define RESC() do{ if(resc){ asm volatile("s_waitcnt lgkmcnt(0)":::"memory"); \
      _Pragma("unroll") for(int d_=0;d_<2;++d_) _Pragma("unroll") for(int r=0;r<16;++r)o[d_][r]*=wsf[crow(r,hi)]; } }while(0)
  f32x16 pA0,pA1,pB0,pB1;
  int sl_prev=0,sl_cur=0,sl_next=SLOTB;
  #define ROT() do{sl_prev=sl_cur;sl_cur=sl_next;sl_next=(sl_next==(NSLOT-1)*SLOTB)?0:sl_next+SLOTB;}while(0)
  DMA_K(2,2*SLOTB);
  WAIT_BAR(3);
  qkt(pA0,pA1,Kbase,qr,negm,r32,hi);asm volatile("s_nop 15\n\ts_nop 7":"+v"(pA0),"+v"(pA1));CMASK(pA0,pA1,0);
  START(pA0,pA1);
  _Pragma("unroll") for(int r=0;r<16;++r)pA1[r]=__builtin_amdgcn_exp2f(pA1[r]);
  WAIT_BAR(0);
  DMA_K(3,0);DMA_V(1,SLOTB);
  ROT();
  kload8(kf,kp0+sl_cur);
  WAIT_BAR(2);
  s16x4 vlo[8],vhi[8]; u32x4 pw0,pw1,pw2,pw3;
  #define PKW(P,B) cvtpk_s(P[B],P[B+1])
  #define PAF(k) __builtin_bit_cast(bf16x8,pw##k)
  #define VFR(i) (bf16x8){vlo[i][0],vlo[i][1],vlo[i][2],vlo[i][3],vhi[i][0],vhi[i][1],vhi[i][2],vhi[i][3]}
  #define PIN(x) asm volatile("":"+v"(x))
  #define MX3(a,b,c) __builtin_fmaxf(__builtin_fmaxf((a),(b)),(c))
  #define GAPA(MF,A0,A1,A2,A3,W0,W1,PW) do{ MF; sacc+=A0; sacc+=A1; sacc+=A2; sacc+=A3; PIN(sacc); W0; W1; PIN(PW); SBAR(); }while(0)
  #define EX(v) __builtin_amdgcn_exp2f(v)
  #define GAPB(MF,X,B) do{ MF; X[B]=EX(X[B]); X[B+1]=EX(X[B+1]); X[B+2]=EX(X[B+2]); X[B+3]=EX(X[B+3]); PIN(X); SBAR(); }while(0)
  #define VRD(i) do{ vlo[i]=vtr(vp_+(((i)>>2)*4096+((i)&3)*1024)); vhi[i]=vtr(vp_+(((i)>>2)*4096+((i)&3)*1024+512)); }while(0)
  #define KRD(G,j) do{ if(G){ kload2(kf,kp0+sl_next,j); SBAR(); } }while(0)
  #define STEP(C0,C1,P0,P1,t,GK,GV,GL) do{ SBAR(); \
    const lds_cptr vp_=vp0+sl_prev; \
    VRD(0); SBAR(); float sacc=(P0[0]+P0[1]); \
    GAPA(C0=__builtin_amdgcn_mfma_f32_32x32x16_bf16(kf[0],qr[0],negm,0,0,0), P0[2],P0[3],P0[4],P0[5],     pw0[0]=PKW(P0,0), pw0[1]=PKW(P0,2), pw0); \
    VRD(4); SBAR(); GAPA(C1=__builtin_amdgcn_mfma_f32_32x32x16_bf16(kf[1],qr[0],negm,0,0,0), P0[6],P0[7],P0[8],P0[9],     pw0[2]=PKW(P0,4), pw0[3]=PKW(P0,6), pw0); \
    VRD(1); SBAR(); GAPA(C0=__builtin_amdgcn_mfma_f32_32x32x16_bf16(kf[2],qr[1],C0,0,0,0),   P0[10],P0[11],P0[12],P0[13], pw1[0]=PKW(P0,8), pw1[1]=PKW(P0,10), pw1); \
    VRD(5); SBAR(); GAPA(C1=__builtin_amdgcn_mfma_f32_32x32x16_bf16(kf[3],qr[1],C1,0,0,0),   P0[14],P0[15],P1[0],P1[1],   pw1[2]=PKW(P0,12),pw1[3]=PKW(P0,14), pw1); \
    VRD(2); SBAR(); GAPA(C0=__builtin_amdgcn_mfma_f32_32x32x16_bf16(kf[4],qr[2],C0,0,0,0),   P1[2],P1[3],P1[4],P1[5],     pw2[0]=PKW(P1,0), pw2[1]=PKW(P1,2), pw2); \
    VRD(6); SBAR(); GAPA(C1=__builtin_amdgcn_mfma_f32_32x32x16_bf16(kf[5],qr[2],C1,0,0,0),   P1[6],P1[7],P1[8],P1[9],     pw2[2]=PKW(P1,4), pw2[3]=PKW(P1,6), pw2); \
    VRD(3); SBAR(); GAPA(C0=__builtin_amdgcn_mfma_f32_32x32x16_bf16(kf[6],qr[3],C0,0,0,0),   P1[10],P1[11],P1[12],P1[13], pw3[0]=PKW(P1,8), pw3[1]=PKW(P1,10), pw3); \
    VRD(7); SBAR(); GAPA(C1=__builtin_amdgcn_mfma_f32_32x32x16_bf16(kf[7],qr[3],C1,0,0,0),   P1[14],P1[15],0.f,0.f,       pw3[2]=PKW(P1,12),pw3[3]=PKW(P1,14), pw3); \
    l_reg+=sacc; \
    if(GK){DMA_K((t)+3,sl_cur);} if(GV){DMA_V((t)+1,sl_next);} \
    CMASK(C0,C1,t); \
    if constexpr(!NOMAX){ float a=MX3(C0[0],C0[1],C1[0]),b=MX3(C0[2],C0[3],C1[1]); a=MX3(a,C1[2],C1[3]); \
      _Pragma("unroll") for(int r=4;r<16;r+=4){a=MX3(a,C0[r],C0[r+1]);b=MX3(b,C0[r+2],C0[r+3]);a=MX3(a,C1[r],C1[r+1]);b=MX3(b,C1[r+2],C1[r+3]);} \
      float rm=__builtin_fmaxf(a,b); { auto rr=__builtin_amdgcn_permlane32_swap(__float_as_uint(rm),__float_as_uint(rm),false,false); rm=__builtin_fmaxf(__uint_as_float(rr[0]),__uint_as_float(rr[1])); } \
      resc=false; \
      if(__builtin_expect(__any(rm>(float)THRL),0)){ const float dl=__builtin_fmaxf(rm,0.f); mhat+=dl; \
        _Pragma("unroll") for(int r=0;r<16;++r){C0[r]-=dl;C1[r]-=dl;} \
        _Pragma("unroll") for(int r=0;r<16;++r)negm[r]=-mhat; asm volatile("":"+v"(negm)); \
        const float f=__builtin_amdgcn_exp2f(-dl); l_reg*=f; if(hi==0)wsf[r32]=f; resc=true; } } \
    SBAR(); \
    GAPB(o[0]=__builtin_amdgcn_mfma_f32_32x32x16_bf16(PAF(0),VFR(0),o[0],0,0,0), C0,0); \
    GAPB(o[1]=__builtin_amdgcn_mfma_f32_32x32x16_bf16(PAF(0),VFR(4),o[1],0,0,0), C0,4); \
    KRD(GL,0); GAPB(o[0]=__builtin_amdgcn_mfma_f32_32x32x16_bf16(PAF(1),VFR(1),o[0],0,0,0), C0,8); \
    KRD(GL,1); GAPB(o[1]=__builtin_amdgcn_mfma_f32_32x32x16_bf16(PAF(1),VFR(5),o[1],0,0,0), C0,12); \
    KRD(GL,2); GAPB(o[0]=__builtin_amdgcn_mfma_f32_32x32x16_bf16(PAF(2),VFR(2),o[0],0,0,0), C1,0); \
    KRD(GL,3); GAPB(o[1]=__builtin_amdgcn_mfma_f32_32x32x16_bf16(PAF(2),VFR(6),o[1],0,0,0), C1,4); \
    GAPB(o[0]=__builtin_amdgcn_mfma_f32_32x32x16_bf16(PAF(3),VFR(3),o[0],0,0,0), C1,8); \
    GAPB(o[1]=__builtin_amdgcn_mfma_f32_32x32x16_bf16(PAF(3),VFR(7),o[1],0,0,0), C1,12); \
    }while(0)
  int t=1;
  #undef CMASK
  #define CMASK(P0,P1,t) do{}while(0)
  for(;t+5<NT;t+=2){
    STEP(pB0,pB1,pA0,pA1,t,true,true,true);     WAIT_BAR(2); RESC(); ROT();
    STEP(pA0,pA1,pB0,pB1,t+1,true,true,true);   WAIT_BAR(2); RESC(); ROT();
  }
  #undef CMASK
  #define CMASK(P0,P1,t) do{}while(0)
  #define ENDW(tt) do{ if((tt)+3<NT){WAIT_BAR(2);} else if((tt)+2<NT){WAIT_BAR(1);} else {WAIT_BAR(0);} }while(0)
  for(;t+1<NT;t+=2){
    STEP(pB0,pB1,pA0,pA1,t,(t+3<NT),(t+1<NT),(t+1<NT));       ENDW(t);   RESC(); ROT();
    STEP(pA0,pA1,pB0,pB1,t+1,(t+4<NT),(t+2<NT),(t+2<NT));     ENDW(t+1); RESC(); ROT();
  }
  STEP(pB0,pB1,pA0,pA1,NT-1,false,false,false); RESC();
  { float sacc=pB0[0]+pB0[1]; _Pragma("unroll") for(int r=2;r<16;++r)sacc+=pB0[r]; _Pragma("unroll") for(int r=0;r<16;++r)sacc+=pB1[r]; l_reg+=sacc;
    pw0=(u32x4){PKW(pB0,0),PKW(pB0,2),PKW(pB0,4),PKW(pB0,6)};pw1=(u32x4){PKW(pB0,8),PKW(pB0,10),PKW(pB0,12),PKW(pB0,14)};pw2=(u32x4){PKW(pB1,0),PKW(pB1,2),PKW(pB1,4),PKW(pB1,6)};pw3=(u32x4){PKW(pB1,8),PKW(pB1,10),PKW(pB1,12),PKW(pB1,14)};
    SBAR(); pv(o,vb0+sl_cur,PAF(0),PAF(1),PAF(2),PAF(3)); }
  #undef PKW
  #undef PAF
  #undef VFR
  #undef PIN
  #undef MX3
  #undef GAPA
  #undef GAPB
  #undef EX
  #undef VRD
  #undef KRD
  #undef STEP
  #undef ENDW
  {auto rr=__builtin_amdgcn_permlane32_swap(__float_as_uint(l_reg),__float_as_uint(l_reg),false,false);l_reg=__uint_as_float(rr[0])+__uint_as_float(rr[1]);}
  if(hi==0)wsf[32+r32]=l_reg;asm volatile("s_waitcnt lgkmcnt(0)":::"memory");
  float rli[16];
  #pragma unroll
  for(int r=0;r<16;++r)rli[r]=__builtin_amdgcn_rcpf(wsf[32+crow(r,hi)]);
  bf16*Ow=O+(rowbase+q0+wid*QBLK)*DM+h*D;
  { bf16*stg=(bf16*)(shm+LDS_OST)+wid*2048;
    #pragma unroll
    for(int r=0;r<16;++r){const int orow=crow(r,hi);
      #pragma unroll
      for(int d0=0;d0<2;++d0)stg[orow*64+d0*32+r32]=__float2bfloat16(o[d0][r]*rli[r]);}
    asm volatile("s_waitcnt lgkmcnt(0)":::"memory");
    #pragma unroll
    for(int i=0;i<4;++i){const int row=i*8+(lane>>3),ch=lane&7; const u32x4 v=*(const u32x4*)(stg+row*64+ch*8); ATTN_STORE16(Ow+(long)row*DM+ch*8,v);} }
  asm volatile("s_waitcnt lgkmcnt(0)\n\ts_barrier":::"memory");
  #undef DMA_K
  #undef DMA_V
  #undef CMASK
  #undef START
  #undef RESC
  #undef ROT
}
constexpr int ATTN_LDS_BYTES=LDS_BYTES;
#undef SBAR
#undef WAIT_BAR
}
#include <hip/hip_cooperative_groups.h>
namespace cg = cooperative_groups;
#define LAS __attribute__((address_space(3)))
typedef unsigned short bf16;
typedef unsigned v4u __attribute__((ext_vector_type(4)));
typedef unsigned v2u __attribute__((ext_vector_type(2)));
typedef float f32x4 __attribute__((ext_vector_type(4)));
typedef short bf16x8 __attribute__((ext_vector_type(8)));

#define XB_TMO      128
#define XB_XCNT(j)  (256  + 64 * (j))
#define XB_XSUB(j)  (1280 + 64 * (j))
#define XB_XGEN(j)  (2304 + 64 * (j))
#define XB_TOP      3328
#define XB_TOPGEN   3392
#define XCD_BAR_WORDS 3456
#define XB_SPIN_CAP (1u << 18)

__device__ __forceinline__ unsigned xb_ld(unsigned* p)              { return __hip_atomic_load(p, __ATOMIC_RELAXED, __HIP_MEMORY_SCOPE_AGENT); }
__device__ __forceinline__ unsigned xb_add(unsigned* p, unsigned v) { return __hip_atomic_fetch_add(p, v, __ATOMIC_RELAXED, __HIP_MEMORY_SCOPE_AGENT); }
__device__ __forceinline__ unsigned xb_xcc_id() { return (unsigned)__builtin_amdgcn_s_getreg((3 << 11) | 20) & 0xFu; }
#define XB_SPIN(cond, bar) do { unsigned _sp = 0; while (cond) { __builtin_amdgcn_s_sleep(1); \
    if ((++_sp & 255u) == 0u) { if (xb_ld(&(bar)[XB_TMO])) break; if (_sp > XB_SPIN_CAP) { atomicAdd(&(bar)[XB_TMO], 1u); break; } } } } while (0)

struct XcdBarrier {
    unsigned* bar; unsigned x;
    volatile LAS unsigned* st;
};

__device__ __forceinline__ XcdBarrier xcd_barrier_post(unsigned* bar, volatile LAS unsigned* st) {
    XcdBarrier b; b.bar = bar; b.x = xb_xcc_id(); b.st = st;
    if (threadIdx.x == 0) (void)xb_add(&bar[XB_XCNT(b.x)], 1u);
    return b;
}
__device__ __forceinline__ void xcd_barrier_complete(unsigned* bar, unsigned x, unsigned& nloc, unsigned& nx) {
    const unsigned G = gridDim.x * gridDim.y * gridDim.z;
    unsigned sum, cnt, mine, sp = 0u;
    for (;;) {
        sum = 0u; cnt = 0u; mine = 0u;
#pragma unroll
        for (unsigned j = 0; j < 16; ++j) { const unsigned c = xb_ld(&bar[XB_XCNT(j)]); sum += c; cnt += (c > 0u) ? 1u : 0u; mine = (j == x) ? c : mine; }
        if (sum == G) break;
        __builtin_amdgcn_s_sleep(1);
        if ((++sp & 255u) == 0u) { if (xb_ld(&bar[XB_TMO])) break; if (sp > XB_SPIN_CAP) { atomicAdd(&bar[XB_TMO], 1u); break; } }
    }
    nloc = mine > 0u ? mine : 1u; nx = cnt > 0u ? cnt : 1u;
}

__device__ __forceinline__ void xcd_barrier(const XcdBarrier& b) {
    asm volatile("s_waitcnt vmcnt(0)" ::: "memory");
    __syncthreads();
    if (threadIdx.x == 0) {
        unsigned* bar = b.bar;
        __builtin_amdgcn_s_waitcnt(0);
        unsigned nloc = b.st[0], nx = b.st[1];
        if (nloc == 0u) { xcd_barrier_complete(bar, b.x, nloc, nx); b.st[0] = nloc; b.st[1] = nx; }
        const unsigned old = xb_add(&bar[XB_XSUB(b.x)], 1u);
        const unsigned gen = old / nloc;
        if (old + 1u == (gen + 1u) * nloc) {
            __builtin_amdgcn_fence(__ATOMIC_RELEASE, "agent");
            asm volatile("s_waitcnt vmcnt(0)" ::: "memory");
            const unsigned og = xb_add(&bar[XB_TOP], 1u);
            const unsigned tg = og / nx;
            if (og + 1u == (tg + 1u) * nx) xb_add(&bar[XB_TOPGEN], 1u);
            else XB_SPIN(xb_ld(&bar[XB_TOPGEN]) == tg, bar);
            __builtin_amdgcn_fence(__ATOMIC_ACQUIRE, "agent");
            xb_add(&bar[XB_XGEN(b.x)], 1u);
            asm volatile("s_waitcnt vmcnt(0)" ::: "memory");
        } else {
            XB_SPIN(xb_ld(&bar[XB_XGEN(b.x)]) == gen, bar);
            __builtin_amdgcn_fence(__ATOMIC_ACQUIRE, "agent");
            asm volatile("s_waitcnt vmcnt(0)" ::: "memory");
        }
    }
    __syncthreads();
}

constexpr int NB = 8, TL = 8192, TC = 256, TB = TL + TC  , MR = NB * TB  , DM = 1024, DFF = 2816, PW = 4608, NMOD = 9216;
constexpr float EPS = 1e-6f;
constexpr int LDS_BYTES = 147456, NTHR = 512, NWAVES = 8;
constexpr int PC_Q = 0, PC_K = 512, PC_V = 640, PC_GQ = 768, PC_GK = 1024, PC_GV = 1280, PC_G6 = 1792, PC_GATE = 2304, PC_LOW = 4352;
constexpr int GLA_S = 132, GLA_ITEMS = 64 * GLA_S;
constexpr size_t MiB = 1u << 20;
constexpr size_t WS_SSQ1 = 5 * MiB, WS_SSQ2 = 5 * MiB + 512 * 1024, WS_SW1 = 6 * MiB, WS_SW2 = 6 * MiB + 512 * 1024;
constexpr size_t WS_MOD = 1 * MiB, WS_DN = 2 * MiB, WS_WUP1 = 8 * MiB, WS_WUP2 = 20 * MiB, WS_WDN1 = 32 * MiB, WS_WDN2 = 38 * MiB, WS_WIN = 44 * MiB, WS_WBR0 = 54 * MiB, WS_WBR1 = 55 * MiB, WS_WOUT = 56 * MiB,
                 WS_HCTX = 64 * MiB, WS_XN = 72 * MiB, WS_OF = 204 * MiB, WS_OB = 270 * MiB, WS_A = 336 * MiB, WS_END = 932 * MiB;
static_assert(WS_XN + (size_t)MR * DM * 2 <= WS_OF && WS_OF + (size_t)MR * 512 * 2 <= WS_OB && WS_OB + (size_t)MR * 512 * 2 <= WS_A && WS_A + (size_t)MR * PW * 2 <= WS_END, "ws map");
static_assert((size_t)GLA_ITEMS * 8192 * 2 <= (size_t)MR * DM * 2 && WS_DN + (size_t)GLA_ITEMS * 64 * 4 <= WS_WUP1, "gla ws");

__device__ __forceinline__ unsigned f2bf(float f) { unsigned u = __builtin_bit_cast(unsigned, f); return (u + 0x7fffu + ((u >> 16) & 1u)) >> 16; }
typedef float pk_f32x2 __attribute__((ext_vector_type(2))); typedef __bf16 pk_bf16x2 __attribute__((ext_vector_type(2)));
__device__ __forceinline__ unsigned pk2(float lo, float hi) { const pk_f32x2 v = {lo, hi}; return __builtin_bit_cast(unsigned, __builtin_convertvector(v, pk_bf16x2)); }
__device__ __forceinline__ float bf2f(unsigned short h) { return __uint_as_float(((unsigned)h) << 16); }
__device__ __forceinline__ float wave_sum(float v) {
#pragma unroll
    for (int o = 1; o < 64; o <<= 1) v += __shfl_xor(v, o);
    return v;
}
__device__ __forceinline__ float silu_f(float v) { return v / (1.f + __expf(-v)); }

__device__ __forceinline__ void transpose_item(const float* W, int K, int N, bf16* WT, int k0, int n0, int drow0, LAS float* scr, int lane) {
#pragma unroll 8
    for (int i = 0; i < 32; ++i) { const int kk = 2 * i + (lane >> 5); scr[kk * 33 + (lane & 31)] = W[(size_t)(k0 + kk) * N + n0 + (lane & 31)]; }
    asm volatile("s_waitcnt lgkmcnt(0)" ::: "memory");
    const int c = lane & 7;
#pragma unroll
    for (int j = 0; j < 4; ++j) { const int n = (lane >> 3) + 8 * j; const LAS float* s = scr + (8 * c) * 33 + n;
        v4u o; o.x = pk2(s[0 * 33], s[1 * 33]); o.y = pk2(s[2 * 33], s[3 * 33]); o.z = pk2(s[4 * 33], s[5 * 33]); o.w = pk2(s[6 * 33], s[7 * 33]);
        *(v4u*)(WT + (size_t)(drow0 + n) * K + k0 + 8 * c) = o; }
    asm volatile("s_waitcnt lgkmcnt(0)" ::: "memory");
}
__device__ __forceinline__ int up_dest(int n0) { return n0 < DFF ? 256 * (n0 / 128) + (n0 % 128) : 256 * ((n0 - DFF) / 128) + 128 + ((n0 - DFF) % 128); }
__device__ __forceinline__ int win_dest(int n0) { return n0 < 2304 ? n0 : (n0 < 2336 ? n0 + 2048 : n0 - 32); }

__device__ __forceinline__ void norm_mod_rows(const float* lat, const float* ctxp, const float* mod, const float* g, int sub, bf16* XN, bool with_ctx, int gw, int NGW, int lane) {
    f32x4 gv[4];
#pragma unroll
    for (int j = 0; j < 4; ++j) gv[j] = *((const f32x4*)g + lane + 64 * j);
    for (int r0 = gw * 8; r0 < MR; r0 += NGW * 8) {
        const int b = r0 / TB, t = r0 % TB; const bool isctx = t >= TL;
        if (isctx && !with_ctx) continue;
        const float* src = isctx ? ctxp + (size_t)(b * TC + t - TL) * DM : lat + (size_t)(b * TL + t) * DM;
        const float* sh = mod + (size_t)(isctx ? 8 : b) * NMOD + (3 * sub) * DM; const float* sc = sh + DM;
        f32x4 v[8][4]; float s[8] = {0.f, 0.f, 0.f, 0.f, 0.f, 0.f, 0.f, 0.f}; f32x4 scv[4], shv[4];
#pragma unroll
        for (int u = 0; u < 8; ++u)
#pragma unroll
            for (int j = 0; j < 4; ++j) { v[u][j] = *((const f32x4*)(src + (size_t)u * DM) + lane + 64 * j); }
#pragma unroll
        for (int j = 0; j < 4; ++j) { scv[j] = *((const f32x4*)sc + lane + 64 * j) + 1.f; shv[j] = *((const f32x4*)sh + lane + 64 * j); }
#pragma unroll
        for (int u = 0; u < 8; ++u)
#pragma unroll
            for (int j = 0; j < 4; ++j) s[u] += (v[u][j].x * v[u][j].x + v[u][j].y * v[u][j].y) + (v[u][j].z * v[u][j].z + v[u][j].w * v[u][j].w);
#pragma unroll
        for (int u = 0; u < 8; ++u) {
            const float rstd = 1.f / sqrtf(wave_sum(s[u]) * (1.f / DM) + EPS);
            unsigned long long* o8 = (unsigned long long*)(XN + (size_t)(r0 + u) * DM) + lane;
#pragma unroll
            for (int j = 0; j < 4; ++j) {
                const f32x4 y = (v[u][j] * rstd * gv[j]) * scv[j] + shv[j];
                o8[64 * j] = (unsigned long long)pk2(y.x, y.y) | ((unsigned long long)pk2(y.z, y.w) << 32); } }
    }
}

constexpr int GS = 72, VS = 136;
constexpr int GL_QE = 0, GL_KE = 9216, GL_KL = 18432, GL_A = 27648, GL_V = 36864, GL_B = 54272, GL_BT = 71680, GL_SEG = 71936, BS = 68;
typedef short v4i16_t __attribute__((ext_vector_type(4)));
__device__ __forceinline__ bf16x8 tr_frag(const LAS bf16* base, int rs  , int col0, int ks, int q4, int qq, int p) {
    const LAS bf16* a0 = base + (32 * ks + 8 * q4 + qq) * rs + col0 + 4 * p;
    const v4i16_t t0 = __builtin_amdgcn_ds_read_tr16_b64_v4i16((LAS v4i16_t*)a0), t1 = __builtin_amdgcn_ds_read_tr16_b64_v4i16((LAS v4i16_t*)(a0 + 4 * rs));
    return (bf16x8){t0[0], t0[1], t0[2], t0[3], t1[0], t1[1], t1[2], t1[3]};
}
#define GLA_ROWOF(c) (rowbase + (dir ? 63 - (c) : (c)))
template <int PASS> __device__ __forceinline__ void gla_pass(LAS unsigned char* lds, const bf16* P, const float* w_decay, const float* b_decay, bf16* Ubuf, float* dn, bf16* OF, bf16* OB, int bx, int G, unsigned* ctr) {
    const int tid = opaque_tid(), lane = tid & 63, w = __builtin_amdgcn_readfirstlane(tid >> 6), l15 = lane & 15, q4 = lane >> 4, qq = (lane & 15) >> 2, p3 = lane & 3;
    constexpr int NV = PASS == 1 ? 64 * 131 : 64 * 128;
    LAS bf16* qeL = (LAS bf16*)(lds + GL_QE); LAS bf16* keL = (LAS bf16*)(lds + GL_KE); LAS bf16* klL = (LAS bf16*)(lds + GL_KL); LAS bf16* AL = (LAS bf16*)(lds + GL_A); LAS bf16* vL = (LAS bf16*)(lds + GL_V);
    LAS float* bL = (LAS float*)(lds + GL_B); LAS float* btL = (LAS float*)(lds + GL_BT); LAS float* segT = (LAS float*)(lds + GL_SEG);
    const int c = tid >> 3, ch = tid & 7, dt = w & 3, half = w >> 2;
    v4u vraw[2], kraw, qraw, lowf[2]; float wdr[8]; float bdr = 0.f; bf16x8 xsn[2];
    vraw[0] = vraw[1] = kraw = qraw = lowf[0] = lowf[1] = (v4u){0u, 0u, 0u, 0u}; xsn[0] = xsn[1] = (bf16x8){0, 0, 0, 0, 0, 0, 0, 0};
#pragma unroll
    for (int j = 0; j < 8; ++j) wdr[j] = 0.f;
#define GLA_DEC(idx_) const int chain = PASS == 1 ? (idx_) / 131 : (idx_) >> 7, s = PASS == 1 ? (idx_) % 131 : 4 + ((idx_) & 127), dir = chain & 1, h = (chain >> 1) & 3, b = chain >> 3; \
    const int rowbase = b * TB + (s < 4 ? TL + (dir ? 3 - s : s) * 64 : (dir ? 127 - (s - 4) : s - 4) * 64); const int item = chain * GLA_S + s; (void)item
#define GLA_LOAD(idx_) do { GLA_DEC(idx_); \
        _Pragma("unroll") for (int i = 0; i < 2; ++i) { const int n = tid + 512 * i; vraw[i] = *(const v4u*)(P + (size_t)GLA_ROWOF(n >> 4) * PW + PC_GV + h * 128 + (n & 15) * 8); } \
        { const size_t ro = (size_t)GLA_ROWOF(c) * PW + h * 64 + ch * 8; kraw = *(const v4u*)(P + ro + PC_GK); if (PASS == 3) qraw = *(const v4u*)(P + ro + PC_GQ); } \
        _Pragma("unroll") for (int i = 0; i < 2; ++i) lowf[i] = *(const v4u*)(P + (size_t)GLA_ROWOF(16 * (2 * half + i) + l15) * PW + PC_LOW + dir * 16 + (q4 & 1) * 8); \
        _Pragma("unroll") for (int j = 0; j < 8; ++j) wdr[j] = w_decay[(dir * 16 + 8 * (q4 & 1) + j) * 256 + h * 64 + 16 * dt + l15]; \
        bdr = b_decay[dir * 256 + h * 64 + 16 * dt + l15]; \
        if (PASS == 3) { _Pragma("unroll") for (int ks = 0; ks < 2; ++ks) xsn[ks] = *(const bf16x8*)(Ubuf + (size_t)item * 8192 + (16 * w + l15) * 64 + 8 * q4 + 32 * ks); } } while (0)
    volatile LAS unsigned* nxtL = (volatile LAS unsigned*)(lds + GL_SEG + 1024);
    int idx = bx;
    if (ctr) { if (tid == 0) nxtL[0] = __hip_atomic_fetch_add(ctr, 1u, __ATOMIC_RELAXED, __HIP_MEMORY_SCOPE_AGENT); __syncthreads(); idx = (int)nxtL[0]; __syncthreads(); }
    if (idx < NV) GLA_LOAD(idx);
    for (; idx < NV;) {
        int nidx = idx + G;
        if (ctr && tid == 0) nxtL[0] = __hip_atomic_fetch_add(ctr, 1u, __ATOMIC_RELAXED, __HIP_MEMORY_SCOPE_AGENT);
        GLA_DEC(idx);
#pragma unroll
        for (int i = 0; i < 2; ++i) { const int n = tid + 512 * i; *(LAS v4u*)(vL + (n >> 4) * VS + (n & 15) * 8) = vraw[i]; }
        float kf[8], qf[8];
        kf[0] = pg8::bflo(kraw.x); kf[1] = pg8::bfhi(kraw.x); kf[2] = pg8::bflo(kraw.y); kf[3] = pg8::bfhi(kraw.y); kf[4] = pg8::bflo(kraw.z); kf[5] = pg8::bfhi(kraw.z); kf[6] = pg8::bflo(kraw.w); kf[7] = pg8::bfhi(kraw.w);
        if (PASS == 3) { qf[0] = pg8::bflo(qraw.x); qf[1] = pg8::bfhi(qraw.x); qf[2] = pg8::bflo(qraw.y); qf[3] = pg8::bfhi(qraw.y); qf[4] = pg8::bflo(qraw.z); qf[5] = pg8::bfhi(qraw.z); qf[6] = pg8::bflo(qraw.w); qf[7] = pg8::bfhi(qraw.w); }
        float bv[2][4], tot[2];
        { bf16x8 yv;
#pragma unroll
          for (int j = 0; j < 8; ++j) { const unsigned hb = f2bf(wdr[j]); const unsigned lb = f2bf(wdr[j] - __uint_as_float(hb << 16)); yv[j] = (short)(q4 < 2 ? hb : lb); }
#pragma unroll
          for (int i = 0; i < 2; ++i) { f32x4 z = {0.f, 0.f, 0.f, 0.f}; z = __builtin_amdgcn_mfma_f32_16x16x32_bf16(__builtin_bit_cast(bf16x8, lowf[i]), yv, z, 0, 0, 0);
              float run = 0.f;
#pragma unroll
              for (int r = 0; r < 4; ++r) { const float zz = z[r] + bdr; run += (fminf(zz, 0.f) - __logf(1.f + __expf(-fabsf(zz)))) * (1.f / 16.f); bv[i][r] = run; }
              float sc = run; float t = __shfl_up(sc, 16); if (q4 >= 1) sc += t; t = __shfl_up(sc, 32); if (q4 >= 2) sc += t;
              const float excl = sc - run; tot[i] = __shfl(sc, 48 + l15);
#pragma unroll
              for (int r = 0; r < 4; ++r) bv[i][r] += excl + (i ? tot[0] : 0.f); }
          if (q4 == 0) segT[half * 64 + 16 * dt + l15] = tot[0] + tot[1]; }
        __syncthreads();
        { const float other = segT[(1 - half) * 64 + 16 * dt + l15]; const float add = half ? other : 0.f;
#pragma unroll
          for (int i = 0; i < 2; ++i)
#pragma unroll
              for (int r = 0; r < 4; ++r) bL[(16 * (2 * half + i) + 4 * q4 + r) * BS + 16 * dt + l15] = bv[i][r] + add;
          if (half == 0 && q4 == 0) btL[16 * dt + l15] = tot[0] + tot[1] + other; }
        __syncthreads();
        float bl[8], btot[8];
        { const f32x4 b0 = *(const LAS f32x4*)(bL + c * BS + 8 * ch), b1 = *(const LAS f32x4*)(bL + c * BS + 8 * ch + 4), t0 = *(const LAS f32x4*)(btL + 8 * ch), t1 = *(const LAS f32x4*)(btL + 8 * ch + 4);
          bl[0] = b0[0]; bl[1] = b0[1]; bl[2] = b0[2]; bl[3] = b0[3]; bl[4] = b1[0]; bl[5] = b1[1]; bl[6] = b1[2]; bl[7] = b1[3];
          btot[0] = t0[0]; btot[1] = t0[1]; btot[2] = t0[2]; btot[3] = t0[3]; btot[4] = t1[0]; btot[5] = t1[1]; btot[6] = t1[2]; btot[7] = t1[3]; }
        if (PASS == 1) {
            float kl[8];
#pragma unroll
            for (int k = 0; k < 8; ++k) kl[k] = kf[k] * __expf(btot[k] - bl[k]);
            v4u o; o.x = pk2(kl[0], kl[1]); o.y = pk2(kl[2], kl[3]); o.z = pk2(kl[4], kl[5]); o.w = pk2(kl[6], kl[7]);
            *(LAS v4u*)(klL + c * GS + 8 * ch) = o;
            if (tid < 8) { f32x4* dp = (f32x4*)(dn + (size_t)item * 64 + 8 * ch); dp[0] = (f32x4){__expf(btot[0]), __expf(btot[1]), __expf(btot[2]), __expf(btot[3])}; dp[1] = (f32x4){__expf(btot[4]), __expf(btot[5]), __expf(btot[6]), __expf(btot[7])}; }
        } else {
            float qe[8], ke[8];
#pragma unroll
            for (int k = 0; k < 8; ++k) { qe[k] = qf[k] * __expf(bl[k]) * 0.125f; ke[k] = kf[k] * __expf(-bl[k]); }
            v4u o; o.x = pk2(qe[0], qe[1]); o.y = pk2(qe[2], qe[3]); o.z = pk2(qe[4], qe[5]); o.w = pk2(qe[6], qe[7]);
            *(LAS v4u*)(qeL + c * GS + 8 * ch) = o;
            o.x = pk2(ke[0], ke[1]); o.y = pk2(ke[2], ke[3]); o.z = pk2(ke[4], ke[5]); o.w = pk2(ke[6], ke[7]);
            *(LAS v4u*)(keL + c * GS + 8 * ch) = o;
        }
        bf16x8 xs[2]; xs[0] = xsn[0]; xs[1] = xsn[1];
        if (ctr) nidx = (int)nxtL[0];
        if (nidx < NV) GLA_LOAD(nidx);
        __syncthreads();
        if (PASS == 1) {
            bf16x8 y[2];
#pragma unroll
            for (int ks = 0; ks < 2; ++ks) y[ks] = tr_frag(vL, VS, 16 * w, ks, q4, qq, p3);
#pragma unroll
            for (int dt = 0; dt < 4; ++dt) { f32x4 acc = {0.f, 0.f, 0.f, 0.f};
#pragma unroll
                for (int ks = 0; ks < 2; ++ks) { const bf16x8 x = tr_frag(klL, GS, 16 * dt, ks, q4, qq, p3); acc = __builtin_amdgcn_mfma_f32_16x16x32_bf16(x, y[ks], acc, 0, 0, 0); }
                v2u o; o.x = pk2(acc[0], acc[1]); o.y = pk2(acc[2], acc[3]);
                *(v2u*)(Ubuf + (size_t)item * 8192 + (16 * w + l15) * 64 + 16 * dt + 4 * q4) = o; }
        } else {
            { const int it = w >> 1;
#pragma unroll
              for (int jj = 0; jj < 2; ++jj) { const int jt = (w & 1) * 2 + jj; f32x4 acc = {0.f, 0.f, 0.f, 0.f};
                  if (jt <= it) {
#pragma unroll
                      for (int ks = 0; ks < 2; ++ks) { const bf16x8 x = *(const LAS bf16x8*)(keL + (16 * jt + l15) * GS + 8 * q4 + 32 * ks), y = *(const LAS bf16x8*)(qeL + (16 * it + l15) * GS + 8 * q4 + 32 * ks);
                          acc = __builtin_amdgcn_mfma_f32_16x16x32_bf16(x, y, acc, 0, 0, 0); }
                      const int i = 16 * it + l15, j0 = 16 * jt + 4 * q4;
#pragma unroll
                      for (int r = 0; r < 4; ++r) if (j0 + r > i) acc[r] = 0.f;
                  }
                  v2u o; o.x = pk2(acc[0], acc[1]); o.y = pk2(acc[2], acc[3]);
                  *(LAS v2u*)(AL + (16 * it + l15) * GS + 16 * jt + 4 * q4) = o; } }
            bf16x8 xv[2];
#pragma unroll
            for (int ks = 0; ks < 2; ++ks) xv[ks] = tr_frag(vL, VS, 16 * w, ks, q4, qq, p3);
            __syncthreads();
            bf16* Ob = dir ? OB : OF;
#pragma unroll
            for (int it = 0; it < 4; ++it) { f32x4 acc = {0.f, 0.f, 0.f, 0.f};
#pragma unroll
                for (int ks = 0; ks < 2; ++ks) { const bf16x8 y = *(const LAS bf16x8*)(AL + (16 * it + l15) * GS + 8 * q4 + 32 * ks); acc = __builtin_amdgcn_mfma_f32_16x16x32_bf16(xv[ks], y, acc, 0, 0, 0); }
#pragma unroll
                for (int ks = 0; ks < 2; ++ks) { const bf16x8 y = *(const LAS bf16x8*)(qeL + (16 * it + l15) * GS + 8 * q4 + 32 * ks); acc = __builtin_amdgcn_mfma_f32_16x16x32_bf16(xs[ks], y, acc, 0, 0, 0); }
                v2u o; o.x = pk2(acc[0], acc[1]); o.y = pk2(acc[2], acc[3]);
                *(v2u*)(Ob + (size_t)GLA_ROWOF(16 * it + l15) * 512 + h * 128 + 16 * w + 4 * q4) = o; }
        }
        __syncthreads();
        idx = nidx;
    }
#undef GLA_DEC
#undef GLA_LOAD
}

struct Args { const float* in[19]; float* out; unsigned char* ws; };
__global__ void __launch_bounds__(NTHR, 2) mk_fwd(Args args) {
    extern __shared__ __attribute__((aligned(16))) unsigned char lds_raw[];
    cg::grid_group grid = cg::this_grid();
    LAS unsigned char* lds = (LAS unsigned char*)lds_raw;
    const int G = gridDim.x, bx = blockIdx.x, NGW = G * NWAVES;
    unsigned long long pacc = 0ull, pt0 = 0ull; (void)pt0;
#define PB(k) do { if ((PROBE_MASK >> (k)) & 1ull) pt0 = __builtin_amdgcn_s_memrealtime(); } while (0)
#define PE(k) do { if ((PROBE_MASK >> (k)) & 1ull) pacc += __builtin_amdgcn_s_memrealtime() - pt0; } while (0)
#define GSYNC() do { xcd_barrier(xbar); if (PROBE_SYNC) { const unsigned long long t_ = __builtin_amdgcn_s_memrealtime(); xcd_barrier(xbar); pacc += __builtin_amdgcn_s_memrealtime() - t_; } } while (0)
#define PH_IDS const int tid = opaque_tid(), lane = tid & 63, wave = __builtin_amdgcn_readfirstlane(tid >> 6), gw = bx * NWAVES + wave; (void)lane; (void)gw
    unsigned char* ws = args.ws;
    const float* x = args.in[0]; const float* cvec = args.in[1]; const float* ctx = args.in[2]; const float* c_ctx = args.in[3]; const float* w_mod = args.in[4]; const float* b_mod = args.in[5];
    const float* g_norm = args.in[6]; const float* w_up = args.in[7]; const float* w_down = args.in[8]; const float* w_in = args.in[9]; const float* g_q = args.in[10]; const float* g_k = args.in[11];
    const float* w_decay = args.in[12]; const float* b_decay = args.in[13]; const float* g_gla = args.in[14]; const float* w_branch = args.in[15]; const float* b_gate = args.in[16]; const float* w_out = args.in[17]; const float* g_final = args.in[18];
    float* H = args.out;
    float* HC = (float*)(ws + WS_HCTX);
    float* mod = (float*)(ws + WS_MOD); float* dn = (float*)(ws + WS_DN);
    bf16* Wup1 = (bf16*)(ws + WS_WUP1); bf16* Wup2 = (bf16*)(ws + WS_WUP2); bf16* Wdn1 = (bf16*)(ws + WS_WDN1); bf16* Wdn2 = (bf16*)(ws + WS_WDN2); bf16* Win = (bf16*)(ws + WS_WIN);
    bf16* Wbr0 = (bf16*)(ws + WS_WBR0); bf16* Wbr1 = (bf16*)(ws + WS_WBR1); bf16* Wout = (bf16*)(ws + WS_WOUT);
    bf16* XN = (bf16*)(ws + WS_XN); bf16* OF = (bf16*)(ws + WS_OF); bf16* OB = (bf16*)(ws + WS_OB); bf16* PA = (bf16*)(ws + WS_A);
    bf16* HID = PA; bf16* Ubuf = XN; bf16* Z = XN;
    float* ssq1 = (float*)(ws + WS_SSQ1); float* ssq2 = (float*)(ws + WS_SSQ2); float* sW1 = (float*)(ws + WS_SW1); float* sW2 = (float*)(ws + WS_SW2);
    bf16* XN2 = OF;

    volatile LAS unsigned* xst = (volatile LAS unsigned*)(lds + LDS_BYTES - 64);
    if (threadIdx.x < 2) xst[threadIdx.x] = 0u;
    unsigned* barw = (unsigned*)ws;
    if (bx == 0) for (int i = threadIdx.x; i < XCD_BAR_WORDS + 128; i += NTHR) __hip_atomic_store(barw + i, 0u, __ATOMIC_RELAXED, __HIP_MEMORY_SCOPE_AGENT);
    XcdBarrier xbar; xbar.bar = barw; xbar.x = 0; xbar.st = xst;
    PB(0);
    {
        PH_IDS;
        LAS float* sc = (LAS float*)lds; LAS float* red = sc + 9 * 1024;
        for (int idx = tid; idx < 9 * 1024; idx += NTHR) { const int j = idx >> 10, k = idx & 1023; const float v = j < 8 ? cvec[j * 1024 + k] : c_ctx[k]; sc[idx] = silu_f(v); }
        __syncthreads();
        for (int it = bx; it < NMOD / 32; it += G) {
            const int cc = tid & 31, ks = tid >> 5, col = it * 32 + cc;
            float a[9];
#pragma unroll
            for (int j = 0; j < 9; ++j) a[j] = 0.f;
#pragma unroll 4
            for (int kk = 0; kk < 64; ++kk) { const int k = ks * 64 + kk; const float wv = w_mod[(size_t)k * NMOD + col];
#pragma unroll
                for (int j = 0; j < 9; ++j) a[j] += sc[j * 1024 + k] * wv; }
#pragma unroll
            for (int j = 0; j < 9; ++j) red[(ks * 9 + j) * 32 + cc] = a[j];
            __syncthreads();
            if (tid < 288) { const int j = tid >> 5, c2 = tid & 31; float s = b_mod[it * 32 + c2];
#pragma unroll
                for (int k2 = 0; k2 < 16; ++k2) s += red[(k2 * 9 + j) * 32 + c2];
                mod[(size_t)j * NMOD + it * 32 + c2] = s; }
            __syncthreads();
        }
        LAS float* scr = (LAS float*)(lds + 65536) + wave * 2176;
        constexpr int I_UP = 16 * 176, I_DN = 44 * 32;
        for (int it = gw; it < I_UP + I_DN; it += NGW) {
            int r = it;
            if (r < I_UP) { const int kb = r / 176, nb = r % 176; transpose_item(w_up, 1024, 5632, Wup1, 64 * kb, 32 * nb, up_dest(32 * nb), scr, lane); continue; } r -= I_UP;
            { const int kb = r / 32, nb = r % 32; transpose_item(w_down, DFF, 1024, Wdn1, 64 * kb, 32 * nb, 32 * nb, scr, lane); }
        }
        for (int i = bx * NTHR + tid; i < 224 * 1024 / 8; i += G * NTHR) ((v4u*)(Win + (size_t)4384 * 1024))[i] = (v4u){0u, 0u, 0u, 0u};
        for (int i = bx * NTHR + tid; i < MR; i += G * NTHR) { ssq1[i] = 0.f; ssq2[i] = 0.f; }
    }
    grid.sync();
    xbar.x = xb_xcc_id(); if (threadIdx.x == 0) xst[2] = xb_add(&barw[XB_XCNT(xbar.x)], 1u);
    PE(0); PB(1);
    { PH_IDS; norm_mod_rows(x, ctx, mod, g_norm + 0 * DM, 0, XN, true, gw, NGW, lane);
      LAS float* sc = (LAS float*)lds; LAS float* red = sc + 9 * 1024;
      for (int it = bx; it < 144 + 176; it += G) {
          const bool second = it >= 144; const int n0 = (second ? it - 144 : it) * 32; const int sub = second ? 2 : 1;
          __syncthreads();
          for (int idx = tid; idx < 9 * 1024; idx += NTHR) sc[idx] = mod[(size_t)(idx >> 10) * NMOD + (3 * sub) * DM + (idx & 1023)];
          __syncthreads();
          const int cc = tid & 31, ks = tid >> 5, nd = n0 + cc; int nsrc; const float* Wp; int ldw;
          if (!second) { Wp = w_in; ldw = 4384; nsrc = nd < 2304 ? nd : (nd < 4352 ? nd + 32 : (nd < 4384 ? nd - 2048 : -1)); }
          else { Wp = w_up + (size_t)1024 * 5632; ldw = 5632; const int tile = nd >> 8, within = nd & 255; nsrc = within < 128 ? 128 * tile + within : DFF + 128 * tile + (within - 128); }
          float a[9];
#pragma unroll
          for (int j = 0; j < 9; ++j) a[j] = 0.f;
          if (nsrc >= 0) {
#pragma unroll 4
              for (int kk = 0; kk < 64; ++kk) { const int k = ks * 64 + kk; const float wv = Wp[(size_t)k * ldw + nsrc];
#pragma unroll
                  for (int j = 0; j < 9; ++j) a[j] += sc[j * 1024 + k] * wv; } }
#pragma unroll
          for (int j = 0; j < 9; ++j) red[(ks * 9 + j) * 32 + cc] = a[j];
          __syncthreads();
          if (tid < 288) { const int j = tid >> 5, c2 = tid & 31; float sum = 0.f;
#pragma unroll
              for (int k2 = 0; k2 < 16; ++k2) sum += red[(k2 * 9 + j) * 32 + c2];
              (second ? sW2 + (size_t)j * 5632 : sW1 + (size_t)j * PW)[n0 + c2] = sum; }
      }
      __syncthreads(); }
    GSYNC(); PE(1); PB(2);
    if (threadIdx.x == 0) { bool uni = (xbar.x < 8u) && ((G & 7) == 0);
        for (unsigned j = 0; j < 16; ++j) { const unsigned cnt_ = xb_ld(&barw[XB_XCNT(j)]); uni = uni && (cnt_ == (j < 8u ? (unsigned)(G >> 3) : 0u)); }
        xst[3] = uni ? (xst[2] * 8u + xbar.x) : (unsigned)bx; }
    __syncthreads();
    const int vb = (int)xst[3];
    { pg8::Gemm g{XN, Wup1, MR, 5632, 1024, 1024, 1024}; pg8::StaticOrder S; S.init(MR, 5632, G, vb);
      pg8::EpiSwiglu E{HID, DFF}; pg8::gemm_phase<pg8::EpiSwiglu, pg8::StaticOrder, true, true>(lds, g, S, E); }
    GSYNC(); PE(2); PB(3);
    { pg8::Gemm g{HID, Wdn1, MR, 1024, DFF, DFF, DFF}; pg8::StaticOrder S; S.init(MR, 1024, G, vb);
      pg8::EpiRes<1, 2, 1, 1> E{x, ctx, H, HC, mod, g_norm + 1 * DM, XN, ssq1}; pg8::gemm_phase<pg8::EpiRes<1, 2, 1, 1>, pg8::StaticOrder, true, true>(lds, g, S, E); }
    { PH_IDS;
      const int rem = (264 * 4) % G, ir = rem ? vb - rem : vb, ni = rem ? G - rem : G;
      if (ir >= 0) {
          LAS float* scr = (LAS float*)(lds + 65536) + wave * 2176;
          constexpr int I_UP = 16 * 176, I_DN = 44 * 32, I_IN = 16 * 137, I_BR = 8 * 32, I_OUT = 16 * 32;
          constexpr int NITEMS = I_UP + I_DN + I_IN + 2 * I_BR + I_OUT;
          for (int it = ir * NWAVES + wave; it < NITEMS; it += ni * NWAVES) {
              int r = it;
              if (r < I_UP) { const int kb = r / 176, nb = r % 176; transpose_item(w_up + (size_t)1024 * 5632, 1024, 5632, Wup2, 64 * kb, 32 * nb, up_dest(32 * nb), scr, lane); continue; } r -= I_UP;
              if (r < I_DN) { const int kb = r / 32, nb = r % 32; transpose_item(w_down + (size_t)DFF * 1024, DFF, 1024, Wdn2, 64 * kb, 32 * nb, 32 * nb, scr, lane); continue; } r -= I_DN;
              if (r < I_IN) { const int kb = r / 137, nb = r % 137; transpose_item(w_in, 1024, 4384, Win, 64 * kb, 32 * nb, win_dest(32 * nb), scr, lane); continue; } r -= I_IN;
              if (r < 2 * I_BR) { const int l = r / I_BR; r %= I_BR; const int kb = r / 32, nb = r % 32; transpose_item(w_branch + (size_t)l * 512 * 1024, 512, 1024, l ? Wbr1 : Wbr0, 64 * kb, 32 * nb, 32 * nb, scr, lane); continue; } r -= 2 * I_BR;
              { const int kb = r / 32, nb = r % 32; transpose_item(w_out, 1024, 1024, Wout, 64 * kb, 32 * nb, 32 * nb, scr, lane); }
          }
      } }
    GSYNC(); PE(3); PB(4);
#if MK_STAGE >= 2
    { pg8::Gemm g{XN, Win, MR, PW, 1024, 1024, 1024}; pg8::StaticOrder S; S.init(MR, PW, G, vb);
      pg8::EpiInproj E{PA, PW, ssq1, sW1, PW}; pg8::gemm_phase<pg8::EpiInproj, pg8::StaticOrder, true, true>(lds, g, S, E); }
    GSYNC(); PE(4); PB(5);
    { PH_IDS;
      const int l7 = lane & 7, l3 = lane & 3; const bool is_hi = (lane & 4) != 0;
      float frq[8], gq8[8], gk8[8];
#pragma unroll
      for (int k = 0; k < 8; ++k) { frq[k] = __builtin_amdgcn_exp2f(-(float)(8 * (l3 & 1) + k) * (13.287712379549449f / 16.f)); gq8[k] = g_q[8 * l7 + k] * attn_body::C2; gk8[k] = g_k[8 * l7 + k]; }
      for (int r0 = gw * 4; r0 < MR; r0 += NGW * 4) {
          const int t0 = r0 % TB; const bool isctx = t0 >= TL;
          v4u qv[4], kv[4];
#pragma unroll
          for (int u = 0; u < 4; ++u) { bf16* rp = PA + (size_t)(r0 + u) * PW; qv[u] = (v4u){0u, 0u, 0u, 0u}; if (!isctx) qv[u] = *(const v4u*)(rp + lane * 8); kv[u] = *(const v4u*)(rp + PC_K + (lane & 15) * 8); }
#pragma unroll
          for (int u = 0; u < 4; ++u) { bf16* rp = PA + (size_t)(r0 + u) * PW; const int t = t0 + u;
              const float pos = (l3 < 2) ? (float)(t >> 6) : (float)(t & 63);
              float cs8[8], sn8[8];
#pragma unroll
              for (int k = 0; k < 8; ++k) { const float ang = pos * frq[k]; cs8[k] = isctx ? 1.f : __cosf(ang); sn8[k] = isctx ? 0.f : __sinf(ang); }
#pragma unroll
              for (int part = 0; part < 2; ++part) { const v4u raw = part ? kv[u] : qv[u];
                  float xv[8]; xv[0] = pg8::bflo(raw.x); xv[1] = pg8::bfhi(raw.x); xv[2] = pg8::bflo(raw.y); xv[3] = pg8::bfhi(raw.y); xv[4] = pg8::bflo(raw.z); xv[5] = pg8::bfhi(raw.z); xv[6] = pg8::bflo(raw.w); xv[7] = pg8::bfhi(raw.w);
                  float ss = 0.f;
#pragma unroll
                  for (int k = 0; k < 8; ++k) ss += xv[k] * xv[k];
                  ss += __shfl_xor(ss, 1); ss += __shfl_xor(ss, 2); ss += __shfl_xor(ss, 4);
                  const float rstd = 1.f / sqrtf(ss * (1.f / 64.f) + EPS);
                  float o[8];
#pragma unroll
                  for (int k = 0; k < 8; ++k) { const float y = xv[k] * rstd * (part ? gk8[k] : gq8[k]); const float py = __shfl_xor(y, 4);
                      o[k] = is_hi ? (py * sn8[k] + y * cs8[k]) : (y * cs8[k] - py * sn8[k]); }
                  v4u w4; w4.x = pk2(o[0], o[1]); w4.y = pk2(o[2], o[3]); w4.z = pk2(o[4], o[5]); w4.w = pk2(o[6], o[7]);
                  if (part == 0) { if (!isctx) *(v4u*)(rp + lane * 8) = w4; } else { if (lane < 16) *(v4u*)(rp + PC_K + lane * 8) = w4; } } } } }
    gla_pass<1>(lds, PA, w_decay, b_decay, Ubuf, dn, OF, OB, vb, G, nullptr);
    GSYNC(); PE(5); PB(6);
    { PH_IDS; const int tg = bx * NTHR + tid;
      for (int q = tg; q < 64 * 2048; q += G * NTHR) { const int chain = q >> 11, e4 = q & 2047; const int d0 = (4 * e4) & 63;
          f32x4 S = {0.f, 0.f, 0.f, 0.f};
          for (int s0 = 0; s0 < GLA_S; s0 += 12) { v2u ur[12]; f32x4 dv[12];
#pragma unroll
              for (int j = 0; j < 12; ++j) { const size_t item = (size_t)chain * GLA_S + s0 + j; ur[j] = (v2u){0u, 0u}; dv[j] = (f32x4){0.f, 0.f, 0.f, 0.f};
                  if (s0 + j < GLA_S - 1) { ur[j] = *(const v2u*)(Ubuf + item * 8192 + 4 * e4); dv[j] = *(const f32x4*)(dn + item * 64 + d0); } }
#pragma unroll
              for (int j = 0; j < 12; ++j) { const size_t item = (size_t)chain * GLA_S + s0 + j;
                  v2u o; o.x = pk2(S[0], S[1]); o.y = pk2(S[2], S[3]); *(v2u*)(Ubuf + item * 8192 + 4 * e4) = o;
                  S[0] = dv[j][0] * S[0] + __uint_as_float(ur[j].x << 16); S[1] = dv[j][1] * S[1] + __uint_as_float(ur[j].x & 0xffff0000u);
                  S[2] = dv[j][2] * S[2] + __uint_as_float(ur[j].y << 16); S[3] = dv[j][3] * S[3] + __uint_as_float(ur[j].y & 0xffff0000u); } } } }
    GSYNC(); PE(6); PB(7);
    bool fastsm;
    { const int l_ = opaque_tid() & 63; float gqm = fabsf(g_q[l_]), gkm = fabsf(g_k[l_]);
#pragma unroll
      for (int o = 1; o < 64; o <<= 1) { gqm = fmaxf(gqm, __shfl_xor(gqm, o)); gkm = fmaxf(gkm, __shfl_xor(gkm, o)); }
      fastsm = __builtin_amdgcn_readfirstlane((2.f * 11.5416f * gqm * gkm + 14.f < 100.f) ? 1 : 0) != 0; }
    { const attn_body::bf16* Qp = (const attn_body::bf16*)(PA + PC_Q); const attn_body::bf16* Kp = (const attn_body::bf16*)(PA + PC_K); const attn_body::bf16* Vp = (const attn_body::bf16*)(PA + PC_V);
      if ((G & 7) == 0) { const int b = vb & 7, ci = vb >> 3, nper = G >> 3;
          for (int idx = ci; idx < 256; idx += nper) { const int h = idx >> 5, qb = idx & 31;
              if (fastsm) attn_body::attn_unit<8, true>(b, h, h >> 2, qb, Qp, Kp, Vp, (attn_body::bf16*)(PA + PC_Q), (char*)lds_raw);
              else attn_body::attn_unit<8, false>(b, h, h >> 2, qb, Qp, Kp, Vp, (attn_body::bf16*)(PA + PC_Q), (char*)lds_raw); } }
      else { for (int u = vb; u < 2048; u += G) { const int b = u >> 8, h = (u >> 5) & 7, qb = u & 31; attn_body::attn_unit<8, false>(b, h, h >> 2, qb, Qp, Kp, Vp, (attn_body::bf16*)(PA + PC_Q), (char*)lds_raw); } }
    }
    __syncthreads();
    PE(7); PB(21);
    gla_pass<3>(lds, PA, w_decay, b_decay, Ubuf, dn, OF, OB, vb, G, barw + XCD_BAR_WORDS + 64);
    GSYNC(); PE(21); PB(8);
    { PH_IDS;
      const int col = lane * 8, e0 = col & 127; float gg8[8];
#pragma unroll
      for (int k = 0; k < 8; ++k) gg8[k] = g_gla[e0 + k];
      for (int r0 = gw * 4; r0 < MR; r0 += NGW * 4) {
          if (r0 % TB >= TL) continue;
          v4u a[4], bq[4], gq[4];
#pragma unroll
          for (int u = 0; u < 4; ++u) { const size_t r = r0 + u; a[u] = *(const v4u*)(OF + r * 512 + col); bq[u] = *(const v4u*)(OB + r * 512 + col); gq[u] = *(const v4u*)(PA + r * PW + PC_G6 + col); }
#pragma unroll
          for (int u = 0; u < 4; ++u) { const size_t r = r0 + u; float o[8], gg[8];
              o[0] = pg8::bflo(a[u].x) + pg8::bflo(bq[u].x); o[1] = pg8::bfhi(a[u].x) + pg8::bfhi(bq[u].x); o[2] = pg8::bflo(a[u].y) + pg8::bflo(bq[u].y); o[3] = pg8::bfhi(a[u].y) + pg8::bfhi(bq[u].y);
              o[4] = pg8::bflo(a[u].z) + pg8::bflo(bq[u].z); o[5] = pg8::bfhi(a[u].z) + pg8::bfhi(bq[u].z); o[6] = pg8::bflo(a[u].w) + pg8::bflo(bq[u].w); o[7] = pg8::bfhi(a[u].w) + pg8::bfhi(bq[u].w);
              gg[0] = pg8::bflo(gq[u].x); gg[1] = pg8::bfhi(gq[u].x); gg[2] = pg8::bflo(gq[u].y); gg[3] = pg8::bfhi(gq[u].y); gg[4] = pg8::bflo(gq[u].z); gg[5] = pg8::bfhi(gq[u].z); gg[6] = pg8::bflo(gq[u].w); gg[7] = pg8::bfhi(gq[u].w);
              float ss = 0.f;
#pragma unroll
              for (int k = 0; k < 8; ++k) ss += o[k] * o[k];
#pragma unroll
              for (int of = 1; of < 16; of <<= 1) ss += __shfl_xor(ss, of);
              const float rstd = 1.f / sqrtf(ss * (1.f / 128.f) + EPS); float y[8];
#pragma unroll
              for (int k = 0; k < 8; ++k) y[k] = o[k] * rstd * gg8[k] * silu_f(gg[k]);
              v4u w4; w4.x = pk2(y[0], y[1]); w4.y = pk2(y[2], y[3]); w4.z = pk2(y[4], y[5]); w4.w = pk2(y[6], y[7]);
              *(v4u*)(OF + r * 512 + col) = w4; } } }
    GSYNC(); PE(8); PB(9);
    { pg8::Gemm g{PA + PC_Q, Wbr0, MR, 1024, 512, PW, 512}; pg8::StaticOrder S; S.init(NB * TL, 1024, G, vb, 1);
      pg8::EpiGate<0> E{PA, b_gate, Z}; pg8::gemm_phase<pg8::EpiGate<0>, pg8::StaticOrder, true, true>(lds, g, S, E); }
    __syncthreads();
    { pg8::Gemm g{OF, Wbr1, MR, 1024, 512, 512, 512}; pg8::StaticOrder S; S.init(NB * TL, 1024, G, vb, 1);
      pg8::EpiGate<1> E{PA, b_gate, Z}; pg8::gemm_phase<pg8::EpiGate<1>, pg8::StaticOrder, true, true>(lds, g, S, E); }
    GSYNC(); PE(9); PB(10);
    { pg8::Gemm g{Z, Wout, MR, 1024, 1024, 1024, 1024}; pg8::StaticOrder S; S.init(NB * TL, 1024, G, vb, 1);
      pg8::EpiRes<1, 5, 0, 2> E{H, HC, H, HC, mod, g_norm + 2 * DM, XN2, ssq2}; pg8::gemm_phase<pg8::EpiRes<1, 5, 0, 2>, pg8::StaticOrder, true, true>(lds, g, S, E); }
    GSYNC(); PE(10); PB(11);
#endif
#if MK_STAGE >= 3
    { pg8::Gemm g{XN2, Wup2, MR, 5632, 1024, 1024, 1024}; pg8::StaticOrder S; S.init(NB * TL, 5632, G, vb, 1);
      pg8::EpiSwigluN E{HID, DFF, ssq2, sW2, 5632}; pg8::gemm_phase<pg8::EpiSwigluN, pg8::StaticOrder, true, true>(lds, g, S, E); }
    GSYNC(); PE(11); PB(12);
    { pg8::Gemm g{HID, Wdn2, MR, 1024, DFF, DFF, DFF}; pg8::StaticOrder S; S.init(NB * TL, 1024, G, vb, 1);
      pg8::EpiRes<0, 8, 1, 0> E{H, HC, H, HC, mod, nullptr, nullptr, nullptr}; pg8::gemm_phase<pg8::EpiRes<0, 8, 1, 0>, pg8::StaticOrder, true, true>(lds, g, S, E); }
    GSYNC(); PE(12); PB(13);
#endif
    { PH_IDS; f32x4 gv[4];
#pragma unroll
      for (int j = 0; j < 4; ++j) gv[j] = *((const f32x4*)g_final + lane + 64 * j);
      for (int r0 = gw * 4; r0 < NB * TL; r0 += NGW * 4) { f32x4* p = (f32x4*)(H + (size_t)r0 * DM) + lane; f32x4 v[4][4]; float s[4] = {0.f, 0.f, 0.f, 0.f};
#pragma unroll
          for (int u = 0; u < 4; ++u)
#pragma unroll
              for (int j = 0; j < 4; ++j) v[u][j] = p[u * 256 + 64 * j];
#pragma unroll
          for (int u = 0; u < 4; ++u)
#pragma unroll
              for (int j = 0; j < 4; ++j) s[u] += (v[u][j].x * v[u][j].x + v[u][j].y * v[u][j].y) + (v[u][j].z * v[u][j].z + v[u][j].w * v[u][j].w);
#pragma unroll
          for (int u = 0; u < 4; ++u) { const float rstd = 1.f / sqrtf(wave_sum(s[u]) * (1.f / DM) + EPS);
#pragma unroll
              for (int j = 0; j < 4; ++j) p[u * 256 + 64 * j] = v[u][j] * rstd * gv[j]; } } }
    PE(13);
    if (PROBE_MASK != 0ull || PROBE_SYNC) { const unsigned long long te = __builtin_amdgcn_s_memrealtime() + (unsigned long long)PROBE_MULT * pacc; while (__builtin_amdgcn_s_memrealtime() < te) __builtin_amdgcn_s_sleep(32); }
}

extern "C" void kernel_launch(void* const* d_in, const int* in_sizes, int n_in, void* d_out, int out_size, void* d_ws, size_t ws_size, hipStream_t stream) {
    static int grid = 0;
    if (grid == 0) {
        int dev = 0, cus = 0, per_cu = 0;
        hipGetDevice(&dev); hipDeviceGetAttribute(&cus, hipDeviceAttributeMultiprocessorCount, dev);
        hipFuncSetAttribute((const void*)mk_fwd, hipFuncAttributeMaxDynamicSharedMemorySize, LDS_BYTES);
        hipOccupancyMaxActiveBlocksPerMultiprocessor(&per_cu, (const void*)mk_fwd, NTHR, LDS_BYTES);
        if (per_cu < 1) per_cu = 1;
        grid = cus * per_cu;
        if (n_in != 19 || ws_size < WS_END) { fprintf(stderr, "kernel_launch: unexpected n_in %d or ws_size %zu\n", n_in, ws_size); }
    }
    Args a{};
    for (int i = 0; i < 19; ++i) a.in[i] = (const float*)d_in[i];
    a.out = (float*)d_out; a.ws = (unsigned char*)d_ws;
    void* kargs[] = {&a};
    hipError_t e = hipLaunchCooperativeKernel((const void*)mk_fwd, dim3(grid), dim3(NTHR), kargs, LDS_BYTES, stream);
    if (e != hipSuccess) fprintf(stderr, "cooperative launch failed: %s (grid %d)\n", hipGetErrorString(e), grid);
}
```

```cpp
#include <hip/hip_runtime.h>
#include <cstdio>
#include <cstdint>
#ifndef MK_STAGE
#define MK_STAGE 3
#endif
#define PROBE_MASK 0ull
#define PROBE_SYNC 0
#define PROBE_MULT 4
__device__ __forceinline__ int opaque_tid() { int t; asm volatile("v_mov_b32 %0, %1" : "=v"(t) : "v"((int)threadIdx.x)); return t; }
namespace pg8 {
#define PG8_LAS __attribute__((address_space(3)))
typedef unsigned short bf16_t;
typedef short bf16x8 __attribute__((ext_vector_type(8)));
typedef float f32x4 __attribute__((ext_vector_type(4)));
typedef unsigned u32x4 __attribute__((ext_vector_type(4)));
constexpr int BM = 256, BK = 64, HALF = 128, HTB = HALF * BK * 2  , STAGE_BYTES = 8 * HTB, NXCD = 8, WGM = 4;

__host__ __device__ __forceinline__ int lds_byte(int r, int c) { const int st = (r >> 4) * 2 + (c >> 5), rr = r & 15, cc = c & 31, ob = rr * 64 + cc * 2; return st * 1024 + (ob ^ (((ob >> 9) & 1) << 5)); }
__host__ __device__ __forceinline__ void stage_rc(int b, int& R, int& C) { const int st = b / 1024, sb = b % 1024, swz = sb ^ (((sb >> 9) & 1) << 5); R = (st >> 1) * 16 + swz / 64; C = (st & 1) * 32 + (swz % 64) / 2; }
__host__ __device__ __forceinline__ int perm32(int rho) { const int n = rho >> 4, i = rho & 15; return 8 * (i >> 2) + 4 * n + (i & 3); }

struct Unit { int pm, pn; };
struct Gemm { const bf16_t* A; const bf16_t* Bt; int M, N, K, lda, ldb; };

struct StaticOrder {
    int nM, nN, nwg, G, c, skip;
    __host__ __device__ void init(int M, int N, int G_, int c_, int skip_ = 0) { nM = M / BM; nN = N / BM; nwg = nM * nN; G = G_; c = c_; skip = skip_; }
    __host__ __device__ bool next(int i, Unit& u) const {
        const long L = (long)i * G + c; if (L >= nwg) return false;
        int wgid = (int)L; { const int q = nwg / NXCD, r = nwg % NXCD, xcd = wgid % NXCD, off = wgid / NXCD; wgid = (xcd < r ? xcd * (q + 1) : r * (q + 1) + (xcd - r) * q) + off; }
        const int nig = WGM * nN, gid = wgid / nig, fm = gid * WGM, gsz = (nM - fm) < WGM ? (nM - fm) : WGM;
        u.pm = fm + ((wgid % nig) % gsz); u.pn = (wgid % nig) / gsz; if (skip) u.pm += u.pm / 32; return true;
    }
    __device__ __forceinline__ void a_ready(const Unit&) const {}
    __device__ __forceinline__ void done(const Unit&) const {}
};

__device__ __forceinline__ unsigned cvt_pk_bf16(float lo, float hi) { unsigned r; asm volatile("v_cvt_pk_bf16_f32 %0, %1, %2" : "=v"(r) : "v"(lo), "v"(hi)); return r; }
__device__ __forceinline__ float fsigmoid(float x) { return __builtin_amdgcn_rcpf(1.f + __builtin_amdgcn_exp2f(-1.4426950408889634f * x)); }
__device__ __forceinline__ float bflo(unsigned w) { return __uint_as_float(w << 16); }
__device__ __forceinline__ float bfhi(unsigned w) { return __uint_as_float(w & 0xffff0000u); }
constexpr int TPB = 33;
constexpr int PWID = 4608;

struct EpiPlain {
    static constexpr bool PERM = true, AFTER_DRAIN = false;
    bf16_t* O; int ldc;
    __device__ __forceinline__ void operator()(const f32x4 (&acc)[2][2][4][2], const Unit& u, int wr, int wc, int fr, int fq) const {
        const int row0 = u.pm * BM + wr * 64 + fr, col0 = u.pn * BM + wc * 32 + 8 * fq;
#pragma unroll
        for (int ai = 0; ai < 2; ++ai)
#pragma unroll
            for (int m = 0; m < 4; ++m) { bf16_t* rowp = O + (size_t)(row0 + ai * HALF + m * 16) * ldc + col0;
#pragma unroll
                for (int bj = 0; bj < 2; ++bj) { const f32x4 v0 = acc[ai][bj][m][0], v1 = acc[ai][bj][m][1];
                    u32x4 w; w.x = cvt_pk_bf16(v0[0], v0[1]); w.y = cvt_pk_bf16(v0[2], v0[3]); w.z = cvt_pk_bf16(v1[0], v1[1]); w.w = cvt_pk_bf16(v1[2], v1[3]);
                    *(u32x4*)(rowp + bj * HALF) = w; } }
    }
};
struct EpiSwiglu {
    static constexpr bool PERM = true, AFTER_DRAIN = false;
    bf16_t* O; int ldc;
    __device__ __forceinline__ void operator()(const f32x4 (&acc)[2][2][4][2], const Unit& u, int wr, int wc, int fr, int fq) const {
        const int row0 = u.pm * BM + wr * 64 + fr, col0 = u.pn * HALF + wc * 32 + 8 * fq;
#pragma unroll
        for (int ai = 0; ai < 2; ++ai)
#pragma unroll
            for (int m = 0; m < 4; ++m) { bf16_t* rowp = O + (size_t)(row0 + ai * HALF + m * 16) * ldc + col0;
                float h[8];
#pragma unroll
                for (int n = 0; n < 2; ++n)
#pragma unroll
                    for (int k = 0; k < 4; ++k) { const float a = acc[ai][0][m][n][k], b = acc[ai][1][m][n][k]; h[n * 4 + k] = a * fsigmoid(a) * b; }
                u32x4 w; w.x = cvt_pk_bf16(h[0], h[1]); w.y = cvt_pk_bf16(h[2], h[3]); w.z = cvt_pk_bf16(h[4], h[5]); w.w = cvt_pk_bf16(h[6], h[7]);
                *(u32x4*)rowp = w; }
    }
};
template <int XNOUT, int GIDX, int HALFCOEF, int NSUB> struct EpiRes {
    static constexpr bool PERM = true, AFTER_DRAIN = false;
    const float* src_lat; const float* src_ctx; float* dst_lat; float* dst_ctx; const float* mod; const float* gnorm; bf16_t* xn; float* ssq;
    static constexpr int gidx = GIDX, nsub = NSUB; static constexpr float coef = HALFCOEF ? 0.5f : 1.0f;
    __device__ __forceinline__ void operator()(const f32x4 (&acc)[2][2][4][2], const Unit& u, int wr, int wc, int fr, int fq) const {
        asm volatile("" : "+v"(fr));
        const int b = u.pm / TPB, j = u.pm % TPB; const bool isctx = (j == TPB - 1);
        const float* src = isctx ? src_ctx + (size_t)b * 256 * 1024 : src_lat + (size_t)(b * 8192 + j * 256) * 1024;
        float* dst = isctx ? dst_ctx + (size_t)b * 256 * 1024 : dst_lat + (size_t)(b * 8192 + j * 256) * 1024;
        const float* mrow = mod + (size_t)(isctx ? 8 : b) * 9216;
        const float* g = mrow + gidx * 1024;
        const int col0 = u.pn * BM + wc * 32 + 8 * fq;
        f32x4 gv[2][2], gs[2][2];
#pragma unroll
        for (int bj = 0; bj < 2; ++bj)
#pragma unroll
            for (int n = 0; n < 2; ++n) { gv[bj][n] = *(const f32x4*)(g + col0 + bj * HALF + 4 * n) * coef;
                if (XNOUT) gs[bj][n] = *(const f32x4*)(gnorm + col0 + bj * HALF + 4 * n) * (*(const f32x4*)(mrow + (3 * nsub + 1) * 1024 + col0 + bj * HALF + 4 * n) + 1.f); }
#pragma unroll
        for (int ai = 0; ai < 2; ++ai)
#pragma unroll
            for (int m = 0; m < 4; ++m) { const int rl = ai * HALF + wr * 64 + m * 16 + fr; const size_t off = (size_t)rl * 1024 + col0; float sq = 0.f;
#pragma unroll
                for (int bj = 0; bj < 2; ++bj) { f32x4 o[2];
#pragma unroll
                    for (int n = 0; n < 2; ++n) { const f32x4 sv = *(const f32x4*)(src + off + bj * HALF + 4 * n); o[n] = sv + gv[bj][n] * acc[ai][bj][m][n];
                        if (!(XNOUT && isctx)) *(f32x4*)(dst + off + bj * HALF + 4 * n) = o[n]; }
                    if (XNOUT) { sq += (o[0][0] * o[0][0] + o[0][1] * o[0][1]) + (o[0][2] * o[0][2] + o[0][3] * o[0][3]) + (o[1][0] * o[1][0] + o[1][1] * o[1][1]) + (o[1][2] * o[1][2] + o[1][3] * o[1][3]);
                        const f32x4 x0 = o[0] * gs[bj][0], x1 = o[1] * gs[bj][1];
                        u32x4 w; w.x = cvt_pk_bf16(x0[0], x0[1]); w.y = cvt_pk_bf16(x0[2], x0[3]); w.z = cvt_pk_bf16(x1[0], x1[1]); w.w = cvt_pk_bf16(x1[2], x1[3]);
                        *(u32x4*)(xn + (size_t)(u.pm * BM + rl) * 1024 + col0 + bj * HALF) = w; } }
                if (XNOUT) { sq += __shfl_xor(sq, 16); sq += __shfl_xor(sq, 32); if (fq == 0) atomicAdd(ssq + u.pm * BM + rl, sq); }
                if (m & 1) asm volatile("" ::: "memory"); }
    }
};
struct EpiInproj {
    static constexpr bool PERM = true, AFTER_DRAIN = false;
    bf16_t* O; int ldc; const float* ssq; const float* sw; int swld;
    __device__ __forceinline__ void operator()(const f32x4 (&acc)[2][2][4][2], const Unit& u, int wr, int wc, int fr, int fq) const {
        const int row0 = u.pm * BM + wr * 64 + fr, col0 = u.pn * BM + wc * 32 + 8 * fq;
        const float* swr = sw + (size_t)((u.pm % TPB == TPB - 1) ? 8 : u.pm / TPB) * swld + col0;
        f32x4 sv[2][2];
#pragma unroll
        for (int bj = 0; bj < 2; ++bj)
#pragma unroll
            for (int n = 0; n < 2; ++n) sv[bj][n] = *(const f32x4*)(swr + bj * HALF + 4 * n);
#pragma unroll
        for (int ai = 0; ai < 2; ++ai)
#pragma unroll
            for (int m = 0; m < 4; ++m) { const int row = row0 + ai * HALF + m * 16; bf16_t* rowp = O + (size_t)row * ldc + col0;
                const float rstd = 1.f / sqrtf(ssq[row] * (1.f / 1024.f) + 1e-6f);
#pragma unroll
                for (int bj = 0; bj < 2; ++bj) { const f32x4 v0 = acc[ai][bj][m][0] * rstd + sv[bj][0], v1 = acc[ai][bj][m][1] * rstd + sv[bj][1];
                    u32x4 w; w.x = cvt_pk_bf16(v0[0], v0[1]); w.y = cvt_pk_bf16(v0[2], v0[3]); w.z = cvt_pk_bf16(v1[0], v1[1]); w.w = cvt_pk_bf16(v1[2], v1[3]);
                    *(u32x4*)(rowp + bj * HALF) = w; } }
    }
};
struct EpiSwigluN {
    static constexpr bool PERM = true, AFTER_DRAIN = false;
    bf16_t* O; int ldc; const float* ssq; const float* sw; int swld;
    __device__ __forceinline__ void operator()(const f32x4 (&acc)[2][2][4][2], const Unit& u, int wr, int wc, int fr, int fq) const {
        const int row0 = u.pm * BM + wr * 64 + fr, col0 = u.pn * HALF + wc * 32 + 8 * fq;
        const float* swr = sw + (size_t)((u.pm % TPB == TPB - 1) ? 8 : u.pm / TPB) * swld + u.pn * BM + wc * 32 + 8 * fq;
        f32x4 sv[2][2];
#pragma unroll
        for (int bj = 0; bj < 2; ++bj)
#pragma unroll
            for (int n = 0; n < 2; ++n) sv[bj][n] = *(const f32x4*)(swr + bj * HALF + 4 * n);
#pragma unroll
        for (int ai = 0; ai < 2; ++ai)
#pragma unroll
            for (int m = 0; m < 4; ++m) { const int row = row0 + ai * HALF + m * 16; bf16_t* rowp = O + (size_t)row * ldc + col0;
                const float rstd = 1.f / sqrtf(ssq[row] * (1.f / 1024.f) + 1e-6f);
                float h[8];
#pragma unroll
                for (int n = 0; n < 2; ++n)
#pragma unroll
                    for (int k = 0; k < 4; ++k) { const float a = acc[ai][0][m][n][k] * rstd + sv[0][n][k], b = acc[ai][1][m][n][k] * rstd + sv[1][n][k]; h[n * 4 + k] = a * fsigmoid(a) * b; }
                u32x4 w; w.x = cvt_pk_bf16(h[0], h[1]); w.y = cvt_pk_bf16(h[2], h[3]); w.z = cvt_pk_bf16(h[4], h[5]); w.w = cvt_pk_bf16(h[6], h[7]);
                *(u32x4*)rowp = w; }
    }
};
template <int SECOND> struct EpiGate {
    static constexpr bool PERM = true, AFTER_DRAIN = false;
    const bf16_t* P; const float* bgate; bf16_t* Z;
    __device__ __forceinline__ void operator()(const f32x4 (&acc)[2][2][4][2], const Unit& u, int wr, int wc, int fr, int fq) const {
        const int row0 = u.pm * BM + wr * 64 + fr, col0 = u.pn * BM + wc * 32 + 8 * fq;
        f32x4 bg[2][2];
#pragma unroll
        for (int bj = 0; bj < 2; ++bj)
#pragma unroll
            for (int n = 0; n < 2; ++n) bg[bj][n] = *(const f32x4*)(bgate + 1024 * SECOND + col0 + bj * HALF + 4 * n);
#pragma unroll
        for (int ai = 0; ai < 2; ++ai)
#pragma unroll
            for (int m = 0; m < 4; ++m) { const size_t row = (size_t)(row0 + ai * HALF + m * 16);
#pragma unroll
                for (int bj = 0; bj < 2; ++bj) { const int c = col0 + bj * HALF;
                    const u32x4 gr = *(const u32x4*)(P + row * PWID + 2304 + 1024 * SECOND + c);
                    float v[8];
                    v[0] = fsigmoid(bflo(gr.x) + bg[bj][0][0]) * acc[ai][bj][m][0][0]; v[1] = fsigmoid(bfhi(gr.x) + bg[bj][0][1]) * acc[ai][bj][m][0][1];
                    v[2] = fsigmoid(bflo(gr.y) + bg[bj][0][2]) * acc[ai][bj][m][0][2]; v[3] = fsigmoid(bfhi(gr.y) + bg[bj][0][3]) * acc[ai][bj][m][0][3];
                    v[4] = fsigmoid(bflo(gr.z) + bg[bj][1][0]) * acc[ai][bj][m][1][0]; v[5] = fsigmoid(bfhi(gr.z) + bg[bj][1][1]) * acc[ai][bj][m][1][1];
                    v[6] = fsigmoid(bflo(gr.w) + bg[bj][1][2]) * acc[ai][bj][m][1][2]; v[7] = fsigmoid(bfhi(gr.w) + bg[bj][1][3]) * acc[ai][bj][m][1][3];
                    bf16_t* zp = Z + row * 1024 + c;
                    if (SECOND) { const u32x4 zr = *(const u32x4*)zp;
                        v[0] += bflo(zr.x); v[1] += bfhi(zr.x); v[2] += bflo(zr.y); v[3] += bfhi(zr.y); v[4] += bflo(zr.z); v[5] += bfhi(zr.z); v[6] += bflo(zr.w); v[7] += bfhi(zr.w); }
                    u32x4 w; w.x = cvt_pk_bf16(v[0], v[1]); w.y = cvt_pk_bf16(v[2], v[3]); w.z = cvt_pk_bf16(v[4], v[5]); w.w = cvt_pk_bf16(v[6], v[7]);
                    *(u32x4*)zp = w; } }
    }
};
template <class Epi, class Sched, bool ALIGN_EPI = false, bool SP2 = false>
__device__ __forceinline__ void gemm_phase(PG8_LAS unsigned char* lds, const Gemm g, const Sched& S, const Epi& E) {
    const int tid = opaque_tid(), wid = __builtin_amdgcn_readfirstlane(tid >> 6), lane = tid & 63, wr = wid >> 2, wc = wid & 3, fr = lane & 15, fq = lane >> 4;
    const int K = g.K, nt = K / BK;
    unsigned voffA[2], voffB[2];
#pragma unroll
    for (int i = 0; i < 2; ++i) { int R, C; stage_rc(tid * 16 + i * 8192, R, C); const int Rb = Epi::PERM ? ((R & ~31) + perm32(R & 31)) : R;
        voffA[i] = (unsigned)(R * g.lda + C) * 2u; voffB[i] = (unsigned)(Rb * g.ldb + C) * 2u; }
    const size_t kstep = (size_t)(BK * 2);
    const size_t hstepA = (size_t)HALF * g.lda * 2, hstepB = (size_t)HALF * g.ldb * 2;
    const size_t tstepA = 2 * hstepA, tstepB = 2 * hstepB;
    const unsigned ldsw = (unsigned)wid * 1024u;
    const int aoff = lds_byte(wr * 64 + fr, fq * 8), boff = lds_byte(wc * 32 + fr, fq * 8);
#define PG8_SA(b, h) (((b) * 2 + (h)) * HTB)
#define PG8_SB(b, h) ((4 + (b) * 2 + (h)) * HTB)
#define PG8_STAGE(bufoff, gbase, voff) do { _Pragma("unroll") for (int _i = 0; _i < 2; ++_i) \
        __builtin_amdgcn_global_load_lds((const unsigned*)((const char*)(gbase) + (voff)[_i]), (PG8_LAS unsigned*)(lds + (bufoff) + ldsw + _i * 8192), 16, 0, 0); } while (0)
#define PG8_LDA(dst, b, h) do { _Pragma("unroll") for (int m = 0; m < 4; ++m) _Pragma("unroll") for (int k = 0; k < 2; ++k) dst[m][k] = *(const PG8_LAS bf16x8*)(lds + PG8_SA(b, h) + aoff + m * 2048 + k * 1024); } while (0)
#define PG8_LDB(dst, b, h) do { _Pragma("unroll") for (int n = 0; n < 2; ++n) _Pragma("unroll") for (int k = 0; k < 2; ++k) dst[n][k] = *(const PG8_LAS bf16x8*)(lds + PG8_SB(b, h) + boff + n * 2048 + k * 1024); } while (0)
#define PG8_MMA(ai, bj, At, Bt) do { __builtin_amdgcn_s_setprio(1); _Pragma("unroll") for (int m = 0; m < 4; ++m) _Pragma("unroll") for (int n = 0; n < 2; ++n) _Pragma("unroll") for (int k = 0; k < 2; ++k) \
        acc[ai][bj][m][n] = __builtin_amdgcn_mfma_f32_16x16x32_bf16(Bt[n][k], At[m][k], acc[ai][bj][m][n], 0, 0, 0); __builtin_amdgcn_s_setprio(0); } while (0)
#define PG8_WAIT_V(n) asm volatile("s_waitcnt vmcnt(" #n ")" ::: "memory")
#define PG8_WAIT_L(n) asm volatile("s_waitcnt lgkmcnt(" #n ")" ::: "memory")
#define PG8_BAR __builtin_amdgcn_s_barrier()
#define PG8_SCHED __builtin_amdgcn_sched_barrier(0)
    Unit cur, nxt; int ui = 0;
    if (!S.next(0, cur)) return;
    f32x4 acc[2][2][4][2];
#pragma unroll
    for (int a = 0; a < 2; ++a)
#pragma unroll
        for (int b = 0; b < 2; ++b)
#pragma unroll
            for (int m = 0; m < 4; ++m)
#pragma unroll
                for (int n = 0; n < 2; ++n) acc[a][b][m][n] = (f32x4){0.f, 0.f, 0.f, 0.f};
    bf16x8 At[4][2], B0[2][2], B1[2][2];
    const char* cA = (const char*)g.A + (size_t)cur.pm * tstepA; const char* cB = (const char*)g.Bt + (size_t)cur.pn * tstepB;
    S.a_ready(cur);
    if constexpr (SP2) {
        PG8_STAGE(PG8_SB(0, 0), cB, voffB); PG8_STAGE(PG8_SB(0, 1), cB + hstepB, voffB); PG8_STAGE(PG8_SA(0, 0), cA, voffA); PG8_STAGE(PG8_SA(0, 1), cA + hstepA, voffA);
        if (wr == 1) PG8_BAR;
        PG8_WAIT_V(2); PG8_BAR;
        PG8_STAGE(PG8_SB(1, 0), cB + kstep, voffB); PG8_STAGE(PG8_SA(1, 0), cA + kstep, voffA); PG8_STAGE(PG8_SB(1, 1), cB + hstepB + kstep, voffB);
        PG8_WAIT_V(6); PG8_BAR;
    } else {
        PG8_STAGE(PG8_SB(0, 0), cB, voffB); PG8_STAGE(PG8_SA(0, 0), cA, voffA); PG8_STAGE(PG8_SB(0, 1), cB + hstepB, voffB); PG8_STAGE(PG8_SA(0, 1), cA + hstepA, voffA);
        if (wr == 1) PG8_BAR;
        PG8_WAIT_V(4); PG8_BAR;
        PG8_STAGE(PG8_SB(1, 0), cB + kstep, voffB); PG8_STAGE(PG8_SA(1, 0), cA + kstep, voffA); PG8_STAGE(PG8_SB(1, 1), cB + hstepB + kstep, voffB);
        PG8_WAIT_V(6); PG8_BAR;
    }
    for (;;) {
        const bool has_next = S.next(ui + 1, nxt);
        const char* nA = has_next ? (const char*)g.A + (size_t)nxt.pm * tstepA : cA; const char* nB = has_next ? (const char*)g.Bt + (size_t)nxt.pn * tstepB : cB;
        for (int t = 0; t < nt; t += 2) {
            const bool last = (t == nt - 2);
            const char* a1 = cA + (size_t)(t + 1) * kstep;
            const char* a2 = last ? nA : cA + (size_t)(t + 2) * kstep; const char* b2 = last ? nB : cB + (size_t)(t + 2) * kstep;
            const char* a3 = a2 + kstep; const char* b3 = b2 + kstep;
            if (last && has_next) S.a_ready(nxt);
            if constexpr (SP2) {
            PG8_LDB(B0, 0, 0); PG8_LDB(B1, 0, 1); PG8_SCHED; PG8_LDA(At, 0, 0); PG8_STAGE(PG8_SA(1, 1), a1 + hstepA, voffA);
            PG8_WAIT_V(8); PG8_WAIT_L(0); PG8_BAR; PG8_MMA(0, 0, At, B0); PG8_MMA(0, 1, At, B1); PG8_BAR; PG8_SCHED;
            PG8_LDA(At, 0, 1); PG8_STAGE(PG8_SB(0, 0), b2, voffB); PG8_STAGE(PG8_SB(0, 1), b2 + hstepB, voffB); PG8_STAGE(PG8_SA(0, 0), a2, voffA);
            PG8_WAIT_V(8); PG8_WAIT_L(0); PG8_BAR; PG8_MMA(1, 0, At, B0); PG8_MMA(1, 1, At, B1); PG8_BAR; PG8_SCHED;
            PG8_LDB(B0, 1, 0); PG8_LDB(B1, 1, 1); PG8_SCHED; PG8_LDA(At, 1, 0); PG8_STAGE(PG8_SA(0, 1), a2 + hstepA, voffA);
            PG8_WAIT_V(8); PG8_WAIT_L(0); PG8_BAR; PG8_MMA(0, 0, At, B0); PG8_MMA(0, 1, At, B1); PG8_BAR; PG8_SCHED;
            PG8_LDA(At, 1, 1); PG8_STAGE(PG8_SB(1, 0), b3, voffB); PG8_STAGE(PG8_SB(1, 1), b3 + hstepB, voffB); PG8_STAGE(PG8_SA(1, 0), a3, voffA);
            PG8_WAIT_V(8); PG8_WAIT_L(0); PG8_BAR; PG8_MMA(1, 0, At, B0); PG8_MMA(1, 1, At, B1); PG8_BAR; PG8_SCHED;
            } else {
            PG8_LDB(B0, 0, 0); PG8_SCHED; PG8_LDA(At, 0, 0); PG8_STAGE(PG8_SA(1, 1), a1 + hstepA, voffA);
            PG8_WAIT_L(8); PG8_BAR; PG8_WAIT_L(0); PG8_MMA(0, 0, At, B0); PG8_BAR; PG8_SCHED;
            PG8_LDB(B1, 0, 1); PG8_STAGE(PG8_SB(0, 0), b2, voffB);
            PG8_BAR; PG8_WAIT_L(0); PG8_MMA(0, 1, At, B1); PG8_BAR;
            PG8_LDA(At, 0, 1); PG8_STAGE(PG8_SA(0, 0), a2, voffA);
            PG8_BAR; PG8_WAIT_L(0); PG8_MMA(1, 0, At, B0); PG8_BAR; PG8_SCHED;
            PG8_STAGE(PG8_SB(0, 1), b2 + hstepB, voffB);
            PG8_WAIT_V(6); PG8_BAR; PG8_MMA(1, 1, At, B1); PG8_BAR;
            PG8_LDB(B0, 1, 0); PG8_SCHED; PG8_LDA(At, 1, 0); PG8_STAGE(PG8_SA(0, 1), a2 + hstepA, voffA);
            PG8_WAIT_L(8); PG8_BAR; PG8_WAIT_L(0); PG8_MMA(0, 0, At, B0); PG8_BAR; PG8_SCHED;
            PG8_LDB(B1, 1, 1); PG8_STAGE(PG8_SB(1, 0), b3, voffB);
            PG8_BAR; PG8_WAIT_L(0); PG8_MMA(0, 1, At, B1); PG8_BAR;
            PG8_LDA(At, 1, 1); PG8_STAGE(PG8_SA(1, 0), a3, voffA);
            PG8_BAR; PG8_WAIT_L(0); PG8_MMA(1, 0, At, B0); PG8_BAR; PG8_SCHED;
            PG8_STAGE(PG8_SB(1, 1), b3 + hstepB, voffB);
            PG8_WAIT_V(6); PG8_BAR; PG8_MMA(1, 1, At, B1); PG8_BAR;
            }
        }
        if constexpr (ALIGN_EPI) { if (wr == 0) PG8_BAR; }
        if constexpr (!Epi::AFTER_DRAIN) { E(acc, cur, wr, wc, fr, fq); S.done(cur); }
        if (!has_next) break;
#pragma unroll
        for (int a = 0; a < 2; ++a)
#pragma unroll
            for (int b = 0; b < 2; ++b)
#pragma unroll
                for (int m = 0; m < 4; ++m)
#pragma unroll
                    for (int n = 0; n < 2; ++n) acc[a][b][m][n] = (f32x4){0.f, 0.f, 0.f, 0.f};
        cur = nxt; cA = nA; cB = nB; ++ui;
        if constexpr (ALIGN_EPI) { if (wr == 1) PG8_BAR; }
    }
    PG8_WAIT_V(0);
    if constexpr (!ALIGN_EPI) { if (wr == 0) PG8_BAR; }
    PG8_BAR;
    if constexpr (Epi::AFTER_DRAIN) { E.fused(acc, cur, wr, wc, fr, fq, lds, wid, lane); S.done(cur); }
#undef PG8_SA
#undef PG8_SB
#undef PG8_STAGE
#undef PG8_LDA
#undef PG8_LDB
#undef PG8_MMA
#undef PG8_WAIT_V
#undef PG8_WAIT_L
#undef PG8_BAR
#undef PG8_SCHED
}
}
#include <hip/hip_bf16.h>
#include <cmath>
namespace attn_body {
using bf16=__hip_bfloat16;
using bf16x8=__attribute__((ext_vector_type(8)))short;
using s16x4=__attribute__((ext_vector_type(4)))short;
using f32x16=__attribute__((ext_vector_type(16)))float;
using u32x4=__attribute__((ext_vector_type(4)))unsigned;
constexpr int SEQ=8448,D=64,DM=4608,NTILES=132;
constexpr int NW=8,QBLK=32,QB=QBLK*NW,KVBLK=64;
constexpr int ATTN_PITCH=DM, ATTN_UNIT_ROWS=QB;
__device__ __forceinline__ int crow(int r,int hi){return (r&3)+8*(r>>2)+4*hi;}
#define SBAR() __builtin_amdgcn_sched_barrier(0)
__device__ __forceinline__ void cmask(f32x16&p0,f32x16&p1,int jb,int qrel,int hi){
  const float NEG=-INFINITY; int kb=64*jb+4*hi;
  #pragma unroll
  for(int r=0;r<16;++r){int kv=kb+(r&3)+8*(r>>2); if(kv>qrel)p0[r]=NEG; if(kv+32>qrel)p1[r]=NEG;}
}

constexpr int NSLOT=3, SLOTB=8192;
constexpr int LDS_K=0, LDS_V=NSLOT*SLOTB, LDS_WS=2*NSLOT*SLOTB, LDS_OST=LDS_WS+NW*64*4, LDS_BYTES=LDS_OST+NW*4096;
constexpr float C2=0.125f*1.4426950408889634f;
__device__ __forceinline__ void glds16(const void*gsrc,unsigned lds_dst){unsigned keep;
  asm volatile("s_mov_b32 %0, m0\n\ts_mov_b32 m0, %2\n\ts_nop 0\n\tglobal_load_lds_dwordx4 %1, off\n\ts_mov_b32 m0, %0":"=&s"(keep):"v"(gsrc),"s"(lds_dst):"memory");}
__device__ __forceinline__ float max3f(float a,float b,float c){float r;asm("v_max3_f32 %0, %1, %2, %3":"=v"(r):"v"(a),"v"(b),"v"(c));return r;}
__device__ __forceinline__ float max2f(float a,float b){float r;asm("v_max_f32_e32 %0, %1, %2":"=v"(r):"v"(a),"v"(b));return r;}
__device__ __forceinline__ float fadd_s(float a,float b){float r;asm("v_add_f32_e32 %0, %1, %2":"=v"(r):"v"(a),"v"(b));return r;}
__device__ __forceinline__ float fsub_s(float a,float b){float r;asm("v_sub_f32_e32 %0, %1, %2":"=v"(r):"v"(a),"v"(b));return r;}
typedef float f32x2_t __attribute__((ext_vector_type(2))); typedef __bf16 bf16x2_t __attribute__((ext_vector_type(2)));
__device__ __forceinline__ unsigned cvtpk_s(float lo,float hi){f32x2_t v={lo,hi};bf16x2_t b=__builtin_convertvector(v,bf16x2_t);return __builtin_bit_cast(unsigned,b);}
#define WAIT_BAR(N) asm volatile("s_waitcnt vmcnt(" #N ") lgkmcnt(0)\n\ts_barrier":::"memory")

__device__ __forceinline__ void qkt(f32x16&p0,f32x16&p1,const char*Kslot,const bf16x8*qr,const f32x16&negm,int r32,int hi){
  const char*kb=Kslot+hi*1024+r32*16;
  #pragma unroll
  for(int d0=0;d0<4;++d0){
    const bf16x8 b0=*reinterpret_cast<const bf16x8*>(kb+d0*2048);
    const bf16x8 b1=*reinterpret_cast<const bf16x8*>(kb+d0*2048+512);
    if(d0==0){p0=__builtin_amdgcn_mfma_f32_32x32x16_bf16(b0,qr[0],negm,0,0,0);p1=__builtin_amdgcn_mfma_f32_32x32x16_bf16(b1,qr[0],negm,0,0,0);}
    else{p0=__builtin_amdgcn_mfma_f32_32x32x16_bf16(b0,qr[d0],p0,0,0,0);p1=__builtin_amdgcn_mfma_f32_32x32x16_bf16(b1,qr[d0],p1,0,0,0);}}
}
typedef __attribute__((address_space(3))) const char* lds_cptr;
typedef short v4i16_t __attribute__((ext_vector_type(4)));
__device__ __forceinline__ void kload8(bf16x8*kf,lds_cptr kp){
  kf[0]=*(const __attribute__((address_space(3))) bf16x8*)(kp);      kf[1]=*(const __attribute__((address_space(3))) bf16x8*)(kp+512);
  kf[2]=*(const __attribute__((address_space(3))) bf16x8*)(kp+2048); kf[3]=*(const __attribute__((address_space(3))) bf16x8*)(kp+2560);
  kf[4]=*(const __attribute__((address_space(3))) bf16x8*)(kp+4096); kf[5]=*(const __attribute__((address_space(3))) bf16x8*)(kp+4608);
  kf[6]=*(const __attribute__((address_space(3))) bf16x8*)(kp+6144); kf[7]=*(const __attribute__((address_space(3))) bf16x8*)(kp+6656);
}
__device__ __forceinline__ void kload2(bf16x8*kf,lds_cptr kp,int j){ kf[2*j]=*(const __attribute__((address_space(3))) bf16x8*)(kp+j*2048); kf[2*j+1]=*(const __attribute__((address_space(3))) bf16x8*)(kp+j*2048+512); }
__device__ __forceinline__ s16x4 vtr(lds_cptr p){ return __builtin_bit_cast(s16x4,__builtin_amdgcn_ds_read_tr16_b64_v4i16((__attribute__((address_space(3))) v4i16_t*)p)); }
__device__ __forceinline__ float rowmax(const f32x16&p0,const f32x16&p1){
  float a=max3f(p0[0],p0[1],p1[0]),b=max3f(p0[2],p0[3],p1[1]);a=max3f(a,p1[2],p1[3]);
  #pragma unroll
  for(int r=4;r<16;r+=4){a=max3f(a,p0[r],p0[r+1]);b=max3f(b,p0[r+2],p0[r+3]);a=max3f(a,p1[r],p1[r+1]);b=max3f(b,p1[r+2],p1[r+3]);}
  const float m=max2f(a,b);
  auto rr=__builtin_amdgcn_permlane32_swap(__float_as_uint(m),__float_as_uint(m),false,false);
  return max2f(__uint_as_float(rr[0]),__uint_as_float(rr[1]));
}
__device__ __forceinline__ void pv(f32x16*o,int vb,bf16x8 pa0,bf16x8 pa1,bf16x8 pa2,bf16x8 pa3){
  #pragma unroll
  for(int d0=0;d0<2;++d0){s16x4 lo[4],hi[4];
    #pragma unroll
    for(int ks=0;ks<4;++ks){
      asm volatile("ds_read_b64_tr_b16 %0,%1 offset:%c2":"=&v"(lo[ks]):"v"(vb),"i"(d0*4096+ks*1024):"memory");
      asm volatile("ds_read_b64_tr_b16 %0,%1 offset:%c2":"=&v"(hi[ks]):"v"(vb),"i"(d0*4096+ks*1024+512):"memory");}
    asm volatile("s_waitcnt lgkmcnt(0)":::"memory");SBAR();
    #define PK(k) (bf16x8){lo[k][0],lo[k][1],lo[k][2],lo[k][3],hi[k][0],hi[k][1],hi[k][2],hi[k][3]}
    o[d0]=__builtin_amdgcn_mfma_f32_32x32x16_bf16(pa0,PK(0),o[d0],0,0,0);
    o[d0]=__builtin_amdgcn_mfma_f32_32x32x16_bf16(pa1,PK(1),o[d0],0,0,0);
    o[d0]=__builtin_amdgcn_mfma_f32_32x32x16_bf16(pa2,PK(2),o[d0],0,0,0);
    o[d0]=__builtin_amdgcn_mfma_f32_32x32x16_bf16(pa3,PK(3),o[d0],0,0,0);
    #undef PK
  }
}

#ifndef ATTN_STORE16
#define ATTN_STORE16(p,v) (*(u32x4*)(p)=(v))
#endif
template<int THRL,bool NOMAX> __device__ __forceinline__ void attn_unit(int b,int h,int hk,int qb,const bf16*Q,const bf16*__restrict__ K,const bf16*__restrict__ V,bf16*O,char*shm){
  const int tid=opaque_tid(),lane=tid&63,r32=lane&31,hi=lane>>5; const int wid=__builtin_amdgcn_readfirstlane(tid>>6);
  const long rowbase=(long)b*SEQ; const int q0=qb*QB;
  const bf16*Qw=Q+(rowbase+q0+wid*QBLK)*DM+h*D;
  const bf16*Kh=K+rowbase*DM+hk*D,*Vh=V+rowbase*DM+hk*D;
  const unsigned lds0=(unsigned)(uintptr_t)shm;
  float*wsf=(float*)(shm+LDS_WS)+wid*64;
  const bf16*ksrc=Kh+(long)lane*DM+wid*8;
  const bf16*vsrc=Vh+(long)(16*(wid&3)+(lane>>2))*DM+(wid>>2)*32+(lane&3)*8;
  const unsigned kdst=lds0+LDS_K+wid*1024, vdst=lds0+LDS_V+wid*1024;
  #define DMA_K(t,slot) glds16(ksrc+(long)(t)*KVBLK*DM,(unsigned)__builtin_amdgcn_readfirstlane(kdst+(slot)))
  #define DMA_V(t,slot) glds16(vsrc+(long)(t)*KVBLK*DM,(unsigned)__builtin_amdgcn_readfirstlane(vdst+(slot)))
  const int vb0=(int)(lds0+LDS_V)+((lane>>4)&1)*32+(lane&3)*8+(4*hi+((lane&15)>>2))*64;
  const char*Kbase=shm+LDS_K; bf16x8 kf[8];
  const lds_cptr shm3=(lds_cptr)shm; const lds_cptr kp0=shm3+LDS_K+hi*1024+r32*16; const lds_cptr vp0=shm3+LDS_V+((lane>>4)&1)*32+(lane&3)*8+(4*hi+((lane&15)>>2))*64;
  constexpr int NT=NTILES;
  DMA_K(0,0);DMA_V(0,0);DMA_K(1,SLOTB);
  bf16x8 qr[4];
  #pragma unroll
  for(int d0=0;d0<4;++d0)qr[d0]=*reinterpret_cast<const bf16x8*>(&Qw[(long)r32*DM+d0*16+hi*8]);
  float mhat=0.f,l_reg=0.f;f32x16 o[2];o[0]=f32x16{};o[1]=f32x16{};f32x16 negm=f32x16{};asm volatile("":"+v"(negm));
  #define CMASK(P0,P1,t) do{}while(0)
  bool resc=false;
  #define START(P0,P1) do{ const float rm=rowmax(P0,P1); resc=false; \
    { const float dl=rm; mhat=fadd_s(mhat,dl); \
      _Pragma("unroll") for(int r=0;r<16;++r){P0[r]=fsub_s(P0[r],dl);P1[r]=fsub_s(P1[r],dl);} \
      _Pragma("unroll") for(int r=0;r<16;++r)negm[r]=-mhat; asm volatile("":"+v"(negm)); } \
    _Pragma("unroll") for(int r=0;r<16;++r)P0[r]=__builtin_amdgcn_exp2f(P0[r]); }while(0)
  #define RESC() do{ if(resc){ asm volatile("s_waitcnt lgkmcnt(0)":::"memory"); \
      _Pragma("unroll") for(int d_=0;d_<2;++d_) _Pragma("unroll") for(int r=0;r<16;++r)o[d_][r]*=wsf[crow(r,hi)]; } }while(0)
  f32x16 pA0,pA1,pB0,pB1;
  int sl_prev=0,sl_cur=0,sl_next=SLOTB;
  #define ROT() do{sl_prev=sl_cur;sl_cur=sl_next;sl_next=(sl_next==(NSLOT-1)*SLOTB)?0:sl_next+SLOTB;}while(0)
  DMA_K(2,2*SLOTB);
  WAIT_BAR(3);
  qkt(pA0,pA1,Kbase,qr,negm,r32,hi);asm volatile("s_nop 15\n\ts_nop 7":"+v"(pA0),"+v"(pA1));CMASK(pA0,pA1,0);
  START(pA0,pA1);
  _Pragma("unroll") for(int r=0;r<16;++r)pA1[r]=__builtin_amdgcn_exp2f(pA1[r]);
  WAIT_BAR(0);
  DMA_K(3,0);DMA_V(1,SLOTB);
  ROT();
  kload8(kf,kp0+sl_cur);
  WAIT_BAR(2);
  s16x4 vlo[8],vhi[8]; u32x4 pw0,pw1,pw2,pw3;
  #define PKW(P,B) cvtpk_s(P[B],P[B+1])
  #define PAF(k) __builtin_bit_cast(bf16x8,pw##k)
  #define VFR(i) (bf16x8){vlo[i][0],vlo[i][1],vlo[i][2],vlo[i][3],vhi[i][0],vhi[i][1],vhi[i][2],vhi[i][3]}
  #define PIN(x) asm volatile("":"+v"(x))
  #define MX3(a,b,c) __builtin_fmaxf(__builtin_fmaxf((a),(b)),(c))
  #define GAPA(MF,A0,A1,A2,A3,W0,W1,PW) do{ MF; sacc+=A0; sacc+=A1; sacc+=A2; sacc+=A3; PIN(sacc); W0; W1; PIN(PW); SBAR(); }while(0)
  #define EX(v) __builtin_amdgcn_exp2f(v)
  #define GAPB(MF,X,B) do{ MF; X[B]=EX(X[B]); X[B+1]=EX(X[B+1]); X[B+2]=EX(X[B+2]); X[B+3]=EX(X[B+3]); PIN(X); SBAR(); }while(0)
  #define VRD(i) do{ vlo[i]=vtr(vp_+(((i)>>2)*4096+((i)&3)*1024)); vhi[i]=vtr(vp_+(((i)>>2)*4096+((i)&3)*1024+512)); }while(0)
  #define KRD(G,j) do{ if(G){ kload2(kf,kp0+sl_next,j); SBAR(); } }while(0)
  #define STEP(C0,C1,P0,P1,t,GK,GV,GL) do{ SBAR(); \
    const lds_cptr vp_=vp0+sl_prev; \
    VRD(0); SBAR(); float sacc=(P0[0]+P0[1]); \
    GAPA(C0=__builtin_amdgcn_mfma_f32_32x32x16_bf16(kf[0],qr[0],negm,0,0,0), P0[2],P0[3],P0[4],P0[5],     pw0[0]=PKW(P0,0), pw0[1]=PKW(P0,2), pw0); \
    VRD(4); SBAR(); GAPA(C1=__builtin_amdgcn_mfma_f32_32x32x16_bf16(kf[1],qr[0],negm,0,0,0), P0[6],P0[7],P0[8],P0[9],     pw0[2]=PKW(P0,4), pw0[3]=PKW(P0,6), pw0); \
    VRD(1); SBAR(); GAPA(C0=__builtin_amdgcn_mfma_f32_32x32x16_bf16(kf[2],qr[1],C0,0,0,0),   P0[10],P0[11],P0[12],P0[13], pw1[0]=PKW(P0,8), pw1[1]=PKW(P0,10), pw1); \
    VRD(5); SBAR(); GAPA(C1=__builtin_amdgcn_mfma_f32_32x32x16_bf16(kf[3],qr[1],C1,0,0,0),   P0[14],P0[15],P1[0],P1[1],   pw1[2]=PKW(P0,12),pw1[3]=PKW(P0,14), pw1); \
    VRD(2); SBAR(); GAPA(C0=__builtin_amdgcn_mfma_f32_32x32x16_bf16(kf[4],qr[2],C0,0,0,0),   P1[2],P1[3],P1[4],P1[5],     pw2[0]=PKW(P1,0), pw2[1]=PKW(P1,2), pw2); \
    VRD(6); SBAR(); GAPA(C1=__builtin_amdgcn_mfma_f32_32x32x16_bf16(kf[5],qr[2],C1,0,0,0),   P1[6],P1[7],P1[8],P1[9],     pw2[2]=PKW(P1,4), pw2[3]=PKW(P1,6), pw2); \
    VRD(3); SBAR(); GAPA(C0=__builtin_amdgcn_mfma_f32_32x32x16_bf16(kf[6],qr[3],C0,0,0,0),   P1[10],P1[11],P1[12],P1[13], pw3[0]=PKW(P1,8), pw3[1]=PKW(P1,10), pw3); \
    VRD(7); SBAR(); GAPA(C1=__builtin_amdgcn_mfma_f32_32x32x16_bf16(kf[7],qr[3],C1,0,0,0),   P1[14],P1[15],0.f,0.f,       pw3[2]=PKW(P1,12),pw3[3]=PKW(P1,14), pw3); \
    l_reg+=sacc; \
    if(GK){DMA_K((t)+3,sl_cur);} if(GV){DMA_V((t)+1,sl_next);} \
    CMASK(C0,C1,t); \
    if constexpr(!NOMAX){ float a=MX3(C0[0],C0[1],C1[0]),b=MX3(C0[2],C0[3],C1[1]); a=MX3(a,C1[2],C1[3]); \
      _Pragma("unroll") for(int r=4;r<16;r+=4){a=MX3(a,C0[r],C0[r+1]);b=MX3(b,C0[r+2],C0[r+3]);a=MX3(a,C1[r],C1[r+1]);b=MX3(b,C1[r+2],C1[r+3]);} \
      float rm=__builtin_fmaxf(a,b); { auto rr=__builtin_amdgcn_permlane32_swap(__float_as_uint(rm),__float_as_uint(rm),false,false); rm=__builtin_fmaxf(__uint_as_float(rr[0]),__uint_as_float(rr[1])); } \
      resc=false; \
      if(__builtin_expect(__any(rm>(float)THRL),0)){ const float dl=__builtin_fmaxf(rm,0.f); mhat+=dl; \
        _Pragma("unroll") for(int r=0;r<16;++r){C0[r]-=dl;C1[r]-=dl;} \
        _Pragma("unroll") for(int r=0;r<16;++r)negm[r]=-mhat; asm volatile("":"+v"(negm)); \
        const float f=__builtin_amdgcn_exp2f(-dl); l_reg*=f; if(hi==0)wsf[r32]=f; resc=true; } } \
    SBAR(); \
    GAPB(o[0]=__builtin_amdgcn_mfma_f32_32x32x16_bf16(PAF(0),VFR(0),o[0],0,0,0), C0,0); \
    GAPB(o[1]=__builtin_amdgcn_mfma_f32_32x32x16_bf16(PAF(0),VFR(4),o[1],0,0,0), C0,4); \
    KRD(GL,0); GAPB(o[0]=__builtin_amdgcn_mfma_f32_32x32x16_bf16(PAF(1),VFR(1),o[0],0,0,0), C0,8); \
    KRD(GL,1); GAPB(o[1]=__builtin_amdgcn_mfma_f32_32x32x16_bf16(PAF(1),VFR(5),o[1],0,0,0), C0,12); \
    KRD(GL,2); GAPB(o[0]=__builtin_amdgcn_mfma_f32_32x32x16_bf16(PAF(2),VFR(2),o[0],0,0,0), C1,0); \
    KRD(GL,3); GAPB(o[1]=__builtin_amdgcn_mfma_f32_32x32x16_bf16(PAF(2),VFR(6),o[1],0,0,0), C1,4); \
    GAPB(o[0]=__builtin_amdgcn_mfma_f32_32x32x16_bf16(PAF(3),VFR(3),o[0],0,0,0), C1,8); \
    GAPB(o[1]=__builtin_amdgcn_mfma_f32_32x32x16_bf16(PAF(3),VFR(7),o[1],0,0,0), C1,12); \
    }while(0)
  int t=1;
  #undef CMASK
  #define CMASK(P0,P1,t) do{}while(0)
  for(;t+5<NT;t+=2){
    STEP(pB0,pB1,pA0,pA1,t,true,true,true);     WAIT_BAR(2); RESC(); ROT();
    STEP(pA0,pA1,pB0,pB1,t+1,true,true,true);   WAIT_BAR(2); RESC(); ROT();
  }
  #undef CMASK
  #define CMASK(P0,P1,t) do{}while(0)
  #define ENDW(tt) do{ if((tt)+3<NT){WAIT_BAR(2);} else if((tt)+2<NT){WAIT_BAR(1);} else {WAIT_BAR(0);} }while(0)
  for(;t+1<NT;t+=2){
    STEP(pB0,pB1,pA0,pA1,t,(t+3<NT),(t+1<NT),(t+1<NT));       ENDW(t);   RESC(); ROT();
    STEP(pA0,pA1,pB0,pB1,t+1,(t+4<NT),(t+2<NT),(t+2<NT));     ENDW(t+1); RESC(); ROT();
  }
  STEP(pB0,pB1,pA0,pA1,NT-1,false,false,false); RESC();
  { float sacc=pB0[0]+pB0[1]; _Pragma("unroll") for(int r=2;r<16;++r)sacc+=pB0[r]; _Pragma("unroll") for(int r=0;r<16;++r)sacc+=pB1[r]; l_reg+=sacc;
    pw0=(u32x4){PKW(pB0,0),PKW(pB0,2),PKW(pB0,4),PKW(pB0,6)};pw1=(u32x4){PKW(pB0,8),PKW(pB0,10),PKW(pB0,12),PKW(pB0,14)};pw2=(u32x4){PKW(pB1,0),PKW(pB1,2),PKW(pB1,4),PKW(pB1,6)};pw3=(u32x4){PKW(pB1,8),PKW(pB1,10),PKW(pB1,12),PKW(pB1,14)};
    SBAR(); pv(o,vb0+sl_cur,PAF(0),PAF(1),PAF(2),PAF(3)); }
  #undef PKW
  #undef PAF
  #undef VFR
  #undef PIN
  #undef MX3
  #undef GAPA
  #undef GAPB
  #undef EX
  #undef VRD
  #undef KRD
  #undef STEP
  #undef ENDW
  {auto rr=__builtin_amdgcn_permlane32_swap(__float_as_uint(l_reg),__float_as_uint(l_reg),false,false);l_reg=__uint_as_float(rr[0])+__uint_as_float(rr[1]);}
  if(hi==0)wsf[32+r32]=l_reg;asm volatile("s_waitcnt lgkmcnt(0)":::"memory");
  float rli[16];
  #pragma unroll
  for(int r=0;r<16;++r)rli[r]=__builtin_amdgcn_rcpf(wsf[32+crow(r,hi)]);
  bf16*Ow=O+(rowbase+q0+wid*QBLK)*DM+h*D;
  { bf16*stg=(bf16*)(shm+LDS_OST)+wid*2048;
    #pragma unroll
    for(int r=0;r<16;++r){const int orow=crow(r,hi);
      #pragma unroll
      for(int d0=0;d0<2;++d0)stg[orow*64+d0*32+r32]=__float2bfloat16(o[d0][r]*rli[r]);}
    asm volatile("s_waitcnt lgkmcnt(0)":::"memory");
    #pragma unroll
    for(int i=0;i<4;++i){const int row=i*8+(lane>>3),ch=lane&7; const u32x4 v=*(const u32x4*)(stg+row*64+ch*8); ATTN_STORE16(Ow+(long)row*DM+ch*8,v);} }
  asm volatile("s_waitcnt lgkmcnt(0)\n\ts_barrier":::"memory");
  #undef DMA_K
  #undef DMA_V
  #undef CMASK
  #undef START
  #undef RESC
  #undef ROT
}
constexpr int ATTN_LDS_BYTES=LDS_BYTES;
#undef SBAR
#undef WAIT_BAR
}
#include <hip/hip_cooperative_groups.h>
namespace cg = cooperative_groups;
#define LAS __attribute__((address_space(3)))
typedef unsigned short bf16;
typedef unsigned v4u __attribute__((ext_vector_type(4)));
typedef unsigned v2u __attribute__((ext_vector_type(2)));
typedef float f32x4 __attribute__((ext_vector_type(4)));
typedef short bf16x8 __attribute__((ext_vector_type(8)));

#define XB_TMO      128
#define XB_XCNT(j)  (256  + 64 * (j))
#define XB_XSUB(j)  (1280 + 64 * (j))
#define XB_XGEN(j)  (2304 + 64 * (j))
#define XB_TOP      3328
#define XB_TOPGEN   3392
#define XCD_BAR_WORDS 3456
#define XB_SPIN_CAP (1u << 18)

__device__ __forceinline__ unsigned xb_ld(unsigned* p)              { return __hip_atomic_load(p, __ATOMIC_RELAXED, __HIP_MEMORY_SCOPE_AGENT); }
__device__ __forceinline__ unsigned xb_add(unsigned* p, unsigned v) { return __hip_atomic_fetch_add(p, v, __ATOMIC_RELAXED, __HIP_MEMORY_SCOPE_AGENT); }
__device__ __forceinline__ unsigned xb_xcc_id() { return (unsigned)__builtin_amdgcn_s_getreg((3 << 11) | 20) & 0xFu; }
#define XB_SPIN(cond, bar) do { unsigned _sp = 0; while (cond) { __builtin_amdgcn_s_sleep(1); \
    if ((++_sp & 255u) == 0u) { if (xb_ld(&(bar)[XB_TMO])) break; if (_sp > XB_SPIN_CAP) { atomicAdd(&(bar)[XB_TMO], 1u); break; } } } } while (0)

struct XcdBarrier {
    unsigned* bar; unsigned x;
    volatile LAS unsigned* st;
};

__device__ __forceinline__ XcdBarrier xcd_barrier_post(unsigned* bar, volatile LAS unsigned* st) {
    XcdBarrier b; b.bar = bar; b.x = xb_xcc_id(); b.st = st;
    if (threadIdx.x == 0) (void)xb_add(&bar[XB_XCNT(b.x)], 1u);
    return b;
}
__device__ __forceinline__ void xcd_barrier_complete(unsigned* bar, unsigned x, unsigned& nloc, unsigned& nx) {
    const unsigned G = gridDim.x * gridDim.y * gridDim.z;
    unsigned sum, cnt, mine, sp = 0u;
    for (;;) {
        sum = 0u; cnt = 0u; mine = 0u;
#pragma unroll
        for (unsigned j = 0; j < 16; ++j) { const unsigned c = xb_ld(&bar[XB_XCNT(j)]); sum += c; cnt += (c > 0u) ? 1u : 0u; mine = (j == x) ? c : mine; }
        if (sum == G) break;
        __builtin_amdgcn_s_sleep(1);
        if ((++sp & 255u) == 0u) { if (xb_ld(&bar[XB_TMO])) break; if (sp > XB_SPIN_CAP) { atomicAdd(&bar[XB_TMO], 1u); break; } }
    }
    nloc = mine > 0u ? mine : 1u; nx = cnt > 0u ? cnt : 1u;
}

__device__ __forceinline__ void xcd_barrier(const XcdBarrier& b) {
    asm volatile("s_waitcnt vmcnt(0)" ::: "memory");
    __syncthreads();
    if (threadIdx.x == 0) {
        unsigned* bar = b.bar;
        __builtin_amdgcn_s_waitcnt(0);
        unsigned nloc = b.st[0], nx = b.st[1];
        if (nloc == 0u) { xcd_barrier_complete(bar, b.x, nloc, nx); b.st[0] = nloc; b.st[1] = nx; }
        const unsigned old = xb_add(&bar[XB_XSUB(b.x)], 1u);
        const unsigned gen = old / nloc;
        if (old + 1u == (gen + 1u) * nloc) {
            __builtin_amdgcn_fence(__ATOMIC_RELEASE, "agent");
            asm volatile("s_waitcnt vmcnt(0)" ::: "memory");
            const unsigned og = xb_add(&bar[XB_TOP], 1u);
            const unsigned tg = og / nx;
            if (og + 1u == (tg + 1u) * nx) xb_add(&bar[XB_TOPGEN], 1u);
            else XB_SPIN(xb_ld(&bar[XB_TOPGEN]) == tg, bar);
            __builtin_amdgcn_fence(__ATOMIC_ACQUIRE, "agent");
            xb_add(&bar[XB_XGEN(b.x)], 1u);
            asm volatile("s_waitcnt vmcnt(0)" ::: "memory");
        } else {
            XB_SPIN(xb_ld(&bar[XB_XGEN(b.x)]) == gen, bar);
            __builtin_amdgcn_fence(__ATOMIC_ACQUIRE, "agent");
            asm volatile("s_waitcnt vmcnt(0)" ::: "memory");
        }
    }
    __syncthreads();
}

constexpr int NB = 8, TL = 8192, TC = 256, TB = TL + TC  , MR = NB * TB  , DM = 1024, DFF = 2816, PW = 4608, NMOD = 9216;
constexpr float EPS = 1e-6f;
constexpr int LDS_BYTES = 147456, NTHR = 512, NWAVES = 8;
constexpr int PC_Q = 0, PC_K = 512, PC_V = 640, PC_GQ = 768, PC_GK = 1024, PC_GV = 1280, PC_G6 = 1792, PC_GATE = 2304, PC_LOW = 4352;
constexpr int GLA_S = 132, GLA_ITEMS = 64 * GLA_S;
constexpr size_t MiB = 1u << 20;
constexpr size_t WS_SSQ1 = 5 * MiB, WS_SSQ2 = 5 * MiB + 512 * 1024, WS_SW1 = 6 * MiB, WS_SW2 = 6 * MiB + 512 * 1024;
constexpr size_t WS_MOD = 1 * MiB, WS_DN = 2 * MiB, WS_WUP1 = 8 * MiB, WS_WUP2 = 20 * MiB, WS_WDN1 = 32 * MiB, WS_WDN2 = 38 * MiB, WS_WIN = 44 * MiB, WS_WBR0 = 54 * MiB, WS_WBR1 = 55 * MiB, WS_WOUT = 56 * MiB,
                 WS_HCTX = 64 * MiB, WS_XN = 72 * MiB, WS_OF = 204 * MiB, WS_OB = 270 * MiB, WS_A = 336 * MiB, WS_END = 932 * MiB;
static_assert(WS_XN + (size_t)MR * DM * 2 <= WS_OF && WS_OF + (size_t)MR * 512 * 2 <= WS_OB && WS_OB + (size_t)MR * 512 * 2 <= WS_A && WS_A + (size_t)MR * PW * 2 <= WS_END, "ws map");
static_assert((size_t)GLA_ITEMS * 8192 * 2 <= (size_t)MR * DM * 2 && WS_DN + (size_t)GLA_ITEMS * 64 * 4 <= WS_WUP1, "gla ws");

__device__ __forceinline__ unsigned f2bf(float f) { unsigned u = __builtin_bit_cast(unsigned, f); return (u + 0x7fffu + ((u >> 16) & 1u)) >> 16; }
typedef float pk_f32x2 __attribute__((ext_vector_type(2))); typedef __bf16 pk_bf16x2 __attribute__((ext_vector_type(2)));
__device__ __forceinline__ unsigned pk2(float lo, float hi) { const pk_f32x2 v = {lo, hi}; return __builtin_bit_cast(unsigned, __builtin_convertvector(v, pk_bf16x2)); }
__device__ __forceinline__ float bf2f(unsigned short h) { return __uint_as_float(((unsigned)h) << 16); }
__device__ __forceinline__ float wave_sum(float v) {
#pragma unroll
    for (int o = 1; o < 64; o <<= 1) v += __shfl_xor(v, o);
    return v;
}
__device__ __forceinline__ float silu_f(float v) { return v / (1.f + __expf(-v)); }

__device__ __forceinline__ void transpose_item(const float* W, int K, int N, bf16* WT, int k0, int n0, int drow0, LAS float* scr, int lane) {
#pragma unroll 8
    for (int i = 0; i < 32; ++i) { const int kk = 2 * i + (lane >> 5); scr[kk * 33 + (lane & 31)] = W[(size_t)(k0 + kk) * N + n0 + (lane & 31)]; }
    asm volatile("s_waitcnt lgkmcnt(0)" ::: "memory");
    const int c = lane & 7;
#pragma unroll
    for (int j = 0; j < 4; ++j) { const int n = (lane >> 3) + 8 * j; const LAS float* s = scr + (8 * c) * 33 + n;
        v4u o; o.x = pk2(s[0 * 33], s[1 * 33]); o.y = pk2(s[2 * 33], s[3 * 33]); o.z = pk2(s[4 * 33], s[5 * 33]); o.w = pk2(s[6 * 33], s[7 * 33]);
        *(v4u*)(WT + (size_t)(drow0 + n) * K + k0 + 8 * c) = o; }
    asm volatile("s_waitcnt lgkmcnt(0)" ::: "memory");
}
__device__ __forceinline__ int up_dest(int n0) { return n0 < DFF ? 256 * (n0 / 128) + (n0 % 128) : 256 * ((n0 - DFF) / 128) + 128 + ((n0 - DFF) % 128); }
__device__ __forceinline__ int win_dest(int n0) { return n0 < 2304 ? n0 : (n0 < 2336 ? n0 + 2048 : n0 - 32); }

__device__ __forceinline__ void norm_mod_rows(const float* lat, const float* ctxp, const float* mod, const float* g, int sub, bf16* XN, bool with_ctx, int gw, int NGW, int lane) {
    f32x4 gv[4];
#pragma unroll
    for (int j = 0; j < 4; ++j) gv[j] = *((const f32x4*)g + lane + 64 * j);
    for (int r0 = gw * 8; r0 < MR; r0 += NGW * 8) {
        const int b = r0 / TB, t = r0 % TB; const bool isctx = t >= TL;
        if (isctx && !with_ctx) continue;
        const float* src = isctx ? ctxp + (size_t)(b * TC + t - TL) * DM : lat + (size_t)(b * TL + t) * DM;
        const float* sh = mod + (size_t)(isctx ? 8 : b) * NMOD + (3 * sub) * DM; const float* sc = sh + DM;
        f32x4 v[8][4]; float s[8] = {0.f, 0.f, 0.f, 0.f, 0.f, 0.f, 0.f, 0.f}; f32x4 scv[4], shv[4];
#pragma unroll
        for (int u = 0; u < 8; ++u)
#pragma unroll
            for (int j = 0; j < 4; ++j) { v[u][j] = *((const f32x4*)(src + (size_t)u * DM) + lane + 64 * j); }
#pragma unroll
        for (int j = 0; j < 4; ++j) { scv[j] = *((const f32x4*)sc + lane + 64 * j) + 1.f; shv[j] = *((const f32x4*)sh + lane + 64 * j); }
#pragma unroll
        for (int u = 0; u < 8; ++u)
#pragma unroll
            for (int j = 0; j < 4; ++j) s[u] += (v[u][j].x * v[u][j].x + v[u][j].y * v[u][j].y) + (v[u][j].z * v[u][j].z + v[u][j].w * v[u][j].w);
#pragma unroll
        for (int u = 0; u < 8; ++u) {
            const float rstd = 1.f / sqrtf(wave_sum(s[u]) * (1.f / DM) + EPS);
            unsigned long long* o8 = (unsigned long long*)(XN + (size_t)(r0 + u) * DM) + lane;
#pragma unroll
            for (int j = 0; j < 4; ++j) {
                const f32x4 y = (v[u][j] * rstd * gv[j]) * scv[j] + shv[j];
                o8[64 * j] = (unsigned long long)pk2(y.x, y.y) | ((unsigned long long)pk2(y.z, y.w) << 32); } }
    }
}

constexpr int GS = 72, VS = 136;
constexpr int GL_QE = 0, GL_KE = 9216, GL_KL = 18432, GL_A = 27648, GL_V = 36864, GL_B = 54272, GL_BT = 71680, GL_SEG = 71936, BS = 68;
typedef short v4i16_t __attribute__((ext_vector_type(4)));
__device__ __forceinline__ bf16x8 tr_frag(const LAS bf16* base, int rs  , int col0, int ks, int q4, int qq, int p) {
    const LAS bf16* a0 = base + (32 * ks + 8 * q4 + qq) * rs + col0 + 4 * p;
    const v4i16_t t0 = __builtin_amdgcn_ds_read_tr16_b64_v4i16((LAS v4i16_t*)a0), t1 = __builtin_amdgcn_ds_read_tr16_b64_v4i16((LAS v4i16_t*)(a0 + 4 * rs));
    return (bf16x8){t0[0], t0[1], t0[2], t0[3], t1[0], t1[1], t1[2], t1[3]};
}
#define GLA_ROWOF(c) (rowbase + (dir ? 63 - (c) : (c)))
template <int PASS> __device__ __forceinline__ void gla_pass(LAS unsigned char* lds, const bf16* P, const float* w_decay, const float* b_decay, bf16* Ubuf, float* dn, bf16* OF, bf16* OB, int bx, int G, unsigned* ctr) {
    const int tid = opaque_tid(), lane = tid & 63, w = __builtin_amdgcn_readfirstlane(tid >> 6), l15 = lane & 15, q4 = lane >> 4, qq = (lane & 15) >> 2, p3 = lane & 3;
    constexpr int NV = PASS == 1 ? 64 * 131 : 64 * 128;
    LAS bf16* qeL = (LAS bf16*)(lds + GL_QE); LAS bf16* keL = (LAS bf16*)(lds + GL_KE); LAS bf16* klL = (LAS bf16*)(lds + GL_KL); LAS bf16* AL = (LAS bf16*)(lds + GL_A); LAS bf16* vL = (LAS bf16*)(lds + GL_V);
    LAS float* bL = (LAS float*)(lds + GL_B); LAS float* btL = (LAS float*)(lds + GL_BT); LAS float* segT = (LAS float*)(lds + GL_SEG);
    const int c = tid >> 3, ch = tid & 7, dt = w & 3, half = w >> 2;
    v4u vraw[2], kraw, qraw, lowf[2]; float wdr[8]; float bdr = 0.f; bf16x8 xsn[2];
    vraw[0] = vraw[1] = kraw = qraw = lowf[0] = lowf[1] = (v4u){0u, 0u, 0u, 0u}; xsn[0] = xsn[1] = (bf16x8){0, 0, 0, 0, 0, 0, 0, 0};
#pragma unroll
    for (int j = 0; j < 8; ++j) wdr[j] = 0.f;
#define GLA_DEC(idx_) const int chain = PASS == 1 ? (idx_) / 131 : (idx_) >> 7, s = PASS == 1 ? (idx_) % 131 : 4 + ((idx_) & 127), dir = chain & 1, h = (chain >> 1) & 3, b = chain >> 3; \
    const int rowbase = b * TB + (s < 4 ? TL + (dir ? 3 - s : s) * 64 : (dir ? 127 - (s - 4) : s - 4) * 64); const int item = chain * GLA_S + s; (void)item
#define GLA_LOAD(idx_) do { GLA_DEC(idx_); \
        _Pragma("unroll") for (int i = 0; i < 2; ++i) { const int n = tid + 512 * i; vraw[i] = *(const v4u*)(P + (size_t)GLA_ROWOF(n >> 4) * PW + PC_GV + h * 128 + (n & 15) * 8); } \
        { const size_t ro = (size_t)GLA_ROWOF(c) * PW + h * 64 + ch * 8; kraw = *(const v4u*)(P + ro + PC_GK); if (PASS == 3) qraw = *(const v4u*)(P + ro + PC_GQ); } \
        _Pragma("unroll") for (int i = 0; i < 2; ++i) lowf[i] = *(const v4u*)(P + (size_t)GLA_ROWOF(16 * (2 * half + i) + l15) * PW + PC_LOW + dir * 16 + (q4 & 1) * 8); \
        _Pragma("unroll") for (int j = 0; j < 8; ++j) wdr[j] = w_decay[(dir * 16 + 8 * (q4 & 1) + j) * 256 + h * 64 + 16 * dt + l15]; \
        bdr = b_decay[dir * 256 + h * 64 + 16 * dt + l15]; \
        if (PASS == 3) { _Pragma("unroll") for (int ks = 0; ks < 2; ++ks) xsn[ks] = *(const bf16x8*)(Ubuf + (size_t)item * 8192 + (16 * w + l15) * 64 + 8 * q4 + 32 * ks); } } while (0)
    volatile LAS unsigned* nxtL = (volatile LAS unsigned*)(lds + GL_SEG + 1024);
    int idx = bx;
    if (ctr) { if (tid == 0) nxtL[0] = __hip_atomic_fetch_add(ctr, 1u, __ATOMIC_RELAXED, __HIP_MEMORY_SCOPE_AGENT); __syncthreads(); idx = (int)nxtL[0]; __syncthreads(); }
    if (idx < NV) GLA_LOAD(idx);
    for (; idx < NV;) {
        int nidx = idx + G;
        if (ctr && tid == 0) nxtL[0] = __hip_atomic_fetch_add(ctr, 1u, __ATOMIC_RELAXED, __HIP_MEMORY_SCOPE_AGENT);
        GLA_DEC(idx);
#pragma unroll
        for (int i = 0; i < 2; ++i) { const int n = tid + 512 * i; *(LAS v4u*)(vL + (n >> 4) * VS + (n & 15) * 8) = vraw[i]; }
        float kf[8], qf[8];
        kf[0] = pg8::bflo(kraw.x); kf[1] = pg8::bfhi(kraw.x); kf[2] = pg8::bflo(kraw.y); kf[3] = pg8::bfhi(kraw.y); kf[4] = pg8::bflo(kraw.z); kf[5] = pg8::bfhi(kraw.z); kf[6] = pg8::bflo(kraw.w); kf[7] = pg8::bfhi(kraw.w);
        if (PASS == 3) { qf[0] = pg8::bflo(qraw.x); qf[1] = pg8::bfhi(qraw.x); qf[2] = pg8::bflo(qraw.y); qf[3] = pg8::bfhi(qraw.y); qf[4] = pg8::bflo(qraw.z); qf[5] = pg8::bfhi(qraw.z); qf[6] = pg8::bflo(qraw.w); qf[7] = pg8::bfhi(qraw.w); }
        float bv[2][4], tot[2];
        { bf16x8 yv;
#pragma unroll
          for (int j = 0; j < 8; ++j) { const unsigned hb = f2bf(wdr[j]); const unsigned lb = f2bf(wdr[j] - __uint_as_float(hb << 16)); yv[j] = (short)(q4 < 2 ? hb : lb); }
#pragma unroll
          for (int i = 0; i < 2; ++i) { f32x4 z = {0.f, 0.f, 0.f, 0.f}; z = __builtin_amdgcn_mfma_f32_16x16x32_bf16(__builtin_bit_cast(bf16x8, lowf[i]), yv, z, 0, 0, 0);
              float run = 0.f;
#pragma unroll
              for (int r = 0; r < 4; ++r) { const float zz = z[r] + bdr; run += (fminf(zz, 0.f) - __logf(1.f + __expf(-fabsf(zz)))) * (1.f / 16.f); bv[i][r] = run; }
              float sc = run; float t = __shfl_up(sc, 16); if (q4 >= 1) sc += t; t = __shfl_up(sc, 32); if (q4 >= 2) sc += t;
              const float excl = sc - run; tot[i] = __shfl(sc, 48 + l15);
#pragma unroll
              for (int r = 0; r < 4; ++r) bv[i][r] += excl + (i ? tot[0] : 0.f); }
          if (q4 == 0) segT[half * 64 + 16 * dt + l15] = tot[0] + tot[1]; }
        __syncthreads();
        { const float other = segT[(1 - half) * 64 + 16 * dt + l15]; const float add = half ? other : 0.f;
#pragma unroll
          for (int i = 0; i < 2; ++i)
#pragma unroll
              for (int r = 0; r < 4; ++r) bL[(16 * (2 * half + i) + 4 * q4 + r) * BS + 16 * dt + l15] = bv[i][r] + add;
          if (half == 0 && q4 == 0) btL[16 * dt + l15] = tot[0] + tot[1] + other; }
        __syncthreads();
        float bl[8], btot[8];
        { const f32x4 b0 = *(const LAS f32x4*)(bL + c * BS + 8 * ch), b1 = *(const LAS f32x4*)(bL + c * BS + 8 * ch + 4), t0 = *(const LAS f32x4*)(btL + 8 * ch), t1 = *(const LAS f32x4*)(btL + 8 * ch + 4);
          bl[0] = b0[0]; bl[1] = b0[1]; bl[2] = b0[2]; bl[3] = b0[3]; bl[4] = b1[0]; bl[5] = b1[1]; bl[6] = b1[2]; bl[7] = b1[3];
          btot[0] = t0[0]; btot[1] = t0[1]; btot[2] = t0[2]; btot[3] = t0[3]; btot[4] = t1[0]; btot[5] = t1[1]; btot[6] = t1[2]; btot[7] = t1[3]; }
        if (PASS == 1) {
            float kl[8];
#pragma unroll
            for (int k = 0; k < 8; ++k) kl[k] = kf[k] * __expf(btot[k] - bl[k]);
            v4u o; o.x = pk2(kl[0], kl[1]); o.y = pk2(kl[2], kl[3]); o.z = pk2(kl[4], kl[5]); o.w = pk2(kl[6], kl[7]);
            *(LAS v4u*)(klL + c * GS + 8 * ch) = o;
            if (tid < 8) { f32x4* dp = (f32x4*)(dn + (size_t)item * 64 + 8 * ch); dp[0] = (f32x4){__expf(btot[0]), __expf(btot[1]), __expf(btot[2]), __expf(btot[3])}; dp[1] = (f32x4){__expf(btot[4]), __expf(btot[5]), __expf(btot[6]), __expf(btot[7])}; }
        } else {
            float qe[8], ke[8];
#pragma unroll
            for (int k = 0; k < 8; ++k) { qe[k] = qf[k] * __expf(bl[k]) * 0.125f; ke[k] = kf[k] * __expf(-bl[k]); }
            v4u o; o.x = pk2(qe[0], qe[1]); o.y = pk2(qe[2], qe[3]); o.z = pk2(qe[4], qe[5]); o.w = pk2(qe[6], qe[7]);
            *(LAS v4u*)(qeL + c * GS + 8 * ch) = o;
            o.x = pk2(ke[0], ke[1]); o.y = pk2(ke[2], ke[3]); o.z = pk2(ke[4], ke[5]); o.w = pk2(ke[6], ke[7]);
            *(LAS v4u*)(keL + c * GS + 8 * ch) = o;
        }
        bf16x8 xs[2]; xs[0] = xsn[0]; xs[1] = xsn[1];
        if (ctr) nidx = (int)nxtL[0];
        if (nidx < NV) GLA_LOAD(nidx);
        __syncthreads();
        if (PASS == 1) {
            bf16x8 y[2];
#pragma unroll
            for (int ks = 0; ks < 2; ++ks) y[ks] = tr_frag(vL, VS, 16 * w, ks, q4, qq, p3);
#pragma unroll
            for (int dt = 0; dt < 4; ++dt) { f32x4 acc = {0.f, 0.f, 0.f, 0.f};
#pragma unroll
                for (int ks = 0; ks < 2; ++ks) { const bf16x8 x = tr_frag(klL, GS, 16 * dt, ks, q4, qq, p3); acc = __builtin_amdgcn_mfma_f32_16x16x32_bf16(x, y[ks], acc, 0, 0, 0); }
                v2u o; o.x = pk2(acc[0], acc[1]); o.y = pk2(acc[2], acc[3]);
                *(v2u*)(Ubuf + (size_t)item * 8192 + (16 * w + l15) * 64 + 16 * dt + 4 * q4) = o; }
        } else {
            { const int it = w >> 1;
#pragma unroll
              for (int jj = 0; jj < 2; ++jj) { const int jt = (w & 1) * 2 + jj; f32x4 acc = {0.f, 0.f, 0.f, 0.f};
                  if (jt <= it) {
#pragma unroll
                      for (int ks = 0; ks < 2; ++ks) { const bf16x8 x = *(const LAS bf16x8*)(keL + (16 * jt + l15) * GS + 8 * q4 + 32 * ks), y = *(const LAS bf16x8*)(qeL + (16 * it + l15) * GS + 8 * q4 + 32 * ks);
                          acc = __builtin_amdgcn_mfma_f32_16x16x32_bf16(x, y, acc, 0, 0, 0); }
                      const int i = 16 * it + l15, j0 = 16 * jt + 4 * q4;
#pragma unroll
                      for (int r = 0; r < 4; ++r) if (j0 + r > i) acc[r] = 0.f;
                  }
                  v2u o; o.x = pk2(acc[0], acc[1]); o.y = pk2(acc[2], acc[3]);
                  *(LAS v2u*)(AL + (16 * it + l15) * GS + 16 * jt + 4 * q4) = o; } }
            bf16x8 xv[2];
#pragma unroll
            for (int ks = 0; ks < 2; ++ks) xv[ks] = tr_frag(vL, VS, 16 * w, ks, q4, qq, p3);
            __syncthreads();
            bf16* Ob = dir ? OB : OF;
#pragma unroll
            for (int it = 0; it < 4; ++it) { f32x4 acc = {0.f, 0.f, 0.f, 0.f};
#pragma unroll
                for (int ks = 0; ks < 2; ++ks) { const bf16x8 y = *(const LAS bf16x8*)(AL + (16 * it + l15) * GS + 8 * q4 + 32 * ks); acc = __builtin_amdgcn_mfma_f32_16x16x32_bf16(xv[ks], y, acc, 0, 0, 0); }
#pragma unroll
                for (int ks = 0; ks < 2; ++ks) { const bf16x8 y = *(const LAS bf16x8*)(qeL + (16 * it + l15) * GS + 8 * q4 + 32 * ks); acc = __builtin_amdgcn_mfma_f32_16x16x32_bf16(xs[ks], y, acc, 0, 0, 0); }
                v2u o; o.x = pk2(acc[0], acc[1]); o.y = pk2(acc[2], acc[3]);
                *(v2u*)(Ob + (size_t)GLA_ROWOF(16 * it + l15) * 512 + h * 128 + 16 * w + 4 * q4) = o; }
        }
        __syncthreads();
        idx = nidx;
    }
#undef GLA_DEC
#undef GLA_LOAD
}

struct Args { const float* in[19]; float* out; unsigned char* ws; };
__global__ void __launch_bounds__(NTHR, 2) mk_fwd(Args args) {
    extern __shared__ __attribute__((aligned(16))) unsigned char lds_raw[];
    cg::grid_group grid = cg::this_grid();
    LAS unsigned char* lds = (LAS unsigned char*)lds_raw;
    const int G = gridDim.x, bx = blockIdx.x, NGW = G * NWAVES;
    unsigned long long pacc = 0ull, pt0 = 0ull; (void)pt0;
#define PB(k) do { if ((PROBE_MASK >> (k)) & 1ull) pt0 = __builtin_amdgcn_s_memrealtime(); } while (0)
#define PE(k) do { if ((PROBE_MASK >> (k)) & 1ull) pacc += __builtin_amdgcn_s_memrealtime() - pt0; } while (0)
#define GSYNC() do { xcd_barrier(xbar); if (PROBE_SYNC) { const unsigned long long t_ = __builtin_amdgcn_s_memrealtime(); xcd_barrier(xbar); pacc += __builtin_amdgcn_s_memrealtime() - t_; } } while (0)
#define PH_IDS const int tid = opaque_tid(), lane = tid & 63, wave = __builtin_amdgcn_readfirstlane(tid >> 6), gw = bx * NWAVES + wave; (void)lane; (void)gw
    unsigned char* ws = args.ws;
    const float* x = args.in[0]; const float* cvec = args.in[1]; const float* ctx = args.in[2]; const float* c_ctx = args.in[3]; const float* w_mod = args.in[4]; const float* b_mod = args.in[5];
    const float* g_norm = args.in[6]; const float* w_up = args.in[7]; const float* w_down = args.in[8]; const float* w_in = args.in[9]; const float* g_q = args.in[10]; const float* g_k = args.in[11];
    const float* w_decay = args.in[12]; const float* b_decay = args.in[13]; const float* g_gla = args.in[14]; const float* w_branch = args.in[15]; const float* b_gate = args.in[16]; const float* w_out = args.in[17]; const float* g_final = args.in[18];
    float* H = args.out;
    float* HC = (float*)(ws + WS_HCTX);
    float* mod = (float*)(ws + WS_MOD); float* dn = (float*)(ws + WS_DN);
    bf16* Wup1 = (bf16*)(ws + WS_WUP1); bf16* Wup2 = (bf16*)(ws + WS_WUP2); bf16* Wdn1 = (bf16*)(ws + WS_WDN1); bf16* Wdn2 = (bf16*)(ws + WS_WDN2); bf16* Win = (bf16*)(ws + WS_WIN);
    bf16* Wbr0 = (bf16*)(ws + WS_WBR0); bf16* Wbr1 = (bf16*)(ws + WS_WBR1); bf16* Wout = (bf16*)(ws + WS_WOUT);
    bf16* XN = (bf16*)(ws + WS_XN); bf16* OF = (bf16*)(ws + WS_OF); bf16* OB = (bf16*)(ws + WS_OB); bf16* PA = (bf16*)(ws + WS_A);
    bf16* HID = PA; bf16* Ubuf = XN; bf16* Z = XN;
    float* ssq1 = (float*)(ws + WS_SSQ1); float* ssq2 = (float*)(ws + WS_SSQ2); float* sW1 = (float*)(ws + WS_SW1); float* sW2 = (float*)(ws + WS_SW2);
    bf16* XN2 = OF;

    volatile LAS unsigned* xst = (volatile LAS unsigned*)(lds + LDS_BYTES - 64);
    if (threadIdx.x < 2) xst[threadIdx.x] = 0u;
    unsigned* barw = (unsigned*)ws;
    if (bx == 0) for (int i = threadIdx.x; i < XCD_BAR_WORDS + 128; i += NTHR) __hip_atomic_store(barw + i, 0u, __ATOMIC_RELAXED, __HIP_MEMORY_SCOPE_AGENT);
    XcdBarrier xbar; xbar.bar = barw; xbar.x = 0; xbar.st = xst;
    PB(0);
    {
        PH_IDS;
        LAS float* sc = (LAS float*)lds; LAS float* red = sc + 9 * 1024;
        for (int idx = tid; idx < 9 * 1024; idx += NTHR) { const int j = idx >> 10, k = idx & 1023; const float v = j < 8 ? cvec[j * 1024 + k] : c_ctx[k]; sc[idx] = silu_f(v); }
        __syncthreads();
        for (int it = bx; it < NMOD / 32; it += G) {
            const int cc = tid & 31, ks = tid >> 5, col = it * 32 + cc;
            float a[9];
#pragma unroll
            for (int j = 0; j < 9; ++j) a[j] = 0.f;
#pragma unroll 4
            for (int kk = 0; kk < 64; ++kk) { const int k = ks * 64 + kk; const float wv = w_mod[(size_t)k * NMOD + col];
#pragma unroll
                for (int j = 0; j < 9; ++j) a[j] += sc[j * 1024 + k] * wv; }
#pragma unroll
            for (int j = 0; j < 9; ++j) red[(ks * 9 + j) * 32 + cc] = a[j];
            __syncthreads();
            if (tid < 288) { const int j = tid >> 5, c2 = tid & 31; float s = b_mod[it * 32 + c2];
#pragma unroll
                for (int k2 = 0; k2 < 16; ++k2) s += red[(k2 * 9 + j) * 32 + c2];
                mod[(size_t)j * NMOD + it * 32 + c2] = s; }
            __syncthreads();
        }
        LAS float* scr = (LAS float*)(lds + 65536) + wave * 2176;
        constexpr int I_UP = 16 * 176, I_DN = 44 * 32;
        for (int it = gw; it < I_UP + I_DN; it += NGW) {
            int r = it;
            if (r < I_UP) { const int kb = r / 176, nb = r % 176; transpose_item(w_up, 1024, 5632, Wup1, 64 * kb, 32 * nb, up_dest(32 * nb), scr, lane); continue; } r -= I_UP;
            { const int kb = r / 32, nb = r % 32; transpose_item(w_down, DFF, 1024, Wdn1, 64 * kb, 32 * nb, 32 * nb, scr, lane); }
        }
        for (int i = bx * NTHR + tid; i < 224 * 1024 / 8; i += G * NTHR) ((v4u*)(Win + (size_t)4384 * 1024))[i] = (v4u){0u, 0u, 0u, 0u};
        for (int i = bx * NTHR + tid; i < MR; i += G * NTHR) { ssq1[i] = 0.f; ssq2[i] = 0.f; }
    }
    grid.sync();
    xbar.x = xb_xcc_id(); if (threadIdx.x == 0) xst[2] = xb_add(&barw[XB_XCNT(xbar.x)], 1u);
    PE(0); PB(1);
    { PH_IDS; norm_mod_rows(x, ctx, mod, g_norm + 0 * DM, 0, XN, true, gw, NGW, lane);
    }
    GSYNC(); PE(1); PB(2);
    if (threadIdx.x == 0) { bool uni = (xbar.x < 8u) && ((G & 7) == 0);
        for (unsigned j = 0; j < 16; ++j) { const unsigned cnt_ = xb_ld(&barw[XB_XCNT(j)]); uni = uni && (cnt_ == (j < 8u ? (unsigned)(G >> 3) : 0u)); }
        xst[3] = uni ? (xst[2] * 8u + xbar.x) : (unsigned)bx; }
    __syncthreads();
    const int vb = (int)xst[3];
    { pg8::Gemm g{XN, Wup1, MR, 5632, 1024, 1024, 1024}; pg8::StaticOrder S; S.init(MR, 5632, G, vb);
      pg8::EpiSwiglu E{HID, DFF}; pg8::gemm_phase<pg8::EpiSwiglu, pg8::StaticOrder, true, true>(lds, g, S, E); }
    { PH_IDS;
      const int rem_ = (264 * 22) % G, ir_ = rem_ ? vb - rem_ : vb, ni_ = rem_ ? G - rem_ : G;
      if (ir_ >= 0) {
      LAS float* sc = (LAS float*)lds; LAS float* red = sc + 9 * 1024;
      for (int it = ir_; it < 144 + 176; it += ni_) {
          const bool second = it >= 144; const int n0 = (second ? it - 144 : it) * 32; const int sub = second ? 2 : 1;
          __syncthreads();
          for (int idx = tid; idx < 9 * 1024; idx += NTHR) sc[idx] = mod[(size_t)(idx >> 10) * NMOD + (3 * sub) * DM + (idx & 1023)];
          __syncthreads();
          const int cc = tid & 31, ks = tid >> 5, nd = n0 + cc; int nsrc; const float* Wp; int ldw;
          if (!second) { Wp = w_in; ldw = 4384; nsrc = nd < 2304 ? nd : (nd < 4352 ? nd + 32 : (nd < 4384 ? nd - 2048 : -1)); }
          else { Wp = w_up + (size_t)1024 * 5632; ldw = 5632; const int tile = nd >> 8, within = nd & 255; nsrc = within < 128 ? 128 * tile + within : DFF + 128 * tile + (within - 128); }
          float a[9];
#pragma unroll
          for (int j = 0; j < 9; ++j) a[j] = 0.f;
          if (nsrc >= 0) {
#pragma unroll 4
              for (int kk = 0; kk < 64; ++kk) { const int k = ks * 64 + kk; const float wv = Wp[(size_t)k * ldw + nsrc];
#pragma unroll
                  for (int j = 0; j < 9; ++j) a[j] += sc[j * 1024 + k] * wv; } }
#pragma unroll
          for (int j = 0; j < 9; ++j) red[(ks * 9 + j) * 32 + cc] = a[j];
          __syncthreads();
          if (tid < 288) { const int j = tid >> 5, c2 = tid & 31; float sum = 0.f;
#pragma unroll
              for (int k2 = 0; k2 < 16; ++k2) sum += red[(k2 * 9 + j) * 32 + c2];
              (second ? sW2 + (size_t)j * 5632 : sW1 + (size_t)j * PW)[n0 + c2] = sum; }
      }
      __syncthreads(); } }
    GSYNC(); PE(2); PB(3);
    { pg8::Gemm g{HID, Wdn1, MR, 1024, DFF, DFF, DFF}; pg8::StaticOrder S; S.init(MR, 1024, G, vb);
      pg8::EpiRes<1, 2, 1, 1> E{x, ctx, H, HC, mod, g_norm + 1 * DM, XN, ssq1}; pg8::gemm_phase<pg8::EpiRes<1, 2, 1, 1>, pg8::StaticOrder, true, true>(lds, g, S, E); }
    { PH_IDS;
      const int rem = (264 * 4) % G, ir = rem ? vb - rem : vb, ni = rem ? G - rem : G;
      if (ir >= 0) {
          LAS float* scr = (LAS float*)(lds + 65536) + wave * 2176;
          constexpr int I_UP = 16 * 176, I_DN = 44 * 32, I_IN = 16 * 137, I_BR = 8 * 32, I_OUT = 16 * 32;
          constexpr int NITEMS = I_UP + I_DN + I_IN + 2 * I_BR + I_OUT;
          for (int it = ir * NWAVES + wave; it < NITEMS; it += ni * NWAVES) {
              int r = it;
              if (r < I_UP) { const int kb = r / 176, nb = r % 176; transpose_item(w_up + (size_t)1024 * 5632, 1024, 5632, Wup2, 64 * kb, 32 * nb, up_dest(32 * nb), scr, lane); continue; } r -= I_UP;
              if (r < I_DN) { const int kb = r / 32, nb = r % 32; transpose_item(w_down + (size_t)DFF * 1024, DFF, 1024, Wdn2, 64 * kb, 32 * nb, 32 * nb, scr, lane); continue; } r -= I_DN;
              if (r < I_IN) { const int kb = r / 137, nb = r % 137; transpose_item(w_in, 1024, 4384, Win, 64 * kb, 32 * nb, win_dest(32 * nb), scr, lane); continue; } r -= I_IN;
              if (r < 2 * I_BR) { const int l = r / I_BR; r %= I_BR; const int kb = r / 32, nb = r % 32; transpose_item(w_branch + (size_t)l * 512 * 1024, 512, 1024, l ? Wbr1 : Wbr0, 64 * kb, 32 * nb, 32 * nb, scr, lane); continue; } r -= 2 * I_BR;
              { const int kb = r / 32, nb = r % 32; transpose_item(w_out, 1024, 1024, Wout, 64 * kb, 32 * nb, 32 * nb, scr, lane); }
          }
      } }
    GSYNC(); PE(3); PB(4);
#if MK_STAGE >= 2
    { pg8::Gemm g{XN, Win, MR, PW, 1024, 1024, 1024}; pg8::StaticOrder S; S.init(MR, PW, G, vb);
      pg8::EpiInproj E{PA, PW, ssq1, sW1, PW}; pg8::gemm_phase<pg8::EpiInproj, pg8::StaticOrder, true, true>(lds, g, S, E); }
    GSYNC(); PE(4); PB(5);
    { PH_IDS;
      const int l7 = lane & 7, l3 = lane & 3; const bool is_hi = (lane & 4) != 0;
      float frq[8], gq8[8], gk8[8];
#pragma unroll
      for (int k = 0; k < 8; ++k) { frq[k] = __builtin_amdgcn_exp2f(-(float)(8 * (l3 & 1) + k) * (13.287712379549449f / 16.f)); gq8[k] = g_q[8 * l7 + k] * attn_body::C2; gk8[k] = g_k[8 * l7 + k]; }
      for (int r0 = gw * 4; r0 < MR; r0 += NGW * 4) {
          const int t0 = r0 % TB; const bool isctx = t0 >= TL;
          v4u qv[4], kv[4];
#pragma unroll
          for (int u = 0; u < 4; ++u) { bf16* rp = PA + (size_t)(r0 + u) * PW; qv[u] = (v4u){0u, 0u, 0u, 0u}; if (!isctx) qv[u] = *(const v4u*)(rp + lane * 8); kv[u] = *(const v4u*)(rp + PC_K + (lane & 15) * 8); }
#pragma unroll
          for (int u = 0; u < 4; ++u) { bf16* rp = PA + (size_t)(r0 + u) * PW; const int t = t0 + u;
              const float pos = (l3 < 2) ? (float)(t >> 6) : (float)(t & 63);
              float cs8[8], sn8[8];
#pragma unroll
              for (int k = 0; k < 8; ++k) { const float ang = pos * frq[k]; cs8[k] = isctx ? 1.f : __cosf(ang); sn8[k] = isctx ? 0.f : __sinf(ang); }
#pragma unroll
              for (int part = 0; part < 2; ++part) { const v4u raw = part ? kv[u] : qv[u];
                  float xv[8]; xv[0] = pg8::bflo(raw.x); xv[1] = pg8::bfhi(raw.x); xv[2] = pg8::bflo(raw.y); xv[3] = pg8::bfhi(raw.y); xv[4] = pg8::bflo(raw.z); xv[5] = pg8::bfhi(raw.z); xv[6] = pg8::bflo(raw.w); xv[7] = pg8::bfhi(raw.w);
                  float ss = 0.f;
#pragma unroll
                  for (int k = 0; k < 8; ++k) ss += xv[k] * xv[k];
                  ss += __shfl_xor(ss, 1); ss += __shfl_xor(ss, 2); ss += __shfl_xor(ss, 4);
                  const float rstd = 1.f / sqrtf(ss * (1.f / 64.f) + EPS);
                  float o[8];
#pragma unroll
                  for (int k = 0; k < 8; ++k) { const float y = xv[k] * rstd * (part ? gk8[k] : gq8[k]); const float py = __shfl_xor(y, 4);
                      o[k] = is_hi ? (py * sn8[k] + y * cs8[k]) : (y * cs8[k] - py * sn8[k]); }
                  v4u w4; w4.x = pk2(o[0], o[1]); w4.y = pk2(o[2], o[3]); w4.z = pk2(o[4], o[5]); w4.w = pk2(o[6], o[7]);
                  if (part == 0) { if (!isctx) *(v4u*)(rp + lane * 8) = w4; } else { if (lane < 16) *(v4u*)(rp + PC_K + lane * 8) = w4; } } } } }
    gla_pass<1>(lds, PA, w_decay, b_decay, Ubuf, dn, OF, OB, vb, G, nullptr);
    GSYNC(); PE(5); PB(6);
    { PH_IDS; const int tg = bx * NTHR + tid;
      for (int q = tg; q < 64 * 2048; q += G * NTHR) { const int chain = q >> 11, e4 = q & 2047; const int d0 = (4 * e4) & 63;
          f32x4 S = {0.f, 0.f, 0.f, 0.f};
          for (int s0 = 0; s0 < GLA_S; s0 += 12) { v2u ur[12]; f32x4 dv[12];
#pragma unroll
              for (int j = 0; j < 12; ++j) { const size_t item = (size_t)chain * GLA_S + s0 + j; ur[j] = (v2u){0u, 0u}; dv[j] = (f32x4){0.f, 0.f, 0.f, 0.f};
                  if (s0 + j < GLA_S - 1) { ur[j] = *(const v2u*)(Ubuf + item * 8192 + 4 * e4); dv[j] = *(const f32x4*)(dn + item * 64 + d0); } }
#pragma unroll
              for (int j = 0; j < 12; ++j) { const size_t item = (size_t)chain * GLA_S + s0 + j;
                  v2u o; o.x = pk2(S[0], S[1]); o.y = pk2(S[2], S[3]); *(v2u*)(Ubuf + item * 8192 + 4 * e4) = o;
                  S[0] = dv[j][0] * S[0] + __uint_as_float(ur[j].x << 16); S[1] = dv[j][1] * S[1] + __uint_as_float(ur[j].x & 0xffff0000u);
                  S[2] = dv[j][2] * S[2] + __uint_as_float(ur[j].y << 16); S[3] = dv[j][3] * S[3] + __uint_as_float(ur[j].y & 0xffff0000u); } } } }
    GSYNC(); PE(6); PB(7);
    bool fastsm;
    { const int l_ = opaque_tid() & 63; float gqm = fabsf(g_q[l_]), gkm = fabsf(g_k[l_]);
#pragma unroll
      for (int o = 1; o < 64; o <<= 1) { gqm = fmaxf(gqm, __shfl_xor(gqm, o)); gkm = fmaxf(gkm, __shfl_xor(gkm, o)); }
      fastsm = __builtin_amdgcn_readfirstlane((2.f * 11.5416f * gqm * gkm + 14.f < 100.f) ? 1 : 0) != 0; }
    { const attn_body::bf16* Qp = (const attn_body::bf16*)(PA + PC_Q); const attn_body::bf16* Kp = (const attn_body::bf16*)(PA + PC_K); const attn_body::bf16* Vp = (const attn_body::bf16*)(PA + PC_V);
      if ((G & 7) == 0) { const int b = vb & 7, ci = vb >> 3, nper = G >> 3;
          for (int idx = ci; idx < 256; idx += nper) { const int h = idx >> 5, qb = idx & 31;
              if (fastsm) attn_body::attn_unit<8, true>(b, h, h >> 2, qb, Qp, Kp, Vp, (attn_body::bf16*)(PA + PC_Q), (char*)lds_raw);
              else attn_body::attn_unit<8, false>(b, h, h >> 2, qb, Qp, Kp, Vp, (attn_body::bf16*)(PA + PC_Q), (char*)lds_raw); } }
      else { for (int u = vb; u < 2048; u += G) { const int b = u >> 8, h = (u >> 5) & 7, qb = u & 31; attn_body::attn_unit<8, false>(b, h, h >> 2, qb, Qp, Kp, Vp, (attn_body::bf16*)(PA + PC_Q), (char*)lds_raw); } }
    }
    __syncthreads();
    PE(7); PB(21);
    gla_pass<3>(lds, PA, w_decay, b_decay, Ubuf, dn, OF, OB, vb, G, barw + XCD_BAR_WORDS + 64);
    GSYNC(); PE(21); PB(8);
    { PH_IDS;
      const int col = lane * 8, e0 = col & 127; float gg8[8];
#pragma unroll
      for (int k = 0; k < 8; ++k) gg8[k] = g_gla[e0 + k];
      for (int r0 = gw * 4; r0 < MR; r0 += NGW * 4) {
          if (r0 % TB >= TL) continue;
          v4u a[4], bq[4], gq[4];
#pragma unroll
          for (int u = 0; u < 4; ++u) { const size_t r = r0 + u; a[u] = *(const v4u*)(OF + r * 512 + col); bq[u] = *(const v4u*)(OB + r * 512 + col); gq[u] = *(const v4u*)(PA + r * PW + PC_G6 + col); }
#pragma unroll
          for (int u = 0; u < 4; ++u) { const size_t r = r0 + u; float o[8], gg[8];
              o[0] = pg8::bflo(a[u].x) + pg8::bflo(bq[u].x); o[1] = pg8::bfhi(a[u].x) + pg8::bfhi(bq[u].x); o[2] = pg8::bflo(a[u].y) + pg8::bflo(bq[u].y); o[3] = pg8::bfhi(a[u].y) + pg8::bfhi(bq[u].y);
              o[4] = pg8::bflo(a[u].z) + pg8::bflo(bq[u].z); o[5] = pg8::bfhi(a[u].z) + pg8::bfhi(bq[u].z); o[6] = pg8::bflo(a[u].w) + pg8::bflo(bq[u].w); o[7] = pg8::bfhi(a[u].w) + pg8::bfhi(bq[u].w);
              gg[0] = pg8::bflo(gq[u].x); gg[1] = pg8::bfhi(gq[u].x); gg[2] = pg8::bflo(gq[u].y); gg[3] = pg8::bfhi(gq[u].y); gg[4] = pg8::bflo(gq[u].z); gg[5] = pg8::bfhi(gq[u].z); gg[6] = pg8::bflo(gq[u].w); gg[7] = pg8::bfhi(gq[u].w);
              float ss = 0.f;
#pragma unroll
              for (int k = 0; k < 8; ++k) ss += o[k] * o[k];
#pragma unroll
              for (int of = 1; of < 16; of <<= 1) ss += __shfl_xor(ss, of);
              const float rstd = 1.f / sqrtf(ss * (1.f / 128.f) + EPS); float y[8];
#pragma unroll
              for (int k = 0; k < 8; ++k) y[k] = o[k] * rstd * gg8[k] * silu_f(gg[k]);
              v4u w4; w4.x = pk2(y[0], y[1]); w4.y = pk2(y[2], y[3]); w4.z = pk2(y[4], y[5]); w4.w = pk2(y[6], y[7]);
              *(v4u*)(OF + r * 512 + col) = w4; } } }
    GSYNC(); PE(8); PB(9);
    { pg8::Gemm g{PA + PC_Q, Wbr0, MR, 1024, 512, PW, 512}; pg8::StaticOrder S; S.init(NB * TL, 1024, G, vb, 1);
      pg8::EpiGate<0> E{PA, b_gate, Z}; pg8::gemm_phase<pg8::EpiGate<0>, pg8::StaticOrder, true, true>(lds, g, S, E); }
    __syncthreads();
    { pg8::Gemm g{OF, Wbr1, MR, 1024, 512, 512, 512}; pg8::StaticOrder S; S.init(NB * TL, 1024, G, vb, 1);
      pg8::EpiGate<1> E{PA, b_gate, Z}; pg8::gemm_phase<pg8::EpiGate<1>, pg8::StaticOrder, true, true>(lds, g, S, E); }
    GSYNC(); PE(9); PB(10);
    { pg8::Gemm g{Z, Wout, MR, 1024, 1024, 1024, 1024}; pg8::StaticOrder S; S.init(NB * TL, 1024, G, vb, 1);
      pg8::EpiRes<1, 5, 0, 2> E{H, HC, H, HC, mod, g_norm + 2 * DM, XN2, ssq2}; pg8::gemm_phase<pg8::EpiRes<1, 5, 0, 2>, pg8::StaticOrder, true, true>(lds, g, S, E); }
    GSYNC(); PE(10); PB(11);
#endif
#if MK_STAGE >= 3
    { pg8::Gemm g{XN2, Wup2, MR, 5632, 1024, 1024, 1024}; pg8::StaticOrder S; S.init(NB * TL, 5632, G, vb, 1);
      pg8::EpiSwigluN E{HID, DFF, ssq2, sW2, 5632}; pg8::gemm_phase<pg8::EpiSwigluN, pg8::StaticOrder, true, true>(lds, g, S, E); }
    GSYNC(); PE(11); PB(12);
    { pg8::Gemm g{HID, Wdn2, MR, 1024, DFF, DFF, DFF}; pg8::StaticOrder S; S.init(NB * TL, 1024, G, vb, 1);
      pg8::EpiRes<0, 8, 1, 0> E{H, HC, H, HC, mod, nullptr, nullptr, nullptr}; pg8::gemm_phase<pg8::EpiRes<0, 8, 1, 0>, pg8::StaticOrder, true, true>(lds, g, S, E); }
    GSYNC(); PE(12); PB(13);
#endif
    { PH_IDS; f32x4 gv[4];
#pragma unroll
      for (int j = 0; j < 4; ++j) gv[j] = *((const f32x4*)g_final + lane + 64 * j);
      for (int r0 = gw * 4; r0 < NB * TL; r0 += NGW * 4) { f32x4* p = (f32x4*)(H + (size_t)r0 * DM) + lane; f32x4 v[4][4]; float s[4] = {0.f, 0.f, 0.f, 0.f};
#pragma unroll
          for (int u = 0; u < 4; ++u)
#pragma unroll
              for (int j = 0; j < 4; ++j) v[u][j] = p[u * 256 + 64 * j];
#pragma unroll
          for (int u = 0; u < 4; ++u)
#pragma unroll
              for (int j = 0; j < 4; ++j) s[u] += (v[u][j].x * v[u][j].x + v[u][j].y * v[u][j].y) + (v[u][j].z * v[u][j].z + v[u][j].w * v[u][j].w);
#pragma unroll
          for (int u = 0; u < 4; ++u) { const float rstd = 1.f / sqrtf(wave_sum(s[u]) * (1.f / DM) + EPS);
#pragma unroll
              for (int j = 0; j < 4; ++j) p[u * 256 + 64 * j] = v[u][j] * rstd * gv[j]; } } }
    PE(13);
    if (PROBE_MASK != 0ull || PROBE_SYNC) { const unsigned long long te = __builtin_amdgcn_s_memrealtime() + (unsigned long long)PROBE_MULT * pacc; while (__builtin_amdgcn_s_memrealtime() < te) __builtin_amdgcn_s_sleep(32); }
}

extern "C" void kernel_launch(void* const* d_in, const int* in_sizes, int n_in, void* d_out, int out_size, void* d_ws, size_t ws_size, hipStream_t stream) {
    static int grid = 0;
    if (grid == 0) {
        int dev = 0, cus = 0, per_cu = 0;
        hipGetDevice(&dev); hipDeviceGetAttribute(&cus, hipDeviceAttributeMultiprocessorCount, dev);
        hipFuncSetAttribute((const void*)mk_fwd, hipFuncAttributeMaxDynamicSharedMemorySize, LDS_BYTES);
        hipOccupancyMaxActiveBlocksPerMultiprocessor(&per_cu, (const void*)mk_fwd, NTHR, LDS_BYTES);
        if (per_cu < 1) per_cu = 1;
        grid = cus * per_cu;
        if (n_in != 19 || ws_size < WS_END) { fprintf(stderr, "kernel_launch: unexpected n_in %d or ws_size %zu\n", n_in, ws_size); }
    }
    Args a{};
    for (int i = 0; i < 19; ++i) a.in[i] = (const float*)d_in[i];
    a.out = (float*)d_out; a.ws = (unsigned char*)d_ws;
    void* kargs[] = {&a};
    hipError_t e = hipLaunchCooperativeKernel((const void*)mk_fwd, dim3(grid), dim3(NTHR), kargs, LDS_BYTES, stream);
    if (e != hipSuccess) fprintf(stderr, "cooperative launch failed: %s (grid %d)\n", hipGetErrorString(e), grid);
}
```

```cpp
#include <hip/hip_runtime.h>
#include <cstdio>
#include <cstdint>
#ifndef MK_STAGE
#define MK_STAGE 3
#endif
#define PROBE_MASK 0ull
#define PROBE_SYNC 0
#define PROBE_MULT 4
__device__ __forceinline__ int opaque_tid() { int t; asm volatile("v_mov_b32 %0, %1" : "=v"(t) : "v"((int)threadIdx.x)); return t; }
namespace pg8 {
#define PG8_LAS __attribute__((address_space(3)))
typedef unsigned short bf16_t;
typedef short bf16x8 __attribute__((ext_vector_type(8)));
typedef float f32x4 __attribute__((ext_vector_type(4)));
typedef unsigned u32x4 __attribute__((ext_vector_type(4)));
constexpr int BM = 256, BK = 64, HALF = 128, HTB = HALF * BK * 2  , STAGE_BYTES = 8 * HTB, NXCD = 8, WGM = 4;

__host__ __device__ __forceinline__ int lds_byte(int r, int c) { const int st = (r >> 4) * 2 + (c >> 5), rr = r & 15, cc = c & 31, ob = rr * 64 + cc * 2; return st * 1024 + (ob ^ (((ob >> 9) & 1) << 5)); }
__host__ __device__ __forceinline__ void stage_rc(int b, int& R, int& C) { const int st = b / 1024, sb = b % 1024, swz = sb ^ (((sb >> 9) & 1) << 5); R = (st >> 1) * 16 + swz / 64; C = (st & 1) * 32 + (swz % 64) / 2; }
__host__ __device__ __forceinline__ int perm32(int rho) { const int n = rho >> 4, i = rho & 15; return 8 * (i >> 2) + 4 * n + (i & 3); }

struct Unit { int pm, pn; };
struct Gemm { const bf16_t* A; const bf16_t* Bt; int M, N, K, lda, ldb; };

struct StaticOrder {
    int nM, nN, nwg, G, c, skip;
    __host__ __device__ void init(int M, int N, int G_, int c_, int skip_ = 0) { nM = M / BM; nN = N / BM; nwg = nM * nN; G = G_; c = c_; skip = skip_; }
    __host__ __device__ bool next(int i, Unit& u) const {
        const long L = (long)i * G + c; if (L >= nwg) return false;
        int wgid = (int)L; { const int q = nwg / NXCD, r = nwg % NXCD, xcd = wgid % NXCD, off = wgid / NXCD; wgid = (xcd < r ? xcd * (q + 1) : r * (q + 1) + (xcd - r) * q) + off; }
        const int nig = WGM * nN, gid = wgid / nig, fm = gid * WGM, gsz = (nM - fm) < WGM ? (nM - fm) : WGM;
        u.pm = fm + ((wgid % nig) % gsz); u.pn = (wgid % nig) / gsz; if (skip) u.pm += u.pm / 32; return true;
    }
    __device__ __forceinline__ void a_ready(const Unit&) const {}
    __device__ __forceinline__ void done(const Unit&) const {}
};

__device__ __forceinline__ unsigned cvt_pk_bf16(float lo, float hi) { unsigned r; asm volatile("v_cvt_pk_bf16_f32 %0, %1, %2" : "=v"(r) : "v"(lo), "v"(hi)); return r; }
__device__ __forceinline__ float fsigmoid(float x) { return __builtin_amdgcn_rcpf(1.f + __builtin_amdgcn_exp2f(-1.4426950408889634f * x)); }
__device__ __forceinline__ float bflo(unsigned w) { return __uint_as_float(w << 16); }
__device__ __forceinline__ float bfhi(unsigned w) { return __uint_as_float(w & 0xffff0000u); }
constexpr int TPB = 33;
constexpr int PWID = 4608;

struct EpiPlain {
    static constexpr bool PERM = true, AFTER_DRAIN = false;
    bf16_t* O; int ldc;
    __device__ __forceinline__ void operator()(const f32x4 (&acc)[2][2][4][2], const Unit& u, int wr, int wc, int fr, int fq) const {
        const int row0 = u.pm * BM + wr * 64 + fr, col0 = u.pn * BM + wc * 32 + 8 * fq;
#pragma unroll
        for (int ai = 0; ai < 2; ++ai)
#pragma unroll
            for (int m = 0; m < 4; ++m) { bf16_t* rowp = O + (size_t)(row0 + ai * HALF + m * 16) * ldc + col0;
#pragma unroll
                for (int bj = 0; bj < 2; ++bj) { const f32x4 v0 = acc[ai][bj][m][0], v1 = acc[ai][bj][m][1];
                    u32x4 w; w.x = cvt_pk_bf16(v0[0], v0[1]); w.y = cvt_pk_bf16(v0[2], v0[3]); w.z = cvt_pk_bf16(v1[0], v1[1]); w.w = cvt_pk_bf16(v1[2], v1[3]);
                    *(u32x4*)(rowp + bj * HALF) = w; } }
    }
};
struct EpiSwiglu {
    static constexpr bool PERM = true, AFTER_DRAIN = false;
    bf16_t* O; int ldc;
    __device__ __forceinline__ void operator()(const f32x4 (&acc)[2][2][4][2], const Unit& u, int wr, int wc, int fr, int fq) const {
        const int row0 = u.pm * BM + wr * 64 + fr, col0 = u.pn * HALF + wc * 32 + 8 * fq;
#pragma unroll
        for (int ai = 0; ai < 2; ++ai)
#pragma unroll
            for (int m = 0; m < 4; ++m) { bf16_t* rowp = O + (size_t)(row0 + ai * HALF + m * 16) * ldc + col0;
                float h[8];
#pragma unroll
                for (int n = 0; n < 2; ++n)
#pragma unroll
                    for (int k = 0; k < 4; ++k) { const float a = acc[ai][0][m][n][k], b = acc[ai][1][m][n][k]; h[n * 4 + k] = a * fsigmoid(a) * b; }
                u32x4 w; w.x = cvt_pk_bf16(h[0], h[1]); w.y = cvt_pk_bf16(h[2], h[3]); w.z = cvt_pk_bf16(h[4], h[5]); w.w = cvt_pk_bf16(h[6], h[7]);
                *(u32x4*)rowp = w; }
    }
};
template <int XNOUT, int GIDX, int HALFCOEF, int NSUB> struct EpiRes {
    static constexpr bool PERM = true, AFTER_DRAIN = false;
    const float* src_lat; const float* src_ctx; float* dst_lat; float* dst_ctx; const float* mod; const float* gnorm; bf16_t* xn; float* ssq;
    static constexpr int gidx = GIDX, nsub = NSUB; static constexpr float coef = HALFCOEF ? 0.5f : 1.0f;
    __device__ __forceinline__ void operator()(const f32x4 (&acc)[2][2][4][2], const Unit& u, int wr, int wc, int fr, int fq) const {
        asm volatile("" : "+v"(fr));
        const int b = u.pm / TPB, j = u.pm % TPB; const bool isctx = (j == TPB - 1);
        const float* src = isctx ? src_ctx + (size_t)b * 256 * 1024 : src_lat + (size_t)(b * 8192 + j * 256) * 1024;
        float* dst = isctx ? dst_ctx + (size_t)b * 256 * 1024 : dst_lat + (size_t)(b * 8192 + j * 256) * 1024;
        const float* mrow = mod + (size_t)(isctx ? 8 : b) * 9216;
        const float* g = mrow + gidx * 1024;
        const int col0 = u.pn * BM + wc * 32 + 8 * fq;
        f32x4 gv[2][2], gs[2][2];
#pragma unroll
        for (int bj = 0; bj < 2; ++bj)
#pragma unroll
            for (int n = 0; n < 2; ++n) { gv[bj][n] = *(const f32x4*)(g + col0 + bj * HALF + 4 * n) * coef;
                if (XNOUT) gs[bj][n] = *(const f32x4*)(gnorm + col0 + bj * HALF + 4 * n) * (*(const f32x4*)(mrow + (3 * nsub + 1) * 1024 + col0 + bj * HALF + 4 * n) + 1.f); }
#pragma unroll
        for (int ai = 0; ai < 2; ++ai)
#pragma unroll
            for (int m = 0; m < 4; ++m) { const int rl = ai * HALF + wr * 64 + m * 16 + fr; const size_t off = (size_t)rl * 1024 + col0; float sq = 0.f;
#pragma unroll
                for (int bj = 0; bj < 2; ++bj) { f32x4 o[2];
#pragma unroll
                    for (int n = 0; n < 2; ++n) { const f32x4 sv = *(const f32x4*)(src + off + bj * HALF + 4 * n); o[n] = sv + gv[bj][n] * acc[ai][bj][m][n];
                        if (!(XNOUT && isctx)) *(f32x4*)(dst + off + bj * HALF + 4 * n) = o[n]; }
                    if (XNOUT) { sq += (o[0][0] * o[0][0] + o[0][1] * o[0][1]) + (o[0][2] * o[0][2] + o[0][3] * o[0][3]) + (o[1][0] * o[1][0] + o[1][1] * o[1][1]) + (o[1][2] * o[1][2] + o[1][3] * o[1][3]);
                        const f32x4 x0 = o[0] * gs[bj][0], x1 = o[1] * gs[bj][1];
                        u32x4 w; w.x = cvt_pk_bf16(x0[0], x0[1]); w.y = cvt_pk_bf16(x0[2], x0[3]); w.z = cvt_pk_bf16(x1[0], x1[1]); w.w = cvt_pk_bf16(x1[2], x1[3]);
                        *(u32x4*)(xn + (size_t)(u.pm * BM + rl) * 1024 + col0 + bj * HALF) = w; } }
                if (XNOUT) { sq += __shfl_xor(sq, 16); sq += __shfl_xor(sq, 32); if (fq == 0) atomicAdd(ssq + u.pm * BM + rl, sq); }
                if (m & 1) asm volatile("" ::: "memory"); }
    }
};
struct EpiInproj {
    static constexpr bool PERM = true, AFTER_DRAIN = false;
    bf16_t* O; int ldc; const float* ssq; const float* sw; int swld;
    __device__ __forceinline__ void operator()(const f32x4 (&acc)[2][2][4][2], const Unit& u, int wr, int wc, int fr, int fq) const {
        const int row0 = u.pm * BM + wr * 64 + fr, col0 = u.pn * BM + wc * 32 + 8 * fq;
        const float* swr = sw + (size_t)((u.pm % TPB == TPB - 1) ? 8 : u.pm / TPB) * swld + col0;
        f32x4 sv[2][2];
#pragma unroll
        for (int bj = 0; bj < 2; ++bj)
#pragma unroll
            for (int n = 0; n < 2; ++n) sv[bj][n] = *(const f32x4*)(swr + bj * HALF + 4 * n);
#pragma unroll
        for (int ai = 0; ai < 2; ++ai)
#pragma unroll
            for (int m = 0; m < 4; ++m) { const int row = row0 + ai * HALF + m * 16; bf16_t* rowp = O + (size_t)row * ldc + col0;
                const float rstd = 1.f / sqrtf(ssq[row] * (1.f / 1024.f) + 1e-6f);
#pragma unroll
                for (int bj = 0; bj < 2; ++bj) { const f32x4 v0 = acc[ai][bj][m][0] * rstd + sv[bj][0], v1 = acc[ai][bj][m][1] * rstd + sv[bj][1];
                    u32x4 w; w.x = cvt_pk_bf16(v0[0], v0[1]); w.y = cvt_pk_bf16(v0[2], v0[3]); w.z = cvt_pk_bf16(v1[0], v1[1]); w.w = cvt_pk_bf16(v1[2], v1[3]);
                    *(u32x4*)(rowp + bj * HALF) = w; } }
    }
};
struct EpiSwigluN {
    static constexpr bool PERM = true, AFTER_DRAIN = false;
    bf16_t* O; int ldc; const float* ssq; const float* sw; int swld;
    __device__ __forceinline__ void operator()(const f32x4 (&acc)[2][2][4][2], const Unit& u, int wr, int wc, int fr, int fq) const {
        const int row0 = u.pm * BM + wr * 64 + fr, col0 = u.pn * HALF + wc * 32 + 8 * fq;
        const float* swr = sw + (size_t)((u.pm % TPB == TPB - 1) ? 8 : u.pm / TPB) * swld + u.pn * BM + wc * 32 + 8 * fq;
        f32x4 sv[2][2];
#pragma unroll
        for (int bj = 0; bj < 2; ++bj)
#pragma unroll
            for (int n = 0; n < 2; ++n) sv[bj][n] = *(const f32x4*)(swr + bj * HALF + 4 * n);
#pragma unroll
        for (int ai = 0; ai < 2; ++ai)
#pragma unroll
            for (int m = 0; m < 4; ++m) { const int row = row0 + ai * HALF + m * 16; bf16_t* rowp = O + (size_t)row * ldc + col0;
                const float rstd = 1.f / sqrtf(ssq[row] * (1.f / 1024.f) + 1e-6f);
                float h[8];
#pragma unroll
                for (int n = 0; n < 2; ++n)
#pragma unroll
                    for (int k = 0; k < 4; ++k) { const float a = acc[ai][0][m][n][k] * rstd + sv[0][n][k], b = acc[ai][1][m][n][k] * rstd + sv[1][n][k]; h[n * 4 + k] = a * fsigmoid(a) * b; }
                u32x4 w; w.x = cvt_pk_bf16(h[0], h[1]); w.y = cvt_pk_bf16(h[2], h[3]); w.z = cvt_pk_bf16(h[4], h[5]); w.w = cvt_pk_bf16(h[6], h[7]);
                *(u32x4*)rowp = w; }
    }
};
template <int SECOND> struct EpiGate {
    static constexpr bool PERM = true, AFTER_DRAIN = false;
    const bf16_t* P; const float* bgate; bf16_t* Z;
    __device__ __forceinline__ void operator()(const f32x4 (&acc)[2][2][4][2], const Unit& u, int wr, int wc, int fr, int fq) const {
        const int row0 = u.pm * BM + wr * 64 + fr, col0 = u.pn * BM + wc * 32 + 8 * fq;
        f32x4 bg[2][2];
#pragma unroll
        for (int bj = 0; bj < 2; ++bj)
#pragma unroll
            for (int n = 0; n < 2; ++n) bg[bj][n] = *(const f32x4*)(bgate + 1024 * SECOND + col0 + bj * HALF + 4 * n);
#pragma unroll
        for (int ai = 0; ai < 2; ++ai)
#pragma unroll
            for (int m = 0; m < 4; ++m) { const size_t row = (size_t)(row0 + ai * HALF + m * 16);
#pragma unroll
                for (int bj = 0; bj < 2; ++bj) { const int c = col0 + bj * HALF;
                    const u32x4 gr = *(const u32x4*)(P + row * PWID + 2304 + 1024 * SECOND + c);
                    float v[8];
                    v[0] = fsigmoid(bflo(gr.x) + bg[bj][0][0]) * acc[ai][bj][m][0][0]; v[1] = fsigmoid(bfhi(gr.x) + bg[bj][0][1]) * acc[ai][bj][m][0][1];
                    v[2] = fsigmoid(bflo(gr.y) + bg[bj][0][2]) * acc[ai][bj][m][0][2]; v[3] = fsigmoid(bfhi(gr.y) + bg[bj][0][3]) * acc[ai][bj][m][0][3];
                    v[4] = fsigmoid(bflo(gr.z) + bg[bj][1][0]) * acc[ai][bj][m][1][0]; v[5] = fsigmoid(bfhi(gr.z) + bg[bj][1][1]) * acc[ai][bj][m][1][1];
                    v[6] = fsigmoid(bflo(gr.w) + bg[bj][1][2]) * acc[ai][bj][m][1][2]; v[7] = fsigmoid(bfhi(gr.w) + bg[bj][1][3]) * acc[ai][bj][m][1][3];
                    bf16_t* zp = Z + row * 1024 + c;
                    if (SECOND) { const u32x4 zr = *(const u32x4*)zp;
                        v[0] += bflo(zr.x); v[1] += bfhi(zr.x); v[2] += bflo(zr.y); v[3] += bfhi(zr.y); v[4] += bflo(zr.z); v[5] += bfhi(zr.z); v[6] += bflo(zr.w); v[7] += bfhi(zr.w); }
                    u32x4 w; w.x = cvt_pk_bf16(v[0], v[1]); w.y = cvt_pk_bf16(v[2], v[3]); w.z = cvt_pk_bf16(v[4], v[5]); w.w = cvt_pk_bf16(v[6], v[7]);
                    *(u32x4*)zp = w; } }
    }
};
template <class Epi, class Sched, bool ALIGN_EPI = false, bool SP2 = false>
__device__ __forceinline__ void gemm_phase(PG8_LAS unsigned char* lds, const Gemm g, const Sched& S, const Epi& E) {
    const int tid = opaque_tid(), wid = __builtin_amdgcn_readfirstlane(tid >> 6), lane = tid & 63, wr = wid >> 2, wc = wid & 3, fr = lane & 15, fq = lane >> 4;
    const int K = g.K, nt = K / BK;
    unsigned voffA[2], voffB[2];
#pragma unroll
    for (int i = 0; i < 2; ++i) { int R, C; stage_rc(tid * 16 + i * 8192, R, C); const int Rb = Epi::PERM ? ((R & ~31) + perm32(R & 31)) : R;
        voffA[i] = (unsigned)(R * g.lda + C) * 2u; voffB[i] = (unsigned)(Rb * g.ldb + C) * 2u; }
    const size_t kstep = (size_t)(BK * 2);
    const size_t hstepA = (size_t)HALF * g.lda * 2, hstepB = (size_t)HALF * g.ldb * 2;
    const size_t tstepA = 2 * hstepA, tstepB = 2 * hstepB;
    const unsigned ldsw = (unsigned)wid * 1024u;
    const int aoff = lds_byte(wr * 64 + fr, fq * 8), boff = lds_byte(wc * 32 + fr, fq * 8);
#define PG8_SA(b, h) (((b) * 2 + (h)) * HTB)
#define PG8_SB(b, h) ((4 + (b) * 2 + (h)) * HTB)
#define PG8_STAGE(bufoff, gbase, voff) do { _Pragma("unroll") for (int _i = 0; _i < 2; ++_i) \
        __builtin_amdgcn_global_load_lds((const unsigned*)((const char*)(gbase) + (voff)[_i]), (PG8_LAS unsigned*)(lds + (bufoff) + ldsw + _i * 8192), 16, 0, 0); } while (0)
#define PG8_LDA(dst, b, h) do { _Pragma("unroll") for (int m = 0; m < 4; ++m) _Pragma("unroll") for (int k = 0; k < 2; ++k) dst[m][k] = *(const PG8_LAS bf16x8*)(lds + PG8_SA(b, h) + aoff + m * 2048 + k * 1024); } while (0)
#define PG8_LDB(dst, b, h) do { _Pragma("unroll") for (int n = 0; n < 2; ++n) _Pragma("unroll") for (int k = 0; k < 2; ++k) dst[n][k] = *(const PG8_LAS bf16x8*)(lds + PG8_SB(b, h) + boff + n * 2048 + k * 1024); } while (0)
#define PG8_MMA(ai, bj, At, Bt) do { __builtin_amdgcn_s_setprio(1); _Pragma("unroll") for (int m = 0; m < 4; ++m) _Pragma("unroll") for (int n = 0; n < 2; ++n) _Pragma("unroll") for (int k = 0; k < 2; ++k) \
        acc[ai][bj][m][n] = __builtin_amdgcn_mfma_f32_16x16x32_bf16(Bt[n][k], At[m][k], acc[ai][bj][m][n], 0, 0, 0); __builtin_amdgcn_s_setprio(0); } while (0)
#define PG8_WAIT_V(n) asm volatile("s_waitcnt vmcnt(" #n ")" ::: "memory")
#define PG8_WAIT_L(n) asm volatile("s_waitcnt lgkmcnt(" #n ")" ::: "memory")
#define PG8_BAR __builtin_amdgcn_s_barrier()
#define PG8_SCHED __builtin_amdgcn_sched_barrier(0)
    Unit cur, nxt; int ui = 0;
    if (!S.next(0, cur)) return;
    f32x4 acc[2][2][4][2];
#pragma unroll
    for (int a = 0; a < 2; ++a)
#pragma unroll
        for (int b = 0; b < 2; ++b)
#pragma unroll
            for (int m = 0; m < 4; ++m)
#pragma unroll
                for (int n = 0; n < 2; ++n) acc[a][b][m][n] = (f32x4){0.f, 0.f, 0.f, 0.f};
    bf16x8 At[4][2], B0[2][2], B1[2][2];
    const char* cA = (const char*)g.A + (size_t)cur.pm * tstepA; const char* cB = (const char*)g.Bt + (size_t)cur.pn * tstepB;
    S.a_ready(cur);
    if constexpr (SP2) {
        PG8_STAGE(PG8_SB(0, 0), cB, voffB); PG8_STAGE(PG8_SB(0, 1), cB + hstepB, voffB); PG8_STAGE(PG8_SA(0, 0), cA, voffA); PG8_STAGE(PG8_SA(0, 1), cA + hstepA, voffA);
        if (wr == 1) PG8_BAR;
        PG8_WAIT_V(2); PG8_BAR;
        PG8_STAGE(PG8_SB(1, 0), cB + kstep, voffB); PG8_STAGE(PG8_SA(1, 0), cA + kstep, voffA); PG8_STAGE(PG8_SB(1, 1), cB + hstepB + kstep, voffB);
        PG8_WAIT_V(6); PG8_BAR;
    } else {
        PG8_STAGE(PG8_SB(0, 0), cB, voffB); PG8_STAGE(PG8_SA(0, 0), cA, voffA); PG8_STAGE(PG8_SB(0, 1), cB + hstepB, voffB); PG8_STAGE(PG8_SA(0, 1), cA + hstepA, voffA);
        if (wr == 1) PG8_BAR;
        PG8_WAIT_V(4); PG8_BAR;
        PG8_STAGE(PG8_SB(1, 0), cB + kstep, voffB); PG8_STAGE(PG8_SA(1, 0), cA + kstep, voffA); PG8_STAGE(PG8_SB(1, 1), cB + hstepB + kstep, voffB);
        PG8_WAIT_V(6); PG8_BAR;
    }
    for (;;) {
        const bool has_next = S.next(ui + 1, nxt);
        const char* nA = has_next ? (const char*)g.A + (size_t)nxt.pm * tstepA : cA; const char* nB = has_next ? (const char*)g.Bt + (size_t)nxt.pn * tstepB : cB;
        for (int t = 0; t < nt; t += 2) {
            const bool last = (t == nt - 2);
            const char* a1 = cA + (size_t)(t + 1) * kstep;
            const char* a2 = last ? nA : cA + (size_t)(t + 2) * kstep; const char* b2 = last ? nB : cB + (size_t)(t + 2) * kstep;
            const char* a3 = a2 + kstep; const char* b3 = b2 + kstep;
            if (last && has_next) S.a_ready(nxt);
            if constexpr (SP2) {
            PG8_LDB(B0, 0, 0); PG8_LDB(B1, 0, 1); PG8_SCHED; PG8_LDA(At, 0, 0); PG8_STAGE(PG8_SA(1, 1), a1 + hstepA, voffA);
            PG8_WAIT_V(8); PG8_WAIT_L(0); PG8_BAR; PG8_MMA(0, 0, At, B0); PG8_MMA(0, 1, At, B1); PG8_BAR; PG8_SCHED;
            PG8_LDA(At, 0, 1); PG8_STAGE(PG8_SB(0, 0), b2, voffB); PG8_STAGE(PG8_SB(0, 1), b2 + hstepB, voffB); PG8_STAGE(PG8_SA(0, 0), a2, voffA);
            PG8_WAIT_V(8); PG8_WAIT_L(0); PG8_BAR; PG8_MMA(1, 0, At, B0); PG8_MMA(1, 1, At, B1); PG8_BAR; PG8_SCHED;
            PG8_LDB(B0, 1, 0); PG8_LDB(B1, 1, 1); PG8_SCHED; PG8_LDA(At, 1, 0); PG8_STAGE(PG8_SA(0, 1), a2 + hstepA, voffA);
            PG8_WAIT_V(8); PG8_WAIT_L(0); PG8_BAR; PG8_MMA(0, 0, At, B0); PG8_MMA(0, 1, At, B1); PG8_BAR; PG8_SCHED;
            PG8_LDA(At, 1, 1); PG8_STAGE(PG8_SB(1, 0), b3, voffB); PG8_STAGE(PG8_SB(1, 1), b3 + hstepB, voffB); PG8_STAGE(PG8_SA(1, 0), a3, voffA);
            PG8_WAIT_V(8); PG8_WAIT_L(0); PG8_BAR; PG8_MMA(1, 0, At, B0); PG8_MMA(1, 1, At, B1); PG8_BAR; PG8_SCHED;
            } else {
            PG8_LDB(B0, 0, 0); PG8_SCHED; PG8_LDA(At, 0, 0); PG8_STAGE(PG8_SA(1, 1), a1 + hstepA, voffA);
            PG8_WAIT_L(8); PG8_BAR; PG8_WAIT_L(0); PG8_MMA(0, 0, At, B0); PG8_BAR; PG8_SCHED;
            PG8_LDB(B1, 0, 1); PG8_STAGE(PG8_SB(0, 0), b2, voffB);
            PG8_BAR; PG8_WAIT_L(0); PG8_MMA(0, 1, At, B1); PG8_BAR;
            PG8_LDA(At, 0, 1); PG8_STAGE(PG8_SA(0, 0), a2, voffA);
            PG8_BAR; PG8_WAIT_L(0); PG8_MMA(1, 0, At, B0); PG8_BAR; PG8_SCHED;
            PG8_STAGE(PG8_SB(0, 1), b2 + hstepB, voffB);
            PG8_WAIT_V(6); PG8_BAR; PG8_MMA(1, 1, At, B1); PG8_BAR;
            PG8_LDB(B0, 1, 0); PG8_SCHED; PG8_LDA(At, 1, 0); PG8_STAGE(PG8_SA(0, 1), a2 + hstepA, voffA);
            PG8_WAIT_L(8); PG8_BAR; PG8_WAIT_L(0); PG8_MMA(0, 0, At, B0); PG8_BAR; PG8_SCHED;
            PG8_LDB(B1, 1, 1); PG8_STAGE(PG8_SB(1, 0), b3, voffB);
            PG8_BAR; PG8_WAIT_L(0); PG8_MMA(0, 1, At, B1); PG8_BAR;
            PG8_LDA(At, 1, 1); PG8_STAGE(PG8_SA(1, 0), a3, voffA);
            PG8_BAR; PG8_WAIT_L(0); PG8_MMA(1, 0, At, B0); PG8_BAR; PG8_SCHED;
            PG8_STAGE(PG8_SB(1, 1), b3 + hstepB, voffB);
            PG8_WAIT_V(6); PG8_BAR; PG8_MMA(1, 1, At, B1); PG8_BAR;
            }
        }
        if constexpr (ALIGN_EPI) { if (wr == 0) PG8_BAR; }
        if constexpr (!Epi::AFTER_DRAIN) { E(acc, cur, wr, wc, fr, fq); S.done(cur); }
        if (!has_next) break;
#pragma unroll
        for (int a = 0; a < 2; ++a)
#pragma unroll
            for (int b = 0; b < 2; ++b)
#pragma unroll
                for (int m = 0; m < 4; ++m)
#pragma unroll
                    for (int n = 0; n < 2; ++n) acc[a][b][m][n] = (f32x4){0.f, 0.f, 0.f, 0.f};
        cur = nxt; cA = nA; cB = nB; ++ui;
        if constexpr (ALIGN_EPI) { if (wr == 1) PG8_BAR; }
    }
    PG8_WAIT_V(0);
    if constexpr (!ALIGN_EPI) { if (wr == 0) PG8_BAR; }
    PG8_BAR;
    if constexpr (Epi::AFTER_DRAIN) { E.fused(acc, cur, wr, wc, fr, fq, lds, wid, lane); S.done(cur); }
#undef PG8_SA
#undef PG8_SB
#undef PG8_STAGE
#undef PG8_LDA
#undef PG8_LDB
#undef PG8_MMA
#undef PG8_WAIT_V
#undef PG8_WAIT_L
#undef PG8_BAR
#undef PG8_SCHED
}
}
#include <hip/hip_bf16.h>
#include <cmath>
namespace attn_body {
using bf16=__hip_bfloat16;
using bf16x8=__attribute__((ext_vector_type(8)))short;
using s16x4=__attribute__((ext_vector_type(4)))short;
using f32x16=__attribute__((ext_vector_type(16)))float;
using u32x4=__attribute__((ext_vector_type(4)))unsigned;
constexpr int SEQ=8448,D=64,DM=4608,NTILES=132;
constexpr int NW=8,QBLK=32,QB=QBLK*NW,KVBLK=64;
constexpr int ATTN_PITCH=DM, ATTN_UNIT_ROWS=QB;
__device__ __forceinline__ int crow(int r,int hi){return (r&3)+8*(r>>2)+4*hi;}
#define SBAR() __builtin_amdgcn_sched_barrier(0)
__device__ __forceinline__ void cmask(f32x16&p0,f32x16&p1,int jb,int qrel,int hi){
  const float NEG=-INFINITY; int kb=64*jb+4*hi;
  #pragma unroll
  for(int r=0;r<16;++r){int kv=kb+(r&3)+8*(r>>2); if(kv>qrel)p0[r]=NEG; if(kv+32>qrel)p1[r]=NEG;}
}

constexpr int NSLOT=3, SLOTB=8192;
constexpr int LDS_K=0, LDS_V=NSLOT*SLOTB, LDS_WS=2*NSLOT*SLOTB, LDS_OST=LDS_WS+NW*64*4, LDS_BYTES=LDS_OST+NW*4096;
constexpr float C2=0.125f*1.4426950408889634f;
__device__ __forceinline__ void glds16(const void*gsrc,unsigned lds_dst){unsigned keep;
  asm volatile("s_mov_b32 %0, m0\n\ts_mov_b32 m0, %2\n\ts_nop 0\n\tglobal_load_lds_dwordx4 %1, off\n\ts_mov_b32 m0, %0":"=&s"(keep):"v"(gsrc),"s"(lds_dst):"memory");}
__device__ __forceinline__ float max3f(float a,float b,float c){float r;asm("v_max3_f32 %0, %1, %2, %3":"=v"(r):"v"(a),"v"(b),"v"(c));return r;}
__device__ __forceinline__ float max2f(float a,float b){float r;asm("v_max_f32_e32 %0, %1, %2":"=v"(r):"v"(a),"v"(b));return r;}
__device__ __forceinline__ float fadd_s(float a,float b){float r;asm("v_add_f32_e32 %0, %1, %2":"=v"(r):"v"(a),"v"(b));return r;}
__device__ __forceinline__ float fsub_s(float a,float b){float r;asm("v_sub_f32_e32 %0, %1, %2":"=v"(r):"v"(a),"v"(b));return r;}
typedef float f32x2_t __attribute__((ext_vector_type(2))); typedef __bf16 bf16x2_t __attribute__((ext_vector_type(2)));
__device__ __forceinline__ unsigned cvtpk_s(float lo,float hi){f32x2_t v={lo,hi};bf16x2_t b=__builtin_convertvector(v,bf16x2_t);return __builtin_bit_cast(unsigned,b);}
#define WAIT_BAR(N) asm volatile("s_waitcnt vmcnt(" #N ") lgkmcnt(0)\n\ts_barrier":::"memory")

__device__ __forceinline__ void qkt(f32x16&p0,f32x16&p1,const char*Kslot,const bf16x8*qr,const f32x16&negm,int r32,int hi){
  const char*kb=Kslot+hi*1024+r32*16;
  #pragma unroll
  for(int d0=0;d0<4;++d0){
    const bf16x8 b0=*reinterpret_cast<const bf16x8*>(kb+d0*2048);
    const bf16x8 b1=*reinterpret_cast<const bf16x8*>(kb+d0*2048+512);
    if(d0==0){p0=__builtin_amdgcn_mfma_f32_32x32x16_bf16(b0,qr[0],negm,0,0,0);p1=__builtin_amdgcn_mfma_f32_32x32x16_bf16(b1,qr[0],negm,0,0,0);}
    else{p0=__builtin_amdgcn_mfma_f32_32x32x16_bf16(b0,qr[d0],p0,0,0,0);p1=__builtin_amdgcn_mfma_f32_32x32x16_bf16(b1,qr[d0],p1,0,0,0);}}
}
typedef __attribute__((address_space(3))) const char* lds_cptr;
typedef short v4i16_t __attribute__((ext_vector_type(4)));
__device__ __forceinline__ void kload8(bf16x8*kf,lds_cptr kp){
  kf[0]=*(const __attribute__((address_space(3))) bf16x8*)(kp);      kf[1]=*(const __attribute__((address_space(3))) bf16x8*)(kp+512);
  kf[2]=*(const __attribute__((address_space(3))) bf16x8*)(kp+2048); kf[3]=*(const __attribute__((address_space(3))) bf16x8*)(kp+2560);
  kf[4]=*(const __attribute__((address_space(3))) bf16x8*)(kp+4096); kf[5]=*(const __attribute__((address_space(3))) bf16x8*)(kp+4608);
  kf[6]=*(const __attribute__((address_space(3))) bf16x8*)(kp+6144); kf[7]=*(const __attribute__((address_space(3))) bf16x8*)(kp+6656);
}
__device__ __forceinline__ void kload2(bf16x8*kf,lds_cptr kp,int j){ kf[2*j]=*(const __attribute__((address_space(3))) bf16x8*)(kp+j*2048); kf[2*j+1]=*(const __attribute__((address_space(3))) bf16x8*)(kp+j*2048+512); }
__device__ __forceinline__ s16x4 vtr(lds_cptr p){ return __builtin_bit_cast(s16x4,__builtin_amdgcn_ds_read_tr16_b64_v4i16((__attribute__((address_space(3))) v4i16_t*)p)); }
__device__ __forceinline__ float rowmax(const f32x16&p0,const f32x16&p1){
  float a=max3f(p0[0],p0[1],p1[0]),b=max3f(p0[2],p0[3],p1[1]);a=max3f(a,p1[2],p1[3]);
  #pragma unroll
  for(int r=4;r<16;r+=4){a=max3f(a,p0[r],p0[r+1]);b=max3f(b,p0[r+2],p0[r+3]);a=max3f(a,p1[r],p1[r+1]);b=max3f(b,p1[r+2],p1[r+3]);}
  const float m=max2f(a,b);
  auto rr=__builtin_amdgcn_permlane32_swap(__float_as_uint(m),__float_as_uint(m),false,false);
  return max2f(__uint_as_float(rr[0]),__uint_as_float(rr[1]));
}
__device__ __forceinline__ void pv(f32x16*o,int vb,bf16x8 pa0,bf16x8 pa1,bf16x8 pa2,bf16x8 pa3){
  #pragma unroll
  for(int d0=0;d0<2;++d0){s16x4 lo[4],hi[4];
    #pragma unroll
    for(int ks=0;ks<4;++ks){
      asm volatile("ds_read_b64_tr_b16 %0,%1 offset:%c2":"=&v"(lo[ks]):"v"(vb),"i"(d0*4096+ks*1024):"memory");
      asm volatile("ds_read_b64_tr_b16 %0,%1 offset:%c2":"=&v"(hi[ks]):"v"(vb),"i"(d0*4096+ks*1024+512):"memory");}
    asm volatile("s_waitcnt lgkmcnt(0)":::"memory");SBAR();
    #define PK(k) (bf16x8){lo[k][0],lo[k][1],lo[k][2],lo[k][3],hi[k][0],hi[k][1],hi[k][2],hi[k][3]}
    o[d0]=__builtin_amdgcn_mfma_f32_32x32x16_bf16(pa0,PK(0),o[d0],0,0,0);
    o[d0]=__builtin_amdgcn_mfma_f32_32x32x16_bf16(pa1,PK(1),o[d0],0,0,0);
    o[d0]=__builtin_amdgcn_mfma_f32_32x32x16_bf16(pa2,PK(2),o[d0],0,0,0);
    o[d0]=__builtin_amdgcn_mfma_f32_32x32x16_bf16(pa3,PK(3),o[d0],0,0,0);
    #undef PK
  }
}

#ifndef ATTN_STORE16
#define ATTN_STORE16(p,v) (*(u32x4*)(p)=(v))
#endif
template<int THRL,bool NOMAX> __device__ __forceinline__ void attn_unit(int b,int h,int hk,int qb,const bf16*Q,const bf16*__restrict__ K,const bf16*__restrict__ V,bf16*O,char*shm){
  const int tid=opaque_tid(),lane=tid&63,r32=lane&31,hi=lane>>5; const int wid=__builtin_amdgcn_readfirstlane(tid>>6);
  const long rowbase=(long)b*SEQ; const int q0=qb*QB;
  const bf16*Qw=Q+(rowbase+q0+wid*QBLK)*DM+h*D;
  const bf16*Kh=K+rowbase*DM+hk*D,*Vh=V+rowbase*DM+hk*D;
  const unsigned lds0=(unsigned)(uintptr_t)shm;
  float*wsf=(float*)(shm+LDS_WS)+wid*64;
  const bf16*ksrc=Kh+(long)lane*DM+wid*8;
  const bf16*vsrc=Vh+(long)(16*(wid&3)+(lane>>2))*DM+(wid>>2)*32+(lane&3)*8;
  const unsigned kdst=lds0+LDS_K+wid*1024, vdst=lds0+LDS_V+wid*1024;
  #define DMA_K(t,slot) glds16(ksrc+(long)(t)*KVBLK*DM,(unsigned)__builtin_amdgcn_readfirstlane(kdst+(slot)))
  #define DMA_V(t,slot) glds16(vsrc+(long)(t)*KVBLK*DM,(unsigned)__builtin_amdgcn_readfirstlane(vdst+(slot)))
  const int vb0=(int)(lds0+LDS_V)+((lane>>4)&1)*32+(lane&3)*8+(4*hi+((lane&15)>>2))*64;
  const char*Kbase=shm+LDS_K; bf16x8 kf[8];
  const lds_cptr shm3=(lds_cptr)shm; const lds_cptr kp0=shm3+LDS_K+hi*1024+r32*16; const lds_cptr vp0=shm3+LDS_V+((lane>>4)&1)*32+(lane&3)*8+(4*hi+((lane&15)>>2))*64;
  constexpr int NT=NTILES;
  DMA_K(0,0);DMA_V(0,0);DMA_K(1,SLOTB);
  bf16x8 qr[4];
  #pragma unroll
  for(int d0=0;d0<4;++d0)qr[d0]=*reinterpret_cast<const bf16x8*>(&Qw[(long)r32*DM+d0*16+hi*8]);
  float mhat=0.f,l_reg=0.f;f32x16 o[2];o[0]=f32x16{};o[1]=f32x16{};f32x16 negm=f32x16{};asm volatile("":"+v"(negm));
  #define CMASK(P0,P1,t) do{}while(0)
  bool resc=false;
  #define START(P0,P1) do{ const float rm=rowmax(P0,P1); resc=false; \
    { const float dl=rm; mhat=fadd_s(mhat,dl); \
      _Pragma("unroll") for(int r=0;r<16;++r){P0[r]=fsub_s(P0[r],dl);P1[r]=fsub_s(P1[r],dl);} \
      _Pragma("unroll") for(int r=0;r<16;++r)negm[r]=-mhat; asm volatile("":"+v"(negm)); } \
    _Pragma("unroll") for(int r=0;r<16;++r)P0[r]=__builtin_amdgcn_exp2f(P0[r]); }while(0)
  #define RESC() do{ if(resc){ asm volatile("s_waitcnt lgkmcnt(0)":::"memory"); \
      _Pragma("unroll") for(int d_=0;d_<2;++d_) _Pragma("unroll") for(int r=0;r<16;++r)o[d_][r]*=wsf[crow(r,hi)]; } }while(0)
  f32x16 pA0,pA1,pB0,pB1;
  int sl_prev=0,sl_cur=0,sl_next=SLOTB;
  #define ROT() do{sl_prev=sl_cur;sl_cur=sl_next;sl_next=(sl_next==(NSLOT-1)*SLOTB)?0:sl_next+SLOTB;}while(0)
  DMA_K(2,2*SLOTB);
  WAIT_BAR(3);
  qkt(pA0,pA1,Kbase,qr,negm,r32,hi);asm volatile("s_nop 15\n\ts_nop 7":"+v"(pA0),"+v"(pA1));CMASK(pA0,pA1,0);
  START(pA0,pA1);
  _Pragma("unroll") for(int r=0;r<16;++r)pA1[r]=__builtin_amdgcn_exp2f(pA1[r]);
  WAIT_BAR(0);
  DMA_K(3,0);DMA_V(1,SLOTB);
  ROT();
  kload8(kf,kp0+sl_cur);
  WAIT_BAR(2);
  s16x4 vlo[8],vhi[8]; u32x4 pw0,pw1,pw2,pw3;
  #define PKW(P,B) cvtpk_s(P[B],P[B+1])
  #define PAF(k) __builtin_bit_cast(bf16x8,pw##k)
  #define VFR(i) (bf16x8){vlo[i][0],vlo[i][1],vlo[i][2],vlo[i][3],vhi[i][0],vhi[i][1],vhi[i][2],vhi[i][3]}
  #define PIN(x) asm volatile("":"+v"(x))
  #define MX3(a,b,c) __builtin_fmaxf(__builtin_fmaxf((a),(b)),(c))
  #define GAPA(MF,A0,A1,A2,A3,W0,W1,PW) do{ MF; sacc+=A0; sacc+=A1; sacc+=A2; sacc+=A3; PIN(sacc); W0; W1; PIN(PW); SBAR(); }while(0)
  #define EX(v) __builtin_amdgcn_exp2f(v)
  #define GAPB(MF,X,B) do{ MF; X[B]=EX(X[B]); X[B+1]=EX(X[B+1]); X[B+2]=EX(X[B+2]); X[B+3]=EX(X[B+3]); PIN(X); SBAR(); }while(0)
  #define VRD(i) do{ vlo[i]=vtr(vp_+(((i)>>2)*4096+((i)&3)*1024)); vhi[i]=vtr(vp_+(((i)>>2)*4096+((i)&3)*1024+512)); }while(0)
  #define KRD(G,j) do{ if(G){ kload2(kf,kp0+sl_next,j); SBAR(); } }while(0)
  #define STEP(C0,C1,P0,P1,t,GK,GV,GL) do{ SBAR(); \
    const lds_cptr vp_=vp0+sl_prev; \
    VRD(0); SBAR(); float sacc=(P0[0]+P0[1]); \
    GAPA(C0=__builtin_amdgcn_mfma_f32_32x32x16_bf16(kf[0],qr[0],negm,0,0,0), P0[2],P0[3],P0[4],P0[5],     pw0[0]=PKW(P0,0), pw0[1]=PKW(P0,2), pw0); \
    VRD(4); SBAR(); GAPA(C1=__builtin_amdgcn_mfma_f32_32x32x16_bf16(kf[1],qr[0],negm,0,0,0), P0[6],P0[7],P0[8],P0[9],     pw0[2]=PKW(P0,4), pw0[3]=PKW(P0,6), pw0); \
    VRD(1); SBAR(); GAPA(C0=__builtin_amdgcn_mfma_f32_32x32x16_bf16(kf[2],qr[1],C0,0,0,0),   P0[10],P0[11],P0[12],P0[13], pw1[0]=PKW(P0,8), pw1[1]=PKW(P0,10), pw1); \
    VRD(5); SBAR(); GAPA(C1=__builtin_amdgcn_mfma_f32_32x32x16_bf16(kf[3],qr[1],C1,0,0,0),   P0[14],P0[15],P1[0],P1[1],   pw1[2]=PKW(P0,12),pw1[3]=PKW(P0,14), pw1); \
    VRD(2); SBAR(); GAPA(C0=__builtin_amdgcn_mfma_f32_32x32x16_bf16(kf[4],qr[2],C0,0,0,0),   P1[2],P1[3],P1[4],P1[5],     pw2[0]=PKW(P1,0), pw2[1]=PKW(P1,2), pw2); \
    VRD(6); SBAR(); GAPA(C1=__builtin_amdgcn_mfma_f32_32x32x16_bf16(kf[5],qr[2],C1,0,0,0),   P1[6],P1[7],P1[8],P1[9],     pw2[2]=PKW(P1,4), pw2[3]=PKW(P1,6), pw2); \
    VRD(3); SBAR(); GAPA(C0=__builtin_amdgcn_mfma_f32_32x32x16_bf16(kf[6],qr[3],C0,0,0,0),   P1[10],P1[11],P1[12],P1[13], pw3[0]=PKW(P1,8), pw3[1]=PKW(P1,10), pw3); \
    VRD(7); SBAR(); GAPA(C1=__builtin_amdgcn_mfma_f32_32x32x16_bf16(kf[7],qr[3],C1,0,0,0),   P1[14],P1[15],0.f,0.f,       pw3[2]=PKW(P1,12),pw3[3]=PKW(P1,14), pw3); \
    l_reg+=sacc; \
    if(GK){DMA_K((t)+3,sl_cur);} if(GV){DMA_V((t)+1,sl_next);} \
    CMASK(C0,C1,t); \
    if constexpr(!NOMAX){ float a=MX3(C0[0],C0[1],C1[0]),b=MX3(C0[2],C0[3],C1[1]); a=MX3(a,C1[2],C1[3]); \
      _Pragma("unroll") for(int r=4;r<16;r+=4){a=MX3(a,C0[r],C0[r+1]);b=MX3(b,C0[r+2],C0[r+3]);a=MX3(a,C1[r],C1[r+1]);b=MX3(b,C1[r+2],C1[r+3]);} \
      float rm=__builtin_fmaxf(a,b); { auto rr=__builtin_amdgcn_permlane32_swap(__float_as_uint(rm),__float_as_uint(rm),false,false); rm=__builtin_fmaxf(__uint_as_float(rr[0]),__uint_as_float(rr[1])); } \
      resc=false; \
      if(__builtin_expect(__any(rm>(float)THRL),0)){ const float dl=__builtin_fmaxf(rm,0.f); mhat+=dl; \
        _Pragma("unroll") for(int r=0;r<16;++r){C0[r]-=dl;C1[r]-=dl;} \
        _Pragma("unroll") for(int r=0;r<16;++r)negm[r]=-mhat; asm volatile("":"+v"(negm)); \
        const float f=__builtin_amdgcn_exp2f(-dl); l_reg*=f; if(hi==0)wsf[r32]=f; resc=true; } } \
    SBAR(); \
    GAPB(o[0]=__builtin_amdgcn_mfma_f32_32x32x16_bf16(PAF(0),VFR(0),o[0],0,0,0), C0,0); \
    GAPB(o[1]=__builtin_amdgcn_mfma_f32_32x32x16_bf16(PAF(0),VFR(4),o[1],0,0,0), C0,4); \
    KRD(GL,0); GAPB(o[0]=__builtin_amdgcn_mfma_f32_32x32x16_bf16(PAF(1),VFR(1),o[0],0,0,0), C0,8); \
    KRD(GL,1); GAPB(o[1]=__builtin_amdgcn_mfma_f32_32x32x16_bf16(PAF(1),VFR(5),o[1],0,0,0), C0,12); \
    KRD(GL,2); GAPB(o[0]=__builtin_amdgcn_mfma_f32_32x32x16_bf16(PAF(2),VFR(2),o[0],0,0,0), C1,0); \
    KRD(GL,3); GAPB(o[1]=__builtin_amdgcn_mfma_f32_32x32x16_bf16(PAF(2),VFR(6),o[1],0,0,0), C1,4); \
    GAPB(o[0]=__builtin_amdgcn_mfma_f32_32x32x16_bf16(PAF(3),VFR(3),o[0],0,0,0), C1,8); \
    GAPB(o[1]=__builtin_amdgcn_mfma_f32_32x32x16_bf16(PAF(3),VFR(7),o[1],0,0,0), C1,12); \
    }while(0)
  int t=1;
  #undef CMASK
  #define CMASK(P0,P1,t) do{}while(0)
  for(;t+5<NT;t+=2){
    STEP(pB0,pB1,pA0,pA1,t,true,true,true);     WAIT_BAR(2); RESC(); ROT();
    STEP(pA0,pA1,pB0,pB1,t+1,true,true,true);   WAIT_BAR(2); RESC(); ROT();
  }
  #undef CMASK
  #define CMASK(P0,P1,t) do{}while(0)
  #define ENDW(tt) do{ if((tt)+3<NT){WAIT_BAR(2);} else if((tt)+2<NT){WAIT_BAR(1);} else {WAIT_BAR(0);} }while(0)
  for(;t+1<NT;t+=2){
    STEP(pB0,pB1,pA0,pA1,t,(t+3<NT),(t+1<NT),(t+1<NT));       ENDW(t);   RESC(); ROT();
    STEP(pA0,pA1,pB0,pB1,t+1,(t+4<NT),(t+2<NT),(t+2<NT));     ENDW(t+1); RESC(); ROT();
  }
  STEP(pB0,pB1,pA0,pA1,NT-1,false,false,false); RESC();
  { float sacc=pB0[0]+pB0[1]; _Pragma("unroll") for(int r=2;r<16;++r)sacc+=pB0[r]; _Pragma("unroll") for(int r=0;r<16;++r)sacc+=pB1[r]; l_reg+=sacc;
    pw0=(u32x4){PKW(pB0,0),PKW(pB0,2),PKW(pB0,4),PKW(pB0,6)};pw1=(u32x4){PKW(pB0,8),PKW(pB0,10),PKW(pB0,12),PKW(pB0,14)};pw2=(u32x4){PKW(pB1,0),PKW(pB1,2),PKW(pB1,4),PKW(pB1,6)};pw3=(u32x4){PKW(pB1,8),PKW(pB1,10),PKW(pB1,12),PKW(pB1,14)};
    SBAR(); pv(o,vb0+sl_cur,PAF(0),PAF(1),PAF(2),PAF(3)); }
  #undef PKW
  #undef PAF
  #undef VFR
  #undef PIN
  #undef MX3
  #undef GAPA
  #undef GAPB
  #undef EX
  #undef VRD
  #undef KRD
  #undef STEP
  #undef ENDW
  {auto rr=__builtin_amdgcn_permlane32_swap(__float_as_uint(l_reg),__float_as_uint(l_reg),false,false);l_reg=__uint_as_float(rr[0])+__uint_as_float(rr[1]);}
  if(hi==0)wsf[32+r32]=l_reg;asm volatile("s_waitcnt lgkmcnt(0)":::"memory");
  float rli[16];
  #pragma unroll
  for(int r=0;r<16;++r)rli[r]=__builtin_amdgcn_rcpf(wsf[32+crow(r,hi)]);
  bf16*Ow=O+(rowbase+q0+wid*QBLK)*DM+h*D;
  { bf16*stg=(bf16*)(shm+LDS_OST)+wid*2048;
    #pragma unroll
    for(int r=0;r<16;++r){const int orow=crow(r,hi);
      #pragma unroll
      for(int d0=0;d0<2;++d0)stg[orow*64+d0*32+r32]=__float2bfloat16(o[d0][r]*rli[r]);}
    asm volatile("s_waitcnt lgkmcnt(0)":::"memory");
    #pragma unroll
    for(int i=0;i<4;++i){const int row=i*8+(lane>>3),ch=lane&7; const u32x4 v=*(const u32x4*)(stg+row*64+ch*8); ATTN_STORE16(Ow+(long)row*DM+ch*8,v);} }
  asm volatile("s_waitcnt lgkmcnt(0)\n\ts_barrier":::"memory");
  #undef DMA_K
  #undef DMA_V
  #undef CMASK
  #undef START
  #undef RESC
  #undef ROT
}
constexpr int ATTN_LDS_BYTES=LDS_BYTES;
#undef SBAR
#undef WAIT_BAR
}
#include <hip/hip_cooperative_groups.h>
namespace cg = cooperative_groups;
#define LAS __attribute__((address_space(3)))
typedef unsigned short bf16;
typedef unsigned v4u __attribute__((ext_vector_type(4)));
typedef unsigned v2u __attribute__((ext_vector_type(2)));
typedef float f32x4 __attribute__((ext_vector_type(4)));
typedef short bf16x8 __attribute__((ext_vector_type(8)));

#define XB_TMO      128
#define XB_XCNT(j)  (256  + 64 * (j))
#define XB_XSUB(j)  (1280 + 64 * (j))
#define XB_XGEN(j)  (2304 + 64 * (j))
#define XB_TOP      3328
#define XB_TOPGEN   3392
#define XCD_BAR_WORDS 3456
#define XB_SPIN_CAP (1u << 18)

__device__ __forceinline__ unsigned xb_ld(unsigned* p)              { return __hip_atomic_load(p, __ATOMIC_RELAXED, __HIP_MEMORY_SCOPE_AGENT); }
__device__ __forceinline__ unsigned xb_add(unsigned* p, unsigned v) { return __hip_atomic_fetch_add(p, v, __ATOMIC_RELAXED, __HIP_MEMORY_SCOPE_AGENT); }
__device__ __forceinline__ unsigned xb_xcc_id() { return (unsigned)__builtin_amdgcn_s_getreg((3 << 11) | 20) & 0xFu; }
#define XB_SPIN(cond, bar) do { unsigned _sp = 0; while (cond) { __builtin_amdgcn_s_sleep(1); \
    if ((++_sp & 255u) == 0u) { if (xb_ld(&(bar)[XB_TMO])) break; if (_sp > XB_SPIN_CAP) { atomicAdd(&(bar)[XB_TMO], 1u); break; } } } } while (0)

struct XcdBarrier {
    unsigned* bar; unsigned x;
    volatile LAS unsigned* st;
};

__device__ __forceinline__ XcdBarrier xcd_barrier_post(unsigned* bar, volatile LAS unsigned* st) {
    XcdBarrier b; b.bar = bar; b.x = xb_xcc_id(); b.st = st;
    if (threadIdx.x == 0) (void)xb_add(&bar[XB_XCNT(b.x)], 1u);
    return b;
}
__device__ __forceinline__ void xcd_barrier_complete(unsigned* bar, unsigned x, unsigned& nloc, unsigned& nx) {
    const unsigned G = gridDim.x * gridDim.y * gridDim.z;
    unsigned sum, cnt, mine, sp = 0u;
    for (;;) {
        sum = 0u; cnt = 0u; mine = 0u;
#pragma unroll
        for (unsigned j = 0; j < 16; ++j) { const unsigned c = xb_ld(&bar[XB_XCNT(j)]); sum += c; cnt += (c > 0u) ? 1u : 0u; mine = (j == x) ? c : mine; }
        if (sum == G) break;
        __builtin_amdgcn_s_sleep(1);
        if ((++sp & 255u) == 0u) { if (xb_ld(&bar[XB_TMO])) break; if (sp > XB_SPIN_CAP) { atomicAdd(&bar[XB_TMO], 1u); break; } }
    }
    nloc = mine > 0u ? mine : 1u; nx = cnt > 0u ? cnt : 1u;
}

__device__ __forceinline__ void xcd_barrier(const XcdBarrier& b) {
    asm volatile("s_waitcnt vmcnt(0)" ::: "memory");
    __syncthreads();
    if (threadIdx.x == 0) {
        unsigned* bar = b.bar;
        __builtin_amdgcn_s_waitcnt(0);
        unsigned nloc = b.st[0], nx = b.st[1];
        if (nloc == 0u) { xcd_barrier_complete(bar, b.x, nloc, nx); b.st[0] = nloc; b.st[1] = nx; }
        const unsigned old = xb_add(&bar[XB_XSUB(b.x)], 1u);
        const unsigned gen = old / nloc;
        if (old + 1u == (gen + 1u) * nloc) {
            __builtin_amdgcn_fence(__ATOMIC_RELEASE, "agent");
            asm volatile("s_waitcnt vmcnt(0)" ::: "memory");
            const unsigned og = xb_add(&bar[XB_TOP], 1u);
            const unsigned tg = og / nx;
            if (og + 1u == (tg + 1u) * nx) xb_add(&bar[XB_TOPGEN], 1u);
            else XB_SPIN(xb_ld(&bar[XB_TOPGEN]) == tg, bar);
            __builtin_amdgcn_fence(__ATOMIC_ACQUIRE, "agent");
            xb_add(&bar[XB_XGEN(b.x)], 1u);
            asm volatile("s_waitcnt vmcnt(0)" ::: "memory");
        } else {
            XB_SPIN(xb_ld(&bar[XB_XGEN(b.x)]) == gen, bar);
            __builtin_amdgcn_fence(__ATOMIC_ACQUIRE, "agent");
            asm volatile("s_waitcnt vmcnt(0)" ::: "memory");
        }
    }
    __syncthreads();
}

constexpr int NB = 8, TL = 8192, TC = 256, TB = TL + TC  , MR = NB * TB  , DM = 1024, DFF = 2816, PW = 4608, NMOD = 9216;
constexpr float EPS = 1e-6f;
constexpr int LDS_BYTES = 147456, NTHR = 512, NWAVES = 8;
constexpr int PC_Q = 0, PC_K = 512, PC_V = 640, PC_GQ = 768, PC_GK = 1024, PC_GV = 1280, PC_G6 = 1792, PC_GATE = 2304, PC_LOW = 4352;
constexpr int GLA_S = 132, GLA_ITEMS = 64 * GLA_S;
constexpr size_t MiB = 1u << 20;
constexpr size_t WS_SSQ1 = 5 * MiB, WS_SSQ2 = 5 * MiB + 512 * 1024, WS_SW1 = 6 * MiB, WS_SW2 = 6 * MiB + 512 * 1024;
constexpr size_t WS_MOD = 1 * MiB, WS_DN = 2 * MiB, WS_WUP1 = 8 * MiB, WS_WUP2 = 20 * MiB, WS_WDN1 = 32 * MiB, WS_WDN2 = 38 * MiB, WS_WIN = 44 * MiB, WS_WBR0 = 54 * MiB, WS_WBR1 = 55 * MiB, WS_WOUT = 56 * MiB,
                 WS_HCTX = 64 * MiB, WS_XN = 72 * MiB, WS_OF = 204 * MiB, WS_OB = 270 * MiB, WS_A = 336 * MiB, WS_END = 932 * MiB;
static_assert(WS_XN + (size_t)MR * DM * 2 <= WS_OF && WS_OF + (size_t)MR * 512 * 2 <= WS_OB && WS_OB + (size_t)MR * 512 * 2 <= WS_A && WS_A + (size_t)MR * PW * 2 <= WS_END, "ws map");
static_assert((size_t)GLA_ITEMS * 8192 * 2 <= (size_t)MR * DM * 2 && WS_DN + (size_t)GLA_ITEMS * 64 * 4 <= WS_WUP1, "gla ws");

__device__ __forceinline__ unsigned f2bf(float f) { unsigned u = __builtin_bit_cast(unsigned, f); return (u + 0x7fffu + ((u >> 16) & 1u)) >> 16; }
typedef float pk_f32x2 __attribute__((ext_vector_type(2))); typedef __bf16 pk_bf16x2 __attribute__((ext_vector_type(2)));
__device__ __forceinline__ unsigned pk2(float lo, float hi) { const pk_f32x2 v = {lo, hi}; return __builtin_bit_cast(unsigned, __builtin_convertvector(v, pk_bf16x2)); }
__device__ __forceinline__ float bf2f(unsigned short h) { return __uint_as_float(((unsigned)h) << 16); }
__device__ __forceinline__ float wave_sum(float v) {
#pragma unroll
    for (int o = 1; o < 64; o <<= 1) v += __shfl_xor(v, o);
    return v;
}
__device__ __forceinline__ float silu_f(float v) { return v / (1.f + __expf(-v)); }

__device__ __forceinline__ void transpose_item(const float* W, int K, int N, bf16* WT, int k0, int n0, int drow0, LAS float* scr, int lane) {
#pragma unroll 8
    for (int i = 0; i < 32; ++i) { const int kk = 2 * i + (lane >> 5); scr[kk * 33 + (lane & 31)] = W[(size_t)(k0 + kk) * N + n0 + (lane & 31)]; }
    asm volatile("s_waitcnt lgkmcnt(0)" ::: "memory");
    const int c = lane & 7;
#pragma unroll
    for (int j = 0; j < 4; ++j) { const int n = (lane >> 3) + 8 * j; const LAS float* s = scr + (8 * c) * 33 + n;
        v4u o; o.x = pk2(s[0 * 33], s[1 * 33]); o.y = pk2(s[2 * 33], s[3 * 33]); o.z = pk2(s[4 * 33], s[5 * 33]); o.w = pk2(s[6 * 33], s[7 * 33]);
        *(v4u*)(WT + (size_t)(drow0 + n) * K + k0 + 8 * c) = o; }
    asm volatile("s_waitcnt lgkmcnt(0)" ::: "memory");
}
__device__ __forceinline__ int up_dest(int n0) { return n0 < DFF ? 256 * (n0 / 128) + (n0 % 128) : 256 * ((n0 - DFF) / 128) + 128 + ((n0 - DFF) % 128); }
__device__ __forceinline__ int win_dest(int n0) { return n0 < 2304 ? n0 : (n0 < 2336 ? n0 + 2048 : n0 - 32); }

__device__ __forceinline__ void norm_mod_rows(const float* lat, const float* ctxp, const float* mod, const float* g, int sub, bf16* XN, bool with_ctx, int gw, int NGW, int lane) {
    f32x4 gv[4];
#pragma unroll
    for (int j = 0; j < 4; ++j) gv[j] = *((const f32x4*)g + lane + 64 * j);
    for (int r0 = gw * 8; r0 < MR; r0 += NGW * 8) {
        const int b = r0 / TB, t = r0 % TB; const bool isctx = t >= TL;
        if (isctx && !with_ctx) continue;
        const float* src = isctx ? ctxp + (size_t)(b * TC + t - TL) * DM : lat + (size_t)(b * TL + t) * DM;
        const float* sh = mod + (size_t)(isctx ? 8 : b) * NMOD + (3 * sub) * DM; const float* sc = sh + DM;
        f32x4 v[8][4]; float s[8] = {0.f, 0.f, 0.f, 0.f, 0.f, 0.f, 0.f, 0.f}; f32x4 scv[4], shv[4];
#pragma unroll
        for (int u = 0; u < 8; ++u)
#pragma unroll
            for (int j = 0; j < 4; ++j) { v[u][j] = *((const f32x4*)(src + (size_t)u * DM) + lane + 64 * j); }
#pragma unroll
        for (int j = 0; j < 4; ++j) { scv[j] = *((const f32x4*)sc + lane + 64 * j) + 1.f; shv[j] = *((const f32x4*)sh + lane + 64 * j); }
#pragma unroll
        for (int u = 0; u < 8; ++u)
#pragma unroll
            for (int j = 0; j < 4; ++j) s[u] += (v[u][j].x * v[u][j].x + v[u][j].y * v[u][j].y) + (v[u][j].z * v[u][j].z + v[u][j].w * v[u][j].w);
#pragma unroll
        for (int u = 0; u < 8; ++u) {
            const float rstd = 1.f / sqrtf(wave_sum(s[u]) * (1.f / DM) + EPS);
            unsigned long long* o8 = (unsigned long long*)(XN + (size_t)(r0 + u) * DM) + lane;
#pragma unroll
            for (int j = 0; j < 4; ++j) {
                const f32x4 y = (v[u][j] * rstd * gv[j]) * scv[j] + shv[j];
                o8[64 * j] = (unsigned long long)pk2(y.x, y.y) | ((unsigned long long)pk2(y.z, y.w) << 32); } }
    }
}

constexpr int GS = 72, VS = 136;
constexpr int GL_QE = 0, GL_KE = 9216, GL_KL = 18432, GL_A = 27648, GL_V = 36864, GL_B = 54272, GL_BT = 71680, GL_SEG = 71936, BS = 68;
typedef short v4i16_t __attribute__((ext_vector_type(4)));
__device__ __forceinline__ bf16x8 tr_frag(const LAS bf16* base, int rs  , int col0, int ks, int q4, int qq, int p) {
    const LAS bf16* a0 = base + (32 * ks + 8 * q4 + qq) * rs + col0 + 4 * p;
    const v4i16_t t0 = __builtin_amdgcn_ds_read_tr16_b64_v4i16((LAS v4i16_t*)a0), t1 = __builtin_amdgcn_ds_read_tr16_b64_v4i16((LAS v4i16_t*)(a0 + 4 * rs));
    return (bf16x8){t0[0], t0[1], t0[2], t0[3], t1[0], t1[1], t1[2], t1[3]};
}
#define GLA_ROWOF(c) (rowbase + (dir ? 63 - (c) : (c)))
template <int PASS> __device__ __forceinline__ void gla_pass(LAS unsigned char* lds, const bf16* P, const float* w_decay, const float* b_decay, bf16* Ubuf, float* dn, bf16* OF, bf16* OB, int bx, int G, unsigned* ctr) {
    const int tid = opaque_tid(), lane = tid & 63, w = __builtin_amdgcn_readfirstlane(tid >> 6), l15 = lane & 15, q4 = lane >> 4, qq = (lane & 15) >> 2, p3 = lane & 3;
    constexpr int NV = PASS == 1 ? 64 * 131 : 64 * 128;
    LAS bf16* qeL = (LAS bf16*)(lds + GL_QE); LAS bf16* keL = (LAS bf16*)(lds + GL_KE); LAS bf16* klL = (LAS bf16*)(lds + GL_KL); LAS bf16* AL = (LAS bf16*)(lds + GL_A); LAS bf16* vL = (LAS bf16*)(lds + GL_V);
    LAS float* bL = (LAS float*)(lds + GL_B); LAS float* btL = (LAS float*)(lds + GL_BT); LAS float* segT = (LAS float*)(lds + GL_SEG);
    const int c = tid >> 3, ch = tid & 7, dt = w & 3, half = w >> 2;
    v4u vraw[2], kraw, qraw, lowf[2]; float wdr[8]; float bdr = 0.f; bf16x8 xsn[2];
    vraw[0] = vraw[1] = kraw = qraw = lowf[0] = lowf[1] = (v4u){0u, 0u, 0u, 0u}; xsn[0] = xsn[1] = (bf16x8){0, 0, 0, 0, 0, 0, 0, 0};
#pragma unroll
    for (int j = 0; j < 8; ++j) wdr[j] = 0.f;
#define GLA_DEC(idx_) const int chain = PASS == 1 ? (idx_) / 131 : (idx_) >> 7, s = PASS == 1 ? (idx_) % 131 : 4 + ((idx_) & 127), dir = chain & 1, h = (chain >> 1) & 3, b = chain >> 3; \
    const int rowbase = b * TB + (s < 4 ? TL + (dir ? 3 - s : s) * 64 : (dir ? 127 - (s - 4) : s - 4) * 64); const int item = chain * GLA_S + s; (void)item
#define GLA_LOAD(idx_) do { GLA_DEC(idx_); \
        _Pragma("unroll") for (int i = 0; i < 2; ++i) { const int n = tid + 512 * i; vraw[i] = *(const v4u*)(P + (size_t)GLA_ROWOF(n >> 4) * PW + PC_GV + h * 128 + (n & 15) * 8); } \
        { const size_t ro = (size_t)GLA_ROWOF(c) * PW + h * 64 + ch * 8; kraw = *(const v4u*)(P + ro + PC_GK); if (PASS == 3) qraw = *(const v4u*)(P + ro + PC_GQ); } \
        _Pragma("unroll") for (int i = 0; i < 2; ++i) lowf[i] = *(const v4u*)(P + (size_t)GLA_ROWOF(16 * (2 * half + i) + l15) * PW + PC_LOW + dir * 16 + (q4 & 1) * 8); \
        _Pragma("unroll") for (int j = 0; j < 8; ++j) wdr[j] = w_decay[(dir * 16 + 8 * (q4 & 1) + j) * 256 + h * 64 + 16 * dt + l15]; \
        bdr = b_decay[dir * 256 + h * 64 + 16 * dt + l15]; \
        if (PASS == 3) { _Pragma("unroll") for (int ks = 0; ks < 2; ++ks) xsn[ks] = *(const bf16x8*)(Ubuf + (size_t)item * 8192 + (16 * w + l15) * 64 + 8 * q4 + 32 * ks); } } while (0)
    volatile LAS unsigned* nxtL = (volatile LAS unsigned*)(lds + GL_SEG + 1024);
    int idx = bx;
    if (ctr) { if (tid == 0) nxtL[0] = __hip_atomic_fetch_add(ctr, 1u, __ATOMIC_RELAXED, __HIP_MEMORY_SCOPE_AGENT); __syncthreads(); idx = (int)nxtL[0]; __syncthreads(); }
    if (idx < NV) GLA_LOAD(idx);
    for (; idx < NV;) {
        int nidx = idx + G;
        if (ctr && tid == 0) nxtL[0] = __hip_atomic_fetch_add(ctr, 1u, __ATOMIC_RELAXED, __HIP_MEMORY_SCOPE_AGENT);
        GLA_DEC(idx);
#pragma unroll
        for (int i = 0; i < 2; ++i) { const int n = tid + 512 * i; *(LAS v4u*)(vL + (n >> 4) * VS + (n & 15) * 8) = vraw[i]; }
        float kf[8], qf[8];
        kf[0] = pg8::bflo(kraw.x); kf[1] = pg8::bfhi(kraw.x); kf[2] = pg8::bflo(kraw.y); kf[3] = pg8::bfhi(kraw.y); kf[4] = pg8::bflo(kraw.z); kf[5] = pg8::bfhi(kraw.z); kf[6] = pg8::bflo(kraw.w); kf[7] = pg8::bfhi(kraw.w);
        if (PASS == 3) { qf[0] = pg8::bflo(qraw.x); qf[1] = pg8::bfhi(qraw.x); qf[2] = pg8::bflo(qraw.y); qf[3] = pg8::bfhi(qraw.y); qf[4] = pg8::bflo(qraw.z); qf[5] = pg8::bfhi(qraw.z); qf[6] = pg8::bflo(qraw.w); qf[7] = pg8::bfhi(qraw.w); }
        float bv[2][4], tot[2];
        { bf16x8 yv;
#pragma unroll
          for (int j = 0; j < 8; ++j) { const unsigned hb = f2bf(wdr[j]); const unsigned lb = f2bf(wdr[j] - __uint_as_float(hb << 16)); yv[j] = (short)(q4 < 2 ? hb : lb); }
#pragma unroll
          for (int i = 0; i < 2; ++i) { f32x4 z = {0.f, 0.f, 0.f, 0.f}; z = __builtin_amdgcn_mfma_f32_16x16x32_bf16(__builtin_bit_cast(bf16x8, lowf[i]), yv, z, 0, 0, 0);
              float run = 0.f;
#pragma unroll
              for (int r = 0; r < 4; ++r) { const float zz = z[r] + bdr; run += (fminf(zz, 0.f) - __logf(1.f + __expf(-fabsf(zz)))) * (1.f / 16.f); bv[i][r] = run; }
              float sc = run; float t = __shfl_up(sc, 16); if (q4 >= 1) sc += t; t = __shfl_up(sc, 32); if (q4 >= 2) sc += t;
              const float excl = sc - run; tot[i] = __shfl(sc, 48 + l15);
#pragma unroll
              for (int r = 0; r < 4; ++r) bv[i][r] += excl + (i ? tot[0] : 0.f); }
          if (q4 == 0) segT[half * 64 + 16 * dt + l15] = tot[0] + tot[1]; }
        __syncthreads();
        { const float other = segT[(1 - half) * 64 + 16 * dt + l15]; const float add = half ? other : 0.f;
#pragma unroll
          for (int i = 0; i < 2; ++i)
#pragma unroll
              for (int r = 0; r < 4; ++r) bL[(16 * (2 * half + i) + 4 * q4 + r) * BS + 16 * dt + l15] = bv[i][r] + add;
          if (half == 0 && q4 == 0) btL[16 * dt + l15] = tot[0] + tot[1] + other; }
        __syncthreads();
        float bl[8], btot[8];
        { const f32x4 b0 = *(const LAS f32x4*)(bL + c * BS + 8 * ch), b1 = *(const LAS f32x4*)(bL + c * BS + 8 * ch + 4), t0 = *(const LAS f32x4*)(btL + 8 * ch), t1 = *(const LAS f32x4*)(btL + 8 * ch + 4);
          bl[0] = b0[0]; bl[1] = b0[1]; bl[2] = b0[2]; bl[3] = b0[3]; bl[4] = b1[0]; bl[5] = b1[1]; bl[6] = b1[2]; bl[7] = b1[3];
          btot[0] = t0[0]; btot[1] = t0[1]; btot[2] = t0[2]; btot[3] = t0[3]; btot[4] = t1[0]; btot[5] = t1[1]; btot[6] = t1[2]; btot[7] = t1[3]; }
        if (PASS == 1) {
            float kl[8];
#pragma unroll
            for (int k = 0; k < 8; ++k) kl[k] = kf[k] * __expf(btot[k] - bl[k]);
            v4u o; o.x = pk2(kl[0], kl[1]); o.y = pk2(kl[2], kl[3]); o.z = pk2(kl[4], kl[5]); o.w = pk2(kl[6], kl[7]);
            *(LAS v4u*)(klL + c * GS + 8 * ch) = o;
            if (tid < 8) { f32x4* dp = (f32x4*)(dn + (size_t)item * 64 + 8 * ch); dp[0] = (f32x4){__expf(btot[0]), __expf(btot[1]), __expf(btot[2]), __expf(btot[3])}; dp[1] = (f32x4){__expf(btot[4]), __expf(btot[5]), __expf(btot[6]), __expf(btot[7])}; }
        } else {
            float qe[8], ke[8];
#pragma unroll
            for (int k = 0; k < 8; ++k) { qe[k] = qf[k] * __expf(bl[k]) * 0.125f; ke[k] = kf[k] * __expf(-bl[k]); }
            v4u o; o.x = pk2(qe[0], qe[1]); o.y = pk2(qe[2], qe[3]); o.z = pk2(qe[4], qe[5]); o.w = pk2(qe[6], qe[7]);
            *(LAS v4u*)(qeL + c * GS + 8 * ch) = o;
            o.x = pk2(ke[0], ke[1]); o.y = pk2(ke[2], ke[3]); o.z = pk2(ke[4], ke[5]); o.w = pk2(ke[6], ke[7]);
            *(LAS v4u*)(keL + c * GS + 8 * ch) = o;
        }
        bf16x8 xs[2]; xs[0] = xsn[0]; xs[1] = xsn[1];
        if (ctr) nidx = (int)nxtL[0];
        if (nidx < NV) GLA_LOAD(nidx);
        __syncthreads();
        if (PASS == 1) {
            bf16x8 y[2];
#pragma unroll
            for (int ks = 0; ks < 2; ++ks) y[ks] = tr_frag(vL, VS, 16 * w, ks, q4, qq, p3);
#pragma unroll
            for (int dt = 0; dt < 4; ++dt) { f32x4 acc = {0.f, 0.f, 0.f, 0.f};
#pragma unroll
                for (int ks = 0; ks < 2; ++ks) { const bf16x8 x = tr_frag(klL, GS, 16 * dt, ks, q4, qq, p3); acc = __builtin_amdgcn_mfma_f32_16x16x32_bf16(x, y[ks], acc, 0, 0, 0); }
                v2u o; o.x = pk2(acc[0], acc[1]); o.y = pk2(acc[2], acc[3]);
                *(v2u*)(Ubuf + (size_t)item * 8192 + (16 * w + l15) * 64 + 16 * dt + 4 * q4) = o; }
        } else {
            { const int it = w >> 1;
#pragma unroll
              for (int jj = 0; jj < 2; ++jj) { const int jt = (w & 1) * 2 + jj; f32x4 acc = {0.f, 0.f, 0.f, 0.f};
                  if (jt <= it) {
#pragma unroll
                      for (int ks = 0; ks < 2; ++ks) { const bf16x8 x = *(const LAS bf16x8*)(keL + (16 * jt + l15) * GS + 8 * q4 + 32 * ks), y = *(const LAS bf16x8*)(qeL + (16 * it + l15) * GS + 8 * q4 + 32 * ks);
                          acc = __builtin_amdgcn_mfma_f32_16x16x32_bf16(x, y, acc, 0, 0, 0); }
                      const int i = 16 * it + l15, j0 = 16 * jt + 4 * q4;
#pragma unroll
                      for (int r = 0; r < 4; ++r) if (j0 + r > i) acc[r] = 0.f;
                  }
                  v2u o; o.x = pk2(acc[0], acc[1]); o.y = pk2(acc[2], acc[3]);
                  *(LAS v2u*)(AL + (16 * it + l15) * GS + 16 * jt + 4 * q4) = o; } }
            bf16x8 xv[2];
#pragma unroll
            for (int ks = 0; ks < 2; ++ks) xv[ks] = tr_frag(vL, VS, 16 * w, ks, q4, qq, p3);
            __syncthreads();
            bf16* Ob = dir ? OB : OF;
#pragma unroll
            for (int it = 0; it < 4; ++it) { f32x4 acc = {0.f, 0.f, 0.f, 0.f};
#pragma unroll
                for (int ks = 0; ks < 2; ++ks) { const bf16x8 y = *(const LAS bf16x8*)(AL + (16 * it + l15) * GS + 8 * q4 + 32 * ks); acc = __builtin_amdgcn_mfma_f32_16x16x32_bf16(xv[ks], y, acc, 0, 0, 0); }
#pragma unroll
                for (int ks = 0; ks < 2; ++ks) { const bf16x8 y = *(const LAS bf16x8*)(qeL + (16 * it + l15) * GS + 8 * q4 + 32 * ks); acc = __builtin_amdgcn_mfma_f32_16x16x32_bf16(xs[ks], y, acc, 0, 0, 0); }
                v2u o; o.x = pk2(acc[0], acc[1]); o.y = pk2(acc[2], acc[3]);
                *(v2u*)(Ob + (size_t)GLA_ROWOF(16 * it + l15) * 512 + h * 128 + 16 * w + 4 * q4) = o; }
        }
        __syncthreads();
        idx = nidx;
    }
#undef GLA_DEC
#undef GLA_LOAD
}

constexpr int GM_QEF = 0, GM_KEF = 9216, GM_QEB = 18432, GM_KEB = 27648, GM_A = 36864, GM_V = 46080, GM_BF = 63488, GM_BB = 80896, GM_SEG = 98304, GM_RED = 99328, GM_NXT = 101376;
__device__ __forceinline__ void gla_pass3m(LAS unsigned char* lds, const bf16* P, const float* w_decay, const float* b_decay, const float* g_gla, const bf16* Ubuf, bf16* OUT, unsigned* ctr) {
    const int tid = opaque_tid(), lane = tid & 63, w = __builtin_amdgcn_readfirstlane(tid >> 6), l15 = lane & 15, q4 = lane >> 4, qq = (lane & 15) >> 2, p3 = lane & 3;
    constexpr int NV = 8 * 4 * 128;
    LAS bf16* qeF = (LAS bf16*)(lds + GM_QEF); LAS bf16* keF = (LAS bf16*)(lds + GM_KEF); LAS bf16* qeB = (LAS bf16*)(lds + GM_QEB); LAS bf16* keB = (LAS bf16*)(lds + GM_KEB); LAS bf16* AL = (LAS bf16*)(lds + GM_A); LAS bf16* vL = (LAS bf16*)(lds + GM_V);
    LAS float* bF = (LAS float*)(lds + GM_BF); LAS float* bB = (LAS float*)(lds + GM_BB); LAS float* segT = (LAS float*)(lds + GM_SEG); LAS float* red = (LAS float*)(lds + GM_RED);
    volatile LAS unsigned* nxtL = (volatile LAS unsigned*)(lds + GM_NXT);
    const int c = tid >> 3, ch = tid & 7, dt = w & 3, half = w >> 2;
    v4u vraw[2], kraw, qraw, lowr[2][2]; float wdr[2][8]; float bdr[2]; bf16x8 xsn[2][2]; v2u g6r[4];
    float gg4[4];
#pragma unroll
    for (int r = 0; r < 4; ++r) gg4[r] = g_gla[16 * w + 4 * q4 + r];
#define GM_DEC(idx_) const int n_ = (idx_) & 127, h = ((idx_) >> 7) & 3, b = (idx_) >> 9; const int rowbase = b * TB + n_ * 64; \
    const size_t itemF = (size_t)((b * 4 + h) * 2 + 0) * GLA_S + 4 + n_, itemB = (size_t)((b * 4 + h) * 2 + 1) * GLA_S + 4 + (127 - n_); (void)itemF; (void)itemB
#define GM_LOAD(idx_) do { GM_DEC(idx_); \
        _Pragma("unroll") for (int i = 0; i < 2; ++i) { const int n = tid + 512 * i; vraw[i] = *(const v4u*)(P + (size_t)(rowbase + (n >> 4)) * PW + PC_GV + h * 128 + (n & 15) * 8); } \
        { const size_t ro = (size_t)(rowbase + c) * PW + h * 64 + ch * 8; kraw = *(const v4u*)(P + ro + PC_GK); qraw = *(const v4u*)(P + ro + PC_GQ); } \
        _Pragma("unroll") for (int dd = 0; dd < 2; ++dd) { \
            _Pragma("unroll") for (int i = 0; i < 2; ++i) lowr[dd][i] = *(const v4u*)(P + (size_t)(rowbase + 16 * (2 * half + i) + l15) * PW + PC_LOW + dd * 16 + (q4 & 1) * 8); \
            _Pragma("unroll") for (int j = 0; j < 8; ++j) wdr[dd][j] = w_decay[(dd * 16 + 8 * (q4 & 1) + j) * 256 + h * 64 + 16 * dt + l15]; \
            bdr[dd] = b_decay[dd * 256 + h * 64 + 16 * dt + l15]; \
            _Pragma("unroll") for (int ks = 0; ks < 2; ++ks) xsn[dd][ks] = *(const bf16x8*)(Ubuf + (dd ? itemB : itemF) * 8192 + (16 * w + l15) * 64 + 8 * q4 + 32 * ks); } \
        _Pragma("unroll") for (int it = 0; it < 4; ++it) g6r[it] = *(const v2u*)(P + (size_t)(rowbase + 16 * it + l15) * PW + PC_G6 + h * 128 + 16 * w + 4 * q4); } while (0)
    if (tid == 0) nxtL[0] = __hip_atomic_fetch_add(ctr, 1u, __ATOMIC_RELAXED, __HIP_MEMORY_SCOPE_AGENT);
    __syncthreads(); int idx = (int)nxtL[0]; __syncthreads();
    if (idx < NV) GM_LOAD(idx);
    for (; idx < NV;) {
        if (tid == 0) nxtL[0] = __hip_atomic_fetch_add(ctr, 1u, __ATOMIC_RELAXED, __HIP_MEMORY_SCOPE_AGENT);
        GM_DEC(idx);
#pragma unroll
        for (int i = 0; i < 2; ++i) { const int n = tid + 512 * i; *(LAS v4u*)(vL + (n >> 4) * VS + (n & 15) * 8) = vraw[i]; }
        float kf[8], qf[8];
        kf[0] = pg8::bflo(kraw.x); kf[1] = pg8::bfhi(kraw.x); kf[2] = pg8::bflo(kraw.y); kf[3] = pg8::bfhi(kraw.y); kf[4] = pg8::bflo(kraw.z); kf[5] = pg8::bfhi(kraw.z); kf[6] = pg8::bflo(kraw.w); kf[7] = pg8::bfhi(kraw.w);
        qf[0] = pg8::bflo(qraw.x); qf[1] = pg8::bfhi(qraw.x); qf[2] = pg8::bflo(qraw.y); qf[3] = pg8::bfhi(qraw.y); qf[4] = pg8::bflo(qraw.z); qf[5] = pg8::bfhi(qraw.z); qf[6] = pg8::bflo(qraw.w); qf[7] = pg8::bfhi(qraw.w);
        float bv[2][2][4], tot[2][2];
#pragma unroll
        for (int dd = 0; dd < 2; ++dd) { bf16x8 yv;
#pragma unroll
            for (int j = 0; j < 8; ++j) { const unsigned hb = f2bf(wdr[dd][j]); const unsigned lb = f2bf(wdr[dd][j] - __uint_as_float(hb << 16)); yv[j] = (short)(q4 < 2 ? hb : lb); }
#pragma unroll
            for (int ii = 0; ii < 2; ++ii) { const int i = dd ? 1 - ii : ii;
                f32x4 z = {0.f, 0.f, 0.f, 0.f}; z = __builtin_amdgcn_mfma_f32_16x16x32_bf16(__builtin_bit_cast(bf16x8, lowr[dd][i]), yv, z, 0, 0, 0);
                float g[4];
#pragma unroll
                for (int r = 0; r < 4; ++r) { const float zz = z[r] + bdr[dd]; g[r] = (fminf(zz, 0.f) - __logf(1.f + __expf(-fabsf(zz)))) * (1.f / 16.f); }
                float run = 0.f;
                if (dd == 0) {
#pragma unroll
                    for (int r = 0; r < 4; ++r) { run += g[r]; bv[dd][i][r] = run; }
                    float sc = run; float t = __shfl_up(sc, 16); if (q4 >= 1) sc += t; t = __shfl_up(sc, 32); if (q4 >= 2) sc += t;
                    const float excl = sc - run; tot[dd][i] = __shfl(sc, 48 + l15);
#pragma unroll
                    for (int r = 0; r < 4; ++r) bv[dd][i][r] += excl + (i ? tot[dd][0] : 0.f);
                } else {
#pragma unroll
                    for (int r = 3; r >= 0; --r) { run += g[r]; bv[dd][i][r] = run; }
                    float sc = run; float t = __shfl_down(sc, 16); if (q4 <= 2) sc += t; t = __shfl_down(sc, 32); if (q4 <= 1) sc += t;
                    const float excl = sc - run; tot[dd][i] = __shfl(sc, l15);
#pragma unroll
                    for (int r = 0; r < 4; ++r) bv[dd][i][r] += excl + (i ? 0.f : tot[dd][1]);
                } }
            if (q4 == 0) segT[(dd * 2 + half) * 64 + 16 * dt + l15] = tot[dd][0] + tot[dd][1]; }
        __syncthreads();
        { const float otherF = segT[(0 * 2 + (1 - half)) * 64 + 16 * dt + l15], otherB = segT[(1 * 2 + (1 - half)) * 64 + 16 * dt + l15];
          const float addF = half ? otherF : 0.f, addB = half ? 0.f : otherB;
#pragma unroll
          for (int i = 0; i < 2; ++i)
#pragma unroll
              for (int r = 0; r < 4; ++r) { const int tok = 16 * (2 * half + i) + 4 * q4 + r; bF[tok * BS + 16 * dt + l15] = bv[0][i][r] + addF; bB[tok * BS + 16 * dt + l15] = bv[1][i][r] + addB; } }
        __syncthreads();
        const int nidx = (int)nxtL[0];
        { const f32x4 f0 = *(const LAS f32x4*)(bF + c * BS + 8 * ch), f1 = *(const LAS f32x4*)(bF + c * BS + 8 * ch + 4), r0 = *(const LAS f32x4*)(bB + c * BS + 8 * ch), r1 = *(const LAS f32x4*)(bB + c * BS + 8 * ch + 4);
          const float bf_[8] = {f0[0], f0[1], f0[2], f0[3], f1[0], f1[1], f1[2], f1[3]}, bb_[8] = {r0[0], r0[1], r0[2], r0[3], r1[0], r1[1], r1[2], r1[3]};
          float a_[8], b_[8];
#pragma unroll
          for (int k = 0; k < 8; ++k) { a_[k] = qf[k] * __expf(bf_[k]) * 0.125f; b_[k] = kf[k] * __expf(-bf_[k]); }
          v4u o; o.x = pk2(a_[0], a_[1]); o.y = pk2(a_[2], a_[3]); o.z = pk2(a_[4], a_[5]); o.w = pk2(a_[6], a_[7]); *(LAS v4u*)(qeF + c * GS + 8 * ch) = o;
          o.x = pk2(b_[0], b_[1]); o.y = pk2(b_[2], b_[3]); o.z = pk2(b_[4], b_[5]); o.w = pk2(b_[6], b_[7]); *(LAS v4u*)(keF + c * GS + 8 * ch) = o;
#pragma unroll
          for (int k = 0; k < 8; ++k) { a_[k] = qf[k] * __expf(bb_[k]) * 0.125f; b_[k] = kf[k] * __expf(-bb_[k]); }
          o.x = pk2(a_[0], a_[1]); o.y = pk2(a_[2], a_[3]); o.z = pk2(a_[4], a_[5]); o.w = pk2(a_[6], a_[7]); *(LAS v4u*)(qeB + c * GS + 8 * ch) = o;
          o.x = pk2(b_[0], b_[1]); o.y = pk2(b_[2], b_[3]); o.z = pk2(b_[4], b_[5]); o.w = pk2(b_[6], b_[7]); *(LAS v4u*)(keB + c * GS + 8 * ch) = o; }
        bf16x8 xs[2][2]; v2u g6c[4];
#pragma unroll
        for (int dd = 0; dd < 2; ++dd) { xs[dd][0] = xsn[dd][0]; xs[dd][1] = xsn[dd][1]; }
#pragma unroll
        for (int it = 0; it < 4; ++it) g6c[it] = g6r[it];
        if (nidx < NV) GM_LOAD(nidx);
        __syncthreads();
        { const int it = w >> 1;
#pragma unroll
          for (int jj = 0; jj < 2; ++jj) { const int jt = (w & 1) * 2 + jj; f32x4 acc = {0.f, 0.f, 0.f, 0.f}; const int i = 16 * it + l15, j0 = 16 * jt + 4 * q4;
              if (jt <= it) { f32x4 af = {0.f, 0.f, 0.f, 0.f};
#pragma unroll
                  for (int ks = 0; ks < 2; ++ks) { const bf16x8 x = *(const LAS bf16x8*)(keF + (16 * jt + l15) * GS + 8 * q4 + 32 * ks), y = *(const LAS bf16x8*)(qeF + (16 * it + l15) * GS + 8 * q4 + 32 * ks);
                      af = __builtin_amdgcn_mfma_f32_16x16x32_bf16(x, y, af, 0, 0, 0); }
#pragma unroll
                  for (int r = 0; r < 4; ++r) acc[r] += (j0 + r <= i) ? af[r] : 0.f; }
              if (jt >= it) { f32x4 ab = {0.f, 0.f, 0.f, 0.f};
#pragma unroll
                  for (int ks = 0; ks < 2; ++ks) { const bf16x8 x = *(const LAS bf16x8*)(keB + (16 * jt + l15) * GS + 8 * q4 + 32 * ks), y = *(const LAS bf16x8*)(qeB + (16 * it + l15) * GS + 8 * q4 + 32 * ks);
                      ab = __builtin_amdgcn_mfma_f32_16x16x32_bf16(x, y, ab, 0, 0, 0); }
#pragma unroll
                  for (int r = 0; r < 4; ++r) acc[r] += (j0 + r >= i) ? ab[r] : 0.f; }
              v2u o; o.x = pk2(acc[0], acc[1]); o.y = pk2(acc[2], acc[3]);
              *(LAS v2u*)(AL + (16 * it + l15) * GS + 16 * jt + 4 * q4) = o; } }
        bf16x8 xv[2];
#pragma unroll
        for (int ks = 0; ks < 2; ++ks) xv[ks] = tr_frag(vL, VS, 16 * w, ks, q4, qq, p3);
        __syncthreads();
        f32x4 oacc[4]; float ssq[4];
#pragma unroll
        for (int it = 0; it < 4; ++it) { f32x4 acc = {0.f, 0.f, 0.f, 0.f};
#pragma unroll
            for (int ks = 0; ks < 2; ++ks) { const bf16x8 y = *(const LAS bf16x8*)(AL + (16 * it + l15) * GS + 8 * q4 + 32 * ks); acc = __builtin_amdgcn_mfma_f32_16x16x32_bf16(xv[ks], y, acc, 0, 0, 0); }
#pragma unroll
            for (int ks = 0; ks < 2; ++ks) { const bf16x8 y = *(const LAS bf16x8*)(qeF + (16 * it + l15) * GS + 8 * q4 + 32 * ks); acc = __builtin_amdgcn_mfma_f32_16x16x32_bf16(xs[0][ks], y, acc, 0, 0, 0); }
#pragma unroll
            for (int ks = 0; ks < 2; ++ks) { const bf16x8 y = *(const LAS bf16x8*)(qeB + (16 * it + l15) * GS + 8 * q4 + 32 * ks); acc = __builtin_amdgcn_mfma_f32_16x16x32_bf16(xs[1][ks], y, acc, 0, 0, 0); }
            oacc[it] = acc; float sq = (acc[0] * acc[0] + acc[1] * acc[1]) + (acc[2] * acc[2] + acc[3] * acc[3]);
            sq += __shfl_xor(sq, 16); sq += __shfl_xor(sq, 32); ssq[it] = sq;
            if (q4 == 0) red[w * 64 + 16 * it + l15] = sq; }
        __syncthreads();
#pragma unroll
        for (int it = 0; it < 4; ++it) { float tsum = 0.f;
#pragma unroll
            for (int w2 = 0; w2 < 8; ++w2) tsum += red[w2 * 64 + 16 * it + l15];
            const float rstd = 1.f / sqrtf(tsum * (1.f / 128.f) + EPS);
            const float gq_[4] = {pg8::bflo(g6c[it].x), pg8::bfhi(g6c[it].x), pg8::bflo(g6c[it].y), pg8::bfhi(g6c[it].y)};
            float y[4];
#pragma unroll
            for (int r = 0; r < 4; ++r) y[r] = oacc[it][r] * rstd * gg4[r] * silu_f(gq_[r]);
            v2u o; o.x = pk2(y[0], y[1]); o.y = pk2(y[2], y[3]);
            *(v2u*)(OUT + (size_t)(rowbase + 16 * it + l15) * 512 + h * 128 + 16 * w + 4 * q4) = o; }
        __syncthreads();
        idx = nidx;
    }
#undef GM_DEC
#undef GM_LOAD
}

struct Args { const float* in[19]; float* out; unsigned char* ws; };
__global__ void __launch_bounds__(NTHR, 2) mk_fwd(Args args) {
    extern __shared__ __attribute__((aligned(16))) unsigned char lds_raw[];
    cg::grid_group grid = cg::this_grid();
    LAS unsigned char* lds = (LAS unsigned char*)lds_raw;
    const int G = gridDim.x, bx = blockIdx.x, NGW = G * NWAVES;
    unsigned long long pacc = 0ull, pt0 = 0ull; (void)pt0;
#define PB(k) do { if ((PROBE_MASK >> (k)) & 1ull) pt0 = __builtin_amdgcn_s_memrealtime(); } while (0)
#define PE(k) do { if ((PROBE_MASK >> (k)) & 1ull) pacc += __builtin_amdgcn_s_memrealtime() - pt0; } while (0)
#define GSYNC() do { xcd_barrier(xbar); if (PROBE_SYNC) { const unsigned long long t_ = __builtin_amdgcn_s_memrealtime(); xcd_barrier(xbar); pacc += __builtin_amdgcn_s_memrealtime() - t_; } } while (0)
#define PH_IDS const int tid = opaque_tid(), lane = tid & 63, wave = __builtin_amdgcn_readfirstlane(tid >> 6), gw = bx * NWAVES + wave; (void)lane; (void)gw
    unsigned char* ws = args.ws;
    const float* x = args.in[0]; const float* cvec = args.in[1]; const float* ctx = args.in[2]; const float* c_ctx = args.in[3]; const float* w_mod = args.in[4]; const float* b_mod = args.in[5];
    const float* g_norm = args.in[6]; const float* w_up = args.in[7]; const float* w_down = args.in[8]; const float* w_in = args.in[9]; const float* g_q = args.in[10]; const float* g_k = args.in[11];
    const float* w_decay = args.in[12]; const float* b_decay = args.in[13]; const float* g_gla = args.in[14]; const float* w_branch = args.in[15]; const float* b_gate = args.in[16]; const float* w_out = args.in[17]; const float* g_final = args.in[18];
    float* H = args.out;
    float* HC = (float*)(ws + WS_HCTX);
    float* mod = (float*)(ws + WS_MOD); float* dn = (float*)(ws + WS_DN);
    bf16* Wup1 = (bf16*)(ws + WS_WUP1); bf16* Wup2 = (bf16*)(ws + WS_WUP2); bf16* Wdn1 = (bf16*)(ws + WS_WDN1); bf16* Wdn2 = (bf16*)(ws + WS_WDN2); bf16* Win = (bf16*)(ws + WS_WIN);
    bf16* Wbr0 = (bf16*)(ws + WS_WBR0); bf16* Wbr1 = (bf16*)(ws + WS_WBR1); bf16* Wout = (bf16*)(ws + WS_WOUT);
    bf16* XN = (bf16*)(ws + WS_XN); bf16* OF = (bf16*)(ws + WS_OF); bf16* OB = (bf16*)(ws + WS_OB); bf16* PA = (bf16*)(ws + WS_A);
    bf16* HID = PA; bf16* Ubuf = XN; bf16* Z = XN;
    float* ssq1 = (float*)(ws + WS_SSQ1); float* ssq2 = (float*)(ws + WS_SSQ2); float* sW1 = (float*)(ws + WS_SW1); float* sW2 = (float*)(ws + WS_SW2);
    bf16* XN2 = OF;

    volatile LAS unsigned* xst = (volatile LAS unsigned*)(lds + LDS_BYTES - 64);
    if (threadIdx.x < 2) xst[threadIdx.x] = 0u;
    unsigned* barw = (unsigned*)ws;
    if (bx == 0) for (int i = threadIdx.x; i < XCD_BAR_WORDS + 128; i += NTHR) __hip_atomic_store(barw + i, 0u, __ATOMIC_RELAXED, __HIP_MEMORY_SCOPE_AGENT);
    XcdBarrier xbar; xbar.bar = barw; xbar.x = 0; xbar.st = xst;
    PB(0);
    {
        PH_IDS;
        LAS float* sc = (LAS float*)lds; LAS float* red = sc + 9 * 1024;
        for (int idx = tid; idx < 9 * 1024; idx += NTHR) { const int j = idx >> 10, k = idx & 1023; const float v = j < 8 ? cvec[j * 1024 + k] : c_ctx[k]; sc[idx] = silu_f(v); }
        __syncthreads();
        for (int it = bx; it < NMOD / 32; it += G) {
            const int cc = tid & 31, ks = tid >> 5, col = it * 32 + cc;
            float a[9];
#pragma unroll
            for (int j = 0; j < 9; ++j) a[j] = 0.f;
#pragma unroll 4
            for (int kk = 0; kk < 64; ++kk) { const int k = ks * 64 + kk; const float wv = w_mod[(size_t)k * NMOD + col];
#pragma unroll
                for (int j = 0; j < 9; ++j) a[j] += sc[j * 1024 + k] * wv; }
#pragma unroll
            for (int j = 0; j < 9; ++j) red[(ks * 9 + j) * 32 + cc] = a[j];
            __syncthreads();
            if (tid < 288) { const int j = tid >> 5, c2 = tid & 31; float s = b_mod[it * 32 + c2];
#pragma unroll
                for (int k2 = 0; k2 < 16; ++k2) s += red[(k2 * 9 + j) * 32 + c2];
                mod[(size_t)j * NMOD + it * 32 + c2] = s; }
            __syncthreads();
        }
        LAS float* scr = (LAS float*)(lds + 65536) + wave * 2176;
        constexpr int I_UP = 16 * 176, I_DN = 44 * 32;
        for (int it = gw; it < I_UP + I_DN; it += NGW) {
            int r = it;
            if (r < I_UP) { const int kb = r / 176, nb = r % 176; transpose_item(w_up, 1024, 5632, Wup1, 64 * kb, 32 * nb, up_dest(32 * nb), scr, lane); continue; } r -= I_UP;
            { const int kb = r / 32, nb = r % 32; transpose_item(w_down, DFF, 1024, Wdn1, 64 * kb, 32 * nb, 32 * nb, scr, lane); }
        }
        for (int i = bx * NTHR + tid; i < 224 * 1024 / 8; i += G * NTHR) ((v4u*)(Win + (size_t)4384 * 1024))[i] = (v4u){0u, 0u, 0u, 0u};
        for (int i = bx * NTHR + tid; i < MR; i += G * NTHR) { ssq1[i] = 0.f; ssq2[i] = 0.f; }
    }
    grid.sync();
    xbar.x = xb_xcc_id(); if (threadIdx.x == 0) xst[2] = xb_add(&barw[XB_XCNT(xbar.x)], 1u);
    PE(0); PB(1);
    { PH_IDS; norm_mod_rows(x, ctx, mod, g_norm + 0 * DM, 0, XN, true, gw, NGW, lane);
    }
    GSYNC(); PE(1); PB(2);
    if (threadIdx.x == 0) { bool uni = (xbar.x < 8u) && ((G & 7) == 0);
        for (unsigned j = 0; j < 16; ++j) { const unsigned cnt_ = xb_ld(&barw[XB_XCNT(j)]); uni = uni && (cnt_ == (j < 8u ? (unsigned)(G >> 3) : 0u)); }
        xst[3] = uni ? (xst[2] * 8u + xbar.x) : (unsigned)bx; }
    __syncthreads();
    const int vb = (int)xst[3];
    { pg8::Gemm g{XN, Wup1, MR, 5632, 1024, 1024, 1024}; pg8::StaticOrder S; S.init(MR, 5632, G, vb);
      pg8::EpiSwiglu E{HID, DFF}; pg8::gemm_phase<pg8::EpiSwiglu, pg8::StaticOrder, true, true>(lds, g, S, E); }
    { PH_IDS;
      const int rem_ = (264 * 22) % G, ir_ = rem_ ? vb - rem_ : vb, ni_ = rem_ ? G - rem_ : G;
      if (ir_ >= 0) {
      LAS float* sc = (LAS float*)lds; LAS float* red = sc + 9 * 1024;
      for (int it = ir_; it < 144 + 176; it += ni_) {
          const bool second = it >= 144; const int n0 = (second ? it - 144 : it) * 32; const int sub = second ? 2 : 1;
          __syncthreads();
          for (int idx = tid; idx < 9 * 1024; idx += NTHR) sc[idx] = mod[(size_t)(idx >> 10) * NMOD + (3 * sub) * DM + (idx & 1023)];
          __syncthreads();
          const int cc = tid & 31, ks = tid >> 5, nd = n0 + cc; int nsrc; const float* Wp; int ldw;
          if (!second) { Wp = w_in; ldw = 4384; nsrc = nd < 2304 ? nd : (nd < 4352 ? nd + 32 : (nd < 4384 ? nd - 2048 : -1)); }
          else { Wp = w_up + (size_t)1024 * 5632; ldw = 5632; const int tile = nd >> 8, within = nd & 255; nsrc = within < 128 ? 128 * tile + within : DFF + 128 * tile + (within - 128); }
          float a[9];
#pragma unroll
          for (int j = 0; j < 9; ++j) a[j] = 0.f;
          if (nsrc >= 0) {
#pragma unroll 4
              for (int kk = 0; kk < 64; ++kk) { const int k = ks * 64 + kk; const float wv = Wp[(size_t)k * ldw + nsrc];
#pragma unroll
                  for (int j = 0; j < 9; ++j) a[j] += sc[j * 1024 + k] * wv; } }
#pragma unroll
          for (int j = 0; j < 9; ++j) red[(ks * 9 + j) * 32 + cc] = a[j];
          __syncthreads();
          if (tid < 288) { const int j = tid >> 5, c2 = tid & 31; float sum = 0.f;
#pragma unroll
              for (int k2 = 0; k2 < 16; ++k2) sum += red[(k2 * 9 + j) * 32 + c2];
              (second ? sW2 + (size_t)j * 5632 : sW1 + (size_t)j * PW)[n0 + c2] = sum; }
      }
      __syncthreads(); } }
    GSYNC(); PE(2); PB(3);
    { pg8::Gemm g{HID, Wdn1, MR, 1024, DFF, DFF, DFF}; pg8::StaticOrder S; S.init(MR, 1024, G, vb);
      pg8::EpiRes<1, 2, 1, 1> E{x, ctx, H, HC, mod, g_norm + 1 * DM, XN, ssq1}; pg8::gemm_phase<pg8::EpiRes<1, 2, 1, 1>, pg8::StaticOrder, true, true>(lds, g, S, E); }
    { PH_IDS;
      const int rem = (264 * 4) % G, ir = rem ? vb - rem : vb, ni = rem ? G - rem : G;
      if (ir >= 0) {
          LAS float* scr = (LAS float*)(lds + 65536) + wave * 2176;
          constexpr int I_UP = 16 * 176, I_DN = 44 * 32, I_IN = 16 * 137, I_BR = 8 * 32, I_OUT = 16 * 32;
          constexpr int NITEMS = I_UP + I_DN + I_IN + 2 * I_BR + I_OUT;
          for (int it = ir * NWAVES + wave; it < NITEMS; it += ni * NWAVES) {
              int r = it;
              if (r < I_UP) { const int kb = r / 176, nb = r % 176; transpose_item(w_up + (size_t)1024 * 5632, 1024, 5632, Wup2, 64 * kb, 32 * nb, up_dest(32 * nb), scr, lane); continue; } r -= I_UP;
              if (r < I_DN) { const int kb = r / 32, nb = r % 32; transpose_item(w_down + (size_t)DFF * 1024, DFF, 1024, Wdn2, 64 * kb, 32 * nb, 32 * nb, scr, lane); continue; } r -= I_DN;
              if (r < I_IN) { const int kb = r / 137, nb = r % 137; transpose_item(w_in, 1024, 4384, Win, 64 * kb, 32 * nb, win_dest(32 * nb), scr, lane); continue; } r -= I_IN;
              if (r < 2 * I_BR) { const int l = r / I_BR; r %= I_BR; const int kb = r / 32, nb = r % 32; transpose_item(w_branch + (size_t)l * 512 * 1024, 512, 1024, l ? Wbr1 : Wbr0, 64 * kb, 32 * nb, 32 * nb, scr, lane); continue; } r -= 2 * I_BR;
              { const int kb = r / 32, nb = r % 32; transpose_item(w_out, 1024, 1024, Wout, 64 * kb, 32 * nb, 32 * nb, scr, lane); }
          }
      } }
    GSYNC(); PE(3); PB(4);
#if MK_STAGE >= 2
    { pg8::Gemm g{XN, Win, MR, PW, 1024, 1024, 1024}; pg8::StaticOrder S; S.init(MR, PW, G, vb);
      pg8::EpiInproj E{PA, PW, ssq1, sW1, PW}; pg8::gemm_phase<pg8::EpiInproj, pg8::StaticOrder, true, true>(lds, g, S, E); }
    GSYNC(); PE(4); PB(5);
    { PH_IDS;
      const int l7 = lane & 7, l3 = lane & 3; const bool is_hi = (lane & 4) != 0;
      float frq[8], gq8[8], gk8[8];
#pragma unroll
      for (int k = 0; k < 8; ++k) { frq[k] = __builtin_amdgcn_exp2f(-(float)(8 * (l3 & 1) + k) * (13.287712379549449f / 16.f)); gq8[k] = g_q[8 * l7 + k] * attn_body::C2; gk8[k] = g_k[8 * l7 + k]; }
      for (int r0 = gw * 4; r0 < MR; r0 += NGW * 4) {
          const int t0 = r0 % TB; const bool isctx = t0 >= TL;
          v4u qv[4], kv[4];
#pragma unroll
          for (int u = 0; u < 4; ++u) { bf16* rp = PA + (size_t)(r0 + u) * PW; qv[u] = (v4u){0u, 0u, 0u, 0u}; if (!isctx) qv[u] = *(const v4u*)(rp + lane * 8); kv[u] = *(const v4u*)(rp + PC_K + (lane & 15) * 8); }
#pragma unroll
          for (int u = 0; u < 4; ++u) { bf16* rp = PA + (size_t)(r0 + u) * PW; const int t = t0 + u;
              const float pos = (l3 < 2) ? (float)(t >> 6) : (float)(t & 63);
              float cs8[8], sn8[8];
#pragma unroll
              for (int k = 0; k < 8; ++k) { const float ang = pos * frq[k]; cs8[k] = isctx ? 1.f : __cosf(ang); sn8[k] = isctx ? 0.f : __sinf(ang); }
#pragma unroll
              for (int part = 0; part < 2; ++part) { const v4u raw = part ? kv[u] : qv[u];
                  float xv[8]; xv[0] = pg8::bflo(raw.x); xv[1] = pg8::bfhi(raw.x); xv[2] = pg8::bflo(raw.y); xv[3] = pg8::bfhi(raw.y); xv[4] = pg8::bflo(raw.z); xv[5] = pg8::bfhi(raw.z); xv[6] = pg8::bflo(raw.w); xv[7] = pg8::bfhi(raw.w);
                  float ss = 0.f;
#pragma unroll
                  for (int k = 0; k < 8; ++k) ss += xv[k] * xv[k];
                  ss += __shfl_xor(ss, 1); ss += __shfl_xor(ss, 2); ss += __shfl_xor(ss, 4);
                  const float rstd = 1.f / sqrtf(ss * (1.f / 64.f) + EPS);
                  float o[8];
#pragma unroll
                  for (int k = 0; k < 8; ++k) { const float y = xv[k] * rstd * (part ? gk8[k] : gq8[k]); const float py = __shfl_xor(y, 4);
                      o[k] = is_hi ? (py * sn8[k] + y * cs8[k]) : (y * cs8[k] - py * sn8[k]); }
                  v4u w4; w4.x = pk2(o[0], o[1]); w4.y = pk2(o[2], o[3]); w4.z = pk2(o[4], o[5]); w4.w = pk2(o[6], o[7]);
                  if (part == 0) { if (!isctx) *(v4u*)(rp + lane * 8) = w4; } else { if (lane < 16) *(v4u*)(rp + PC_K + lane * 8) = w4; } } } } }
    gla_pass<1>(lds, PA, w_decay, b_decay, Ubuf, dn, OF, OB, vb, G, nullptr);
    GSYNC(); PE(5); PB(6);
    { PH_IDS; const int tg = bx * NTHR + tid;
      for (int q = tg; q < 64 * 2048; q += G * NTHR) { const int chain = q >> 11, e4 = q & 2047; const int d0 = (4 * e4) & 63;
          f32x4 S = {0.f, 0.f, 0.f, 0.f};
          for (int s0 = 0; s0 < GLA_S; s0 += 12) { v2u ur[12]; f32x4 dv[12];
#pragma unroll
              for (int j = 0; j < 12; ++j) { const size_t item = (size_t)chain * GLA_S + s0 + j; ur[j] = (v2u){0u, 0u}; dv[j] = (f32x4){0.f, 0.f, 0.f, 0.f};
                  if (s0 + j < GLA_S - 1) { ur[j] = *(const v2u*)(Ubuf + item * 8192 + 4 * e4); dv[j] = *(const f32x4*)(dn + item * 64 + d0); } }
#pragma unroll
              for (int j = 0; j < 12; ++j) { const size_t item = (size_t)chain * GLA_S + s0 + j;
                  v2u o; o.x = pk2(S[0], S[1]); o.y = pk2(S[2], S[3]); *(v2u*)(Ubuf + item * 8192 + 4 * e4) = o;
                  S[0] = dv[j][0] * S[0] + __uint_as_float(ur[j].x << 16); S[1] = dv[j][1] * S[1] + __uint_as_float(ur[j].x & 0xffff0000u);
                  S[2] = dv[j][2] * S[2] + __uint_as_float(ur[j].y << 16); S[3] = dv[j][3] * S[3] + __uint_as_float(ur[j].y & 0xffff0000u); } } } }
    GSYNC(); PE(6); PB(7);
    bool fastsm;
    { const int l_ = opaque_tid() & 63; float gqm = fabsf(g_q[l_]), gkm = fabsf(g_k[l_]);
#pragma unroll
      for (int o = 1; o < 64; o <<= 1) { gqm = fmaxf(gqm, __shfl_xor(gqm, o)); gkm = fmaxf(gkm, __shfl_xor(gkm, o)); }
      fastsm = __builtin_amdgcn_readfirstlane((2.f * 11.5416f * gqm * gkm + 14.f < 100.f) ? 1 : 0) != 0; }
    { const attn_body::bf16* Qp = (const attn_body::bf16*)(PA + PC_Q); const attn_body::bf16* Kp = (const attn_body::bf16*)(PA + PC_K); const attn_body::bf16* Vp = (const attn_body::bf16*)(PA + PC_V);
      if ((G & 7) == 0) { const int b = vb & 7, ci = vb >> 3, nper = G >> 3;
          for (int idx = ci; idx < 256; idx += nper) { const int h = idx >> 5, qb = idx & 31;
              if (fastsm) attn_body::attn_unit<8, true>(b, h, h >> 2, qb, Qp, Kp, Vp, (attn_body::bf16*)(PA + PC_Q), (char*)lds_raw);
              else attn_body::attn_unit<8, false>(b, h, h >> 2, qb, Qp, Kp, Vp, (attn_body::bf16*)(PA + PC_Q), (char*)lds_raw); } }
      else { for (int u = vb; u < 2048; u += G) { const int b = u >> 8, h = (u >> 5) & 7, qb = u & 31; attn_body::attn_unit<8, false>(b, h, h >> 2, qb, Qp, Kp, Vp, (attn_body::bf16*)(PA + PC_Q), (char*)lds_raw); } }
    }
    __syncthreads();
    PE(7); PB(21);
    gla_pass3m(lds, PA, w_decay, b_decay, g_gla, Ubuf, OF, barw + XCD_BAR_WORDS + 64);
    PE(21); PB(8);
    GSYNC(); PE(8); PB(9);
    { pg8::Gemm g{PA + PC_Q, Wbr0, MR, 1024, 512, PW, 512}; pg8::StaticOrder S; S.init(NB * TL, 1024, G, vb, 1);
      pg8::EpiGate<0> E{PA, b_gate, Z}; pg8::gemm_phase<pg8::EpiGate<0>, pg8::StaticOrder, true, true>(lds, g, S, E); }
    __syncthreads();
    { pg8::Gemm g{OF, Wbr1, MR, 1024, 512, 512, 512}; pg8::StaticOrder S; S.init(NB * TL, 1024, G, vb, 1);
      pg8::EpiGate<1> E{PA, b_gate, Z}; pg8::gemm_phase<pg8::EpiGate<1>, pg8::StaticOrder, true, true>(lds, g, S, E); }
    GSYNC(); PE(9); PB(10);
    { pg8::Gemm g{Z, Wout, MR, 1024, 1024, 1024, 1024}; pg8::StaticOrder S; S.init(NB * TL, 1024, G, vb, 1);
      pg8::EpiRes<1, 5, 0, 2> E{H, HC, H, HC, mod, g_norm + 2 * DM, XN2, ssq2}; pg8::gemm_phase<pg8::EpiRes<1, 5, 0, 2>, pg8::StaticOrder, true, true>(lds, g, S, E); }
    GSYNC(); PE(10); PB(11);
#endif
#if MK_STAGE >= 3
    { pg8::Gemm g{XN2, Wup2, MR, 5632, 1024, 1024, 1024}; pg8::StaticOrder S; S.init(NB * TL, 5632, G, vb, 1);
      pg8::EpiSwigluN E{HID, DFF, ssq2, sW2, 5632}; pg8::gemm_phase<pg8::EpiSwigluN, pg8::StaticOrder, true, true>(lds, g, S, E); }
    GSYNC(); PE(11); PB(12);
    { pg8::Gemm g{HID, Wdn2, MR, 1024, DFF, DFF, DFF}; pg8::StaticOrder S; S.init(NB * TL, 1024, G, vb, 1);
      pg8::EpiRes<0, 8, 1, 0> E{H, HC, H, HC, mod, nullptr, nullptr, nullptr}; pg8::gemm_phase<pg8::EpiRes<0, 8, 1, 0>, pg8::StaticOrder, true, true>(lds, g, S, E); }
    GSYNC(); PE(12); PB(13);
#endif
    { PH_IDS; f32x4 gv[4];
#pragma unroll
      for (int j = 0; j < 4; ++j) gv[j] = *((const f32x4*)g_final + lane + 64 * j);
      for (int r0 = gw * 4; r0 < NB * TL; r0 += NGW * 4) { f32x4* p = (f32x4*)(H + (size_t)r0 * DM) + lane; f32x4 v[4][4]; float s[4] = {0.f, 0.f, 0.f, 0.f};
#pragma unroll
          for (int u = 0; u < 4; ++u)
#pragma unroll
              for (int j = 0; j < 4; ++j) v[u][j] = p[u * 256 + 64 * j];
#pragma unroll
          for (int u = 0; u < 4; ++u)
#pragma unroll
              for (int j = 0; j < 4; ++j) s[u] += (v[u][j].x * v[u][j].x + v[u][j].y * v[u][j].y) + (v[u][j].z * v[u][j].z + v[u][j].w * v[u][j].w);
#pragma unroll
          for (int u = 0; u < 4; ++u) { const float rstd = 1.f / sqrtf(wave_sum(s[u]) * (1.f / DM) + EPS);
#pragma unroll
              for (int j = 0; j < 4; ++j) p[u * 256 + 64 * j] = v[u][j] * rstd * gv[j]; } } }
    PE(13);
    if (PROBE_MASK != 0ull || PROBE_SYNC) { const unsigned long long te = __builtin_amdgcn_s_memrealtime() + (unsigned long long)PROBE_MULT * pacc; while (__builtin_amdgcn_s_memrealtime() < te) __builtin_amdgcn_s_sleep(32); }
}

extern "C" void kernel_launch(void* const* d_in, const int* in_sizes, int n_in, void* d_out, int out_size, void* d_ws, size_t ws_size, hipStream_t stream) {
    static int grid = 0;
    if (grid == 0) {
        int dev = 0, cus = 0, per_cu = 0;
        hipGetDevice(&dev); hipDeviceGetAttribute(&cus, hipDeviceAttributeMultiprocessorCount, dev);
        hipFuncSetAttribute((const void*)mk_fwd, hipFuncAttributeMaxDynamicSharedMemorySize, LDS_BYTES);
        hipOccupancyMaxActiveBlocksPerMultiprocessor(&per_cu, (const void*)mk_fwd, NTHR, LDS_BYTES);
        if (per_cu < 1) per_cu = 1;
        grid = cus * per_cu;
        if (n_in != 19 || ws_size < WS_END) { fprintf(stderr, "kernel_launch: unexpected n_in %d or ws_size %zu\n", n_in, ws_size); }
    }
    Args a{};
    for (int i = 0; i < 19; ++i) a.in[i] = (const float*)d_in[i];
    a.out = (float*)d_out; a.ws = (unsigned char*)d_ws;
    void* kargs[] = {&a};
    hipError_t e = hipLaunchCooperativeKernel((const void*)mk_fwd, dim3(grid), dim3(NTHR), kargs, LDS_BYTES, stream);
    if (e != hipSuccess) fprintf(stderr, "cooperative launch failed: %s (grid %d)\n", hipGetErrorString(e), grid);
}
```

```cpp
#include <hip/hip_runtime.h>
#include <cstdio>
#include <cstdint>
#ifndef MK_STAGE
#define MK_STAGE 3
#endif
#define PROBE_MASK 0ull
#define PROBE_SYNC 0
#define PROBE_MULT 4
__device__ __forceinline__ int opaque_tid() { int t; asm volatile("v_mov_b32 %0, %1" : "=v"(t) : "v"((int)threadIdx.x)); return t; }
namespace pg8 {
#define PG8_LAS __attribute__((address_space(3)))
typedef unsigned short bf16_t;
typedef short bf16x8 __attribute__((ext_vector_type(8)));
typedef float f32x4 __attribute__((ext_vector_type(4)));
typedef unsigned u32x4 __attribute__((ext_vector_type(4)));
constexpr int BM = 256, BK = 64, HALF = 128, HTB = HALF * BK * 2  , STAGE_BYTES = 8 * HTB, NXCD = 8, WGM = 4;

__host__ __device__ __forceinline__ int lds_byte(int r, int c) { const int st = (r >> 4) * 2 + (c >> 5), rr = r & 15, cc = c & 31, ob = rr * 64 + cc * 2; return st * 1024 + (ob ^ (((ob >> 9) & 1) << 5)); }
__host__ __device__ __forceinline__ void stage_rc(int b, int& R, int& C) { const int st = b / 1024, sb = b % 1024, swz = sb ^ (((sb >> 9) & 1) << 5); R = (st >> 1) * 16 + swz / 64; C = (st & 1) * 32 + (swz % 64) / 2; }
__host__ __device__ __forceinline__ int perm32(int rho) { const int n = rho >> 4, i = rho & 15; return 8 * (i >> 2) + 4 * n + (i & 3); }

struct Unit { int pm, pn; };
struct Gemm { const bf16_t* A; const bf16_t* Bt; int M, N, K, lda, ldb; };

struct StaticOrder {
    int nM, nN, nwg, G, c, skip;
    __host__ __device__ void init(int M, int N, int G_, int c_, int skip_ = 0) { nM = M / BM; nN = N / BM; nwg = nM * nN; G = G_; c = c_; skip = skip_; }
    __host__ __device__ bool next(int i, Unit& u) const {
        const long L = (long)i * G + c; if (L >= nwg) return false;
        int wgid = (int)L; { const int q = nwg / NXCD, r = nwg % NXCD, xcd = wgid % NXCD, off = wgid / NXCD; wgid = (xcd < r ? xcd * (q + 1) : r * (q + 1) + (xcd - r) * q) + off; }
        const int nig = WGM * nN, gid = wgid / nig, fm = gid * WGM, gsz = (nM - fm) < WGM ? (nM - fm) : WGM;
        u.pm = fm + ((wgid % nig) % gsz); u.pn = (wgid % nig) / gsz; if (skip) u.pm += u.pm / 32; return true;
    }
    __device__ __forceinline__ void a_ready(const Unit&) const {}
    __device__ __forceinline__ void done(const Unit&) const {}
};

__device__ __forceinline__ unsigned cvt_pk_bf16(float lo, float hi) { unsigned r; asm volatile("v_cvt_pk_bf16_f32 %0, %1, %2" : "=v"(r) : "v"(lo), "v"(hi)); return r; }
__device__ __forceinline__ float fsigmoid(float x) { return __builtin_amdgcn_rcpf(1.f + __builtin_amdgcn_exp2f(-1.4426950408889634f * x)); }
__device__ __forceinline__ float bflo(unsigned w) { return __uint_as_float(w << 16); }
__device__ __forceinline__ float bfhi(unsigned w) { return __uint_as_float(w & 0xffff0000u); }
constexpr int TPB = 33;
constexpr int PWID = 4608;

struct EpiPlain {
    static constexpr bool PERM = true, AFTER_DRAIN = false;
    bf16_t* O; int ldc;
    __device__ __forceinline__ void operator()(const f32x4 (&acc)[2][2][4][2], const Unit& u, int wr, int wc, int fr, int fq) const {
        const int row0 = u.pm * BM + wr * 64 + fr, col0 = u.pn * BM + wc * 32 + 8 * fq;
#pragma unroll
        for (int ai = 0; ai < 2; ++ai)
#pragma unroll
            for (int m = 0; m < 4; ++m) { bf16_t* rowp = O + (size_t)(row0 + ai * HALF + m * 16) * ldc + col0;
#pragma unroll
                for (int bj = 0; bj < 2; ++bj) { const f32x4 v0 = acc[ai][bj][m][0], v1 = acc[ai][bj][m][1];
                    u32x4 w; w.x = cvt_pk_bf16(v0[0], v0[1]); w.y = cvt_pk_bf16(v0[2], v0[3]); w.z = cvt_pk_bf16(v1[0], v1[1]); w.w = cvt_pk_bf16(v1[2], v1[3]);
                    *(u32x4*)(rowp + bj * HALF) = w; } }
    }
};
struct EpiSwiglu {
    static constexpr bool PERM = true, AFTER_DRAIN = false;
    bf16_t* O; int ldc;
    __device__ __forceinline__ void operator()(const f32x4 (&acc)[2][2][4][2], const Unit& u, int wr, int wc, int fr, int fq) const {
        const int row0 = u.pm * BM + wr * 64 + fr, col0 = u.pn * HALF + wc * 32 + 8 * fq;
#pragma unroll
        for (int ai = 0; ai < 2; ++ai)
#pragma unroll
            for (int m = 0; m < 4; ++m) { bf16_t* rowp = O + (size_t)(row0 + ai * HALF + m * 16) * ldc + col0;
                float h[8];
#pragma unroll
                for (int n = 0; n < 2; ++n)
#pragma unroll
                    for (int k = 0; k < 4; ++k) { const float a = acc[ai][0][m][n][k], b = acc[ai][1][m][n][k]; h[n * 4 + k] = a * fsigmoid(a) * b; }
                u32x4 w; w.x = cvt_pk_bf16(h[0], h[1]); w.y = cvt_pk_bf16(h[2], h[3]); w.z = cvt_pk_bf16(h[4], h[5]); w.w = cvt_pk_bf16(h[6], h[7]);
                *(u32x4*)rowp = w; }
    }
};
template <int XNOUT, int GIDX, int HALFCOEF, int NSUB> struct EpiRes {
    static constexpr bool PERM = true, AFTER_DRAIN = false;
    const float* src_lat; const float* src_ctx; float* dst_lat; float* dst_ctx; const float* mod; const float* gnorm; bf16_t* xn; float* ssq;
    static constexpr int gidx = GIDX, nsub = NSUB; static constexpr float coef = HALFCOEF ? 0.5f : 1.0f;
    __device__ __forceinline__ void operator()(const f32x4 (&acc)[2][2][4][2], const Unit& u, int wr, int wc, int fr, int fq) const {
        asm volatile("" : "+v"(fr));
        const int b = u.pm / TPB, j = u.pm % TPB; const bool isctx = (j == TPB - 1);
        const float* src = isctx ? src_ctx + (size_t)b * 256 * 1024 : src_lat + (size_t)(b * 8192 + j * 256) * 1024;
        float* dst = isctx ? dst_ctx + (size_t)b * 256 * 1024 : dst_lat + (size_t)(b * 8192 + j * 256) * 1024;
        const float* mrow = mod + (size_t)(isctx ? 8 : b) * 9216;
        const float* g = mrow + gidx * 1024;
        const int col0 = u.pn * BM + wc * 32 + 8 * fq;
        f32x4 gv[2][2], gs[2][2];
#pragma unroll
        for (int bj = 0; bj < 2; ++bj)
#pragma unroll
            for (int n = 0; n < 2; ++n) { gv[bj][n] = *(const f32x4*)(g + col0 + bj * HALF + 4 * n) * coef;
                if (XNOUT) gs[bj][n] = *(const f32x4*)(gnorm + col0 + bj * HALF + 4 * n) * (*(const f32x4*)(mrow + (3 * nsub + 1) * 1024 + col0 + bj * HALF + 4 * n) + 1.f); }
#pragma unroll
        for (int ai = 0; ai < 2; ++ai)
#pragma unroll
            for (int m = 0; m < 4; ++m) { const int rl = ai * HALF + wr * 64 + m * 16 + fr; const size_t off = (size_t)rl * 1024 + col0; float sq = 0.f;
#pragma unroll
                for (int bj = 0; bj < 2; ++bj) { f32x4 o[2];
#pragma unroll
                    for (int n = 0; n < 2; ++n) { const f32x4 sv = *(const f32x4*)(src + off + bj * HALF + 4 * n); o[n] = sv + gv[bj][n] * acc[ai][bj][m][n];
                        if (!(XNOUT && isctx)) *(f32x4*)(dst + off + bj * HALF + 4 * n) = o[n]; }
                    if (XNOUT) { sq += (o[0][0] * o[0][0] + o[0][1] * o[0][1]) + (o[0][2] * o[0][2] + o[0][3] * o[0][3]) + (o[1][0] * o[1][0] + o[1][1] * o[1][1]) + (o[1][2] * o[1][2] + o[1][3] * o[1][3]);
                        const f32x4 x0 = o[0] * gs[bj][0], x1 = o[1] * gs[bj][1];
                        u32x4 w; w.x = cvt_pk_bf16(x0[0], x0[1]); w.y = cvt_pk_bf16(x0[2], x0[3]); w.z = cvt_pk_bf16(x1[0], x1[1]); w.w = cvt_pk_bf16(x1[2], x1[3]);
                        *(u32x4*)(xn + (size_t)(u.pm * BM + rl) * 1024 + col0 + bj * HALF) = w; } }
                if (XNOUT) { sq += __shfl_xor(sq, 16); sq += __shfl_xor(sq, 32); if (fq == 0) atomicAdd(ssq + u.pm * BM + rl, sq); }
                if (m & 1) asm volatile("" ::: "memory"); }
    }
};
struct EpiInproj {
    static constexpr bool PERM = true, AFTER_DRAIN = false;
    bf16_t* O; int ldc; const float* ssq; const float* sw; int swld;
    __device__ __forceinline__ void operator()(const f32x4 (&acc)[2][2][4][2], const Unit& u, int wr, int wc, int fr, int fq) const {
        const int row0 = u.pm * BM + wr * 64 + fr, col0 = u.pn * BM + wc * 32 + 8 * fq;
        const float* swr = sw + (size_t)((u.pm % TPB == TPB - 1) ? 8 : u.pm / TPB) * swld + col0;
        f32x4 sv[2][2];
#pragma unroll
        for (int bj = 0; bj < 2; ++bj)
#pragma unroll
            for (int n = 0; n < 2; ++n) sv[bj][n] = *(const f32x4*)(swr + bj * HALF + 4 * n);
#pragma unroll
        for (int ai = 0; ai < 2; ++ai)
#pragma unroll
            for (int m = 0; m < 4; ++m) { const int row = row0 + ai * HALF + m * 16; bf16_t* rowp = O + (size_t)row * ldc + col0;
                const float rstd = 1.f / sqrtf(ssq[row] * (1.f / 1024.f) + 1e-6f);
#pragma unroll
                for (int bj = 0; bj < 2; ++bj) { const f32x4 v0 = acc[ai][bj][m][0] * rstd + sv[bj][0], v1 = acc[ai][bj][m][1] * rstd + sv[bj][1];
                    u32x4 w; w.x = cvt_pk_bf16(v0[0], v0[1]); w.y = cvt_pk_bf16(v0[2], v0[3]); w.z = cvt_pk_bf16(v1[0], v1[1]); w.w = cvt_pk_bf16(v1[2], v1[3]);
                    *(u32x4*)(rowp + bj * HALF) = w; } }
    }
};
struct EpiSwigluN {
    static constexpr bool PERM = true, AFTER_DRAIN = false;
    bf16_t* O; int ldc; const float* ssq; const float* sw; int swld;
    __device__ __forceinline__ void operator()(const f32x4 (&acc)[2][2][4][2], const Unit& u, int wr, int wc, int fr, int fq) const {
        const int row0 = u.pm * BM + wr * 64 + fr, col0 = u.pn * HALF + wc * 32 + 8 * fq;
        const float* swr = sw + (size_t)((u.pm % TPB == TPB - 1) ? 8 : u.pm / TPB) * swld + u.pn * BM + wc * 32 + 8 * fq;
        f32x4 sv[2][2];
#pragma unroll
        for (int bj = 0; bj < 2; ++bj)
#pragma unroll
            for (int n = 0; n < 2; ++n) sv[bj][n] = *(const f32x4*)(swr + bj * HALF + 4 * n);
#pragma unroll
        for (int ai = 0; ai < 2; ++ai)
#pragma unroll
            for (int m = 0; m < 4; ++m) { const int row = row0 + ai * HALF + m * 16; bf16_t* rowp = O + (size_t)row * ldc + col0;
                const float rstd = 1.f / sqrtf(ssq[row] * (1.f / 1024.f) + 1e-6f);
                float h[8];
#pragma unroll
                for (int n = 0; n < 2; ++n)
#pragma unroll
                    for (int k = 0; k < 4; ++k) { const float a = acc[ai][0][m][n][k] * rstd + sv[0][n][k], b = acc[ai][1][m][n][k] * rstd + sv[1][n][k]; h[n * 4 + k] = a * fsigmoid(a) * b; }
                u32x4 w; w.x = cvt_pk_bf16(h[0], h[1]); w.y = cvt_pk_bf16(h[2], h[3]); w.z = cvt_pk_bf16(h[4], h[5]); w.w = cvt_pk_bf16(h[6], h[7]);
                *(u32x4*)rowp = w; }
    }
};
template <int SECOND> struct EpiGate {
    static constexpr bool PERM = true, AFTER_DRAIN = false;
    const bf16_t* P; const float* bgate; bf16_t* Z;
    __device__ __forceinline__ void operator()(const f32x4 (&acc)[2][2][4][2], const Unit& u, int wr, int wc, int fr, int fq) const {
        const int row0 = u.pm * BM + wr * 64 + fr, col0 = u.pn * BM + wc * 32 + 8 * fq;
        f32x4 bg[2][2];
#pragma unroll
        for (int bj = 0; bj < 2; ++bj)
#pragma unroll
            for (int n = 0; n < 2; ++n) bg[bj][n] = *(const f32x4*)(bgate + 1024 * SECOND + col0 + bj * HALF + 4 * n);
#pragma unroll
        for (int ai = 0; ai < 2; ++ai)
#pragma unroll
            for (int m = 0; m < 4; ++m) { const size_t row = (size_t)(row0 + ai * HALF + m * 16);
#pragma unroll
                for (int bj = 0; bj < 2; ++bj) { const int c = col0 + bj * HALF;
                    const u32x4 gr = *(const u32x4*)(P + row * PWID + 2304 + 1024 * SECOND + c);
                    float v[8];
                    v[0] = fsigmoid(bflo(gr.x) + bg[bj][0][0]) * acc[ai][bj][m][0][0]; v[1] = fsigmoid(bfhi(gr.x) + bg[bj][0][1]) * acc[ai][bj][m][0][1];
                    v[2] = fsigmoid(bflo(gr.y) + bg[bj][0][2]) * acc[ai][bj][m][0][2]; v[3] = fsigmoid(bfhi(gr.y) + bg[bj][0][3]) * acc[ai][bj][m][0][3];
                    v[4] = fsigmoid(bflo(gr.z) + bg[bj][1][0]) * acc[ai][bj][m][1][0]; v[5] = fsigmoid(bfhi(gr.z) + bg[bj][1][1]) * acc[ai][bj][m][1][1];
                    v[6] = fsigmoid(bflo(gr.w) + bg[bj][1][2]) * acc[ai][bj][m][1][2]; v[7] = fsigmoid(bfhi(gr.w) + bg[bj][1][3]) * acc[ai][bj][m][1][3];
                    bf16_t* zp = Z + row * 1024 + c;
                    if (SECOND) { const u32x4 zr = *(const u32x4*)zp;
                        v[0] += bflo(zr.x); v[1] += bfhi(zr.x); v[2] += bflo(zr.y); v[3] += bfhi(zr.y); v[4] += bflo(zr.z); v[5] += bfhi(zr.z); v[6] += bflo(zr.w); v[7] += bfhi(zr.w); }
                    u32x4 w; w.x = cvt_pk_bf16(v[0], v[1]); w.y = cvt_pk_bf16(v[2], v[3]); w.z = cvt_pk_bf16(v[4], v[5]); w.w = cvt_pk_bf16(v[6], v[7]);
                    *(u32x4*)zp = w; } }
    }
};
template <class Epi, class Sched, bool ALIGN_EPI = false, bool SP2 = false>
__device__ __forceinline__ void gemm_phase(PG8_LAS unsigned char* lds, const Gemm g, const Sched& S, const Epi& E) {
    const int tid = opaque_tid(), wid = __builtin_amdgcn_readfirstlane(tid >> 6), lane = tid & 63, wr = wid >> 2, wc = wid & 3, fr = lane & 15, fq = lane >> 4;
    const int K = g.K, nt = K / BK;
    unsigned voffA[2], voffB[2];
#pragma unroll
    for (int i = 0; i < 2; ++i) { int R, C; stage_rc(tid * 16 + i * 8192, R, C); const int Rb = Epi::PERM ? ((R & ~31) + perm32(R & 31)) : R;
        voffA[i] = (unsigned)(R * g.lda + C) * 2u; voffB[i] = (unsigned)(Rb * g.ldb + C) * 2u; }
    const size_t kstep = (size_t)(BK * 2);
    const size_t hstepA = (size_t)HALF * g.lda * 2, hstepB = (size_t)HALF * g.ldb * 2;
    const size_t tstepA = 2 * hstepA, tstepB = 2 * hstepB;
    const unsigned ldsw = (unsigned)wid * 1024u;
    const int aoff = lds_byte(wr * 64 + fr, fq * 8), boff = lds_byte(wc * 32 + fr, fq * 8);
#define PG8_SA(b, h) (((b) * 2 + (h)) * HTB)
#define PG8_SB(b, h) ((4 + (b) * 2 + (h)) * HTB)
#define PG8_STAGE(bufoff, gbase, voff) do { _Pragma("unroll") for (int _i = 0; _i < 2; ++_i) \
        __builtin_amdgcn_global_load_lds((const unsigned*)((const char*)(gbase) + (voff)[_i]), (PG8_LAS unsigned*)(lds + (bufoff) + ldsw + _i * 8192), 16, 0, 0); } while (0)
#define PG8_LDA(dst, b, h) do { _Pragma("unroll") for (int m = 0; m < 4; ++m) _Pragma("unroll") for (int k = 0; k < 2; ++k) dst[m][k] = *(const PG8_LAS bf16x8*)(lds + PG8_SA(b, h) + aoff + m * 2048 + k * 1024); } while (0)
#define PG8_LDB(dst, b, h) do { _Pragma("unroll") for (int n = 0; n < 2; ++n) _Pragma("unroll") for (int k = 0; k < 2; ++k) dst[n][k] = *(const PG8_LAS bf16x8*)(lds + PG8_SB(b, h) + boff + n * 2048 + k * 1024); } while (0)
#define PG8_MMA(ai, bj, At, Bt) do { __builtin_amdgcn_s_setprio(1); _Pragma("unroll") for (int m = 0; m < 4; ++m) _Pragma("unroll") for (int n = 0; n < 2; ++n) _Pragma("unroll") for (int k = 0; k < 2; ++k) \
        acc[ai][bj][m][n] = __builtin_amdgcn_mfma_f32_16x16x32_bf16(Bt[n][k], At[m][k], acc[ai][bj][m][n], 0, 0, 0); __builtin_amdgcn_s_setprio(0); } while (0)
#define PG8_WAIT_V(n) asm volatile("s_waitcnt vmcnt(" #n ")" ::: "memory")
#define PG8_WAIT_L(n) asm volatile("s_waitcnt lgkmcnt(" #n ")" ::: "memory")
#define PG8_BAR __builtin_amdgcn_s_barrier()
#define PG8_SCHED __builtin_amdgcn_sched_barrier(0)
    Unit cur, nxt; int ui = 0;
    if (!S.next(0, cur)) return;
    f32x4 acc[2][2][4][2];
#pragma unroll
    for (int a = 0; a < 2; ++a)
#pragma unroll
        for (int b = 0; b < 2; ++b)
#pragma unroll
            for (int m = 0; m < 4; ++m)
#pragma unroll
                for (int n = 0; n < 2; ++n) acc[a][b][m][n] = (f32x4){0.f, 0.f, 0.f, 0.f};
    bf16x8 At[4][2], B0[2][2], B1[2][2];
    const char* cA = (const char*)g.A + (size_t)cur.pm * tstepA; const char* cB = (const char*)g.Bt + (size_t)cur.pn * tstepB;
    S.a_ready(cur);
    if constexpr (SP2) {
        PG8_STAGE(PG8_SB(0, 0), cB, voffB); PG8_STAGE(PG8_SB(0, 1), cB + hstepB, voffB); PG8_STAGE(PG8_SA(0, 0), cA, voffA); PG8_STAGE(PG8_SA(0, 1), cA + hstepA, voffA);
        if (wr == 1) PG8_BAR;
        PG8_WAIT_V(2); PG8_BAR;
        PG8_STAGE(PG8_SB(1, 0), cB + kstep, voffB); PG8_STAGE(PG8_SA(1, 0), cA + kstep, voffA); PG8_STAGE(PG8_SB(1, 1), cB + hstepB + kstep, voffB);
        PG8_WAIT_V(6); PG8_BAR;
    } else {
        PG8_STAGE(PG8_SB(0, 0), cB, voffB); PG8_STAGE(PG8_SA(0, 0), cA, voffA); PG8_STAGE(PG8_SB(0, 1), cB + hstepB, voffB); PG8_STAGE(PG8_SA(0, 1), cA + hstepA, voffA);
        if (wr == 1) PG8_BAR;
        PG8_WAIT_V(4); PG8_BAR;
        PG8_STAGE(PG8_SB(1, 0), cB + kstep, voffB); PG8_STAGE(PG8_SA(1, 0), cA + kstep, voffA); PG8_STAGE(PG8_SB(1, 1), cB + hstepB + kstep, voffB);
        PG8_WAIT_V(6); PG8_BAR;
    }
    for (;;) {
        const bool has_next = S.next(ui + 1, nxt);
        const char* nA = has_next ? (const char*)g.A + (size_t)nxt.pm * tstepA : cA; const char* nB = has_next ? (const char*)g.Bt + (size_t)nxt.pn * tstepB : cB;
        for (int t = 0; t < nt; t += 2) {
            const bool last = (t == nt - 2);
            const char* a1 = cA + (size_t)(t + 1) * kstep;
            const char* a2 = last ? nA : cA + (size_t)(t + 2) * kstep; const char* b2 = last ? nB : cB + (size_t)(t + 2) * kstep;
            const char* a3 = a2 + kstep; const char* b3 = b2 + kstep;
            if (last && has_next) S.a_ready(nxt);
            if constexpr (SP2) {
            PG8_LDB(B0, 0, 0); PG8_LDB(B1, 0, 1); PG8_SCHED; PG8_LDA(At, 0, 0); PG8_STAGE(PG8_SA(1, 1), a1 + hstepA, voffA);
            PG8_WAIT_V(8); PG8_WAIT_L(0); PG8_BAR; PG8_MMA(0, 0, At, B0); PG8_MMA(0, 1, At, B1); PG8_BAR; PG8_SCHED;
            PG8_LDA(At, 0, 1); PG8_STAGE(PG8_SB(0, 0), b2, voffB); PG8_STAGE(PG8_SB(0, 1), b2 + hstepB, voffB); PG8_STAGE(PG8_SA(0, 0), a2, voffA);
            PG8_WAIT_V(8); PG8_WAIT_L(0); PG8_BAR; PG8_MMA(1, 0, At, B0); PG8_MMA(1, 1, At, B1); PG8_BAR; PG8_SCHED;
            PG8_LDB(B0, 1, 0); PG8_LDB(B1, 1, 1); PG8_SCHED; PG8_LDA(At, 1, 0); PG8_STAGE(PG8_SA(0, 1), a2 + hstepA, voffA);
            PG8_WAIT_V(8); PG8_WAIT_L(0); PG8_BAR; PG8_MMA(0, 0, At, B0); PG8_MMA(0, 1, At, B1); PG8_BAR; PG8_SCHED;
            PG8_LDA(At, 1, 1); PG8_STAGE(PG8_SB(1, 0), b3, voffB); PG8_STAGE(PG8_SB(1, 1), b3 + hstepB, voffB); PG8_STAGE(PG8_SA(1, 0), a3, voffA);
            PG8_WAIT_V(8); PG8_WAIT_L(0); PG8_BAR; PG8_MMA(1, 0, At, B0); PG8_MMA(1, 1, At, B1); PG8_BAR; PG8_SCHED;
            } else {
            PG8_LDB(B0, 0, 0); PG8_SCHED; PG8_LDA(At, 0, 0); PG8_STAGE(PG8_SA(1, 1), a1 + hstepA, voffA);
            PG8_WAIT_L(8); PG8_BAR; PG8_WAIT_L(0); PG8_MMA(0, 0, At, B0); PG8_BAR; PG8_SCHED;
            PG8_LDB(B1, 0, 1); PG8_STAGE(PG8_SB(0, 0), b2, voffB);
            PG8_BAR; PG8_WAIT_L(0); PG8_MMA(0, 1, At, B1); PG8_BAR;
            PG8_LDA(At, 0, 1); PG8_STAGE(PG8_SA(0, 0), a2, voffA);
            PG8_BAR; PG8_WAIT_L(0); PG8_MMA(1, 0, At, B0); PG8_BAR; PG8_SCHED;
            PG8_STAGE(PG8_SB(0, 1), b2 + hstepB, voffB);
            PG8_WAIT_V(6); PG8_BAR; PG8_MMA(1, 1, At, B1); PG8_BAR;
            PG8_LDB(B0, 1, 0); PG8_SCHED; PG8_LDA(At, 1, 0); PG8_STAGE(PG8_SA(0, 1), a2 + hstepA, voffA);
            PG8_WAIT_L(8); PG8_BAR; PG8_WAIT_L(0); PG8_MMA(0, 0, At, B0); PG8_BAR; PG8_SCHED;
            PG8_LDB(B1, 1, 1); PG8_STAGE(PG8_SB(1, 0), b3, voffB);
            PG8_BAR; PG8_WAIT_L(0); PG8_MMA(0, 1, At, B1); PG8_BAR;
            PG8_LDA(At, 1, 1); PG8_STAGE(PG8_SA(1, 0), a3, voffA);
            PG8_BAR; PG8_WAIT_L(0); PG8_MMA(1, 0, At, B0); PG8_BAR; PG8_SCHED;
            PG8_STAGE(PG8_SB(1, 1), b3 + hstepB, voffB);
            PG8_WAIT_V(6); PG8_BAR; PG8_MMA(1, 1, At, B1); PG8_BAR;
            }
        }
        if constexpr (ALIGN_EPI) { if (wr == 0) PG8_BAR; }
        if constexpr (!Epi::AFTER_DRAIN) { E(acc, cur, wr, wc, fr, fq); S.done(cur); }
        if (!has_next) break;
#pragma unroll
        for (int a = 0; a < 2; ++a)
#pragma unroll
            for (int b = 0; b < 2; ++b)
#pragma unroll
                for (int m = 0; m < 4; ++m)
#pragma unroll
                    for (int n = 0; n < 2; ++n) acc[a][b][m][n] = (f32x4){0.f, 0.f, 0.f, 0.f};
        cur = nxt; cA = nA; cB = nB; ++ui;
        if constexpr (ALIGN_EPI) { if (wr == 1) PG8_BAR; }
    }
    PG8_WAIT_V(0);
    if constexpr (!ALIGN_EPI) { if (wr == 0) PG8_BAR; }
    PG8_BAR;
    if constexpr (Epi::AFTER_DRAIN) { E.fused(acc, cur, wr, wc, fr, fq, lds, wid, lane); S.done(cur); }
#undef PG8_SA
#undef PG8_SB
#undef PG8_STAGE
#undef PG8_LDA
#undef PG8_LDB
#undef PG8_MMA
#undef PG8_WAIT_V
#undef PG8_WAIT_L
#undef PG8_BAR
#undef PG8_SCHED
}
}
#include <hip/hip_bf16.h>
#include <cmath>
namespace attn_body {
using bf16=__hip_bfloat16;
using bf16x8=__attribute__((ext_vector_type(8)))short;
using s16x4=__attribute__((ext_vector_type(4)))short;
using f32x16=__attribute__((ext_vector_type(16)))float;
using u32x4=__attribute__((ext_vector_type(4)))unsigned;
constexpr int SEQ=8448,D=64,DM=4608,NTILES=132;
constexpr int NW=8,QBLK=32,QB=QBLK*NW,KVBLK=64;
constexpr int ATTN_PITCH=DM, ATTN_UNIT_ROWS=QB;
__device__ __forceinline__ int crow(int r,int hi){return (r&3)+8*(r>>2)+4*hi;}
#define SBAR() __builtin_amdgcn_sched_barrier(0)
__device__ __forceinline__ void cmask(f32x16&p0,f32x16&p1,int jb,int qrel,int hi){
  const float NEG=-INFINITY; int kb=64*jb+4*hi;
  #pragma unroll
  for(int r=0;r<16;++r){int kv=kb+(r&3)+8*(r>>2); if(kv>qrel)p0[r]=NEG; if(kv+32>qrel)p1[r]=NEG;}
}

constexpr int NSLOT=3, SLOTB=8192;
constexpr int LDS_K=0, LDS_V=NSLOT*SLOTB, LDS_WS=2*NSLOT*SLOTB, LDS_OST=LDS_WS+NW*64*4, LDS_BYTES=LDS_OST+NW*4096;
constexpr float C2=0.125f*1.4426950408889634f;
__device__ __forceinline__ void glds16(const void*gsrc,unsigned lds_dst){unsigned keep;
  asm volatile("s_mov_b32 %0, m0\n\ts_mov_b32 m0, %2\n\ts_nop 0\n\tglobal_load_lds_dwordx4 %1, off\n\ts_mov_b32 m0, %0":"=&s"(keep):"v"(gsrc),"s"(lds_dst):"memory");}
__device__ __forceinline__ float max3f(float a,float b,float c){float r;asm("v_max3_f32 %0, %1, %2, %3":"=v"(r):"v"(a),"v"(b),"v"(c));return r;}
__device__ __forceinline__ float max2f(float a,float b){float r;asm("v_max_f32_e32 %0, %1, %2":"=v"(r):"v"(a),"v"(b));return r;}
__device__ __forceinline__ float fadd_s(float a,float b){float r;asm("v_add_f32_e32 %0, %1, %2":"=v"(r):"v"(a),"v"(b));return r;}
__device__ __forceinline__ float fsub_s(float a,float b){float r;asm("v_sub_f32_e32 %0, %1, %2":"=v"(r):"v"(a),"v"(b));return r;}
typedef float f32x2_t __attribute__((ext_vector_type(2))); typedef __bf16 bf16x2_t __attribute__((ext_vector_type(2)));
__device__ __forceinline__ unsigned cvtpk_s(float lo,float hi){f32x2_t v={lo,hi};bf16x2_t b=__builtin_convertvector(v,bf16x2_t);return __builtin_bit_cast(unsigned,b);}
#define WAIT_BAR(N) asm volatile("s_waitcnt vmcnt(" #N ") lgkmcnt(0)\n\ts_barrier":::"memory")

__device__ __forceinline__ void qkt(f32x16&p0,f32x16&p1,const char*Kslot,const bf16x8*qr,const f32x16&negm,int r32,int hi){
  const char*kb=Kslot+hi*1024+r32*16;
  #pragma unroll
  for(int d0=0;d0<4;++d0){
    const bf16x8 b0=*reinterpret_cast<const bf16x8*>(kb+d0*2048);
    const bf16x8 b1=*reinterpret_cast<const bf16x8*>(kb+d0*2048+512);
    if(d0==0){p0=__builtin_amdgcn_mfma_f32_32x32x16_bf16(b0,qr[0],negm,0,0,0);p1=__builtin_amdgcn_mfma_f32_32x32x16_bf16(b1,qr[0],negm,0,0,0);}
    else{p0=__builtin_amdgcn_mfma_f32_32x32x16_bf16(b0,qr[d0],p0,0,0,0);p1=__builtin_amdgcn_mfma_f32_32x32x16_bf16(b1,qr[d0],p1,0,0,0);}}
}
typedef __attribute__((address_space(3))) const char* lds_cptr;
typedef short v4i16_t __attribute__((ext_vector_type(4)));
__device__ __forceinline__ void kload8(bf16x8*kf,lds_cptr kp){
  kf[0]=*(const __attribute__((address_space(3))) bf16x8*)(kp);      kf[1]=*(const __attribute__((address_space(3))) bf16x8*)(kp+512);
  kf[2]=*(const __attribute__((address_space(3))) bf16x8*)(kp+2048); kf[3]=*(const __attribute__((address_space(3))) bf16x8*)(kp+2560);
  kf[4]=*(const __attribute__((address_space(3))) bf16x8*)(kp+4096); kf[5]=*(const __attribute__((address_space(3))) bf16x8*)(kp+4608);
  kf[6]=*(const __attribute__((address_space(3))) bf16x8*)(kp+6144); kf[7]=*(const __attribute__((address_space(3))) bf16x8*)(kp+6656);
}
__device__ __forceinline__ void kload2(bf16x8*kf,lds_cptr kp,int j){ kf[2*j]=*(const __attribute__((address_space(3))) bf16x8*)(kp+j*2048); kf[2*j+1]=*(const __attribute__((address_space(3))) bf16x8*)(kp+j*2048+512); }
__device__ __forceinline__ s16x4 vtr(lds_cptr p){ return __builtin_bit_cast(s16x4,__builtin_amdgcn_ds_read_tr16_b64_v4i16((__attribute__((address_space(3))) v4i16_t*)p)); }
__device__ __forceinline__ float rowmax(const f32x16&p0,const f32x16&p1){
  float a=max3f(p0[0],p0[1],p1[0]),b=max3f(p0[2],p0[3],p1[1]);a=max3f(a,p1[2],p1[3]);
  #pragma unroll
  for(int r=4;r<16;r+=4){a=max3f(a,p0[r],p0[r+1]);b=max3f(b,p0[r+2],p0[r+3]);a=max3f(a,p1[r],p1[r+1]);b=max3f(b,p1[r+2],p1[r+3]);}
  const float m=max2f(a,b);
  auto rr=__builtin_amdgcn_permlane32_swap(__float_as_uint(m),__float_as_uint(m),false,false);
  return max2f(__uint_as_float(rr[0]),__uint_as_float(rr[1]));
}
__device__ __forceinline__ void pv(f32x16*o,int vb,bf16x8 pa0,bf16x8 pa1,bf16x8 pa2,bf16x8 pa3){
  #pragma unroll
  for(int d0=0;d0<2;++d0){s16x4 lo[4],hi[4];
    #pragma unroll
    for(int ks=0;ks<4;++ks){
      asm volatile("ds_read_b64_tr_b16 %0,%1 offset:%c2":"=&v"(lo[ks]):"v"(vb),"i"(d0*4096+ks*1024):"memory");
      asm volatile("ds_read_b64_tr_b16 %0,%1 offset:%c2":"=&v"(hi[ks]):"v"(vb),"i"(d0*4096+ks*1024+512):"memory");}
    asm volatile("s_waitcnt lgkmcnt(0)":::"memory");SBAR();
    #define PK(k) (bf16x8){lo[k][0],lo[k][1],lo[k][2],lo[k][3],hi[k][0],hi[k][1],hi[k][2],hi[k][3]}
    o[d0]=__builtin_amdgcn_mfma_f32_32x32x16_bf16(pa0,PK(0),o[d0],0,0,0);
    o[d0]=__builtin_amdgcn_mfma_f32_32x32x16_bf16(pa1,PK(1),o[d0],0,0,0);
    o[d0]=__builtin_amdgcn_mfma_f32_32x32x16_bf16(pa2,PK(2),o[d0],0,0,0);
    o[d0]=__builtin_amdgcn_mfma_f32_32x32x16_bf16(pa3,PK(3),o[d0],0,0,0);
    #undef PK
  }
}

#ifndef ATTN_STORE16
#define ATTN_STORE16(p,v) (*(u32x4*)(p)=(v))
#endif
template<int THRL,bool NOMAX> __device__ __forceinline__ void attn_unit(int b,int h,int hk,int qb,const bf16*Q,const bf16*__restrict__ K,const bf16*__restrict__ V,bf16*O,char*shm){
  const int tid=opaque_tid(),lane=tid&63,r32=lane&31,hi=lane>>5; const int wid=__builtin_amdgcn_readfirstlane(tid>>6);
  const long rowbase=(long)b*SEQ; const int q0=qb*QB;
  const bf16*Qw=Q+(rowbase+q0+wid*QBLK)*DM+h*D;
  const bf16*Kh=K+rowbase*DM+hk*D,*Vh=V+rowbase*DM+hk*D;
  const unsigned lds0=(unsigned)(uintptr_t)shm;
  float*wsf=(float*)(shm+LDS_WS)+wid*64;
  const bf16*ksrc=Kh+(long)lane*DM+wid*8;
  const bf16*vsrc=Vh+(long)(16*(wid&3)+(lane>>2))*DM+(wid>>2)*32+(lane&3)*8;
  const unsigned kdst=lds0+LDS_K+wid*1024, vdst=lds0+LDS_V+wid*1024;
  #define DMA_K(t,slot) glds16(ksrc+(long)(t)*KVBLK*DM,(unsigned)__builtin_amdgcn_readfirstlane(kdst+(slot)))
  #define DMA_V(t,slot) glds16(vsrc+(long)(t)*KVBLK*DM,(unsigned)__builtin_amdgcn_readfirstlane(vdst+(slot)))
  const int vb0=(int)(lds0+LDS_V)+((lane>>4)&1)*32+(lane&3)*8+(4*hi+((lane&15)>>2))*64;
  const char*Kbase=shm+LDS_K; bf16x8 kf[8];
  const lds_cptr shm3=(lds_cptr)shm; const lds_cptr kp0=shm3+LDS_K+hi*1024+r32*16; const lds_cptr vp0=shm3+LDS_V+((lane>>4)&1)*32+(lane&3)*8+(4*hi+((lane&15)>>2))*64;
  constexpr int NT=NTILES;
  DMA_K(0,0);DMA_V(0,0);DMA_K(1,SLOTB);
  bf16x8 qr[4];
  #pragma unroll
  for(int d0=0;d0<4;++d0)qr[d0]=*reinterpret_cast<const bf16x8*>(&Qw[(long)r32*DM+d0*16+hi*8]);
  float mhat=0.f,l_reg=0.f;f32x16 o[2];o[0]=f32x16{};o[1]=f32x16{};f32x16 negm=f32x16{};asm volatile("":"+v"(negm));
  #define CMASK(P0,P1,t) do{}while(0)
  bool resc=false;
  #define START(P0,P1) do{ const float rm=rowmax(P0,P1); resc=false; \
    { const float dl=rm; mhat=fadd_s(mhat,dl); \
      _Pragma("unroll") for(int r=0;r<16;++r){P0[r]=fsub_s(P0[r],dl);P1[r]=fsub_s(P1[r],dl);} \
      _Pragma("unroll") for(int r=0;r<16;++r)negm[r]=-mhat; asm volatile("":"+v"(negm)); } \
    _Pragma("unroll") for(int r=0;r<16;++r)P0[r]=__builtin_amdgcn_exp2f(P0[r]); }while(0)
  #define RESC() do{ if(resc){ asm volatile("s_waitcnt lgkmcnt(0)":::"memory"); \
      _Pragma("unroll") for(int d_=0;d_<2;++d_) _Pragma("unroll") for(int r=0;r<16;++r)o[d_][r]*=wsf[crow(r,hi)]; } }while(0)
  f32x16 pA0,pA1,pB0,pB1;
  int sl_prev=0,sl_cur=0,sl_next=SLOTB;
  #define ROT() do{sl_prev=sl_cur;sl_cur=sl_next;sl_next=(sl_next==(NSLOT-1)*SLOTB)?0:sl_next+SLOTB;}while(0)
  DMA_K(2,2*SLOTB);
  WAIT_BAR(3);
  qkt(pA0,pA1,Kbase,qr,negm,r32,hi);asm volatile("s_nop 15\n\ts_nop 7":"+v"(pA0),"+v"(pA1));CMASK(pA0,pA1,0);
  START(pA0,pA1);
  _Pragma("unroll") for(int r=0;r<16;++r)pA1[r]=__builtin_amdgcn_exp2f(pA1[r]);
  WAIT_BAR(0);
  DMA_K(3,0);DMA_V(1,SLOTB);
  ROT();
  kload8(kf,kp0+sl_cur);
  WAIT_BAR(2);
  s16x4 vlo[8],vhi[8]; u32x4 pw0,pw1,pw2,pw3;
  #define PKW(P,B) cvtpk_s(P[B],P[B+1])
  #define PAF(k) __builtin_bit_cast(bf16x8,pw##k)
  #define VFR(i) (bf16x8){vlo[i][0],vlo[i][1],vlo[i][2],vlo[i][3],vhi[i][0],vhi[i][1],vhi[i][2],vhi[i][3]}
  #define PIN(x) asm volatile("":"+v"(x))
  #define MX3(a,b,c) __builtin_fmaxf(__builtin_fmaxf((a),(b)),(c))
  #define GAPA(MF,A0,A1,A2,A3,W0,W1,PW) do{ MF; sacc+=A0; sacc+=A1; sacc+=A2; sacc+=A3; PIN(sacc); W0; W1; PIN(PW); SBAR(); }while(0)
  #define EX(v) __builtin_amdgcn_exp2f(v)
  #define GAPB(MF,X,B) do{ MF; X[B]=EX(X[B]); X[B+1]=EX(X[B+1]); X[B+2]=EX(X[B+2]); X[B+3]=EX(X[B+3]); PIN(X); SBAR(); }while(0)
  #define VRD(i) do{ vlo[i]=vtr(vp_+(((i)>>2)*4096+((i)&3)*1024)); vhi[i]=vtr(vp_+(((i)>>2)*4096+((i)&3)*1024+512)); }while(0)
  #define KRD(G,j) do{ if(G){ kload2(kf,kp0+sl_next,j); SBAR(); } }while(0)
  #define STEP(C0,C1,P0,P1,t,GK,GV,GL) do{ SBAR(); \
    const lds_cptr vp_=vp0+sl_prev; \
    VRD(0); SBAR(); float sacc=(P0[0]+P0[1]); \
    GAPA(C0=__builtin_amdgcn_mfma_f32_32x32x16_bf16(kf[0],qr[0],negm,0,0,0), P0[2],P0[3],P0[4],P0[5],     pw0[0]=PKW(P0,0), pw0[1]=PKW(P0,2), pw0); \
    VRD(4); SBAR(); GAPA(C1=__builtin_amdgcn_mfma_f32_32x32x16_bf16(kf[1],qr[0],negm,0,0,0), P0[6],P0[7],P0[8],P0[9],     pw0[2]=PKW(P0,4), pw0[3]=PKW(P0,6), pw0); \
    VRD(1); SBAR(); GAPA(C0=__builtin_amdgcn_mfma_f32_32x32x16_bf16(kf[2],qr[1],C0,0,0,0),   P0[10],P0[11],P0[12],P0[13], pw1[0]=PKW(P0,8), pw1[1]=PKW(P0,10), pw1); \
    VRD(5); SBAR(); GAPA(C1=__builtin_amdgcn_mfma_f32_32x32x16_bf16(kf[3],qr[1],C1,0,0,0),   P0[14],P0[15],P1[0],P1[1],   pw1[2]=PKW(P0,12),pw1[3]=PKW(P0,14), pw1); \
    VRD(2); SBAR(); GAPA(C0=__builtin_amdgcn_mfma_f32_32x32x16_bf16(kf[4],qr[2],C0,0,0,0),   P1[2],P1[3],P1[4],P1[5],     pw2[0]=PKW(P1,0), pw2[1]=PKW(P1,2), pw2); \
    VRD(6); SBAR(); GAPA(C1=__builtin_amdgcn_mfma_f32_32x32x16_bf16(kf[5],qr[2],C1,0,0,0),   P1[6],P1[7],P1[8],P1[9],     pw2[2]=PKW(P1,4), pw2[3]=PKW(P1,6), pw2); \
    VRD(3); SBAR(); GAPA(C0=__builtin_amdgcn_mfma_f32_32x32x16_bf16(kf[6],qr[3],C0,0,0,0),   P1[10],P1[11],P1[12],P1[13], pw3[0]=PKW(P1,8), pw3[1]=PKW(P1,10), pw3); \
    VRD(7); SBAR(); GAPA(C1=__builtin_amdgcn_mfma_f32_32x32x16_bf16(kf[7],qr[3],C1,0,0,0),   P1[14],P1[15],0.f,0.f,       pw3[2]=PKW(P1,12),pw3[3]=PKW(P1,14), pw3); \
    l_reg+=sacc; \
    if(GK){DMA_K((t)+3,sl_cur);} if(GV){DMA_V((t)+1,sl_next);} \
    CMASK(C0,C1,t); \
    if constexpr(!NOMAX){ float a=MX3(C0[0],C0[1],C1[0]),b=MX3(C0[2],C0[3],C1[1]); a=MX3(a,C1[2],C1[3]); \
      _Pragma("unroll") for(int r=4;r<16;r+=4){a=MX3(a,C0[r],C0[r+1]);b=MX3(b,C0[r+2],C0[r+3]);a=MX3(a,C1[r],C1[r+1]);b=MX3(b,C1[r+2],C1[r+3]);} \
      float rm=__builtin_fmaxf(a,b); { auto rr=__builtin_amdgcn_permlane32_swap(__float_as_uint(rm),__float_as_uint(rm),false,false); rm=__builtin_fmaxf(__uint_as_float(rr[0]),__uint_as_float(rr[1])); } \
      resc=false; \
      if(__builtin_expect(__any(rm>(float)THRL),0)){ const float dl=__builtin_fmaxf(rm,0.f); mhat+=dl; \
        _Pragma("unroll") for(int r=0;r<16;++r){C0[r]-=dl;C1[r]-=dl;} \
        _Pragma("unroll") for(int r=0;r<16;++r)negm[r]=-mhat; asm volatile("":"+v"(negm)); \
        const float f=__builtin_amdgcn_exp2f(-dl); l_reg*=f; if(hi==0)wsf[r32]=f; resc=true; } } \
    SBAR(); \
    GAPB(o[0]=__builtin_amdgcn_mfma_f32_32x32x16_bf16(PAF(0),VFR(0),o[0],0,0,0), C0,0); \
    GAPB(o[1]=__builtin_amdgcn_mfma_f32_32x32x16_bf16(PAF(0),VFR(4),o[1],0,0,0), C0,4); \
    KRD(GL,0); GAPB(o[0]=__builtin_amdgcn_mfma_f32_32x32x16_bf16(PAF(1),VFR(1),o[0],0,0,0), C0,8); \
    KRD(GL,1); GAPB(o[1]=__builtin_amdgcn_mfma_f32_32x32x16_bf16(PAF(1),VFR(5),o[1],0,0,0), C0,12); \
    KRD(GL,2); GAPB(o[0]=__builtin_amdgcn_mfma_f32_32x32x16_bf16(PAF(2),VFR(2),o[0],0,0,0), C1,0); \
    KRD(GL,3); GAPB(o[1]=__builtin_amdgcn_mfma_f32_32x32x16_bf16(PAF(2),VFR(6),o[1],0,0,0), C1,4); \
    GAPB(o[0]=__builtin_amdgcn_mfma_f32_32x32x16_bf16(PAF(3),VFR(3),o[0],0,0,0), C1,8); \
    GAPB(o[1]=__builtin_amdgcn_mfma_f32_32x32x16_bf16(PAF(3),VFR(7),o[1],0,0,0), C1,12); \
    }while(0)
  int t=1;
  #undef CMASK
  #define CMASK(P0,P1,t) do{}while(0)
  for(;t+5<NT;t+=2){
    STEP(pB0,pB1,pA0,pA1,t,true,true,true);     WAIT_BAR(2); RESC(); ROT();
    STEP(pA0,pA1,pB0,pB1,t+1,true,true,true);   WAIT_BAR(2); RESC(); ROT();
  }
  #undef CMASK
  #define CMASK(P0,P1,t) do{}while(0)
  #define ENDW(tt) do{ if((tt)+3<NT){WAIT_BAR(2);} else if((tt)+2<NT){WAIT_BAR(1);} else {WAIT_BAR(0);} }while(0)
  for(;t+1<NT;t+=2){
    STEP(pB0,pB1,pA0,pA1,t,(t+3<NT),(t+1<NT),(t+1<NT));       ENDW(t);   RESC(); ROT();
    STEP(pA0,pA1,pB0,pB1,t+1,(t+4<NT),(t+2<NT),(t+2<NT));     ENDW(t+1); RESC(); ROT();
  }
  STEP(pB0,pB1,pA0,pA1,NT-1,false,false,false); RESC();
  { float sacc=pB0[0]+pB0[1]; _Pragma("unroll") for(int r=2;r<16;++r)sacc+=pB0[r]; _Pragma("unroll") for(int r=0;r<16;++r)sacc+=pB1[r]; l_reg+=sacc;
    pw0=(u32x4){PKW(pB0,0),PKW(pB0,2),PKW(pB0,4),PKW(pB0,6)};pw1=(u32x4){PKW(pB0,8),PKW(pB0,10),PKW(pB0,12),PKW(pB0,14)};pw2=(u32x4){PKW(pB1,0),PKW(pB1,2),PKW(pB1,4),PKW(pB1,6)};pw3=(u32x4){PKW(pB1,8),PKW(pB1,10),PKW(pB1,12),PKW(pB1,14)};
    SBAR(); pv(o,vb0+sl_cur,PAF(0),PAF(1),PAF(2),PAF(3)); }
  #undef PKW
  #undef PAF
  #undef VFR
  #undef PIN
  #undef MX3
  #undef GAPA
  #undef GAPB
  #undef EX
  #undef VRD
  #undef KRD
  #undef STEP
  #undef ENDW
  {auto rr=__builtin_amdgcn_permlane32_swap(__float_as_uint(l_reg),__float_as_uint(l_reg),false,false);l_reg=__uint_as_float(rr[0])+__uint_as_float(rr[1]);}
  if(hi==0)wsf[32+r32]=l_reg;asm volatile("s_waitcnt lgkmcnt(0)":::"memory");
  float rli[16];
  #pragma unroll
  for(int r=0;r<16;++r)rli[r]=__builtin_amdgcn_rcpf(wsf[32+crow(r,hi)]);
  bf16*Ow=O+(rowbase+q0+wid*QBLK)*DM+h*D;
  { bf16*stg=(bf16*)(shm+LDS_OST)+wid*2048;
    #pragma unroll
    for(int r=0;r<16;++r){const int orow=crow(r,hi);
      #pragma unroll
      for(int d0=0;d0<2;++d0)stg[orow*64+d0*32+r32]=__float2bfloat16(o[d0][r]*rli[r]);}
    asm volatile("s_waitcnt lgkmcnt(0)":::"memory");
    #pragma unroll
    for(int i=0;i<4;++i){const int row=i*8+(lane>>3),ch=lane&7; const u32x4 v=*(const u32x4*)(stg+row*64+ch*8); ATTN_STORE16(Ow+(long)row*DM+ch*8,v);} }
  asm volatile("s_waitcnt lgkmcnt(0)\n\ts_barrier":::"memory");
  #undef DMA_K
  #undef DMA_V
  #undef CMASK
  #undef START
  #undef RESC
  #undef ROT
}
constexpr int ATTN_LDS_BYTES=LDS_BYTES;
#undef SBAR
#undef WAIT_BAR
}
#include <hip/hip_cooperative_groups.h>
namespace cg = cooperative_groups;
#define LAS __attribute__((address_space(3)))
typedef unsigned short bf16;
typedef unsigned v4u __attribute__((ext_vector_type(4)));
typedef unsigned v2u __attribute__((ext_vector_type(2)));
typedef float f32x4 __attribute__((ext_vector_type(4)));
typedef short bf16x8 __attribute__((ext_vector_type(8)));

#define XB_TMO      128
#define XB_XCNT(j)  (256  + 64 * (j))
#define XB_XSUB(j)  (1280 + 64 * (j))
#define XB_XGEN(j)  (2304 + 64 * (j))
#define XB_TOP      3328
#define XB_TOPGEN   3392
#define XCD_BAR_WORDS 3456
#define XB_SPIN_CAP (1u << 18)

__device__ __forceinline__ unsigned xb_ld(unsigned* p)              { return __hip_atomic_load(p, __ATOMIC_RELAXED, __HIP_MEMORY_SCOPE_AGENT); }
__device__ __forceinline__ unsigned xb_add(unsigned* p, unsigned v) { return __hip_atomic_fetch_add(p, v, __ATOMIC_RELAXED, __HIP_MEMORY_SCOPE_AGENT); }
__device__ __forceinline__ unsigned xb_xcc_id() { return (unsigned)__builtin_amdgcn_s_getreg((3 << 11) | 20) & 0xFu; }
#define XB_SPIN(cond, bar) do { unsigned _sp = 0; while (cond) { __builtin_amdgcn_s_sleep(1); \
    if ((++_sp & 255u) == 0u) { if (xb_ld(&(bar)[XB_TMO])) break; if (_sp > XB_SPIN_CAP) { atomicAdd(&(bar)[XB_TMO], 1u); break; } } } } while (0)

struct XcdBarrier {
    unsigned* bar; unsigned x;
    volatile LAS unsigned* st;
};

__device__ __forceinline__ XcdBarrier xcd_barrier_post(unsigned* bar, volatile LAS unsigned* st) {
    XcdBarrier b; b.bar = bar; b.x = xb_xcc_id(); b.st = st;
    if (threadIdx.x == 0) (void)xb_add(&bar[XB_XCNT(b.x)], 1u);
    return b;
}
__device__ __forceinline__ void xcd_barrier_complete(unsigned* bar, unsigned x, unsigned& nloc, unsigned& nx) {
    const unsigned G = gridDim.x * gridDim.y * gridDim.z;
    unsigned sum, cnt, mine, sp = 0u;
    for (;;) {
        sum = 0u; cnt = 0u; mine = 0u;
#pragma unroll
        for (unsigned j = 0; j < 16; ++j) { const unsigned c = xb_ld(&bar[XB_XCNT(j)]); sum += c; cnt += (c > 0u) ? 1u : 0u; mine = (j == x) ? c : mine; }
        if (sum == G) break;
        __builtin_amdgcn_s_sleep(1);
        if ((++sp & 255u) == 0u) { if (xb_ld(&bar[XB_TMO])) break; if (sp > XB_SPIN_CAP) { atomicAdd(&bar[XB_TMO], 1u); break; } }
    }
    nloc = mine > 0u ? mine : 1u; nx = cnt > 0u ? cnt : 1u;
}

__device__ __forceinline__ void xcd_barrier(const XcdBarrier& b) {
    asm volatile("s_waitcnt vmcnt(0)" ::: "memory");
    __syncthreads();
    if (threadIdx.x == 0) {
        unsigned* bar = b.bar;
        __builtin_amdgcn_s_waitcnt(0);
        unsigned nloc = b.st[0], nx = b.st[1];
        if (nloc == 0u) { xcd_barrier_complete(bar, b.x, nloc, nx); b.st[0] = nloc; b.st[1] = nx; }
        const unsigned old = xb_add(&bar[XB_XSUB(b.x)], 1u);
        const unsigned gen = old / nloc;
        if (old + 1u == (gen + 1u) * nloc) {
            __builtin_amdgcn_fence(__ATOMIC_RELEASE, "agent");
            asm volatile("s_waitcnt vmcnt(0)" ::: "memory");
            const unsigned og = xb_add(&bar[XB_TOP], 1u);
            const unsigned tg = og / nx;
            if (og + 1u == (tg + 1u) * nx) xb_add(&bar[XB_TOPGEN], 1u);
            else XB_SPIN(xb_ld(&bar[XB_TOPGEN]) == tg, bar);
            __builtin_amdgcn_fence(__ATOMIC_ACQUIRE, "agent");
            xb_add(&bar[XB_XGEN(b.x)], 1u);
            asm volatile("s_waitcnt vmcnt(0)" ::: "memory");
        } else {
            XB_SPIN(xb_ld(&bar[XB_XGEN(b.x)]) == gen, bar);
            __builtin_amdgcn_fence(__ATOMIC_ACQUIRE, "agent");
            asm volatile("s_waitcnt vmcnt(0)" ::: "memory");
        }
    }
    __syncthreads();
}

constexpr int NB = 8, TL = 8192, TC = 256, TB = TL + TC  , MR = NB * TB  , DM = 1024, DFF = 2816, PW = 4608, NMOD = 9216;
constexpr float EPS = 1e-6f;
constexpr int LDS_BYTES = 147456, NTHR = 512, NWAVES = 8;
constexpr int PC_Q = 0, PC_K = 512, PC_V = 640, PC_GQ = 768, PC_GK = 1024, PC_GV = 1280, PC_G6 = 1792, PC_GATE = 2304, PC_LOW = 4352;
constexpr int GLA_S = 132, GLA_ITEMS = 64 * GLA_S;
constexpr size_t MiB = 1u << 20;
constexpr size_t WS_SSQ1 = 5 * MiB, WS_SSQ2 = 5 * MiB + 512 * 1024, WS_SW1 = 6 * MiB, WS_SW2 = 6 * MiB + 512 * 1024;
constexpr size_t WS_MOD = 1 * MiB, WS_DN = 2 * MiB, WS_WUP1 = 8 * MiB, WS_WUP2 = 20 * MiB, WS_WDN1 = 32 * MiB, WS_WDN2 = 38 * MiB, WS_WIN = 44 * MiB, WS_WBR0 = 54 * MiB, WS_WBR1 = 55 * MiB, WS_WOUT = 56 * MiB,
                 WS_HCTX = 64 * MiB, WS_XN = 72 * MiB, WS_OF = 204 * MiB, WS_OB = 270 * MiB, WS_A = 336 * MiB, WS_END = 932 * MiB;
static_assert(WS_XN + (size_t)MR * DM * 2 <= WS_OF && WS_OF + (size_t)MR * 512 * 2 <= WS_OB && WS_OB + (size_t)MR * 512 * 2 <= WS_A && WS_A + (size_t)MR * PW * 2 <= WS_END, "ws map");
static_assert((size_t)GLA_ITEMS * 8192 * 2 <= (size_t)MR * DM * 2 && WS_DN + (size_t)GLA_ITEMS * 64 * 4 <= WS_WUP1, "gla ws");

__device__ __forceinline__ unsigned f2bf(float f) { unsigned u = __builtin_bit_cast(unsigned, f); return (u + 0x7fffu + ((u >> 16) & 1u)) >> 16; }
typedef float pk_f32x2 __attribute__((ext_vector_type(2))); typedef __bf16 pk_bf16x2 __attribute__((ext_vector_type(2)));
__device__ __forceinline__ unsigned pk2(float lo, float hi) { const pk_f32x2 v = {lo, hi}; return __builtin_bit_cast(unsigned, __builtin_convertvector(v, pk_bf16x2)); }
__device__ __forceinline__ float bf2f(unsigned short h) { return __uint_as_float(((unsigned)h) << 16); }
__device__ __forceinline__ float wave_sum(float v) {
#pragma unroll
    for (int o = 1; o < 64; o <<= 1) v += __shfl_xor(v, o);
    return v;
}
__device__ __forceinline__ float silu_f(float v) { return v / (1.f + __expf(-v)); }

__device__ __forceinline__ void transpose_item(const float* W, int K, int N, bf16* WT, int k0, int n0, int drow0, LAS float* scr, int lane) {
#pragma unroll 8
    for (int i = 0; i < 32; ++i) { const int kk = 2 * i + (lane >> 5); scr[kk * 33 + (lane & 31)] = W[(size_t)(k0 + kk) * N + n0 + (lane & 31)]; }
    asm volatile("s_waitcnt lgkmcnt(0)" ::: "memory");
    const int c = lane & 7;
#pragma unroll
    for (int j = 0; j < 4; ++j) { const int n = (lane >> 3) + 8 * j; const LAS float* s = scr + (8 * c) * 33 + n;
        v4u o; o.x = pk2(s[0 * 33], s[1 * 33]); o.y = pk2(s[2 * 33], s[3 * 33]); o.z = pk2(s[4 * 33], s[5 * 33]); o.w = pk2(s[6 * 33], s[7 * 33]);
        *(v4u*)(WT + (size_t)(drow0 + n) * K + k0 + 8 * c) = o; }
    asm volatile("s_waitcnt lgkmcnt(0)" ::: "memory");
}
__device__ __forceinline__ int up_dest(int n0) { return n0 < DFF ? 256 * (n0 / 128) + (n0 % 128) : 256 * ((n0 - DFF) / 128) + 128 + ((n0 - DFF) % 128); }
__device__ __forceinline__ int win_dest(int n0) { return n0 < 2304 ? n0 : (n0 < 2336 ? n0 + 2048 : n0 - 32); }

__device__ __forceinline__ void norm_mod_rows(const float* lat, const float* ctxp, const float* mod, const float* g, int sub, bf16* XN, bool with_ctx, int gw, int NGW, int lane) {
    f32x4 gv[4];
#pragma unroll
    for (int j = 0; j < 4; ++j) gv[j] = *((const f32x4*)g + lane + 64 * j);
    for (int r0 = gw * 8; r0 < MR; r0 += NGW * 8) {
        const int b = r0 / TB, t = r0 % TB; const bool isctx = t >= TL;
        if (isctx && !with_ctx) continue;
        const float* src = isctx ? ctxp + (size_t)(b * TC + t - TL) * DM : lat + (size_t)(b * TL + t) * DM;
        const float* sh = mod + (size_t)(isctx ? 8 : b) * NMOD + (3 * sub) * DM; const float* sc = sh + DM;
        f32x4 v[8][4]; float s[8] = {0.f, 0.f, 0.f, 0.f, 0.f, 0.f, 0.f, 0.f}; f32x4 scv[4], shv[4];
#pragma unroll
        for (int u = 0; u < 8; ++u)
#pragma unroll
            for (int j = 0; j < 4; ++j) { v[u][j] = *((const f32x4*)(src + (size_t)u * DM) + lane + 64 * j); }
#pragma unroll
        for (int j = 0; j < 4; ++j) { scv[j] = *((const f32x4*)sc + lane + 64 * j) + 1.f; shv[j] = *((const f32x4*)sh + lane + 64 * j); }
#pragma unroll
        for (int u = 0; u < 8; ++u)
#pragma unroll
            for (int j = 0; j < 4; ++j) s[u] += (v[u][j].x * v[u][j].x + v[u][j].y * v[u][j].y) + (v[u][j].z * v[u][j].z + v[u][j].w * v[u][j].w);
#pragma unroll
        for (int u = 0; u < 8; ++u) {
            const float rstd = 1.f / sqrtf(wave_sum(s[u]) * (1.f / DM) + EPS);
            unsigned long long* o8 = (unsigned long long*)(XN + (size_t)(r0 + u) * DM) + lane;
#pragma unroll
            for (int j = 0; j < 4; ++j) {
                const f32x4 y = (v[u][j] * rstd * gv[j]) * scv[j] + shv[j];
                o8[64 * j] = (unsigned long long)pk2(y.x, y.y) | ((unsigned long long)pk2(y.z, y.w) << 32); } }
    }
}

constexpr int GS = 72, VS = 136;
constexpr int GL_QE = 0, GL_KE = 9216, GL_KL = 18432, GL_A = 27648, GL_V = 36864, GL_B = 54272, GL_BT = 71680, GL_SEG = 71936, BS = 68;
typedef short v4i16_t __attribute__((ext_vector_type(4)));
__device__ __forceinline__ bf16x8 tr_frag(const LAS bf16* base, int rs  , int col0, int ks, int q4, int qq, int p) {
    const LAS bf16* a0 = base + (32 * ks + 8 * q4 + qq) * rs + col0 + 4 * p;
    const v4i16_t t0 = __builtin_amdgcn_ds_read_tr16_b64_v4i16((LAS v4i16_t*)a0), t1 = __builtin_amdgcn_ds_read_tr16_b64_v4i16((LAS v4i16_t*)(a0 + 4 * rs));
    return (bf16x8){t0[0], t0[1], t0[2], t0[3], t1[0], t1[1], t1[2], t1[3]};
}
#define GLA_ROWOF(c) (rowbase + (dir ? 63 - (c) : (c)))
template <int PASS> __device__ __forceinline__ void gla_pass(LAS unsigned char* lds, const bf16* P, const float* w_decay, const float* b_decay, bf16* Ubuf, float* dn, bf16* OF, bf16* OB, int bx, int G, unsigned* ctr) {
    const int tid = opaque_tid(), lane = tid & 63, w = __builtin_amdgcn_readfirstlane(tid >> 6), l15 = lane & 15, q4 = lane >> 4, qq = (lane & 15) >> 2, p3 = lane & 3;
    constexpr int NV = PASS == 1 ? 64 * 131 : 64 * 128;
    LAS bf16* qeL = (LAS bf16*)(lds + GL_QE); LAS bf16* keL = (LAS bf16*)(lds + GL_KE); LAS bf16* klL = (LAS bf16*)(lds + GL_KL); LAS bf16* AL = (LAS bf16*)(lds + GL_A); LAS bf16* vL = (LAS bf16*)(lds + GL_V);
    LAS float* bL = (LAS float*)(lds + GL_B); LAS float* btL = (LAS float*)(lds + GL_BT); LAS float* segT = (LAS float*)(lds + GL_SEG);
    const int c = tid >> 3, ch = tid & 7, dt = w & 3, half = w >> 2;
    v4u vraw[2], kraw, qraw, lowf[2]; float wdr[8]; float bdr = 0.f; bf16x8 xsn[2];
    vraw[0] = vraw[1] = kraw = qraw = lowf[0] = lowf[1] = (v4u){0u, 0u, 0u, 0u}; xsn[0] = xsn[1] = (bf16x8){0, 0, 0, 0, 0, 0, 0, 0};
#pragma unroll
    for (int j = 0; j < 8; ++j) wdr[j] = 0.f;
#define GLA_DEC(idx_) const int chain = PASS == 1 ? (idx_) / 131 : (idx_) >> 7, s = PASS == 1 ? (idx_) % 131 : 4 + ((idx_) & 127), dir = chain & 1, h = (chain >> 1) & 3, b = chain >> 3; \
    const int rowbase = b * TB + (s < 4 ? TL + (dir ? 3 - s : s) * 64 : (dir ? 127 - (s - 4) : s - 4) * 64); const int item = chain * GLA_S + s; (void)item
#define GLA_LOAD(idx_) do { GLA_DEC(idx_); \
        _Pragma("unroll") for (int i = 0; i < 2; ++i) { const int n = tid + 512 * i; vraw[i] = *(const v4u*)(P + (size_t)GLA_ROWOF(n >> 4) * PW + PC_GV + h * 128 + (n & 15) * 8); } \
        { const size_t ro = (size_t)GLA_ROWOF(c) * PW + h * 64 + ch * 8; kraw = *(const v4u*)(P + ro + PC_GK); if (PASS == 3) qraw = *(const v4u*)(P + ro + PC_GQ); } \
        _Pragma("unroll") for (int i = 0; i < 2; ++i) lowf[i] = *(const v4u*)(P + (size_t)GLA_ROWOF(16 * (2 * half + i) + l15) * PW + PC_LOW + dir * 16 + (q4 & 1) * 8); \
        _Pragma("unroll") for (int j = 0; j < 8; ++j) wdr[j] = w_decay[(dir * 16 + 8 * (q4 & 1) + j) * 256 + h * 64 + 16 * dt + l15]; \
        bdr = b_decay[dir * 256 + h * 64 + 16 * dt + l15]; \
        if (PASS == 3) { _Pragma("unroll") for (int ks = 0; ks < 2; ++ks) xsn[ks] = *(const bf16x8*)(Ubuf + (size_t)item * 8192 + (16 * w + l15) * 64 + 8 * q4 + 32 * ks); } } while (0)
    volatile LAS unsigned* nxtL = (volatile LAS unsigned*)(lds + GL_SEG + 1024);
    int idx = bx;
    if (ctr) { if (tid == 0) nxtL[0] = __hip_atomic_fetch_add(ctr, 1u, __ATOMIC_RELAXED, __HIP_MEMORY_SCOPE_AGENT); __syncthreads(); idx = (int)nxtL[0]; __syncthreads(); }
    if (idx < NV) GLA_LOAD(idx);
    for (; idx < NV;) {
        int nidx = idx + G;
        if (ctr && tid == 0) nxtL[0] = __hip_atomic_fetch_add(ctr, 1u, __ATOMIC_RELAXED, __HIP_MEMORY_SCOPE_AGENT);
        GLA_DEC(idx);
#pragma unroll
        for (int i = 0; i < 2; ++i) { const int n = tid + 512 * i; *(LAS v4u*)(vL + (n >> 4) * VS + (n & 15) * 8) = vraw[i]; }
        float kf[8], qf[8];
        kf[0] = pg8::bflo(kraw.x); kf[1] = pg8::bfhi(kraw.x); kf[2] = pg8::bflo(kraw.y); kf[3] = pg8::bfhi(kraw.y); kf[4] = pg8::bflo(kraw.z); kf[5] = pg8::bfhi(kraw.z); kf[6] = pg8::bflo(kraw.w); kf[7] = pg8::bfhi(kraw.w);
        if (PASS == 3) { qf[0] = pg8::bflo(qraw.x); qf[1] = pg8::bfhi(qraw.x); qf[2] = pg8::bflo(qraw.y); qf[3] = pg8::bfhi(qraw.y); qf[4] = pg8::bflo(qraw.z); qf[5] = pg8::bfhi(qraw.z); qf[6] = pg8::bflo(qraw.w); qf[7] = pg8::bfhi(qraw.w); }
        float bv[2][4], tot[2];
        { bf16x8 yv;
#pragma unroll
          for (int j = 0; j < 8; ++j) { const unsigned hb = f2bf(wdr[j]); const unsigned lb = f2bf(wdr[j] - __uint_as_float(hb << 16)); yv[j] = (short)(q4 < 2 ? hb : lb); }
#pragma unroll
          for (int i = 0; i < 2; ++i) { f32x4 z = {0.f, 0.f, 0.f, 0.f}; z = __builtin_amdgcn_mfma_f32_16x16x32_bf16(__builtin_bit_cast(bf16x8, lowf[i]), yv, z, 0, 0, 0);
              float run = 0.f;
#pragma unroll
              for (int r = 0; r < 4; ++r) { const float zz = z[r] + bdr; run += (fminf(zz, 0.f) - __logf(1.f + __expf(-fabsf(zz)))) * (1.f / 16.f); bv[i][r] = run; }
              float sc = run; float t = __shfl_up(sc, 16); if (q4 >= 1) sc += t; t = __shfl_up(sc, 32); if (q4 >= 2) sc += t;
              const float excl = sc - run; tot[i] = __shfl(sc, 48 + l15);
#pragma unroll
              for (int r = 0; r < 4; ++r) bv[i][r] += excl + (i ? tot[0] : 0.f); }
          if (q4 == 0) segT[half * 64 + 16 * dt + l15] = tot[0] + tot[1]; }
        __syncthreads();
        { const float other = segT[(1 - half) * 64 + 16 * dt + l15]; const float add = half ? other : 0.f;
#pragma unroll
          for (int i = 0; i < 2; ++i)
#pragma unroll
              for (int r = 0; r < 4; ++r) bL[(16 * (2 * half + i) + 4 * q4 + r) * BS + 16 * dt + l15] = bv[i][r] + add;
          if (half == 0 && q4 == 0) btL[16 * dt + l15] = tot[0] + tot[1] + other; }
        __syncthreads();
        float bl[8], btot[8];
        { const f32x4 b0 = *(const LAS f32x4*)(bL + c * BS + 8 * ch), b1 = *(const LAS f32x4*)(bL + c * BS + 8 * ch + 4), t0 = *(const LAS f32x4*)(btL + 8 * ch), t1 = *(const LAS f32x4*)(btL + 8 * ch + 4);
          bl[0] = b0[0]; bl[1] = b0[1]; bl[2] = b0[2]; bl[3] = b0[3]; bl[4] = b1[0]; bl[5] = b1[1]; bl[6] = b1[2]; bl[7] = b1[3];
          btot[0] = t0[0]; btot[1] = t0[1]; btot[2] = t0[2]; btot[3] = t0[3]; btot[4] = t1[0]; btot[5] = t1[1]; btot[6] = t1[2]; btot[7] = t1[3]; }
        if (PASS == 1) {
            float kl[8];
#pragma unroll
            for (int k = 0; k < 8; ++k) kl[k] = kf[k] * __expf(btot[k] - bl[k]);
            v4u o; o.x = pk2(kl[0], kl[1]); o.y = pk2(kl[2], kl[3]); o.z = pk2(kl[4], kl[5]); o.w = pk2(kl[6], kl[7]);
            *(LAS v4u*)(klL + c * GS + 8 * ch) = o;
            if (tid < 8) { f32x4* dp = (f32x4*)(dn + (size_t)item * 64 + 8 * ch); dp[0] = (f32x4){__expf(btot[0]), __expf(btot[1]), __expf(btot[2]), __expf(btot[3])}; dp[1] = (f32x4){__expf(btot[4]), __expf(btot[5]), __expf(btot[6]), __expf(btot[7])}; }
        } else {
            float qe[8], ke[8];
#pragma unroll
            for (int k = 0; k < 8; ++k) { qe[k] = qf[k] * __expf(bl[k]) * 0.125f; ke[k] = kf[k] * __expf(-bl[k]); }
            v4u o; o.x = pk2(qe[0], qe[1]); o.y = pk2(qe[2], qe[3]); o.z = pk2(qe[4], qe[5]); o.w = pk2(qe[6], qe[7]);
            *(LAS v4u*)(qeL + c * GS + 8 * ch) = o;
            o.x = pk2(ke[0], ke[1]); o.y = pk2(ke[2], ke[3]); o.z = pk2(ke[4], ke[5]); o.w = pk2(ke[6], ke[7]);
            *(LAS v4u*)(keL + c * GS + 8 * ch) = o;
        }
        bf16x8 xs[2]; xs[0] = xsn[0]; xs[1] = xsn[1];
        if (ctr) nidx = (int)nxtL[0];
        if (nidx < NV) GLA_LOAD(nidx);
        __syncthreads();
        if (PASS == 1) {
            bf16x8 y[2];
#pragma unroll
            for (int ks = 0; ks < 2; ++ks) y[ks] = tr_frag(vL, VS, 16 * w, ks, q4, qq, p3);
#pragma unroll
            for (int dt = 0; dt < 4; ++dt) { f32x4 acc = {0.f, 0.f, 0.f, 0.f};
#pragma unroll
                for (int ks = 0; ks < 2; ++ks) { const bf16x8 x = tr_frag(klL, GS, 16 * dt, ks, q4, qq, p3); acc = __builtin_amdgcn_mfma_f32_16x16x32_bf16(x, y[ks], acc, 0, 0, 0); }
                v2u o; o.x = pk2(acc[0], acc[1]); o.y = pk2(acc[2], acc[3]);
                *(v2u*)(Ubuf + (size_t)item * 8192 + (16 * w + l15) * 64 + 16 * dt + 4 * q4) = o; }
        } else {
            { const int it = w >> 1;
#pragma unroll
              for (int jj = 0; jj < 2; ++jj) { const int jt = (w & 1) * 2 + jj; f32x4 acc = {0.f, 0.f, 0.f, 0.f};
                  if (jt <= it) {
#pragma unroll
                      for (int ks = 0; ks < 2; ++ks) { const bf16x8 x = *(const LAS bf16x8*)(keL + (16 * jt + l15) * GS + 8 * q4 + 32 * ks), y = *(const LAS bf16x8*)(qeL + (16 * it + l15) * GS + 8 * q4 + 32 * ks);
                          acc = __builtin_amdgcn_mfma_f32_16x16x32_bf16(x, y, acc, 0, 0, 0); }
                      const int i = 16 * it + l15, j0 = 16 * jt + 4 * q4;
#pragma unroll
                      for (int r = 0; r < 4; ++r) if (j0 + r > i) acc[r] = 0.f;
                  }
                  v2u o; o.x = pk2(acc[0], acc[1]); o.y = pk2(acc[2], acc[3]);
                  *(LAS v2u*)(AL + (16 * it + l15) * GS + 16 * jt + 4 * q4) = o; } }
            bf16x8 xv[2];
#pragma unroll
            for (int ks = 0; ks < 2; ++ks) xv[ks] = tr_frag(vL, VS, 16 * w, ks, q4, qq, p3);
            __syncthreads();
            bf16* Ob = dir ? OB : OF;
#pragma unroll
            for (int it = 0; it < 4; ++it) { f32x4 acc = {0.f, 0.f, 0.f, 0.f};
#pragma unroll
                for (int ks = 0; ks < 2; ++ks) { const bf16x8 y = *(const LAS bf16x8*)(AL + (16 * it + l15) * GS + 8 * q4 + 32 * ks); acc = __builtin_amdgcn_mfma_f32_16x16x32_bf16(xv[ks], y, acc, 0, 0, 0); }
#pragma unroll
                for (int ks = 0; ks < 2; ++ks) { const bf16x8 y = *(const LAS bf16x8*)(qeL + (16 * it + l15) * GS + 8 * q4 + 32 * ks); acc = __builtin_amdgcn_mfma_f32_16x16x32_bf16(xs[ks], y, acc, 0, 0, 0); }
                v2u o; o.x = pk2(acc[0], acc[1]); o.y = pk2(acc[2], acc[3]);
                *(v2u*)(Ob + (size_t)GLA_ROWOF(16 * it + l15) * 512 + h * 128 + 16 * w + 4 * q4) = o; }
        }
        __syncthreads();
        idx = nidx;
    }
#undef GLA_DEC
#undef GLA_LOAD
}

constexpr int GM_QEF = 0, GM_KEF = 9216, GM_QEB = 18432, GM_KEB = 27648, GM_A = 36864, GM_V = 46080, GM_BF = 63488, GM_BB = 80896, GM_SEG = 98304, GM_RED = 99328, GM_NXT = 101376;
__device__ __forceinline__ void gla_pass3m(LAS unsigned char* lds, const bf16* P, const float* w_decay, const float* b_decay, const float* g_gla, const bf16* Ubuf, bf16* OUT, unsigned* ctr) {
    const int tid = opaque_tid(), lane = tid & 63, w = __builtin_amdgcn_readfirstlane(tid >> 6), l15 = lane & 15, q4 = lane >> 4, qq = (lane & 15) >> 2, p3 = lane & 3;
    constexpr int NV = 8 * 4 * 128;
    LAS bf16* qeF = (LAS bf16*)(lds + GM_QEF); LAS bf16* keF = (LAS bf16*)(lds + GM_KEF); LAS bf16* qeB = (LAS bf16*)(lds + GM_QEB); LAS bf16* keB = (LAS bf16*)(lds + GM_KEB); LAS bf16* AL = (LAS bf16*)(lds + GM_A); LAS bf16* vL = (LAS bf16*)(lds + GM_V);
    LAS float* bF = (LAS float*)(lds + GM_BF); LAS float* bB = (LAS float*)(lds + GM_BB); LAS float* segT = (LAS float*)(lds + GM_SEG); LAS float* red = (LAS float*)(lds + GM_RED);
    volatile LAS unsigned* nxtL = (volatile LAS unsigned*)(lds + GM_NXT);
    const int c = tid >> 3, ch = tid & 7, dt = w & 3, half = w >> 2;
    v4u vraw[2], kraw, qraw, lowr[2][2]; float wdr[2][8]; float bdr[2]; bf16x8 xsn[2][2]; v2u g6r[4];
    float gg4[4];
#pragma unroll
    for (int r = 0; r < 4; ++r) gg4[r] = g_gla[16 * w + 4 * q4 + r];
#define GM_DEC(idx_) const int n_ = (idx_) & 127, h = ((idx_) >> 7) & 3, b = (idx_) >> 9; const int rowbase = b * TB + n_ * 64; \
    const size_t itemF = (size_t)((b * 4 + h) * 2 + 0) * GLA_S + 4 + n_, itemB = (size_t)((b * 4 + h) * 2 + 1) * GLA_S + 4 + (127 - n_); (void)itemF; (void)itemB
#define GM_LOAD(idx_) do { GM_DEC(idx_); \
        _Pragma("unroll") for (int i = 0; i < 2; ++i) { const int n = tid + 512 * i; vraw[i] = *(const v4u*)(P + (size_t)(rowbase + (n >> 4)) * PW + PC_GV + h * 128 + (n & 15) * 8); } \
        { const size_t ro = (size_t)(rowbase + c) * PW + h * 64 + ch * 8; kraw = *(const v4u*)(P + ro + PC_GK); qraw = *(const v4u*)(P + ro + PC_GQ); } \
        _Pragma("unroll") for (int dd = 0; dd < 2; ++dd) { \
            _Pragma("unroll") for (int i = 0; i < 2; ++i) lowr[dd][i] = *(const v4u*)(P + (size_t)(rowbase + 16 * (2 * half + i) + l15) * PW + PC_LOW + dd * 16 + (q4 & 1) * 8); \
            _Pragma("unroll") for (int j = 0; j < 8; ++j) wdr[dd][j] = w_decay[(dd * 16 + 8 * (q4 & 1) + j) * 256 + h * 64 + 16 * dt + l15]; \
            bdr[dd] = b_decay[dd * 256 + h * 64 + 16 * dt + l15]; \
            _Pragma("unroll") for (int ks = 0; ks < 2; ++ks) xsn[dd][ks] = *(const bf16x8*)(Ubuf + (dd ? itemB : itemF) * 8192 + (16 * w + l15) * 64 + 8 * q4 + 32 * ks); } \
        _Pragma("unroll") for (int it = 0; it < 4; ++it) g6r[it] = *(const v2u*)(P + (size_t)(rowbase + 16 * it + l15) * PW + PC_G6 + h * 128 + 16 * w + 4 * q4); } while (0)
    if (tid == 0) nxtL[0] = __hip_atomic_fetch_add(ctr, 1u, __ATOMIC_RELAXED, __HIP_MEMORY_SCOPE_AGENT);
    __syncthreads(); int idx = (int)nxtL[0]; __syncthreads();
    if (idx < NV) GM_LOAD(idx);
    for (; idx < NV;) {
        if (tid == 0) nxtL[0] = __hip_atomic_fetch_add(ctr, 1u, __ATOMIC_RELAXED, __HIP_MEMORY_SCOPE_AGENT);
        GM_DEC(idx);
#pragma unroll
        for (int i = 0; i < 2; ++i) { const int n = tid + 512 * i; *(LAS v4u*)(vL + (n >> 4) * VS + (n & 15) * 8) = vraw[i]; }
        float kf[8], qf[8];
        kf[0] = pg8::bflo(kraw.x); kf[1] = pg8::bfhi(kraw.x); kf[2] = pg8::bflo(kraw.y); kf[3] = pg8::bfhi(kraw.y); kf[4] = pg8::bflo(kraw.z); kf[5] = pg8::bfhi(kraw.z); kf[6] = pg8::bflo(kraw.w); kf[7] = pg8::bfhi(kraw.w);
        qf[0] = pg8::bflo(qraw.x); qf[1] = pg8::bfhi(qraw.x); qf[2] = pg8::bflo(qraw.y); qf[3] = pg8::bfhi(qraw.y); qf[4] = pg8::bflo(qraw.z); qf[5] = pg8::bfhi(qraw.z); qf[6] = pg8::bflo(qraw.w); qf[7] = pg8::bfhi(qraw.w);
        float bv[2][2][4], tot[2][2];
#pragma unroll
        for (int dd = 0; dd < 2; ++dd) { bf16x8 yv;
#pragma unroll
            for (int j = 0; j < 8; ++j) { const unsigned hb = f2bf(wdr[dd][j]); const unsigned lb = f2bf(wdr[dd][j] - __uint_as_float(hb << 16)); yv[j] = (short)(q4 < 2 ? hb : lb); }
#pragma unroll
            for (int ii = 0; ii < 2; ++ii) { const int i = dd ? 1 - ii : ii;
                f32x4 z = {0.f, 0.f, 0.f, 0.f}; z = __builtin_amdgcn_mfma_f32_16x16x32_bf16(__builtin_bit_cast(bf16x8, lowr[dd][i]), yv, z, 0, 0, 0);
                float g[4];
#pragma unroll
                for (int r = 0; r < 4; ++r) { const float zz = z[r] + bdr[dd]; g[r] = (fminf(zz, 0.f) - __logf(1.f + __expf(-fabsf(zz)))) * (1.f / 16.f); }
                float run = 0.f;
                if (dd == 0) {
#pragma unroll
                    for (int r = 0; r < 4; ++r) { run += g[r]; bv[dd][i][r] = run; }
                    float sc = run; float t = __shfl_up(sc, 16); if (q4 >= 1) sc += t; t = __shfl_up(sc, 32); if (q4 >= 2) sc += t;
                    const float excl = sc - run; tot[dd][i] = __shfl(sc, 48 + l15);
#pragma unroll
                    for (int r = 0; r < 4; ++r) bv[dd][i][r] += excl + (i ? tot[dd][0] : 0.f);
                } else {
#pragma unroll
                    for (int r = 3; r >= 0; --r) { run += g[r]; bv[dd][i][r] = run; }
                    float sc = run; float t = __shfl_down(sc, 16); if (q4 <= 2) sc += t; t = __shfl_down(sc, 32); if (q4 <= 1) sc += t;
                    const float excl = sc - run; tot[dd][i] = __shfl(sc, l15);
#pragma unroll
                    for (int r = 0; r < 4; ++r) bv[dd][i][r] += excl + (i ? 0.f : tot[dd][1]);
                } }
            if (q4 == 0) segT[(dd * 2 + half) * 64 + 16 * dt + l15] = tot[dd][0] + tot[dd][1]; }
        __syncthreads();
        { const float otherF = segT[(0 * 2 + (1 - half)) * 64 + 16 * dt + l15], otherB = segT[(1 * 2 + (1 - half)) * 64 + 16 * dt + l15];
          const float addF = half ? otherF : 0.f, addB = half ? 0.f : otherB;
#pragma unroll
          for (int i = 0; i < 2; ++i)
#pragma unroll
              for (int r = 0; r < 4; ++r) { const int tok = 16 * (2 * half + i) + 4 * q4 + r; bF[tok * BS + 16 * dt + l15] = bv[0][i][r] + addF; bB[tok * BS + 16 * dt + l15] = bv[1][i][r] + addB; } }
        __syncthreads();
        const int nidx = (int)nxtL[0];
        { const f32x4 f0 = *(const LAS f32x4*)(bF + c * BS + 8 * ch), f1 = *(const LAS f32x4*)(bF + c * BS + 8 * ch + 4), r0 = *(const LAS f32x4*)(bB + c * BS + 8 * ch), r1 = *(const LAS f32x4*)(bB + c * BS + 8 * ch + 4);
          const float bf_[8] = {f0[0], f0[1], f0[2], f0[3], f1[0], f1[1], f1[2], f1[3]}, bb_[8] = {r0[0], r0[1], r0[2], r0[3], r1[0], r1[1], r1[2], r1[3]};
          float a_[8], b_[8];
#pragma unroll
          for (int k = 0; k < 8; ++k) { a_[k] = qf[k] * __expf(bf_[k]) * 0.125f; b_[k] = kf[k] * __expf(-bf_[k]); }
          v4u o; o.x = pk2(a_[0], a_[1]); o.y = pk2(a_[2], a_[3]); o.z = pk2(a_[4], a_[5]); o.w = pk2(a_[6], a_[7]); *(LAS v4u*)(qeF + c * GS + 8 * ch) = o;
          o.x = pk2(b_[0], b_[1]); o.y = pk2(b_[2], b_[3]); o.z = pk2(b_[4], b_[5]); o.w = pk2(b_[6], b_[7]); *(LAS v4u*)(keF + c * GS + 8 * ch) = o;
#pragma unroll
          for (int k = 0; k < 8; ++k) { a_[k] = qf[k] * __expf(bb_[k]) * 0.125f; b_[k] = kf[k] * __expf(-bb_[k]); }
          o.x = pk2(a_[0], a_[1]); o.y = pk2(a_[2], a_[3]); o.z = pk2(a_[4], a_[5]); o.w = pk2(a_[6], a_[7]); *(LAS v4u*)(qeB + c * GS + 8 * ch) = o;
          o.x = pk2(b_[0], b_[1]); o.y = pk2(b_[2], b_[3]); o.z = pk2(b_[4], b_[5]); o.w = pk2(b_[6], b_[7]); *(LAS v4u*)(keB + c * GS + 8 * ch) = o; }
        bf16x8 xs[2][2]; v2u g6c[4];
#pragma unroll
        for (int dd = 0; dd < 2; ++dd) { xs[dd][0] = xsn[dd][0]; xs[dd][1] = xsn[dd][1]; }
#pragma unroll
        for (int it = 0; it < 4; ++it) g6c[it] = g6r[it];
        if (nidx < NV) GM_LOAD(nidx);
        __syncthreads();
        { const int it = w >> 1;
#pragma unroll
          for (int jj = 0; jj < 2; ++jj) { const int jt = (w & 1) * 2 + jj; f32x4 acc = {0.f, 0.f, 0.f, 0.f}; const int i = 16 * it + l15, j0 = 16 * jt + 4 * q4;
              if (jt <= it) { f32x4 af = {0.f, 0.f, 0.f, 0.f};
#pragma unroll
                  for (int ks = 0; ks < 2; ++ks) { const bf16x8 x = *(const LAS bf16x8*)(keF + (16 * jt + l15) * GS + 8 * q4 + 32 * ks), y = *(const LAS bf16x8*)(qeF + (16 * it + l15) * GS + 8 * q4 + 32 * ks);
                      af = __builtin_amdgcn_mfma_f32_16x16x32_bf16(x, y, af, 0, 0, 0); }
#pragma unroll
                  for (int r = 0; r < 4; ++r) acc[r] += (j0 + r <= i) ? af[r] : 0.f; }
              if (jt >= it) { f32x4 ab = {0.f, 0.f, 0.f, 0.f};
#pragma unroll
                  for (int ks = 0; ks < 2; ++ks) { const bf16x8 x = *(const LAS bf16x8*)(keB + (16 * jt + l15) * GS + 8 * q4 + 32 * ks), y = *(const LAS bf16x8*)(qeB + (16 * it + l15) * GS + 8 * q4 + 32 * ks);
                      ab = __builtin_amdgcn_mfma_f32_16x16x32_bf16(x, y, ab, 0, 0, 0); }
#pragma unroll
                  for (int r = 0; r < 4; ++r) acc[r] += (j0 + r >= i) ? ab[r] : 0.f; }
              v2u o; o.x = pk2(acc[0], acc[1]); o.y = pk2(acc[2], acc[3]);
              *(LAS v2u*)(AL + (16 * it + l15) * GS + 16 * jt + 4 * q4) = o; } }
        bf16x8 xv[2];
#pragma unroll
        for (int ks = 0; ks < 2; ++ks) xv[ks] = tr_frag(vL, VS, 16 * w, ks, q4, qq, p3);
        __syncthreads();
        f32x4 oacc[4]; float ssq[4];
#pragma unroll
        for (int it = 0; it < 4; ++it) { f32x4 acc = {0.f, 0.f, 0.f, 0.f};
#pragma unroll
            for (int ks = 0; ks < 2; ++ks) { const bf16x8 y = *(const LAS bf16x8*)(AL + (16 * it + l15) * GS + 8 * q4 + 32 * ks); acc = __builtin_amdgcn_mfma_f32_16x16x32_bf16(xv[ks], y, acc, 0, 0, 0); }
#pragma unroll
            for (int ks = 0; ks < 2; ++ks) { const bf16x8 y = *(const LAS bf16x8*)(qeF + (16 * it + l15) * GS + 8 * q4 + 32 * ks); acc = __builtin_amdgcn_mfma_f32_16x16x32_bf16(xs[0][ks], y, acc, 0, 0, 0); }
#pragma unroll
            for (int ks = 0; ks < 2; ++ks) { const bf16x8 y = *(const LAS bf16x8*)(qeB + (16 * it + l15) * GS + 8 * q4 + 32 * ks); acc = __builtin_amdgcn_mfma_f32_16x16x32_bf16(xs[1][ks], y, acc, 0, 0, 0); }
            oacc[it] = acc; float sq = (acc[0] * acc[0] + acc[1] * acc[1]) + (acc[2] * acc[2] + acc[3] * acc[3]);
            sq += __shfl_xor(sq, 16); sq += __shfl_xor(sq, 32); ssq[it] = sq;
            if (q4 == 0) red[w * 64 + 16 * it + l15] = sq; }
        __syncthreads();
#pragma unroll
        for (int it = 0; it < 4; ++it) { float tsum = 0.f;
#pragma unroll
            for (int w2 = 0; w2 < 8; ++w2) tsum += red[w2 * 64 + 16 * it + l15];
            const float rstd = 1.f / sqrtf(tsum * (1.f / 128.f) + EPS);
            const float gq_[4] = {pg8::bflo(g6c[it].x), pg8::bfhi(g6c[it].x), pg8::bflo(g6c[it].y), pg8::bfhi(g6c[it].y)};
            float y[4];
#pragma unroll
            for (int r = 0; r < 4; ++r) y[r] = oacc[it][r] * rstd * gg4[r] * silu_f(gq_[r]);
            v2u o; o.x = pk2(y[0], y[1]); o.y = pk2(y[2], y[3]);
            *(v2u*)(OUT + (size_t)(rowbase + 16 * it + l15) * 512 + h * 128 + 16 * w + 4 * q4) = o; }
        __syncthreads();
        idx = nidx;
    }
#undef GM_DEC
#undef GM_LOAD
}

__device__ __forceinline__ void gla_pass1m(LAS unsigned char* lds, const bf16* P, const float* w_decay, const float* b_decay, bf16* Ubuf, float* dn, unsigned* ctr) {
    const int tid = opaque_tid(), lane = tid & 63, w = __builtin_amdgcn_readfirstlane(tid >> 6), l15 = lane & 15, q4 = lane >> 4, qq = (lane & 15) >> 2, p3 = lane & 3;
    constexpr int NV = 8 * 4 * 132;
    LAS bf16* klF = (LAS bf16*)(lds + GM_QEF); LAS bf16* klB = (LAS bf16*)(lds + GM_KEF); LAS bf16* vL = (LAS bf16*)(lds + GM_V);
    LAS float* bF = (LAS float*)(lds + GM_BF); LAS float* bB = (LAS float*)(lds + GM_BB); LAS float* segT = (LAS float*)(lds + GM_SEG);
    volatile LAS unsigned* nxtL = (volatile LAS unsigned*)(lds + GM_NXT);
    const int c = tid >> 3, ch = tid & 7, dt = w & 3, half = w >> 2;
    v4u vraw[2], kraw, lowr[2][2]; float wdr[2][8]; float bdr[2];
#define G1_DEC(idx_) const int p_ = (idx_) % 132, bh_ = (idx_) / 132, h = bh_ & 3, b = bh_ >> 2; const int rowbase = b * TB + (p_ < 4 ? TL + p_ * 64 : (p_ - 4) * 64); \
    const size_t itemF = (size_t)(bh_ * 2 + 0) * GLA_S + p_, itemB = (size_t)(bh_ * 2 + 1) * GLA_S + (p_ < 4 ? 3 - p_ : 135 - p_); (void)itemF; (void)itemB
#define G1_LOAD(idx_) do { G1_DEC(idx_); \
        _Pragma("unroll") for (int i = 0; i < 2; ++i) { const int n = tid + 512 * i; vraw[i] = *(const v4u*)(P + (size_t)(rowbase + (n >> 4)) * PW + PC_GV + h * 128 + (n & 15) * 8); } \
        kraw = *(const v4u*)(P + (size_t)(rowbase + c) * PW + h * 64 + ch * 8 + PC_GK); \
        _Pragma("unroll") for (int dd = 0; dd < 2; ++dd) { \
            _Pragma("unroll") for (int i = 0; i < 2; ++i) lowr[dd][i] = *(const v4u*)(P + (size_t)(rowbase + 16 * (2 * half + i) + l15) * PW + PC_LOW + dd * 16 + (q4 & 1) * 8); \
            _Pragma("unroll") for (int j = 0; j < 8; ++j) wdr[dd][j] = w_decay[(dd * 16 + 8 * (q4 & 1) + j) * 256 + h * 64 + 16 * dt + l15]; \
            bdr[dd] = b_decay[dd * 256 + h * 64 + 16 * dt + l15]; } } while (0)
    if (tid == 0) nxtL[0] = __hip_atomic_fetch_add(ctr, 1u, __ATOMIC_RELAXED, __HIP_MEMORY_SCOPE_AGENT);
    __syncthreads(); int idx = (int)nxtL[0]; __syncthreads();
    if (idx < NV) G1_LOAD(idx);
    for (; idx < NV;) {
        if (tid == 0) nxtL[0] = __hip_atomic_fetch_add(ctr, 1u, __ATOMIC_RELAXED, __HIP_MEMORY_SCOPE_AGENT);
        G1_DEC(idx);
#pragma unroll
        for (int i = 0; i < 2; ++i) { const int n = tid + 512 * i; *(LAS v4u*)(vL + (n >> 4) * VS + (n & 15) * 8) = vraw[i]; }
        float kf[8];
        kf[0] = pg8::bflo(kraw.x); kf[1] = pg8::bfhi(kraw.x); kf[2] = pg8::bflo(kraw.y); kf[3] = pg8::bfhi(kraw.y); kf[4] = pg8::bflo(kraw.z); kf[5] = pg8::bfhi(kraw.z); kf[6] = pg8::bflo(kraw.w); kf[7] = pg8::bfhi(kraw.w);
        float bv[2][2][4], tot[2][2];
#pragma unroll
        for (int dd = 0; dd < 2; ++dd) { bf16x8 yv;
#pragma unroll
            for (int j = 0; j < 8; ++j) { const unsigned hb = f2bf(wdr[dd][j]); const unsigned lb = f2bf(wdr[dd][j] - __uint_as_float(hb << 16)); yv[j] = (short)(q4 < 2 ? hb : lb); }
#pragma unroll
            for (int ii = 0; ii < 2; ++ii) { const int i = dd ? 1 - ii : ii;
                f32x4 z = {0.f, 0.f, 0.f, 0.f}; z = __builtin_amdgcn_mfma_f32_16x16x32_bf16(__builtin_bit_cast(bf16x8, lowr[dd][i]), yv, z, 0, 0, 0);
                float g[4];
#pragma unroll
                for (int r = 0; r < 4; ++r) { const float zz = z[r] + bdr[dd]; g[r] = (fminf(zz, 0.f) - __logf(1.f + __expf(-fabsf(zz)))) * (1.f / 16.f); }
                float run = 0.f;
                if (dd == 0) {
#pragma unroll
                    for (int r = 0; r < 4; ++r) { run += g[r]; bv[dd][i][r] = run; }
                    float sc = run; float t = __shfl_up(sc, 16); if (q4 >= 1) sc += t; t = __shfl_up(sc, 32); if (q4 >= 2) sc += t;
                    const float excl = sc - run; tot[dd][i] = __shfl(sc, 48 + l15);
#pragma unroll
                    for (int r = 0; r < 4; ++r) bv[dd][i][r] += excl + (i ? tot[dd][0] : 0.f);
                } else {
#pragma unroll
                    for (int r = 3; r >= 0; --r) { run += g[r]; bv[dd][i][r] = run; }
                    float sc = run; float t = __shfl_down(sc, 16); if (q4 <= 2) sc += t; t = __shfl_down(sc, 32); if (q4 <= 1) sc += t;
                    const float excl = sc - run; tot[dd][i] = __shfl(sc, l15);
#pragma unroll
                    for (int r = 0; r < 4; ++r) bv[dd][i][r] += excl + (i ? 0.f : tot[dd][1]);
                } }
            if (q4 == 0) segT[(dd * 2 + half) * 64 + 16 * dt + l15] = tot[dd][0] + tot[dd][1]; }
        __syncthreads();
        { const float otherF = segT[(0 * 2 + (1 - half)) * 64 + 16 * dt + l15], otherB = segT[(1 * 2 + (1 - half)) * 64 + 16 * dt + l15];
          const float addF = half ? otherF : 0.f, addB = half ? 0.f : otherB;
#pragma unroll
          for (int i = 0; i < 2; ++i)
#pragma unroll
              for (int r = 0; r < 4; ++r) { const int tok = 16 * (2 * half + i) + 4 * q4 + r; bF[tok * BS + 16 * dt + l15] = bv[0][i][r] + addF; bB[tok * BS + 16 * dt + l15] = bv[1][i][r] + addB; } }
        __syncthreads();
        const int nidx = (int)nxtL[0];
        { const f32x4 f0 = *(const LAS f32x4*)(bF + c * BS + 8 * ch), f1 = *(const LAS f32x4*)(bF + c * BS + 8 * ch + 4), r0 = *(const LAS f32x4*)(bB + c * BS + 8 * ch), r1 = *(const LAS f32x4*)(bB + c * BS + 8 * ch + 4);
          const f32x4 tf0 = *(const LAS f32x4*)(bF + 63 * BS + 8 * ch), tf1 = *(const LAS f32x4*)(bF + 63 * BS + 8 * ch + 4), tb0 = *(const LAS f32x4*)(bB + 8 * ch), tb1 = *(const LAS f32x4*)(bB + 8 * ch + 4);
          const float bf_[8] = {f0[0], f0[1], f0[2], f0[3], f1[0], f1[1], f1[2], f1[3]}, bb_[8] = {r0[0], r0[1], r0[2], r0[3], r1[0], r1[1], r1[2], r1[3]};
          const float tF[8] = {tf0[0], tf0[1], tf0[2], tf0[3], tf1[0], tf1[1], tf1[2], tf1[3]}, tB[8] = {tb0[0], tb0[1], tb0[2], tb0[3], tb1[0], tb1[1], tb1[2], tb1[3]};
          float a_[8];
#pragma unroll
          for (int k = 0; k < 8; ++k) a_[k] = kf[k] * __expf(tF[k] - bf_[k]);
          v4u o; o.x = pk2(a_[0], a_[1]); o.y = pk2(a_[2], a_[3]); o.z = pk2(a_[4], a_[5]); o.w = pk2(a_[6], a_[7]); *(LAS v4u*)(klF + c * GS + 8 * ch) = o;
#pragma unroll
          for (int k = 0; k < 8; ++k) a_[k] = kf[k] * __expf(tB[k] - bb_[k]);
          o.x = pk2(a_[0], a_[1]); o.y = pk2(a_[2], a_[3]); o.z = pk2(a_[4], a_[5]); o.w = pk2(a_[6], a_[7]); *(LAS v4u*)(klB + c * GS + 8 * ch) = o;
          if (tid < 8) { f32x4* dp = (f32x4*)(dn + itemF * 64 + 8 * ch); dp[0] = (f32x4){__expf(tF[0]), __expf(tF[1]), __expf(tF[2]), __expf(tF[3])}; dp[1] = (f32x4){__expf(tF[4]), __expf(tF[5]), __expf(tF[6]), __expf(tF[7])};
              f32x4* dq = (f32x4*)(dn + itemB * 64 + 8 * ch); dq[0] = (f32x4){__expf(tB[0]), __expf(tB[1]), __expf(tB[2]), __expf(tB[3])}; dq[1] = (f32x4){__expf(tB[4]), __expf(tB[5]), __expf(tB[6]), __expf(tB[7])}; } }
        if (nidx < NV) G1_LOAD(nidx);
        __syncthreads();
        { bf16x8 y[2];
#pragma unroll
          for (int ks = 0; ks < 2; ++ks) y[ks] = tr_frag(vL, VS, 16 * w, ks, q4, qq, p3);
#pragma unroll
          for (int dt2 = 0; dt2 < 4; ++dt2) { f32x4 accF = {0.f, 0.f, 0.f, 0.f}, accB = {0.f, 0.f, 0.f, 0.f};
#pragma unroll
              for (int ks = 0; ks < 2; ++ks) { const bf16x8 xf = tr_frag(klF, GS, 16 * dt2, ks, q4, qq, p3), xb = tr_frag(klB, GS, 16 * dt2, ks, q4, qq, p3);
                  accF = __builtin_amdgcn_mfma_f32_16x16x32_bf16(xf, y[ks], accF, 0, 0, 0); accB = __builtin_amdgcn_mfma_f32_16x16x32_bf16(xb, y[ks], accB, 0, 0, 0); }
              v2u o; o.x = pk2(accF[0], accF[1]); o.y = pk2(accF[2], accF[3]);
              *(v2u*)(Ubuf + itemF * 8192 + (16 * w + l15) * 64 + 16 * dt2 + 4 * q4) = o;
              o.x = pk2(accB[0], accB[1]); o.y = pk2(accB[2], accB[3]);
              *(v2u*)(Ubuf + itemB * 8192 + (16 * w + l15) * 64 + 16 * dt2 + 4 * q4) = o; } }
        __syncthreads();
        idx = nidx;
    }
#undef G1_DEC
#undef G1_LOAD
}

struct Args { const float* in[19]; float* out; unsigned char* ws; };
__global__ void __launch_bounds__(NTHR, 2) mk_fwd(Args args) {
    extern __shared__ __attribute__((aligned(16))) unsigned char lds_raw[];
    cg::grid_group grid = cg::this_grid();
    LAS unsigned char* lds = (LAS unsigned char*)lds_raw;
    const int G = gridDim.x, bx = blockIdx.x, NGW = G * NWAVES;
    unsigned long long pacc = 0ull, pt0 = 0ull; (void)pt0;
#define PB(k) do { if ((PROBE_MASK >> (k)) & 1ull) pt0 = __builtin_amdgcn_s_memrealtime(); } while (0)
#define PE(k) do { if ((PROBE_MASK >> (k)) & 1ull) pacc += __builtin_amdgcn_s_memrealtime() - pt0; } while (0)
#define GSYNC() do { xcd_barrier(xbar); if (PROBE_SYNC) { const unsigned long long t_ = __builtin_amdgcn_s_memrealtime(); xcd_barrier(xbar); pacc += __builtin_amdgcn_s_memrealtime() - t_; } } while (0)
#define PH_IDS const int tid = opaque_tid(), lane = tid & 63, wave = __builtin_amdgcn_readfirstlane(tid >> 6), gw = bx * NWAVES + wave; (void)lane; (void)gw
    unsigned char* ws = args.ws;
    const float* x = args.in[0]; const float* cvec = args.in[1]; const float* ctx = args.in[2]; const float* c_ctx = args.in[3]; const float* w_mod = args.in[4]; const float* b_mod = args.in[5];
    const float* g_norm = args.in[6]; const float* w_up = args.in[7]; const float* w_down = args.in[8]; const float* w_in = args.in[9]; const float* g_q = args.in[10]; const float* g_k = args.in[11];
    const float* w_decay = args.in[12]; const float* b_decay = args.in[13]; const float* g_gla = args.in[14]; const float* w_branch = args.in[15]; const float* b_gate = args.in[16]; const float* w_out = args.in[17]; const float* g_final = args.in[18];
    float* H = args.out;
    float* HC = (float*)(ws + WS_HCTX);
    float* mod = (float*)(ws + WS_MOD); float* dn = (float*)(ws + WS_DN);
    bf16* Wup1 = (bf16*)(ws + WS_WUP1); bf16* Wup2 = (bf16*)(ws + WS_WUP2); bf16* Wdn1 = (bf16*)(ws + WS_WDN1); bf16* Wdn2 = (bf16*)(ws + WS_WDN2); bf16* Win = (bf16*)(ws + WS_WIN);
    bf16* Wbr0 = (bf16*)(ws + WS_WBR0); bf16* Wbr1 = (bf16*)(ws + WS_WBR1); bf16* Wout = (bf16*)(ws + WS_WOUT);
    bf16* XN = (bf16*)(ws + WS_XN); bf16* OF = (bf16*)(ws + WS_OF); bf16* OB = (bf16*)(ws + WS_OB); bf16* PA = (bf16*)(ws + WS_A);
    bf16* HID = PA; bf16* Ubuf = XN; bf16* Z = XN;
    float* ssq1 = (float*)(ws + WS_SSQ1); float* ssq2 = (float*)(ws + WS_SSQ2); float* sW1 = (float*)(ws + WS_SW1); float* sW2 = (float*)(ws + WS_SW2);
    bf16* XN2 = OF;

    volatile LAS unsigned* xst = (volatile LAS unsigned*)(lds + LDS_BYTES - 64);
    if (threadIdx.x < 2) xst[threadIdx.x] = 0u;
    unsigned* barw = (unsigned*)ws;
    if (bx == 0) for (int i = threadIdx.x; i < XCD_BAR_WORDS + 128; i += NTHR) __hip_atomic_store(barw + i, 0u, __ATOMIC_RELAXED, __HIP_MEMORY_SCOPE_AGENT);
    XcdBarrier xbar; xbar.bar = barw; xbar.x = 0; xbar.st = xst;
    PB(0);
    {
        PH_IDS;
        LAS float* sc = (LAS float*)lds; LAS float* red = sc + 9 * 1024;
        for (int idx = tid; idx < 9 * 1024; idx += NTHR) { const int j = idx >> 10, k = idx & 1023; const float v = j < 8 ? cvec[j * 1024 + k] : c_ctx[k]; sc[idx] = silu_f(v); }
        __syncthreads();
        for (int it = bx; it < NMOD / 32; it += G) {
            const int cc = tid & 31, ks = tid >> 5, col = it * 32 + cc;
            float a[9];
#pragma unroll
            for (int j = 0; j < 9; ++j) a[j] = 0.f;
#pragma unroll 4
            for (int kk = 0; kk < 64; ++kk) { const int k = ks * 64 + kk; const float wv = w_mod[(size_t)k * NMOD + col];
#pragma unroll
                for (int j = 0; j < 9; ++j) a[j] += sc[j * 1024 + k] * wv; }
#pragma unroll
            for (int j = 0; j < 9; ++j) red[(ks * 9 + j) * 32 + cc] = a[j];
            __syncthreads();
            if (tid < 288) { const int j = tid >> 5, c2 = tid & 31; float s = b_mod[it * 32 + c2];
#pragma unroll
                for (int k2 = 0; k2 < 16; ++k2) s += red[(k2 * 9 + j) * 32 + c2];
                mod[(size_t)j * NMOD + it * 32 + c2] = s; }
            __syncthreads();
        }
        LAS float* scr = (LAS float*)(lds + 65536) + wave * 2176;
        constexpr int I_UP = 16 * 176, I_DN = 44 * 32;
        for (int it = gw; it < I_UP + I_DN; it += NGW) {
            int r = it;
            if (r < I_UP) { const int kb = r / 176, nb = r % 176; transpose_item(w_up, 1024, 5632, Wup1, 64 * kb, 32 * nb, up_dest(32 * nb), scr, lane); continue; } r -= I_UP;
            { const int kb = r / 32, nb = r % 32; transpose_item(w_down, DFF, 1024, Wdn1, 64 * kb, 32 * nb, 32 * nb, scr, lane); }
        }
        for (int i = bx * NTHR + tid; i < 224 * 1024 / 8; i += G * NTHR) ((v4u*)(Win + (size_t)4384 * 1024))[i] = (v4u){0u, 0u, 0u, 0u};
        for (int i = bx * NTHR + tid; i < MR; i += G * NTHR) { ssq1[i] = 0.f; ssq2[i] = 0.f; }
    }
    grid.sync();
    xbar.x = xb_xcc_id(); if (threadIdx.x == 0) xst[2] = xb_add(&barw[XB_XCNT(xbar.x)], 1u);
    PE(0); PB(1);
    { PH_IDS; norm_mod_rows(x, ctx, mod, g_norm + 0 * DM, 0, XN, true, gw, NGW, lane);
    }
    GSYNC(); PE(1); PB(2);
    if (threadIdx.x == 0) { bool uni = (xbar.x < 8u) && ((G & 7) == 0);
        for (unsigned j = 0; j < 16; ++j) { const unsigned cnt_ = xb_ld(&barw[XB_XCNT(j)]); uni = uni && (cnt_ == (j < 8u ? (unsigned)(G >> 3) : 0u)); }
        xst[3] = uni ? (xst[2] * 8u + xbar.x) : (unsigned)bx; }
    __syncthreads();
    const int vb = (int)xst[3];
    { pg8::Gemm g{XN, Wup1, MR, 5632, 1024, 1024, 1024}; pg8::StaticOrder S; S.init(MR, 5632, G, vb);
      pg8::EpiSwiglu E{HID, DFF}; pg8::gemm_phase<pg8::EpiSwiglu, pg8::StaticOrder, true, true>(lds, g, S, E); }
    { PH_IDS;
      const int rem_ = (264 * 22) % G, ir_ = rem_ ? vb - rem_ : vb, ni_ = rem_ ? G - rem_ : G;
      if (ir_ >= 0) {
      LAS float* sc = (LAS float*)lds; LAS float* red = sc + 9 * 1024;
      for (int it = ir_; it < 144 + 176; it += ni_) {
          const bool second = it >= 144; const int n0 = (second ? it - 144 : it) * 32; const int sub = second ? 2 : 1;
          __syncthreads();
          for (int idx = tid; idx < 9 * 1024; idx += NTHR) sc[idx] = mod[(size_t)(idx >> 10) * NMOD + (3 * sub) * DM + (idx & 1023)];
          __syncthreads();
          const int cc = tid & 31, ks = tid >> 5, nd = n0 + cc; int nsrc; const float* Wp; int ldw;
          if (!second) { Wp = w_in; ldw = 4384; nsrc = nd < 2304 ? nd : (nd < 4352 ? nd + 32 : (nd < 4384 ? nd - 2048 : -1)); }
          else { Wp = w_up + (size_t)1024 * 5632; ldw = 5632; const int tile = nd >> 8, within = nd & 255; nsrc = within < 128 ? 128 * tile + within : DFF + 128 * tile + (within - 128); }
          float a[9];
#pragma unroll
          for (int j = 0; j < 9; ++j) a[j] = 0.f;
          if (nsrc >= 0) {
#pragma unroll 4
              for (int kk = 0; kk < 64; ++kk) { const int k = ks * 64 + kk; const float wv = Wp[(size_t)k * ldw + nsrc];
#pragma unroll
                  for (int j = 0; j < 9; ++j) a[j] += sc[j * 1024 + k] * wv; } }
#pragma unroll
          for (int j = 0; j < 9; ++j) red[(ks * 9 + j) * 32 + cc] = a[j];
          __syncthreads();
          if (tid < 288) { const int j = tid >> 5, c2 = tid & 31; float sum = 0.f;
#pragma unroll
              for (int k2 = 0; k2 < 16; ++k2) sum += red[(k2 * 9 + j) * 32 + c2];
              (second ? sW2 + (size_t)j * 5632 : sW1 + (size_t)j * PW)[n0 + c2] = sum; }
      }
      __syncthreads(); } }
    GSYNC(); PE(2); PB(3);
    { pg8::Gemm g{HID, Wdn1, MR, 1024, DFF, DFF, DFF}; pg8::StaticOrder S; S.init(MR, 1024, G, vb);
      pg8::EpiRes<1, 2, 1, 1> E{x, ctx, H, HC, mod, g_norm + 1 * DM, XN, ssq1}; pg8::gemm_phase<pg8::EpiRes<1, 2, 1, 1>, pg8::StaticOrder, true, true>(lds, g, S, E); }
    { PH_IDS;
      const int rem = (264 * 4) % G, ir = rem ? vb - rem : vb, ni = rem ? G - rem : G;
      if (ir >= 0) {
          LAS float* scr = (LAS float*)(lds + 65536) + wave * 2176;
          constexpr int I_UP = 16 * 176, I_DN = 44 * 32, I_IN = 16 * 137, I_BR = 8 * 32, I_OUT = 16 * 32;
          constexpr int NITEMS = I_UP + I_DN + I_IN + 2 * I_BR + I_OUT;
          for (int it = ir * NWAVES + wave; it < NITEMS; it += ni * NWAVES) {
              int r = it;
              if (r < I_UP) { const int kb = r / 176, nb = r % 176; transpose_item(w_up + (size_t)1024 * 5632, 1024, 5632, Wup2, 64 * kb, 32 * nb, up_dest(32 * nb), scr, lane); continue; } r -= I_UP;
              if (r < I_DN) { const int kb = r / 32, nb = r % 32; transpose_item(w_down + (size_t)DFF * 1024, DFF, 1024, Wdn2, 64 * kb, 32 * nb, 32 * nb, scr, lane); continue; } r -= I_DN;
              if (r < I_IN) { const int kb = r / 137, nb = r % 137; transpose_item(w_in, 1024, 4384, Win, 64 * kb, 32 * nb, win_dest(32 * nb), scr, lane); continue; } r -= I_IN;
              if (r < 2 * I_BR) { const int l = r / I_BR; r %= I_BR; const int kb = r / 32, nb = r % 32; transpose_item(w_branch + (size_t)l * 512 * 1024, 512, 1024, l ? Wbr1 : Wbr0, 64 * kb, 32 * nb, 32 * nb, scr, lane); continue; } r -= 2 * I_BR;
              { const int kb = r / 32, nb = r % 32; transpose_item(w_out, 1024, 1024, Wout, 64 * kb, 32 * nb, 32 * nb, scr, lane); }
          }
      } }
    GSYNC(); PE(3); PB(4);
#if MK_STAGE >= 2
    { pg8::Gemm g{XN, Win, MR, PW, 1024, 1024, 1024}; pg8::StaticOrder S; S.init(MR, PW, G, vb);
      pg8::EpiInproj E{PA, PW, ssq1, sW1, PW}; pg8::gemm_phase<pg8::EpiInproj, pg8::StaticOrder, true, true>(lds, g, S, E); }
    GSYNC(); PE(4); PB(5);
    { PH_IDS;
      const int l7 = lane & 7, l3 = lane & 3; const bool is_hi = (lane & 4) != 0;
      float frq[8], gq8[8], gk8[8];
#pragma unroll
      for (int k = 0; k < 8; ++k) { frq[k] = __builtin_amdgcn_exp2f(-(float)(8 * (l3 & 1) + k) * (13.287712379549449f / 16.f)); gq8[k] = g_q[8 * l7 + k] * attn_body::C2; gk8[k] = g_k[8 * l7 + k]; }
      for (int r0 = gw * 4; r0 < MR; r0 += NGW * 4) {
          const int t0 = r0 % TB; const bool isctx = t0 >= TL;
          v4u qv[4], kv[4];
#pragma unroll
          for (int u = 0; u < 4; ++u) { bf16* rp = PA + (size_t)(r0 + u) * PW; qv[u] = (v4u){0u, 0u, 0u, 0u}; if (!isctx) qv[u] = *(const v4u*)(rp + lane * 8); kv[u] = *(const v4u*)(rp + PC_K + (lane & 15) * 8); }
#pragma unroll
          for (int u = 0; u < 4; ++u) { bf16* rp = PA + (size_t)(r0 + u) * PW; const int t = t0 + u;
              const float pos = (l3 < 2) ? (float)(t >> 6) : (float)(t & 63);
              float cs8[8], sn8[8];
#pragma unroll
              for (int k = 0; k < 8; ++k) { const float ang = pos * frq[k]; cs8[k] = isctx ? 1.f : __cosf(ang); sn8[k] = isctx ? 0.f : __sinf(ang); }
#pragma unroll
              for (int part = 0; part < 2; ++part) { const v4u raw = part ? kv[u] : qv[u];
                  float xv[8]; xv[0] = pg8::bflo(raw.x); xv[1] = pg8::bfhi(raw.x); xv[2] = pg8::bflo(raw.y); xv[3] = pg8::bfhi(raw.y); xv[4] = pg8::bflo(raw.z); xv[5] = pg8::bfhi(raw.z); xv[6] = pg8::bflo(raw.w); xv[7] = pg8::bfhi(raw.w);
                  float ss = 0.f;
#pragma unroll
                  for (int k = 0; k < 8; ++k) ss += xv[k] * xv[k];
                  ss += __shfl_xor(ss, 1); ss += __shfl_xor(ss, 2); ss += __shfl_xor(ss, 4);
                  const float rstd = 1.f / sqrtf(ss * (1.f / 64.f) + EPS);
                  float o[8];
#pragma unroll
                  for (int k = 0; k < 8; ++k) { const float y = xv[k] * rstd * (part ? gk8[k] : gq8[k]); const float py = __shfl_xor(y, 4);
                      o[k] = is_hi ? (py * sn8[k] + y * cs8[k]) : (y * cs8[k] - py * sn8[k]); }
                  v4u w4; w4.x = pk2(o[0], o[1]); w4.y = pk2(o[2], o[3]); w4.z = pk2(o[4], o[5]); w4.w = pk2(o[6], o[7]);
                  if (part == 0) { if (!isctx) *(v4u*)(rp + lane * 8) = w4; } else { if (lane < 16) *(v4u*)(rp + PC_K + lane * 8) = w4; } } } } }
    gla_pass1m(lds, PA, w_decay, b_decay, Ubuf, dn, barw + XCD_BAR_WORDS + 96);
    GSYNC(); PE(5); PB(6);
    { PH_IDS; const int tg = bx * NTHR + tid;
      for (int q = tg; q < 64 * 2048; q += G * NTHR) { const int chain = q >> 11, e4 = q & 2047; const int d0 = (4 * e4) & 63;
          f32x4 S = {0.f, 0.f, 0.f, 0.f};
          for (int s0 = 0; s0 < GLA_S; s0 += 12) { v2u ur[12]; f32x4 dv[12];
#pragma unroll
              for (int j = 0; j < 12; ++j) { const size_t item = (size_t)chain * GLA_S + s0 + j; ur[j] = (v2u){0u, 0u}; dv[j] = (f32x4){0.f, 0.f, 0.f, 0.f};
                  if (s0 + j < GLA_S - 1) { ur[j] = *(const v2u*)(Ubuf + item * 8192 + 4 * e4); dv[j] = *(const f32x4*)(dn + item * 64 + d0); } }
#pragma unroll
              for (int j = 0; j < 12; ++j) { const size_t item = (size_t)chain * GLA_S + s0 + j;
                  v2u o; o.x = pk2(S[0], S[1]); o.y = pk2(S[2], S[3]); *(v2u*)(Ubuf + item * 8192 + 4 * e4) = o;
                  S[0] = dv[j][0] * S[0] + __uint_as_float(ur[j].x << 16); S[1] = dv[j][1] * S[1] + __uint_as_float(ur[j].x & 0xffff0000u);
                  S[2] = dv[j][2] * S[2] + __uint_as_float(ur[j].y << 16); S[3] = dv[j][3] * S[3] + __uint_as_float(ur[j].y & 0xffff0000u); } } } }
    GSYNC(); PE(6); PB(7);
    bool fastsm;
    { const int l_ = opaque_tid() & 63; float gqm = fabsf(g_q[l_]), gkm = fabsf(g_k[l_]);
#pragma unroll
      for (int o = 1; o < 64; o <<= 1) { gqm = fmaxf(gqm, __shfl_xor(gqm, o)); gkm = fmaxf(gkm, __shfl_xor(gkm, o)); }
      fastsm = __builtin_amdgcn_readfirstlane((2.f * 11.5416f * gqm * gkm + 14.f < 100.f) ? 1 : 0) != 0; }
    { const attn_body::bf16* Qp = (const attn_body::bf16*)(PA + PC_Q); const attn_body::bf16* Kp = (const attn_body::bf16*)(PA + PC_K); const attn_body::bf16* Vp = (const attn_body::bf16*)(PA + PC_V);
      if ((G & 7) == 0) { const int b = vb & 7, ci = vb >> 3, nper = G >> 3;
          for (int idx = ci; idx < 256; idx += nper) { const int h = idx >> 5, qb = idx & 31;
              if (fastsm) attn_body::attn_unit<8, true>(b, h, h >> 2, qb, Qp, Kp, Vp, (attn_body::bf16*)(PA + PC_Q), (char*)lds_raw);
              else attn_body::attn_unit<8, false>(b, h, h >> 2, qb, Qp, Kp, Vp, (attn_body::bf16*)(PA + PC_Q), (char*)lds_raw); } }
      else { for (int u = vb; u < 2048; u += G) { const int b = u >> 8, h = (u >> 5) & 7, qb = u & 31; attn_body::attn_unit<8, false>(b, h, h >> 2, qb, Qp, Kp, Vp, (attn_body::bf16*)(PA + PC_Q), (char*)lds_raw); } }
    }
    __syncthreads();
    PE(7); PB(21);
    gla_pass3m(lds, PA, w_decay, b_decay, g_gla, Ubuf, OF, barw + XCD_BAR_WORDS + 64);
    PE(21); PB(8);
    GSYNC(); PE(8); PB(9);
    { pg8::Gemm g{PA + PC_Q, Wbr0, MR, 1024, 512, PW, 512}; pg8::StaticOrder S; S.init(NB * TL, 1024, G, vb, 1);
      pg8::EpiGate<0> E{PA, b_gate, Z}; pg8::gemm_phase<pg8::EpiGate<0>, pg8::StaticOrder, true, true>(lds, g, S, E); }
    __syncthreads();
    { pg8::Gemm g{OF, Wbr1, MR, 1024, 512, 512, 512}; pg8::StaticOrder S; S.init(NB * TL, 1024, G, vb, 1);
      pg8::EpiGate<1> E{PA, b_gate, Z}; pg8::gemm_phase<pg8::EpiGate<1>, pg8::StaticOrder, true, true>(lds, g, S, E); }
    GSYNC(); PE(9); PB(10);
    { pg8::Gemm g{Z, Wout, MR, 1024, 1024, 1024, 1024}; pg8::StaticOrder S; S.init(NB * TL, 1024, G, vb, 1);
      pg8::EpiRes<1, 5, 0, 2> E{H, HC, H, HC, mod, g_norm + 2 * DM, XN2, ssq2}; pg8::gemm_phase<pg8::EpiRes<1, 5, 0, 2>, pg8::StaticOrder, true, true>(lds, g, S, E); }
    GSYNC(); PE(10); PB(11);
#endif
#if MK_STAGE >= 3
    { pg8::Gemm g{XN2, Wup2, MR, 5632, 1024, 1024, 1024}; pg8::StaticOrder S; S.init(NB * TL, 5632, G, vb, 1);
      pg8::EpiSwigluN E{HID, DFF, ssq2, sW2, 5632}; pg8::gemm_phase<pg8::EpiSwigluN, pg8::StaticOrder, true, true>(lds, g, S, E); }
    GSYNC(); PE(11); PB(12);
    { pg8::Gemm g{HID, Wdn2, MR, 1024, DFF, DFF, DFF}; pg8::StaticOrder S; S.init(NB * TL, 1024, G, vb, 1);
      pg8::EpiRes<0, 8, 1, 0> E{H, HC, H, HC, mod, nullptr, nullptr, nullptr}; pg8::gemm_phase<pg8::EpiRes<0, 8, 1, 0>, pg8::StaticOrder, true, true>(lds, g, S, E); }
    GSYNC(); PE(12); PB(13);
#endif
    { PH_IDS; f32x4 gv[4];
#pragma unroll
      for (int j = 0; j < 4; ++j) gv[j] = *((const f32x4*)g_final + lane + 64 * j);
      for (int r0 = gw * 4; r0 < NB * TL; r0 += NGW * 4) { f32x4* p = (f32x4*)(H + (size_t)r0 * DM) + lane; f32x4 v[4][4]; float s[4] = {0.f, 0.f, 0.f, 0.f};
#pragma unroll
          for (int u = 0; u < 4; ++u)
#pragma unroll
              for (int j = 0; j < 4; ++j) v[u][j] = p[u * 256 + 64 * j];
#pragma unroll
          for (int u = 0; u < 4; ++u)
#pragma unroll
              for (int j = 0; j < 4; ++j) s[u] += (v[u][j].x * v[u][j].x + v[u][j].y * v[u][j].y) + (v[u][j].z * v[u][j].z + v[u][j].w * v[u][j].w);
#pragma unroll
          for (int u = 0; u < 4; ++u) { const float rstd = 1.f / sqrtf(wave_sum(s[u]) * (1.f / DM) + EPS);
#pragma unroll
              for (int j = 0; j < 4; ++j) p[u * 256 + 64 * j] = v[u][j] * rstd * gv[j]; } } }
    PE(13);
    if (PROBE_MASK != 0ull || PROBE_SYNC) { const unsigned long long te = __builtin_amdgcn_s_memrealtime() + (unsigned long long)PROBE_MULT * pacc; while (__builtin_amdgcn_s_memrealtime() < te) __builtin_amdgcn_s_sleep(32); }
}

extern "C" void kernel_launch(void* const* d_in, const int* in_sizes, int n_in, void* d_out, int out_size, void* d_ws, size_t ws_size, hipStream_t stream) {
    static int grid = 0;
    if (grid == 0) {
        int dev = 0, cus = 0, per_cu = 0;
        hipGetDevice(&dev); hipDeviceGetAttribute(&cus, hipDeviceAttributeMultiprocessorCount, dev);
        hipFuncSetAttribute((const void*)mk_fwd, hipFuncAttributeMaxDynamicSharedMemorySize, LDS_BYTES);
        hipOccupancyMaxActiveBlocksPerMultiprocessor(&per_cu, (const void*)mk_fwd, NTHR, LDS_BYTES);
        if (per_cu < 1) per_cu = 1;
        grid = cus * per_cu;
        if (n_in != 19 || ws_size < WS_END) { fprintf(stderr, "kernel_launch: unexpected n_in %d or ws_size %zu\n", n_in, ws_size); }
    }
    Args a{};
    for (int i = 0; i < 19; ++i) a.in[i] = (const float*)d_in[i];
    a.out = (float*)d_out; a.ws = (unsigned char*)d_ws;
    void* kargs[] = {&a};
    hipError_t e = hipLaunchCooperativeKernel((const void*)mk_fwd, dim3(grid), dim3(NTHR), kargs, LDS_BYTES, stream);
    if (e != hipSuccess) fprintf(stderr, "cooperative launch failed: %s (grid %d)\n", hipGetErrorString(e), grid);
}
```

```cpp
#include <hip/hip_runtime.h>
#include <cstdio>
#include <cstdint>
#ifndef MK_STAGE
#define MK_STAGE 3
#endif
#define PROBE_MASK 0ull
#define PROBE_SYNC 0
#define PROBE_MULT 4
__device__ __forceinline__ int opaque_tid() { int t; asm volatile("v_mov_b32 %0, %1" : "=v"(t) : "v"((int)threadIdx.x)); return t; }
namespace pg8 {
#define PG8_LAS __attribute__((address_space(3)))
typedef unsigned short bf16_t;
typedef short bf16x8 __attribute__((ext_vector_type(8)));
typedef float f32x4 __attribute__((ext_vector_type(4)));
typedef unsigned u32x4 __attribute__((ext_vector_type(4)));
constexpr int BM = 256, BK = 64, HALF = 128, HTB = HALF * BK * 2  , STAGE_BYTES = 8 * HTB, NXCD = 8, WGM = 4;

__host__ __device__ __forceinline__ int lds_byte(int r, int c) { const int st = (r >> 4) * 2 + (c >> 5), rr = r & 15, cc = c & 31, ob = rr * 64 + cc * 2; return st * 1024 + (ob ^ (((ob >> 9) & 1) << 5)); }
__host__ __device__ __forceinline__ void stage_rc(int b, int& R, int& C) { const int st = b / 1024, sb = b % 1024, swz = sb ^ (((sb >> 9) & 1) << 5); R = (st >> 1) * 16 + swz / 64; C = (st & 1) * 32 + (swz % 64) / 2; }
__host__ __device__ __forceinline__ int perm32(int rho) { const int n = rho >> 4, i = rho & 15; return 8 * (i >> 2) + 4 * n + (i & 3); }

struct Unit { int pm, pn; };
struct Gemm { const bf16_t* A; const bf16_t* Bt; int M, N, K, lda, ldb; };

struct StaticOrder {
    int nM, nN, nwg, G, c, skip;
    __host__ __device__ void init(int M, int N, int G_, int c_, int skip_ = 0) { nM = M / BM; nN = N / BM; nwg = nM * nN; G = G_; c = c_; skip = skip_; }
    __host__ __device__ bool next(int i, Unit& u) const {
        const long L = (long)i * G + c; if (L >= nwg) return false;
        int wgid = (int)L; { const int q = nwg / NXCD, r = nwg % NXCD, xcd = wgid % NXCD, off = wgid / NXCD; wgid = (xcd < r ? xcd * (q + 1) : r * (q + 1) + (xcd - r) * q) + off; }
        const int nig = WGM * nN, gid = wgid / nig, fm = gid * WGM, gsz = (nM - fm) < WGM ? (nM - fm) : WGM;
        u.pm = fm + ((wgid % nig) % gsz); u.pn = (wgid % nig) / gsz; if (skip) u.pm += u.pm / 32; return true;
    }
    __device__ __forceinline__ void a_ready(const Unit&) const {}
    __device__ __forceinline__ void done(const Unit&) const {}
};

__device__ __forceinline__ unsigned cvt_pk_bf16(float lo, float hi) { unsigned r; asm volatile("v_cvt_pk_bf16_f32 %0, %1, %2" : "=v"(r) : "v"(lo), "v"(hi)); return r; }
__device__ __forceinline__ float fsigmoid(float x) { return __builtin_amdgcn_rcpf(1.f + __builtin_amdgcn_exp2f(-1.4426950408889634f * x)); }
__device__ __forceinline__ float bflo(unsigned w) { return __uint_as_float(w << 16); }
__device__ __forceinline__ float bfhi(unsigned w) { return __uint_as_float(w & 0xffff0000u); }
constexpr int TPB = 33;
constexpr int PWID = 4608;

struct EpiPlain {
    static constexpr bool PERM = true, AFTER_DRAIN = false;
    bf16_t* O; int ldc;
    __device__ __forceinline__ void operator()(const f32x4 (&acc)[2][2][4][2], const Unit& u, int wr, int wc, int fr, int fq) const {
        const int row0 = u.pm * BM + wr * 64 + fr, col0 = u.pn * BM + wc * 32 + 8 * fq;
#pragma unroll
        for (int ai = 0; ai < 2; ++ai)
#pragma unroll
            for (int m = 0; m < 4; ++m) { bf16_t* rowp = O + (size_t)(row0 + ai * HALF + m * 16) * ldc + col0;
#pragma unroll
                for (int bj = 0; bj < 2; ++bj) { const f32x4 v0 = acc[ai][bj][m][0], v1 = acc[ai][bj][m][1];
                    u32x4 w; w.x = cvt_pk_bf16(v0[0], v0[1]); w.y = cvt_pk_bf16(v0[2], v0[3]); w.z = cvt_pk_bf16(v1[0], v1[1]); w.w = cvt_pk_bf16(v1[2], v1[3]);
                    *(u32x4*)(rowp + bj * HALF) = w; } }
    }
};
struct EpiSwiglu {
    static constexpr bool PERM = true, AFTER_DRAIN = false;
    bf16_t* O; int ldc;
    __device__ __forceinline__ void operator()(const f32x4 (&acc)[2][2][4][2], const Unit& u, int wr, int wc, int fr, int fq) const {
        const int row0 = u.pm * BM + wr * 64 + fr, col0 = u.pn * HALF + wc * 32 + 8 * fq;
#pragma unroll
        for (int ai = 0; ai < 2; ++ai)
#pragma unroll
            for (int m = 0; m < 4; ++m) { bf16_t* rowp = O + (size_t)(row0 + ai * HALF + m * 16) * ldc + col0;
                float h[8];
#pragma unroll
                for (int n = 0; n < 2; ++n)
#pragma unroll
                    for (int k = 0; k < 4; ++k) { const float a = acc[ai][0][m][n][k], b = acc[ai][1][m][n][k]; h[n * 4 + k] = a * fsigmoid(a) * b; }
                u32x4 w; w.x = cvt_pk_bf16(h[0], h[1]); w.y = cvt_pk_bf16(h[2], h[3]); w.z = cvt_pk_bf16(h[4], h[5]); w.w = cvt_pk_bf16(h[6], h[7]);
                *(u32x4*)rowp = w; }
    }
};
template <int XNOUT, int GIDX, int HALFCOEF, int NSUB> struct EpiRes {
    static constexpr bool PERM = true, AFTER_DRAIN = false;
    const float* src_lat; const float* src_ctx; float* dst_lat; float* dst_ctx; const float* mod; const float* gnorm; bf16_t* xn; float* ssq;
    static constexpr int gidx = GIDX, nsub = NSUB; static constexpr float coef = HALFCOEF ? 0.5f : 1.0f;
    __device__ __forceinline__ void operator()(const f32x4 (&acc)[2][2][4][2], const Unit& u, int wr, int wc, int fr, int fq) const {
        asm volatile("" : "+v"(fr));
        const int b = u.pm / TPB, j = u.pm % TPB; const bool isctx = (j == TPB - 1);
        const float* src = isctx ? src_ctx + (size_t)b * 256 * 1024 : src_lat + (size_t)(b * 8192 + j * 256) * 1024;
        float* dst = isctx ? dst_ctx + (size_t)b * 256 * 1024 : dst_lat + (size_t)(b * 8192 + j * 256) * 1024;
        const float* mrow = mod + (size_t)(isctx ? 8 : b) * 9216;
        const float* g = mrow + gidx * 1024;
        const int col0 = u.pn * BM + wc * 32 + 8 * fq;
        f32x4 gv[2][2], gs[2][2];
#pragma unroll
        for (int bj = 0; bj < 2; ++bj)
#pragma unroll
            for (int n = 0; n < 2; ++n) { gv[bj][n] = *(const f32x4*)(g + col0 + bj * HALF + 4 * n) * coef;
                if (XNOUT) gs[bj][n] = *(const f32x4*)(gnorm + col0 + bj * HALF + 4 * n) * (*(const f32x4*)(mrow + (3 * nsub + 1) * 1024 + col0 + bj * HALF + 4 * n) + 1.f); }
#pragma unroll
        for (int ai = 0; ai < 2; ++ai)
#pragma unroll
            for (int m = 0; m < 4; ++m) { const int rl = ai * HALF + wr * 64 + m * 16 + fr; const size_t off = (size_t)rl * 1024 + col0; float sq = 0.f;
#pragma unroll
                for (int bj = 0; bj < 2; ++bj) { f32x4 o[2];
#pragma unroll
                    for (int n = 0; n < 2; ++n) { const f32x4 sv = *(const f32x4*)(src + off + bj * HALF + 4 * n); o[n] = sv + gv[bj][n] * acc[ai][bj][m][n];
                        if (!(XNOUT && isctx)) *(f32x4*)(dst + off + bj * HALF + 4 * n) = o[n]; }
                    if (XNOUT) { sq += (o[0][0] * o[0][0] + o[0][1] * o[0][1]) + (o[0][2] * o[0][2] + o[0][3] * o[0][3]) + (o[1][0] * o[1][0] + o[1][1] * o[1][1]) + (o[1][2] * o[1][2] + o[1][3] * o[1][3]);
                        const f32x4 x0 = o[0] * gs[bj][0], x1 = o[1] * gs[bj][1];
                        u32x4 w; w.x = cvt_pk_bf16(x0[0], x0[1]); w.y = cvt_pk_bf16(x0[2], x0[3]); w.z = cvt_pk_bf16(x1[0], x1[1]); w.w = cvt_pk_bf16(x1[2], x1[3]);
                        *(u32x4*)(xn + (size_t)(u.pm * BM + rl) * 1024 + col0 + bj * HALF) = w; } }
                if (XNOUT) { sq += __shfl_xor(sq, 16); sq += __shfl_xor(sq, 32); if (fq == 0) atomicAdd(ssq + u.pm * BM + rl, sq); }
                if (m & 1) asm volatile("" ::: "memory"); }
    }
};
struct EpiInproj {
    static constexpr bool PERM = true, AFTER_DRAIN = false;
    bf16_t* O; int ldc; const float* ssq; const float* sw; int swld;
    __device__ __forceinline__ void operator()(const f32x4 (&acc)[2][2][4][2], const Unit& u, int wr, int wc, int fr, int fq) const {
        const int row0 = u.pm * BM + wr * 64 + fr, col0 = u.pn * BM + wc * 32 + 8 * fq;
        const float* swr = sw + (size_t)((u.pm % TPB == TPB - 1) ? 8 : u.pm / TPB) * swld + col0;
        f32x4 sv[2][2];
#pragma unroll
        for (int bj = 0; bj < 2; ++bj)
#pragma unroll
            for (int n = 0; n < 2; ++n) sv[bj][n] = *(const f32x4*)(swr + bj * HALF + 4 * n);
#pragma unroll
        for (int ai = 0; ai < 2; ++ai)
#pragma unroll
            for (int m = 0; m < 4; ++m) { const int row = row0 + ai * HALF + m * 16; bf16_t* rowp = O + (size_t)row * ldc + col0;
                const float rstd = 1.f / sqrtf(ssq[row] * (1.f / 1024.f) + 1e-6f);
#pragma unroll
                for (int bj = 0; bj < 2; ++bj) { const f32x4 v0 = acc[ai][bj][m][0] * rstd + sv[bj][0], v1 = acc[ai][bj][m][1] * rstd + sv[bj][1];
                    u32x4 w; w.x = cvt_pk_bf16(v0[0], v0[1]); w.y = cvt_pk_bf16(v0[2], v0[3]); w.z = cvt_pk_bf16(v1[0], v1[1]); w.w = cvt_pk_bf16(v1[2], v1[3]);
                    *(u32x4*)(rowp + bj * HALF) = w; } }
    }
};
struct EpiSwigluN {
    static constexpr bool PERM = true, AFTER_DRAIN = false;
    bf16_t* O; int ldc; const float* ssq; const float* sw; int swld;
    __device__ __forceinline__ void operator()(const f32x4 (&acc)[2][2][4][2], const Unit& u, int wr, int wc, int fr, int fq) const {
        const int row0 = u.pm * BM + wr * 64 + fr, col0 = u.pn * HALF + wc * 32 + 8 * fq;
        const float* swr = sw + (size_t)((u.pm % TPB == TPB - 1) ? 8 : u.pm / TPB) * swld + u.pn * BM + wc * 32 + 8 * fq;
        f32x4 sv[2][2];
#pragma unroll
        for (int bj = 0; bj < 2; ++bj)
#pragma unroll
            for (int n = 0; n < 2; ++n) sv[bj][n] = *(const f32x4*)(swr + bj * HALF + 4 * n);
#pragma unroll
        for (int ai = 0; ai < 2; ++ai)
#pragma unroll
            for (int m = 0; m < 4; ++m) { const int row = row0 + ai * HALF + m * 16; bf16_t* rowp = O + (size_t)row * ldc + col0;
                const float rstd = 1.f / sqrtf(ssq[row] * (1.f / 1024.f) + 1e-6f);
                float h[8];
#pragma unroll
                for (int n = 0; n < 2; ++n)
#pragma unroll
                    for (int k = 0; k < 4; ++k) { const float a = acc[ai][0][m][n][k] * rstd + sv[0][n][k], b = acc[ai][1][m][n][k] * rstd + sv[1][n][k]; h[n * 4 + k] = a * fsigmoid(a) * b; }
                u32x4 w; w.x = cvt_pk_bf16(h[0], h[1]); w.y = cvt_pk_bf16(h[2], h[3]); w.z = cvt_pk_bf16(h[4], h[5]); w.w = cvt_pk_bf16(h[6], h[7]);
                *(u32x4*)rowp = w; }
    }
};
template <int SECOND> struct EpiGate {
    static constexpr bool PERM = true, AFTER_DRAIN = false;
    const bf16_t* P; const float* bgate; bf16_t* Z;
    __device__ __forceinline__ void operator()(const f32x4 (&acc)[2][2][4][2], const Unit& u, int wr, int wc, int fr, int fq) const {
        const int row0 = u.pm * BM + wr * 64 + fr, col0 = u.pn * BM + wc * 32 + 8 * fq;
        f32x4 bg[2][2];
#pragma unroll
        for (int bj = 0; bj < 2; ++bj)
#pragma unroll
            for (int n = 0; n < 2; ++n) bg[bj][n] = *(const f32x4*)(bgate + 1024 * SECOND + col0 + bj * HALF + 4 * n);
#pragma unroll
        for (int ai = 0; ai < 2; ++ai)
#pragma unroll
            for (int m = 0; m < 4; ++m) { const size_t row = (size_t)(row0 + ai * HALF + m * 16);
#pragma unroll
                for (int bj = 0; bj < 2; ++bj) { const int c = col0 + bj * HALF;
                    const u32x4 gr = *(const u32x4*)(P + row * PWID + 2304 + 1024 * SECOND + c);
                    float v[8];
                    v[0] = fsigmoid(bflo(gr.x) + bg[bj][0][0]) * acc[ai][bj][m][0][0]; v[1] = fsigmoid(bfhi(gr.x) + bg[bj][0][1]) * acc[ai][bj][m][0][1];
                    v[2] = fsigmoid(bflo(gr.y) + bg[bj][0][2]) * acc[ai][bj][m][0][2]; v[3] = fsigmoid(bfhi(gr.y) + bg[bj][0][3]) * acc[ai][bj][m][0][3];
                    v[4] = fsigmoid(bflo(gr.z) + bg[bj][1][0]) * acc[ai][bj][m][1][0]; v[5] = fsigmoid(bfhi(gr.z) + bg[bj][1][1]) * acc[ai][bj][m][1][1];
                    v[6] = fsigmoid(bflo(gr.w) + bg[bj][1][2]) * acc[ai][bj][m][1][2]; v[7] = fsigmoid(bfhi(gr.w) + bg[bj][1][3]) * acc[ai][bj][m][1][3];
                    bf16_t* zp = Z + row * 1024 + c;
                    if (SECOND) { const u32x4 zr = *(const u32x4*)zp;
                        v[0] += bflo(zr.x); v[1] += bfhi(zr.x); v[2] += bflo(zr.y); v[3] += bfhi(zr.y); v[4] += bflo(zr.z); v[5] += bfhi(zr.z); v[6] += bflo(zr.w); v[7] += bfhi(zr.w); }
                    u32x4 w; w.x = cvt_pk_bf16(v[0], v[1]); w.y = cvt_pk_bf16(v[2], v[3]); w.z = cvt_pk_bf16(v[4], v[5]); w.w = cvt_pk_bf16(v[6], v[7]);
                    *(u32x4*)zp = w; } }
    }
};
template <class Epi, class Sched, bool ALIGN_EPI = false, bool SP2 = false>
__device__ __forceinline__ void gemm_phase(PG8_LAS unsigned char* lds, const Gemm g, const Sched& S, const Epi& E) {
    const int tid = opaque_tid(), wid = __builtin_amdgcn_readfirstlane(tid >> 6), lane = tid & 63, wr = wid >> 2, wc = wid & 3, fr = lane & 15, fq = lane >> 4;
    const int K = g.K, nt = K / BK;
    unsigned voffA[2], voffB[2];
#pragma unroll
    for (int i = 0; i < 2; ++i) { int R, C; stage_rc(tid * 16 + i * 8192, R, C); const int Rb = Epi::PERM ? ((R & ~31) + perm32(R & 31)) : R;
        voffA[i] = (unsigned)(R * g.lda + C) * 2u; voffB[i] = (unsigned)(Rb * g.ldb + C) * 2u; }
    const size_t kstep = (size_t)(BK * 2);
    const size_t hstepA = (size_t)HALF * g.lda * 2, hstepB = (size_t)HALF * g.ldb * 2;
    const size_t tstepA = 2 * hstepA, tstepB = 2 * hstepB;
    const unsigned ldsw = (unsigned)wid * 1024u;
    const int aoff = lds_byte(wr * 64 + fr, fq * 8), boff = lds_byte(wc * 32 + fr, fq * 8);
#define PG8_SA(b, h) (((b) * 2 + (h)) * HTB)
#define PG8_SB(b, h) ((4 + (b) * 2 + (h)) * HTB)
#define PG8_STAGE(bufoff, gbase, voff) do { _Pragma("unroll") for (int _i = 0; _i < 2; ++_i) \
        __builtin_amdgcn_global_load_lds((const unsigned*)((const char*)(gbase) + (voff)[_i]), (PG8_LAS unsigned*)(lds + (bufoff) + ldsw + _i * 8192), 16, 0, 0); } while (0)
#define PG8_LDA(dst, b, h) do { _Pragma("unroll") for (int m = 0; m < 4; ++m) _Pragma("unroll") for (int k = 0; k < 2; ++k) dst[m][k] = *(const PG8_LAS bf16x8*)(lds + PG8_SA(b, h) + aoff + m * 2048 + k * 1024); } while (0)
#define PG8_LDB(dst, b, h) do { _Pragma("unroll") for (int n = 0; n < 2; ++n) _Pragma("unroll") for (int k = 0; k < 2; ++k) dst[n][k] = *(const PG8_LAS bf16x8*)(lds + PG8_SB(b, h) + boff + n * 2048 + k * 1024); } while (0)
#define PG8_MMA(ai, bj, At, Bt) do { __builtin_amdgcn_s_setprio(1); _Pragma("unroll") for (int m = 0; m < 4; ++m) _Pragma("unroll") for (int n = 0; n < 2; ++n) _Pragma("unroll") for (int k = 0; k < 2; ++k) \
        acc[ai][bj][m][n] = __builtin_amdgcn_mfma_f32_16x16x32_bf16(Bt[n][k], At[m][k], acc[ai][bj][m][n], 0, 0, 0); __builtin_amdgcn_s_setprio(0); } while (0)
#define PG8_WAIT_V(n) asm volatile("s_waitcnt vmcnt(" #n ")" ::: "memory")
#define PG8_WAIT_L(n) asm volatile("s_waitcnt lgkmcnt(" #n ")" ::: "memory")
#define PG8_BAR __builtin_amdgcn_s_barrier()
#define PG8_SCHED __builtin_amdgcn_sched_barrier(0)
    Unit cur, nxt; int ui = 0;
    if (!S.next(0, cur)) return;
    f32x4 acc[2][2][4][2];
#pragma unroll
    for (int a = 0; a < 2; ++a)
#pragma unroll
        for (int b = 0; b < 2; ++b)
#pragma unroll
            for (int m = 0; m < 4; ++m)
#pragma unroll
                for (int n = 0; n < 2; ++n) acc[a][b][m][n] = (f32x4){0.f, 0.f, 0.f, 0.f};
    bf16x8 At[4][2], B0[2][2], B1[2][2];
    const char* cA = (const char*)g.A + (size_t)cur.pm * tstepA; const char* cB = (const char*)g.Bt + (size_t)cur.pn * tstepB;
    S.a_ready(cur);
    if constexpr (SP2) {
        PG8_STAGE(PG8_SB(0, 0), cB, voffB); PG8_STAGE(PG8_SB(0, 1), cB + hstepB, voffB); PG8_STAGE(PG8_SA(0, 0), cA, voffA); PG8_STAGE(PG8_SA(0, 1), cA + hstepA, voffA);
        if (wr == 1) PG8_BAR;
        PG8_WAIT_V(2); PG8_BAR;
        PG8_STAGE(PG8_SB(1, 0), cB + kstep, voffB); PG8_STAGE(PG8_SA(1, 0), cA + kstep, voffA); PG8_STAGE(PG8_SB(1, 1), cB + hstepB + kstep, voffB);
        PG8_WAIT_V(6); PG8_BAR;
    } else {
        PG8_STAGE(PG8_SB(0, 0), cB, voffB); PG8_STAGE(PG8_SA(0, 0), cA, voffA); PG8_STAGE(PG8_SB(0, 1), cB + hstepB, voffB); PG8_STAGE(PG8_SA(0, 1), cA + hstepA, voffA);
        if (wr == 1) PG8_BAR;
        PG8_WAIT_V(4); PG8_BAR;
        PG8_STAGE(PG8_SB(1, 0), cB + kstep, voffB); PG8_STAGE(PG8_SA(1, 0), cA + kstep, voffA); PG8_STAGE(PG8_SB(1, 1), cB + hstepB + kstep, voffB);
        PG8_WAIT_V(6); PG8_BAR;
    }
    for (;;) {
        const bool has_next = S.next(ui + 1, nxt);
        const char* nA = has_next ? (const char*)g.A + (size_t)nxt.pm * tstepA : cA; const char* nB = has_next ? (const char*)g.Bt + (size_t)nxt.pn * tstepB : cB;
        for (int t = 0; t < nt; t += 2) {
            const bool last = (t == nt - 2);
            const char* a1 = cA + (size_t)(t + 1) * kstep;
            const char* a2 = last ? nA : cA + (size_t)(t + 2) * kstep; const char* b2 = last ? nB : cB + (size_t)(t + 2) * kstep;
            const char* a3 = a2 + kstep; const char* b3 = b2 + kstep;
            if (last && has_next) S.a_ready(nxt);
            if constexpr (SP2) {
            PG8_LDB(B0, 0, 0); PG8_LDB(B1, 0, 1); PG8_SCHED; PG8_LDA(At, 0, 0); PG8_STAGE(PG8_SA(1, 1), a1 + hstepA, voffA);
            PG8_WAIT_V(8); PG8_WAIT_L(0); PG8_BAR; PG8_MMA(0, 0, At, B0); PG8_MMA(0, 1, At, B1); PG8_BAR; PG8_SCHED;
            PG8_LDA(At, 0, 1); PG8_STAGE(PG8_SB(0, 0), b2, voffB); PG8_STAGE(PG8_SB(0, 1), b2 + hstepB, voffB); PG8_STAGE(PG8_SA(0, 0), a2, voffA);
            PG8_WAIT_V(8); PG8_WAIT_L(0); PG8_BAR; PG8_MMA(1, 0, At, B0); PG8_MMA(1, 1, At, B1); PG8_BAR; PG8_SCHED;
            PG8_LDB(B0, 1, 0); PG8_LDB(B1, 1, 1); PG8_SCHED; PG8_LDA(At, 1, 0); PG8_STAGE(PG8_SA(0, 1), a2 + hstepA, voffA);
            PG8_WAIT_V(8); PG8_WAIT_L(0); PG8_BAR; PG8_MMA(0, 0, At, B0); PG8_MMA(0, 1, At, B1); PG8_BAR; PG8_SCHED;
            PG8_LDA(At, 1, 1); PG8_STAGE(PG8_SB(1, 0), b3, voffB); PG8_STAGE(PG8_SB(1, 1), b3 + hstepB, voffB); PG8_STAGE(PG8_SA(1, 0), a3, voffA);
            PG8_WAIT_V(8); PG8_WAIT_L(0); PG8_BAR; PG8_MMA(1, 0, At, B0); PG8_MMA(1, 1, At, B1); PG8_BAR; PG8_SCHED;
            } else {
            PG8_LDB(B0, 0, 0); PG8_SCHED; PG8_LDA(At, 0, 0); PG8_STAGE(PG8_SA(1, 1), a1 + hstepA, voffA);
            PG8_WAIT_L(8); PG8_BAR; PG8_WAIT_L(0); PG8_MMA(0, 0, At, B0); PG8_BAR; PG8_SCHED;
            PG8_LDB(B1, 0, 1); PG8_STAGE(PG8_SB(0, 0), b2, voffB);
            PG8_BAR; PG8_WAIT_L(0); PG8_MMA(0, 1, At, B1); PG8_BAR;
            PG8_LDA(At, 0, 1); PG8_STAGE(PG8_SA(0, 0), a2, voffA);
            PG8_BAR; PG8_WAIT_L(0); PG8_MMA(1, 0, At, B0); PG8_BAR; PG8_SCHED;
            PG8_STAGE(PG8_SB(0, 1), b2 + hstepB, voffB);
            PG8_WAIT_V(6); PG8_BAR; PG8_MMA(1, 1, At, B1); PG8_BAR;
            PG8_LDB(B0, 1, 0); PG8_SCHED; PG8_LDA(At, 1, 0); PG8_STAGE(PG8_SA(0, 1), a2 + hstepA, voffA);
            PG8_WAIT_L(8); PG8_BAR; PG8_WAIT_L(0); PG8_MMA(0, 0, At, B0); PG8_BAR; PG8_SCHED;
            PG8_LDB(B1, 1, 1); PG8_STAGE(PG8_SB(1, 0), b3, voffB);
            PG8_BAR; PG8_WAIT_L(0); PG8_MMA(0, 1, At, B1); PG8_BAR;
            PG8_LDA(At, 1, 1); PG8_STAGE(PG8_SA(1, 0), a3, voffA);
            PG8_BAR; PG8_WAIT_L(0); PG8_MMA(1, 0, At, B0); PG8_BAR; PG8_SCHED;
            PG8_STAGE(PG8_SB(1, 1), b3 + hstepB, voffB);
            PG8_WAIT_V(6); PG8_BAR; PG8_MMA(1, 1, At, B1); PG8_BAR;
            }
        }
        if constexpr (ALIGN_EPI) { if (wr == 0) PG8_BAR; }
        if constexpr (!Epi::AFTER_DRAIN) { E(acc, cur, wr, wc, fr, fq); S.done(cur); }
        if (!has_next) break;
#pragma unroll
        for (int a = 0; a < 2; ++a)
#pragma unroll
            for (int b = 0; b < 2; ++b)
#pragma unroll
                for (int m = 0; m < 4; ++m)
#pragma unroll
                    for (int n = 0; n < 2; ++n) acc[a][b][m][n] = (f32x4){0.f, 0.f, 0.f, 0.f};
        cur = nxt; cA = nA; cB = nB; ++ui;
        if constexpr (ALIGN_EPI) { if (wr == 1) PG8_BAR; }
    }
    PG8_WAIT_V(0);
    if constexpr (!ALIGN_EPI) { if (wr == 0) PG8_BAR; }
    PG8_BAR;
    if constexpr (Epi::AFTER_DRAIN) { E.fused(acc, cur, wr, wc, fr, fq, lds, wid, lane); S.done(cur); }
#undef PG8_SA
#undef PG8_SB
#undef PG8_STAGE
#undef PG8_LDA
#undef PG8_LDB
#undef PG8_MMA
#undef PG8_WAIT_V
#undef PG8_WAIT_L
#undef PG8_BAR
#undef PG8_SCHED
}
}
#include <hip/hip_bf16.h>
#include <cmath>
namespace attn_body {
using bf16=__hip_bfloat16;
using bf16x8=__attribute__((ext_vector_type(8)))short;
using s16x4=__attribute__((ext_vector_type(4)))short;
using f32x16=__attribute__((ext_vector_type(16)))float;
using u32x4=__attribute__((ext_vector_type(4)))unsigned;
constexpr int SEQ=8448,D=64,DM=4608,NTILES=132;
constexpr int NW=8,QBLK=32,QB=QBLK*NW,KVBLK=64;
constexpr int ATTN_PITCH=DM, ATTN_UNIT_ROWS=QB;
__device__ __forceinline__ int crow(int r,int hi){return (r&3)+8*(r>>2)+4*hi;}
#define SBAR() __builtin_amdgcn_sched_barrier(0)
__device__ __forceinline__ void cmask(f32x16&p0,f32x16&p1,int jb,int qrel,int hi){
  const float NEG=-INFINITY; int kb=64*jb+4*hi;
  #pragma unroll
  for(int r=0;r<16;++r){int kv=kb+(r&3)+8*(r>>2); if(kv>qrel)p0[r]=NEG; if(kv+32>qrel)p1[r]=NEG;}
}

constexpr int NSLOT=3, SLOTB=8192;
constexpr int LDS_K=0, LDS_V=NSLOT*SLOTB, LDS_WS=2*NSLOT*SLOTB, LDS_OST=LDS_WS+NW*64*4, LDS_BYTES=LDS_OST+NW*4096;
constexpr float C2=0.125f*1.4426950408889634f;
__device__ __forceinline__ void glds16(const void*gsrc,unsigned lds_dst){unsigned keep;
  asm volatile("s_mov_b32 %0, m0\n\ts_mov_b32 m0, %2\n\ts_nop 0\n\tglobal_load_lds_dwordx4 %1, off\n\ts_mov_b32 m0, %0":"=&s"(keep):"v"(gsrc),"s"(lds_dst):"memory");}
__device__ __forceinline__ float max3f(float a,float b,float c){float r;asm("v_max3_f32 %0, %1, %2, %3":"=v"(r):"v"(a),"v"(b),"v"(c));return r;}
__device__ __forceinline__ float max2f(float a,float b){float r;asm("v_max_f32_e32 %0, %1, %2":"=v"(r):"v"(a),"v"(b));return r;}
__device__ __forceinline__ float fadd_s(float a,float b){float r;asm("v_add_f32_e32 %0, %1, %2":"=v"(r):"v"(a),"v"(b));return r;}
__device__ __forceinline__ float fsub_s(float a,float b){float r;asm("v_sub_f32_e32 %0, %1, %2":"=v"(r):"v"(a),"v"(b));return r;}
typedef float f32x2_t __attribute__((ext_vector_type(2))); typedef __bf16 bf16x2_t __attribute__((ext_vector_type(2)));
__device__ __forceinline__ unsigned cvtpk_s(float lo,float hi){f32x2_t v={lo,hi};bf16x2_t b=__builtin_convertvector(v,bf16x2_t);return __builtin_bit_cast(unsigned,b);}
#define WAIT_BAR(N) asm volatile("s_waitcnt vmcnt(" #N ") lgkmcnt(0)\n\ts_barrier":::"memory")

__device__ __forceinline__ void qkt(f32x16&p0,f32x16&p1,const char*Kslot,const bf16x8*qr,const f32x16&negm,int r32,int hi){
  const char*kb=Kslot+hi*1024+r32*16;
  #pragma unroll
  for(int d0=0;d0<4;++d0){
    const bf16x8 b0=*reinterpret_cast<const bf16x8*>(kb+d0*2048);
    const bf16x8 b1=*reinterpret_cast<const bf16x8*>(kb+d0*2048+512);
    if(d0==0){p0=__builtin_amdgcn_mfma_f32_32x32x16_bf16(b0,qr[0],negm,0,0,0);p1=__builtin_amdgcn_mfma_f32_32x32x16_bf16(b1,qr[0],negm,0,0,0);}
    else{p0=__builtin_amdgcn_mfma_f32_32x32x16_bf16(b0,qr[d0],p0,0,0,0);p1=__builtin_amdgcn_mfma_f32_32x32x16_bf16(b1,qr[d0],p1,0,0,0);}}
}
typedef __attribute__((address_space(3))) const char* lds_cptr;
typedef short v4i16_t __attribute__((ext_vector_type(4)));
__device__ __forceinline__ void kload8(bf16x8*kf,lds_cptr kp){
  kf[0]=*(const __attribute__((address_space(3))) bf16x8*)(kp);      kf[1]=*(const __attribute__((address_space(3))) bf16x8*)(kp+512);
  kf[2]=*(const __attribute__((address_space(3))) bf16x8*)(kp+2048); kf[3]=*(const __attribute__((address_space(3))) bf16x8*)(kp+2560);
  kf[4]=*(const __attribute__((address_space(3))) bf16x8*)(kp+4096); kf[5]=*(const __attribute__((address_space(3))) bf16x8*)(kp+4608);
  kf[6]=*(const __attribute__((address_space(3))) bf16x8*)(kp+6144); kf[7]=*(const __attribute__((address_space(3))) bf16x8*)(kp+6656);
}
__device__ __forceinline__ void kload2(bf16x8*kf,lds_cptr kp,int j){ kf[2*j]=*(const __attribute__((address_space(3))) bf16x8*)(kp+j*2048); kf[2*j+1]=*(const __attribute__((address_space(3))) bf16x8*)(kp+j*2048+512); }
__device__ __forceinline__ s16x4 vtr(lds_cptr p){ return __builtin_bit_cast(s16x4,__builtin_amdgcn_ds_read_tr16_b64_v4i16((__attribute__((address_space(3))) v4i16_t*)p)); }
__device__ __forceinline__ float rowmax(const f32x16&p0,const f32x16&p1){
  float a=max3f(p0[0],p0[1],p1[0]),b=max3f(p0[2],p0[3],p1[1]);a=max3f(a,p1[2],p1[3]);
  #pragma unroll
  for(int r=4;r<16;r+=4){a=max3f(a,p0[r],p0[r+1]);b=max3f(b,p0[r+2],p0[r+3]);a=max3f(a,p1[r],p1[r+1]);b=max3f(b,p1[r+2],p1[r+3]);}
  const float m=max2f(a,b);
  auto rr=__builtin_amdgcn_permlane32_swap(__float_as_uint(m),__float_as_uint(m),false,false);
  return max2f(__uint_as_float(rr[0]),__uint_as_float(rr[1]));
}
__device__ __forceinline__ void pv(f32x16*o,int vb,bf16x8 pa0,bf16x8 pa1,bf16x8 pa2,bf16x8 pa3){
  #pragma unroll
  for(int d0=0;d0<2;++d0){s16x4 lo[4],hi[4];
    #pragma unroll
    for(int ks=0;ks<4;++ks){
      asm volatile("ds_read_b64_tr_b16 %0,%1 offset:%c2":"=&v"(lo[ks]):"v"(vb),"i"(d0*4096+ks*1024):"memory");
      asm volatile("ds_read_b64_tr_b16 %0,%1 offset:%c2":"=&v"(hi[ks]):"v"(vb),"i"(d0*4096+ks*1024+512):"memory");}
    asm volatile("s_waitcnt lgkmcnt(0)":::"memory");SBAR();
    #define PK(k) (bf16x8){lo[k][0],lo[k][1],lo[k][2],lo[k][3],hi[k][0],hi[k][1],hi[k][2],hi[k][3]}
    o[d0]=__builtin_amdgcn_mfma_f32_32x32x16_bf16(pa0,PK(0),o[d0],0,0,0);
    o[d0]=__builtin_amdgcn_mfma_f32_32x32x16_bf16(pa1,PK(1),o[d0],0,0,0);
    o[d0]=__builtin_amdgcn_mfma_f32_32x32x16_bf16(pa2,PK(2),o[d0],0,0,0);
    o[d0]=__builtin_amdgcn_mfma_f32_32x32x16_bf16(pa3,PK(3),o[d0],0,0,0);
    #undef PK
  }
}

#ifndef ATTN_STORE16
#define ATTN_STORE16(p,v) (*(u32x4*)(p)=(v))
#endif
template<int THRL,bool NOMAX> __device__ __forceinline__ void attn_unit(int b,int h,int hk,int qb,const bf16*Q,const bf16*__restrict__ K,const bf16*__restrict__ V,bf16*O,char*shm,const float*gq){
  const int tid=opaque_tid(),lane=tid&63,r32=lane&31,hi=lane>>5; const int wid=__builtin_amdgcn_readfirstlane(tid>>6);
  const long rowbase=(long)b*SEQ; const int q0=qb*QB;
  const bf16*Qw=Q+(rowbase+q0+wid*QBLK)*DM+h*D;
  const bf16*Kh=K+rowbase*DM+hk*D,*Vh=V+rowbase*DM+hk*D;
  const unsigned lds0=(unsigned)(uintptr_t)shm;
  float*wsf=(float*)(shm+LDS_WS)+wid*64;
  const bf16*ksrc=Kh+(long)lane*DM+wid*8;
  const bf16*vsrc=Vh+(long)(16*(wid&3)+(lane>>2))*DM+(wid>>2)*32+(lane&3)*8;
  const unsigned kdst=lds0+LDS_K+wid*1024, vdst=lds0+LDS_V+wid*1024;
  #define DMA_K(t,slot) glds16(ksrc+(long)(t)*KVBLK*DM,(unsigned)__builtin_amdgcn_readfirstlane(kdst+(slot)))
  #define DMA_V(t,slot) glds16(vsrc+(long)(t)*KVBLK*DM,(unsigned)__builtin_amdgcn_readfirstlane(vdst+(slot)))
  const int vb0=(int)(lds0+LDS_V)+((lane>>4)&1)*32+(lane&3)*8+(4*hi+((lane&15)>>2))*64;
  const char*Kbase=shm+LDS_K; bf16x8 kf[8];
  const lds_cptr shm3=(lds_cptr)shm; const lds_cptr kp0=shm3+LDS_K+hi*1024+r32*16; const lds_cptr vp0=shm3+LDS_V+((lane>>4)&1)*32+(lane&3)*8+(4*hi+((lane&15)>>2))*64;
  constexpr int NT=NTILES;
  DMA_K(0,0);DMA_V(0,0);DMA_K(1,SLOTB);
  bf16x8 qr[4];
  #pragma unroll
  for(int d0=0;d0<4;++d0)qr[d0]=*reinterpret_cast<const bf16x8*>(&Qw[(long)r32*DM+d0*16+hi*8]);
  { float xf[4][8]; float ss=0.f;
    #pragma unroll
    for(int d0=0;d0<4;++d0){
      #pragma unroll
      for(int k=0;k<8;++k){ xf[d0][k]=__uint_as_float(((unsigned)(unsigned short)qr[d0][k])<<16); ss+=xf[d0][k]*xf[d0][k]; } }
    ss+=__shfl_xor(ss,32);
    const float rstd=C2/sqrtf(ss*(1.f/64.f)+1e-6f);
    const int tq=q0+wid*QBLK+r32; const float posr=(float)(tq>>6),posc=(float)(tq&63);
    #pragma unroll
    for(int k=0;k<8;++k){
      const float fr=__builtin_amdgcn_exp2f(-(float)(8*hi+k)*(13.287712379549449f/16.f));
      const float a1=posr*fr,a2=posc*fr; const float c1=__cosf(a1),s1=__sinf(a1),c2=__cosf(a2),s2=__sinf(a2);
      const float y0=xf[0][k]*rstd*gq[8*hi+k],y2=xf[2][k]*rstd*gq[32+8*hi+k],y1=xf[1][k]*rstd*gq[16+8*hi+k],y3=xf[3][k]*rstd*gq[48+8*hi+k];
      xf[0][k]=y0*c1-y2*s1; xf[2][k]=y0*s1+y2*c1; xf[1][k]=y1*c2-y3*s2; xf[3][k]=y1*s2+y3*c2; }
    #pragma unroll
    for(int d0=0;d0<4;++d0){ u32x4 pw_; pw_[0]=cvtpk_s(xf[d0][0],xf[d0][1]); pw_[1]=cvtpk_s(xf[d0][2],xf[d0][3]); pw_[2]=cvtpk_s(xf[d0][4],xf[d0][5]); pw_[3]=cvtpk_s(xf[d0][6],xf[d0][7]); qr[d0]=__builtin_bit_cast(bf16x8,pw_); } }
  float mhat=0.f,l_reg=0.f;f32x16 o[2];o[0]=f32x16{};o[1]=f32x16{};f32x16 negm=f32x16{};asm volatile("":"+v"(negm));
  #define CMASK(P0,P1,t) do{}while(0)
  bool resc=false;
  #define START(P0,P1) do{ const float rm=rowmax(P0,P1); resc=false; \
    { const float dl=rm; mhat=fadd_s(mhat,dl); \
      _Pragma("unroll") for(int r=0;r<16;++r){P0[r]=fsub_s(P0[r],dl);P1[r]=fsub_s(P1[r],dl);} \
      _Pragma("unroll") for(int r=0;r<16;++r)negm[r]=-mhat; asm volatile("":"+v"(negm)); } \
    _Pragma("unroll") for(int r=0;r<16;++r)P0[r]=__builtin_amdgcn_exp2f(P0[r]); }while(0)
  #define RESC() do{ if(resc){ asm volatile("s_waitcnt lgkmcnt(0)":::"memory"); \
      _Pragma("unroll") for(int d_=0;d_<2;++d_) _Pragma("unroll") for(int r=0;r<16;++r)o[d_][r]*=wsf[crow(r,hi)]; } }while(0)
  f32x16 pA0,pA1,pB0,pB1;
  int sl_prev=0,sl_cur=0,sl_next=SLOTB;
  #define ROT() do{sl_prev=sl_cur;sl_cur=sl_next;sl_next=(sl_next==(NSLOT-1)*SLOTB)?0:sl_next+SLOTB;}while(0)
  DMA_K(2,2*SLOTB);
  WAIT_BAR(3);
  qkt(pA0,pA1,Kbase,qr,negm,r32,hi);asm volatile("s_nop 15\n\ts_nop 7":"+v"(pA0),"+v"(pA1));CMASK(pA0,pA1,0);
  START(pA0,pA1);
  _Pragma("unroll") for(int r=0;r<16;++r)pA1[r]=__builtin_amdgcn_exp2f(pA1[r]);
  WAIT_BAR(0);
  DMA_K(3,0);DMA_V(1,SLOTB);
  ROT();
  kload8(kf,kp0+sl_cur);
  WAIT_BAR(2);
  s16x4 vlo[8],vhi[8]; u32x4 pw0,pw1,pw2,pw3;
  #define PKW(P,B) cvtpk_s(P[B],P[B+1])
  #define PAF(k) __builtin_bit_cast(bf16x8,pw##k)
  #define VFR(i) (bf16x8){vlo[i][0],vlo[i][1],vlo[i][2],vlo[i][3],vhi[i][0],vhi[i][1],vhi[i][2],vhi[i][3]}
  #define PIN(x) asm volatile("":"+v"(x))
  #define MX3(a,b,c) __builtin_fmaxf(__builtin_fmaxf((a),(b)),(c))
  #define GAPA(MF,A0,A1,A2,A3,W0,W1,PW) do{ MF; sacc+=A0; sacc+=A1; sacc+=A2; sacc+=A3; PIN(sacc); W0; W1; PIN(PW); SBAR(); }while(0)
  #define EX(v) __builtin_amdgcn_exp2f(v)
  #define GAPB(MF,X,B) do{ MF; X[B]=EX(X[B]); X[B+1]=EX(X[B+1]); X[B+2]=EX(X[B+2]); X[B+3]=EX(X[B+3]); PIN(X); SBAR(); }while(0)
  #define VRD(i) do{ vlo[i]=vtr(vp_+(((i)>>2)*4096+((i)&3)*1024)); vhi[i]=vtr(vp_+(((i)>>2)*4096+((i)&3)*1024+512)); }while(0)
  #define KRD(G,j) do{ if(G){ kload2(kf,kp0+sl_next,j); SBAR(); } }while(0)
  #define STEP(C0,C1,P0,P1,t,GK,GV,GL) do{ SBAR(); \
    const lds_cptr vp_=vp0+sl_prev; \
    VRD(0); SBAR(); float sacc=(P0[0]+P0[1]); \
    GAPA(C0=__builtin_amdgcn_mfma_f32_32x32x16_bf16(kf[0],qr[0],negm,0,0,0), P0[2],P0[3],P0[4],P0[5],     pw0[0]=PKW(P0,0), pw0[1]=PKW(P0,2), pw0); \
    VRD(4); SBAR(); GAPA(C1=__builtin_amdgcn_mfma_f32_32x32x16_bf16(kf[1],qr[0],negm,0,0,0), P0[6],P0[7],P0[8],P0[9],     pw0[2]=PKW(P0,4), pw0[3]=PKW(P0,6), pw0); \
    VRD(1); SBAR(); GAPA(C0=__builtin_amdgcn_mfma_f32_32x32x16_bf16(kf[2],qr[1],C0,0,0,0),   P0[10],P0[11],P0[12],P0[13], pw1[0]=PKW(P0,8), pw1[1]=PKW(P0,10), pw1); \
    VRD(5); SBAR(); GAPA(C1=__builtin_amdgcn_mfma_f32_32x32x16_bf16(kf[3],qr[1],C1,0,0,0),   P0[14],P0[15],P1[0],P1[1],   pw1[2]=PKW(P0,12),pw1[3]=PKW(P0,14), pw1); \
    VRD(2); SBAR(); GAPA(C0=__builtin_amdgcn_mfma_f32_32x32x16_bf16(kf[4],qr[2],C0,0,0,0),   P1[2],P1[3],P1[4],P1[5],     pw2[0]=PKW(P1,0), pw2[1]=PKW(P1,2), pw2); \
    VRD(6); SBAR(); GAPA(C1=__builtin_amdgcn_mfma_f32_32x32x16_bf16(kf[5],qr[2],C1,0,0,0),   P1[6],P1[7],P1[8],P1[9],     pw2[2]=PKW(P1,4), pw2[3]=PKW(P1,6), pw2); \
    VRD(3); SBAR(); GAPA(C0=__builtin_amdgcn_mfma_f32_32x32x16_bf16(kf[6],qr[3],C0,0,0,0),   P1[10],P1[11],P1[12],P1[13], pw3[0]=PKW(P1,8), pw3[1]=PKW(P1,10), pw3); \
    VRD(7); SBAR(); GAPA(C1=__builtin_amdgcn_mfma_f32_32x32x16_bf16(kf[7],qr[3],C1,0,0,0),   P1[14],P1[15],0.f,0.f,       pw3[2]=PKW(P1,12),pw3[3]=PKW(P1,14), pw3); \
    l_reg+=sacc; \
    if(GK){DMA_K((t)+3,sl_cur);} if(GV){DMA_V((t)+1,sl_next);} \
    CMASK(C0,C1,t); \
    if constexpr(!NOMAX){ float a=MX3(C0[0],C0[1],C1[0]),b=MX3(C0[2],C0[3],C1[1]); a=MX3(a,C1[2],C1[3]); \
      _Pragma("unroll") for(int r=4;r<16;r+=4){a=MX3(a,C0[r],C0[r+1]);b=MX3(b,C0[r+2],C0[r+3]);a=MX3(a,C1[r],C1[r+1]);b=MX3(b,C1[r+2],C1[r+3]);} \
      float rm=__builtin_fmaxf(a,b); { auto rr=__builtin_amdgcn_permlane32_swap(__float_as_uint(rm),__float_as_uint(rm),false,false); rm=__builtin_fmaxf(__uint_as_float(rr[0]),__uint_as_float(rr[1])); } \
      resc=false; \
      if(__builtin_expect(__any(rm>(float)THRL),0)){ const float dl=__builtin_fmaxf(rm,0.f); mhat+=dl; \
        _Pragma("unroll") for(int r=0;r<16;++r){C0[r]-=dl;C1[r]-=dl;} \
        _Pragma("unroll") for(int r=0;r<16;++r)negm[r]=-mhat; asm volatile("":"+v"(negm)); \
        const float f=__builtin_amdgcn_exp2f(-dl); l_reg*=f; if(hi==0)wsf[r32]=f; resc=true; } } \
    SBAR(); \
    GAPB(o[0]=__builtin_amdgcn_mfma_f32_32x32x16_bf16(PAF(0),VFR(0),o[0],0,0,0), C0,0); \
    GAPB(o[1]=__builtin_amdgcn_mfma_f32_32x32x16_bf16(PAF(0),VFR(4),o[1],0,0,0), C0,4); \
    KRD(GL,0); GAPB(o[0]=__builtin_amdgcn_mfma_f32_32x32x16_bf16(PAF(1),VFR(1),o[0],0,0,0), C0,8); \
    KRD(GL,1); GAPB(o[1]=__builtin_amdgcn_mfma_f32_32x32x16_bf16(PAF(1),VFR(5),o[1],0,0,0), C0,12); \
    KRD(GL,2); GAPB(o[0]=__builtin_amdgcn_mfma_f32_32x32x16_bf16(PAF(2),VFR(2),o[0],0,0,0), C1,0); \
    KRD(GL,3); GAPB(o[1]=__builtin_amdgcn_mfma_f32_32x32x16_bf16(PAF(2),VFR(6),o[1],0,0,0), C1,4); \
    GAPB(o[0]=__builtin_amdgcn_mfma_f32_32x32x16_bf16(PAF(3),VFR(3),o[0],0,0,0), C1,8); \
    GAPB(o[1]=__builtin_amdgcn_mfma_f32_32x32x16_bf16(PAF(3),VFR(7),o[1],0,0,0), C1,12); \
    }while(0)
  int t=1;
  #undef CMASK
  #define CMASK(P0,P1,t) do{}while(0)
  for(;t+5<NT;t+=2){
    STEP(pB0,pB1,pA0,pA1,t,true,true,true);     WAIT_BAR(2); RESC(); ROT();
    STEP(pA0,pA1,pB0,pB1,t+1,true,true,true);   WAIT_BAR(2); RESC(); ROT();
  }
  #undef CMASK
  #define CMASK(P0,P1,t) do{}while(0)
  #define ENDW(tt) do{ if((tt)+3<NT){WAIT_BAR(2);} else if((tt)+2<NT){WAIT_BAR(1);} else {WAIT_BAR(0);} }while(0)
  for(;t+1<NT;t+=2){
    STEP(pB0,pB1,pA0,pA1,t,(t+3<NT),(t+1<NT),(t+1<NT));       ENDW(t);   RESC(); ROT();
    STEP(pA0,pA1,pB0,pB1,t+1,(t+4<NT),(t+2<NT),(t+2<NT));     ENDW(t+1); RESC(); ROT();
  }
  STEP(pB0,pB1,pA0,pA1,NT-1,false,false,false); RESC();
  { float sacc=pB0[0]+pB0[1]; _Pragma("unroll") for(int r=2;r<16;++r)sacc+=pB0[r]; _Pragma("unroll") for(int r=0;r<16;++r)sacc+=pB1[r]; l_reg+=sacc;
    pw0=(u32x4){PKW(pB0,0),PKW(pB0,2),PKW(pB0,4),PKW(pB0,6)};pw1=(u32x4){PKW(pB0,8),PKW(pB0,10),PKW(pB0,12),PKW(pB0,14)};pw2=(u32x4){PKW(pB1,0),PKW(pB1,2),PKW(pB1,4),PKW(pB1,6)};pw3=(u32x4){PKW(pB1,8),PKW(pB1,10),PKW(pB1,12),PKW(pB1,14)};
    SBAR(); pv(o,vb0+sl_cur,PAF(0),PAF(1),PAF(2),PAF(3)); }
  #undef PKW
  #undef PAF
  #undef VFR
  #undef PIN
  #undef MX3
  #undef GAPA
  #undef GAPB
  #undef EX
  #undef VRD
  #undef KRD
  #undef STEP
  #undef ENDW
  {auto rr=__builtin_amdgcn_permlane32_swap(__float_as_uint(l_reg),__float_as_uint(l_reg),false,false);l_reg=__uint_as_float(rr[0])+__uint_as_float(rr[1]);}
  if(hi==0)wsf[32+r32]=l_reg;asm volatile("s_waitcnt lgkmcnt(0)":::"memory");
  float rli[16];
  #pragma unroll
  for(int r=0;r<16;++r)rli[r]=__builtin_amdgcn_rcpf(wsf[32+crow(r,hi)]);
  bf16*Ow=O+(rowbase+q0+wid*QBLK)*DM+h*D;
  { bf16*stg=(bf16*)(shm+LDS_OST)+wid*2048;
    #pragma unroll
    for(int r=0;r<16;++r){const int orow=crow(r,hi);
      #pragma unroll
      for(int d0=0;d0<2;++d0)stg[orow*64+d0*32+r32]=__float2bfloat16(o[d0][r]*rli[r]);}
    asm volatile("s_waitcnt lgkmcnt(0)":::"memory");
    #pragma unroll
    for(int i=0;i<4;++i){const int row=i*8+(lane>>3),ch=lane&7; const u32x4 v=*(const u32x4*)(stg+row*64+ch*8); ATTN_STORE16(Ow+(long)row*DM+ch*8,v);} }
  asm volatile("s_waitcnt lgkmcnt(0)\n\ts_barrier":::"memory");
  #undef DMA_K
  #undef DMA_V
  #undef CMASK
  #undef START
  #undef RESC
  #undef ROT
}
constexpr int ATTN_LDS_BYTES=LDS_BYTES;
#undef SBAR
#undef WAIT_BAR
}
#include <hip/hip_cooperative_groups.h>
namespace cg = cooperative_groups;
#define LAS __attribute__((address_space(3)))
typedef unsigned short bf16;
typedef unsigned v4u __attribute__((ext_vector_type(4)));
typedef unsigned v2u __attribute__((ext_vector_type(2)));
typedef float f32x4 __attribute__((ext_vector_type(4)));
typedef short bf16x8 __attribute__((ext_vector_type(8)));

#define XB_TMO      128
#define XB_XCNT(j)  (256  + 64 * (j))
#define XB_XSUB(j)  (1280 + 64 * (j))
#define XB_XGEN(j)  (2304 + 64 * (j))
#define XB_TOP      3328
#define XB_TOPGEN   3392
#define XCD_BAR_WORDS 3456
#define XB_SPIN_CAP (1u << 18)

__device__ __forceinline__ unsigned xb_ld(unsigned* p)              { return __hip_atomic_load(p, __ATOMIC_RELAXED, __HIP_MEMORY_SCOPE_AGENT); }
__device__ __forceinline__ unsigned xb_add(unsigned* p, unsigned v) { return __hip_atomic_fetch_add(p, v, __ATOMIC_RELAXED, __HIP_MEMORY_SCOPE_AGENT); }
__device__ __forceinline__ unsigned xb_xcc_id() { return (unsigned)__builtin_amdgcn_s_getreg((3 << 11) | 20) & 0xFu; }
#define XB_SPIN(cond, bar) do { unsigned _sp = 0; while (cond) { __builtin_amdgcn_s_sleep(1); \
    if ((++_sp & 255u) == 0u) { if (xb_ld(&(bar)[XB_TMO])) break; if (_sp > XB_SPIN_CAP) { atomicAdd(&(bar)[XB_TMO], 1u); break; } } } } while (0)

struct XcdBarrier {
    unsigned* bar; unsigned x;
    volatile LAS unsigned* st;
};

__device__ __forceinline__ XcdBarrier xcd_barrier_post(unsigned* bar, volatile LAS unsigned* st) {
    XcdBarrier b; b.bar = bar; b.x = xb_xcc_id(); b.st = st;
    if (threadIdx.x == 0) (void)xb_add(&bar[XB_XCNT(b.x)], 1u);
    return b;
}
__device__ __forceinline__ void xcd_barrier_complete(unsigned* bar, unsigned x, unsigned& nloc, unsigned& nx) {
    const unsigned G = gridDim.x * gridDim.y * gridDim.z;
    unsigned sum, cnt, mine, sp = 0u;
    for (;;) {
        sum = 0u; cnt = 0u; mine = 0u;
#pragma unroll
        for (unsigned j = 0; j < 16; ++j) { const unsigned c = xb_ld(&bar[XB_XCNT(j)]); sum += c; cnt += (c > 0u) ? 1u : 0u; mine = (j == x) ? c : mine; }
        if (sum == G) break;
        __builtin_amdgcn_s_sleep(1);
        if ((++sp & 255u) == 0u) { if (xb_ld(&bar[XB_TMO])) break; if (sp > XB_SPIN_CAP) { atomicAdd(&bar[XB_TMO], 1u); break; } }
    }
    nloc = mine > 0u ? mine : 1u; nx = cnt > 0u ? cnt : 1u;
}

__device__ __forceinline__ void xcd_barrier(const XcdBarrier& b) {
    asm volatile("s_waitcnt vmcnt(0)" ::: "memory");
    __syncthreads();
    if (threadIdx.x == 0) {
        unsigned* bar = b.bar;
        __builtin_amdgcn_s_waitcnt(0);
        unsigned nloc = b.st[0], nx = b.st[1];
        if (nloc == 0u) { xcd_barrier_complete(bar, b.x, nloc, nx); b.st[0] = nloc; b.st[1] = nx; }
        const unsigned old = xb_add(&bar[XB_XSUB(b.x)], 1u);
        const unsigned gen = old / nloc;
        if (old + 1u == (gen + 1u) * nloc) {
            __builtin_amdgcn_fence(__ATOMIC_RELEASE, "agent");
            asm volatile("s_waitcnt vmcnt(0)" ::: "memory");
            const unsigned og = xb_add(&bar[XB_TOP], 1u);
            const unsigned tg = og / nx;
            if (og + 1u == (tg + 1u) * nx) xb_add(&bar[XB_TOPGEN], 1u);
            else XB_SPIN(xb_ld(&bar[XB_TOPGEN]) == tg, bar);
            __builtin_amdgcn_fence(__ATOMIC_ACQUIRE, "agent");
            xb_add(&bar[XB_XGEN(b.x)], 1u);
            asm volatile("s_waitcnt vmcnt(0)" ::: "memory");
        } else {
            XB_SPIN(xb_ld(&bar[XB_XGEN(b.x)]) == gen, bar);
            __builtin_amdgcn_fence(__ATOMIC_ACQUIRE, "agent");
            asm volatile("s_waitcnt vmcnt(0)" ::: "memory");
        }
    }
    __syncthreads();
}

constexpr int NB = 8, TL = 8192, TC = 256, TB = TL + TC  , MR = NB * TB  , DM = 1024, DFF = 2816, PW = 4608, NMOD = 9216;
constexpr float EPS = 1e-6f;
constexpr int LDS_BYTES = 147456, NTHR = 512, NWAVES = 8;
constexpr int PC_Q = 0, PC_K = 512, PC_V = 640, PC_GQ = 768, PC_GK = 1024, PC_GV = 1280, PC_G6 = 1792, PC_GATE = 2304, PC_LOW = 4352;
constexpr int GLA_S = 132, GLA_ITEMS = 64 * GLA_S;
constexpr size_t MiB = 1u << 20;
constexpr size_t WS_SSQ1 = 5 * MiB, WS_SSQ2 = 5 * MiB + 512 * 1024, WS_SW1 = 6 * MiB, WS_SW2 = 6 * MiB + 512 * 1024;
constexpr size_t WS_MOD = 1 * MiB, WS_DN = 2 * MiB, WS_WUP1 = 8 * MiB, WS_WUP2 = 20 * MiB, WS_WDN1 = 32 * MiB, WS_WDN2 = 38 * MiB, WS_WIN = 44 * MiB, WS_WBR0 = 54 * MiB, WS_WBR1 = 55 * MiB, WS_WOUT = 56 * MiB,
                 WS_HCTX = 64 * MiB, WS_XN = 72 * MiB, WS_OF = 204 * MiB, WS_OB = 270 * MiB, WS_A = 336 * MiB, WS_END = 932 * MiB;
static_assert(WS_XN + (size_t)MR * DM * 2 <= WS_OF && WS_OF + (size_t)MR * 512 * 2 <= WS_OB && WS_OB + (size_t)MR * 512 * 2 <= WS_A && WS_A + (size_t)MR * PW * 2 <= WS_END, "ws map");
static_assert((size_t)GLA_ITEMS * 8192 * 2 <= (size_t)MR * DM * 2 && WS_DN + (size_t)GLA_ITEMS * 64 * 4 <= WS_WUP1, "gla ws");

__device__ __forceinline__ unsigned f2bf(float f) { unsigned u = __builtin_bit_cast(unsigned, f); return (u + 0x7fffu + ((u >> 16) & 1u)) >> 16; }
typedef float pk_f32x2 __attribute__((ext_vector_type(2))); typedef __bf16 pk_bf16x2 __attribute__((ext_vector_type(2)));
__device__ __forceinline__ unsigned pk2(float lo, float hi) { const pk_f32x2 v = {lo, hi}; return __builtin_bit_cast(unsigned, __builtin_convertvector(v, pk_bf16x2)); }
__device__ __forceinline__ float bf2f(unsigned short h) { return __uint_as_float(((unsigned)h) << 16); }
__device__ __forceinline__ float wave_sum(float v) {
#pragma unroll
    for (int o = 1; o < 64; o <<= 1) v += __shfl_xor(v, o);
    return v;
}
__device__ __forceinline__ float silu_f(float v) { return v / (1.f + __expf(-v)); }

__device__ __forceinline__ void transpose_item(const float* W, int K, int N, bf16* WT, int k0, int n0, int drow0, LAS float* scr, int lane) {
#pragma unroll 8
    for (int i = 0; i < 32; ++i) { const int kk = 2 * i + (lane >> 5); scr[kk * 33 + (lane & 31)] = W[(size_t)(k0 + kk) * N + n0 + (lane & 31)]; }
    asm volatile("s_waitcnt lgkmcnt(0)" ::: "memory");
    const int c = lane & 7;
#pragma unroll
    for (int j = 0; j < 4; ++j) { const int n = (lane >> 3) + 8 * j; const LAS float* s = scr + (8 * c) * 33 + n;
        v4u o; o.x = pk2(s[0 * 33], s[1 * 33]); o.y = pk2(s[2 * 33], s[3 * 33]); o.z = pk2(s[4 * 33], s[5 * 33]); o.w = pk2(s[6 * 33], s[7 * 33]);
        *(v4u*)(WT + (size_t)(drow0 + n) * K + k0 + 8 * c) = o; }
    asm volatile("s_waitcnt lgkmcnt(0)" ::: "memory");
}
__device__ __forceinline__ int up_dest(int n0) { return n0 < DFF ? 256 * (n0 / 128) + (n0 % 128) : 256 * ((n0 - DFF) / 128) + 128 + ((n0 - DFF) % 128); }
__device__ __forceinline__ int win_dest(int n0) { return n0 < 2304 ? n0 : (n0 < 2336 ? n0 + 2048 : n0 - 32); }

__device__ __forceinline__ void norm_mod_rows(const float* lat, const float* ctxp, const float* mod, const float* g, int sub, bf16* XN, bool with_ctx, int gw, int NGW, int lane) {
    f32x4 gv[4];
#pragma unroll
    for (int j = 0; j < 4; ++j) gv[j] = *((const f32x4*)g + lane + 64 * j);
    for (int r0 = gw * 8; r0 < MR; r0 += NGW * 8) {
        const int b = r0 / TB, t = r0 % TB; const bool isctx = t >= TL;
        if (isctx && !with_ctx) continue;
        const float* src = isctx ? ctxp + (size_t)(b * TC + t - TL) * DM : lat + (size_t)(b * TL + t) * DM;
        const float* sh = mod + (size_t)(isctx ? 8 : b) * NMOD + (3 * sub) * DM; const float* sc = sh + DM;
        f32x4 v[8][4]; float s[8] = {0.f, 0.f, 0.f, 0.f, 0.f, 0.f, 0.f, 0.f}; f32x4 scv[4], shv[4];
#pragma unroll
        for (int u = 0; u < 8; ++u)
#pragma unroll
            for (int j = 0; j < 4; ++j) { v[u][j] = *((const f32x4*)(src + (size_t)u * DM) + lane + 64 * j); }
#pragma unroll
        for (int j = 0; j < 4; ++j) { scv[j] = *((const f32x4*)sc + lane + 64 * j) + 1.f; shv[j] = *((const f32x4*)sh + lane + 64 * j); }
#pragma unroll
        for (int u = 0; u < 8; ++u)
#pragma unroll
            for (int j = 0; j < 4; ++j) s[u] += (v[u][j].x * v[u][j].x + v[u][j].y * v[u][j].y) + (v[u][j].z * v[u][j].z + v[u][j].w * v[u][j].w);
#pragma unroll
        for (int u = 0; u < 8; ++u) {
            const float rstd = 1.f / sqrtf(wave_sum(s[u]) * (1.f / DM) + EPS);
            unsigned long long* o8 = (unsigned long long*)(XN + (size_t)(r0 + u) * DM) + lane;
#pragma unroll
            for (int j = 0; j < 4; ++j) {
                const f32x4 y = (v[u][j] * rstd * gv[j]) * scv[j] + shv[j];
                o8[64 * j] = (unsigned long long)pk2(y.x, y.y) | ((unsigned long long)pk2(y.z, y.w) << 32); } }
    }
}

constexpr int GS = 72, VS = 136;
constexpr int GL_QE = 0, GL_KE = 9216, GL_KL = 18432, GL_A = 27648, GL_V = 36864, GL_B = 54272, GL_BT = 71680, GL_SEG = 71936, BS = 68;
typedef short v4i16_t __attribute__((ext_vector_type(4)));
__device__ __forceinline__ bf16x8 tr_frag(const LAS bf16* base, int rs  , int col0, int ks, int q4, int qq, int p) {
    const LAS bf16* a0 = base + (32 * ks + 8 * q4 + qq) * rs + col0 + 4 * p;
    const v4i16_t t0 = __builtin_amdgcn_ds_read_tr16_b64_v4i16((LAS v4i16_t*)a0), t1 = __builtin_amdgcn_ds_read_tr16_b64_v4i16((LAS v4i16_t*)(a0 + 4 * rs));
    return (bf16x8){t0[0], t0[1], t0[2], t0[3], t1[0], t1[1], t1[2], t1[3]};
}
#define GLA_ROWOF(c) (rowbase + (dir ? 63 - (c) : (c)))
template <int PASS> __device__ __forceinline__ void gla_pass(LAS unsigned char* lds, const bf16* P, const float* w_decay, const float* b_decay, bf16* Ubuf, float* dn, bf16* OF, bf16* OB, int bx, int G, unsigned* ctr) {
    const int tid = opaque_tid(), lane = tid & 63, w = __builtin_amdgcn_readfirstlane(tid >> 6), l15 = lane & 15, q4 = lane >> 4, qq = (lane & 15) >> 2, p3 = lane & 3;
    constexpr int NV = PASS == 1 ? 64 * 131 : 64 * 128;
    LAS bf16* qeL = (LAS bf16*)(lds + GL_QE); LAS bf16* keL = (LAS bf16*)(lds + GL_KE); LAS bf16* klL = (LAS bf16*)(lds + GL_KL); LAS bf16* AL = (LAS bf16*)(lds + GL_A); LAS bf16* vL = (LAS bf16*)(lds + GL_V);
    LAS float* bL = (LAS float*)(lds + GL_B); LAS float* btL = (LAS float*)(lds + GL_BT); LAS float* segT = (LAS float*)(lds + GL_SEG);
    const int c = tid >> 3, ch = tid & 7, dt = w & 3, half = w >> 2;
    v4u vraw[2], kraw, qraw, lowf[2]; float wdr[8]; float bdr = 0.f; bf16x8 xsn[2];
    vraw[0] = vraw[1] = kraw = qraw = lowf[0] = lowf[1] = (v4u){0u, 0u, 0u, 0u}; xsn[0] = xsn[1] = (bf16x8){0, 0, 0, 0, 0, 0, 0, 0};
#pragma unroll
    for (int j = 0; j < 8; ++j) wdr[j] = 0.f;
#define GLA_DEC(idx_) const int chain = PASS == 1 ? (idx_) / 131 : (idx_) >> 7, s = PASS == 1 ? (idx_) % 131 : 4 + ((idx_) & 127), dir = chain & 1, h = (chain >> 1) & 3, b = chain >> 3; \
    const int rowbase = b * TB + (s < 4 ? TL + (dir ? 3 - s : s) * 64 : (dir ? 127 - (s - 4) : s - 4) * 64); const int item = chain * GLA_S + s; (void)item
#define GLA_LOAD(idx_) do { GLA_DEC(idx_); \
        _Pragma("unroll") for (int i = 0; i < 2; ++i) { const int n = tid + 512 * i; vraw[i] = *(const v4u*)(P + (size_t)GLA_ROWOF(n >> 4) * PW + PC_GV + h * 128 + (n & 15) * 8); } \
        { const size_t ro = (size_t)GLA_ROWOF(c) * PW + h * 64 + ch * 8; kraw = *(const v4u*)(P + ro + PC_GK); if (PASS == 3) qraw = *(const v4u*)(P + ro + PC_GQ); } \
        _Pragma("unroll") for (int i = 0; i < 2; ++i) lowf[i] = *(const v4u*)(P + (size_t)GLA_ROWOF(16 * (2 * half + i) + l15) * PW + PC_LOW + dir * 16 + (q4 & 1) * 8); \
        _Pragma("unroll") for (int j = 0; j < 8; ++j) wdr[j] = w_decay[(dir * 16 + 8 * (q4 & 1) + j) * 256 + h * 64 + 16 * dt + l15]; \
        bdr = b_decay[dir * 256 + h * 64 + 16 * dt + l15]; \
        if (PASS == 3) { _Pragma("unroll") for (int ks = 0; ks < 2; ++ks) xsn[ks] = *(const bf16x8*)(Ubuf + (size_t)item * 8192 + (16 * w + l15) * 64 + 8 * q4 + 32 * ks); } } while (0)
    volatile LAS unsigned* nxtL = (volatile LAS unsigned*)(lds + GL_SEG + 1024);
    int idx = bx;
    if (ctr) { if (tid == 0) nxtL[0] = __hip_atomic_fetch_add(ctr, 1u, __ATOMIC_RELAXED, __HIP_MEMORY_SCOPE_AGENT); __syncthreads(); idx = (int)nxtL[0]; __syncthreads(); }
    if (idx < NV) GLA_LOAD(idx);
    for (; idx < NV;) {
        int nidx = idx + G;
        if (ctr && tid == 0) nxtL[0] = __hip_atomic_fetch_add(ctr, 1u, __ATOMIC_RELAXED, __HIP_MEMORY_SCOPE_AGENT);
        GLA_DEC(idx);
#pragma unroll
        for (int i = 0; i < 2; ++i) { const int n = tid + 512 * i; *(LAS v4u*)(vL + (n >> 4) * VS + (n & 15) * 8) = vraw[i]; }
        float kf[8], qf[8];
        kf[0] = pg8::bflo(kraw.x); kf[1] = pg8::bfhi(kraw.x); kf[2] = pg8::bflo(kraw.y); kf[3] = pg8::bfhi(kraw.y); kf[4] = pg8::bflo(kraw.z); kf[5] = pg8::bfhi(kraw.z); kf[6] = pg8::bflo(kraw.w); kf[7] = pg8::bfhi(kraw.w);
        if (PASS == 3) { qf[0] = pg8::bflo(qraw.x); qf[1] = pg8::bfhi(qraw.x); qf[2] = pg8::bflo(qraw.y); qf[3] = pg8::bfhi(qraw.y); qf[4] = pg8::bflo(qraw.z); qf[5] = pg8::bfhi(qraw.z); qf[6] = pg8::bflo(qraw.w); qf[7] = pg8::bfhi(qraw.w); }
        float bv[2][4], tot[2];
        { bf16x8 yv;
#pragma unroll
          for (int j = 0; j < 8; ++j) { const unsigned hb = f2bf(wdr[j]); const unsigned lb = f2bf(wdr[j] - __uint_as_float(hb << 16)); yv[j] = (short)(q4 < 2 ? hb : lb); }
#pragma unroll
          for (int i = 0; i < 2; ++i) { f32x4 z = {0.f, 0.f, 0.f, 0.f}; z = __builtin_amdgcn_mfma_f32_16x16x32_bf16(__builtin_bit_cast(bf16x8, lowf[i]), yv, z, 0, 0, 0);
              float run = 0.f;
#pragma unroll
              for (int r = 0; r < 4; ++r) { const float zz = z[r] + bdr; run += (fminf(zz, 0.f) - __logf(1.f + __expf(-fabsf(zz)))) * (1.f / 16.f); bv[i][r] = run; }
              float sc = run; float t = __shfl_up(sc, 16); if (q4 >= 1) sc += t; t = __shfl_up(sc, 32); if (q4 >= 2) sc += t;
              const float excl = sc - run; tot[i] = __shfl(sc, 48 + l15);
#pragma unroll
              for (int r = 0; r < 4; ++r) bv[i][r] += excl + (i ? tot[0] : 0.f); }
          if (q4 == 0) segT[half * 64 + 16 * dt + l15] = tot[0] + tot[1]; }
        __syncthreads();
        { const float other = segT[(1 - half) * 64 + 16 * dt + l15]; const float add = half ? other : 0.f;
#pragma unroll
          for (int i = 0; i < 2; ++i)
#pragma unroll
              for (int r = 0; r < 4; ++r) bL[(16 * (2 * half + i) + 4 * q4 + r) * BS + 16 * dt + l15] = bv[i][r] + add;
          if (half == 0 && q4 == 0) btL[16 * dt + l15] = tot[0] + tot[1] + other; }
        __syncthreads();
        float bl[8], btot[8];
        { const f32x4 b0 = *(const LAS f32x4*)(bL + c * BS + 8 * ch), b1 = *(const LAS f32x4*)(bL + c * BS + 8 * ch + 4), t0 = *(const LAS f32x4*)(btL + 8 * ch), t1 = *(const LAS f32x4*)(btL + 8 * ch + 4);
          bl[0] = b0[0]; bl[1] = b0[1]; bl[2] = b0[2]; bl[3] = b0[3]; bl[4] = b1[0]; bl[5] = b1[1]; bl[6] = b1[2]; bl[7] = b1[3];
          btot[0] = t0[0]; btot[1] = t0[1]; btot[2] = t0[2]; btot[3] = t0[3]; btot[4] = t1[0]; btot[5] = t1[1]; btot[6] = t1[2]; btot[7] = t1[3]; }
        if (PASS == 1) {
            float kl[8];
#pragma unroll
            for (int k = 0; k < 8; ++k) kl[k] = kf[k] * __expf(btot[k] - bl[k]);
            v4u o; o.x = pk2(kl[0], kl[1]); o.y = pk2(kl[2], kl[3]); o.z = pk2(kl[4], kl[5]); o.w = pk2(kl[6], kl[7]);
            *(LAS v4u*)(klL + c * GS + 8 * ch) = o;
            if (tid < 8) { f32x4* dp = (f32x4*)(dn + (size_t)item * 64 + 8 * ch); dp[0] = (f32x4){__expf(btot[0]), __expf(btot[1]), __expf(btot[2]), __expf(btot[3])}; dp[1] = (f32x4){__expf(btot[4]), __expf(btot[5]), __expf(btot[6]), __expf(btot[7])}; }
        } else {
            float qe[8], ke[8];
#pragma unroll
            for (int k = 0; k < 8; ++k) { qe[k] = qf[k] * __expf(bl[k]) * 0.125f; ke[k] = kf[k] * __expf(-bl[k]); }
            v4u o; o.x = pk2(qe[0], qe[1]); o.y = pk2(qe[2], qe[3]); o.z = pk2(qe[4], qe[5]); o.w = pk2(qe[6], qe[7]);
            *(LAS v4u*)(qeL + c * GS + 8 * ch) = o;
            o.x = pk2(ke[0], ke[1]); o.y = pk2(ke[2], ke[3]); o.z = pk2(ke[4], ke[5]); o.w = pk2(ke[6], ke[7]);
            *(LAS v4u*)(keL + c * GS + 8 * ch) = o;
        }
        bf16x8 xs[2]; xs[0] = xsn[0]; xs[1] = xsn[1];
        if (ctr) nidx = (int)nxtL[0];
        if (nidx < NV) GLA_LOAD(nidx);
        __syncthreads();
        if (PASS == 1) {
            bf16x8 y[2];
#pragma unroll
            for (int ks = 0; ks < 2; ++ks) y[ks] = tr_frag(vL, VS, 16 * w, ks, q4, qq, p3);
#pragma unroll
            for (int dt = 0; dt < 4; ++dt) { f32x4 acc = {0.f, 0.f, 0.f, 0.f};
#pragma unroll
                for (int ks = 0; ks < 2; ++ks) { const bf16x8 x = tr_frag(klL, GS, 16 * dt, ks, q4, qq, p3); acc = __builtin_amdgcn_mfma_f32_16x16x32_bf16(x, y[ks], acc, 0, 0, 0); }
                v2u o; o.x = pk2(acc[0], acc[1]); o.y = pk2(acc[2], acc[3]);
                *(v2u*)(Ubuf + (size_t)item * 8192 + (16 * w + l15) * 64 + 16 * dt + 4 * q4) = o; }
        } else {
            { const int it = w >> 1;
#pragma unroll
              for (int jj = 0; jj < 2; ++jj) { const int jt = (w & 1) * 2 + jj; f32x4 acc = {0.f, 0.f, 0.f, 0.f};
                  if (jt <= it) {
#pragma unroll
                      for (int ks = 0; ks < 2; ++ks) { const bf16x8 x = *(const LAS bf16x8*)(keL + (16 * jt + l15) * GS + 8 * q4 + 32 * ks), y = *(const LAS bf16x8*)(qeL + (16 * it + l15) * GS + 8 * q4 + 32 * ks);
                          acc = __builtin_amdgcn_mfma_f32_16x16x32_bf16(x, y, acc, 0, 0, 0); }
                      const int i = 16 * it + l15, j0 = 16 * jt + 4 * q4;
#pragma unroll
                      for (int r = 0; r < 4; ++r) if (j0 + r > i) acc[r] = 0.f;
                  }
                  v2u o; o.x = pk2(acc[0], acc[1]); o.y = pk2(acc[2], acc[3]);
                  *(LAS v2u*)(AL + (16 * it + l15) * GS + 16 * jt + 4 * q4) = o; } }
            bf16x8 xv[2];
#pragma unroll
            for (int ks = 0; ks < 2; ++ks) xv[ks] = tr_frag(vL, VS, 16 * w, ks, q4, qq, p3);
            __syncthreads();
            bf16* Ob = dir ? OB : OF;
#pragma unroll
            for (int it = 0; it < 4; ++it) { f32x4 acc = {0.f, 0.f, 0.f, 0.f};
#pragma unroll
                for (int ks = 0; ks < 2; ++ks) { const bf16x8 y = *(const LAS bf16x8*)(AL + (16 * it + l15) * GS + 8 * q4 + 32 * ks); acc = __builtin_amdgcn_mfma_f32_16x16x32_bf16(xv[ks], y, acc, 0, 0, 0); }
#pragma unroll
                for (int ks = 0; ks < 2; ++ks) { const bf16x8 y = *(const LAS bf16x8*)(qeL + (16 * it + l15) * GS + 8 * q4 + 32 * ks); acc = __builtin_amdgcn_mfma_f32_16x16x32_bf16(xs[ks], y, acc, 0, 0, 0); }
                v2u o; o.x = pk2(acc[0], acc[1]); o.y = pk2(acc[2], acc[3]);
                *(v2u*)(Ob + (size_t)GLA_ROWOF(16 * it + l15) * 512 + h * 128 + 16 * w + 4 * q4) = o; }
        }
        __syncthreads();
        idx = nidx;
    }
#undef GLA_DEC
#undef GLA_LOAD
}

constexpr int GM_QEF = 0, GM_KEF = 9216, GM_QEB = 18432, GM_KEB = 27648, GM_A = 36864, GM_V = 46080, GM_BF = 63488, GM_BB = 80896, GM_SEG = 98304, GM_RED = 99328, GM_NXT = 101376;
__device__ __forceinline__ void gla_pass3m(LAS unsigned char* lds, const bf16* P, const float* w_decay, const float* b_decay, const float* g_gla, const bf16* Ubuf, bf16* OUT, unsigned* ctr) {
    const int tid = opaque_tid(), lane = tid & 63, w = __builtin_amdgcn_readfirstlane(tid >> 6), l15 = lane & 15, q4 = lane >> 4, qq = (lane & 15) >> 2, p3 = lane & 3;
    constexpr int NV = 8 * 4 * 128;
    LAS bf16* qeF = (LAS bf16*)(lds + GM_QEF); LAS bf16* keF = (LAS bf16*)(lds + GM_KEF); LAS bf16* qeB = (LAS bf16*)(lds + GM_QEB); LAS bf16* keB = (LAS bf16*)(lds + GM_KEB); LAS bf16* AL = (LAS bf16*)(lds + GM_A); LAS bf16* vL = (LAS bf16*)(lds + GM_V);
    LAS float* bF = (LAS float*)(lds + GM_BF); LAS float* bB = (LAS float*)(lds + GM_BB); LAS float* segT = (LAS float*)(lds + GM_SEG); LAS float* red = (LAS float*)(lds + GM_RED);
    volatile LAS unsigned* nxtL = (volatile LAS unsigned*)(lds + GM_NXT);
    const int c = tid >> 3, ch = tid & 7, dt = w & 3, half = w >> 2;
    v4u vraw[2], kraw, qraw, lowr[2][2]; float wdr[2][8]; float bdr[2]; bf16x8 xsn[2][2]; v2u g6r[4];
    float gg4[4];
#pragma unroll
    for (int r = 0; r < 4; ++r) gg4[r] = g_gla[16 * w + 4 * q4 + r];
#define GM_DEC(idx_) const int n_ = (idx_) & 127, h = ((idx_) >> 7) & 3, b = (idx_) >> 9; const int rowbase = b * TB + n_ * 64; \
    const size_t itemF = (size_t)((b * 4 + h) * 2 + 0) * GLA_S + 4 + n_, itemB = (size_t)((b * 4 + h) * 2 + 1) * GLA_S + 4 + (127 - n_); (void)itemF; (void)itemB
#define GM_LOAD(idx_) do { GM_DEC(idx_); \
        _Pragma("unroll") for (int i = 0; i < 2; ++i) { const int n = tid + 512 * i; vraw[i] = *(const v4u*)(P + (size_t)(rowbase + (n >> 4)) * PW + PC_GV + h * 128 + (n & 15) * 8); } \
        { const size_t ro = (size_t)(rowbase + c) * PW + h * 64 + ch * 8; kraw = *(const v4u*)(P + ro + PC_GK); qraw = *(const v4u*)(P + ro + PC_GQ); } \
        _Pragma("unroll") for (int dd = 0; dd < 2; ++dd) { \
            _Pragma("unroll") for (int i = 0; i < 2; ++i) lowr[dd][i] = *(const v4u*)(P + (size_t)(rowbase + 16 * (2 * half + i) + l15) * PW + PC_LOW + dd * 16 + (q4 & 1) * 8); \
            _Pragma("unroll") for (int j = 0; j < 8; ++j) wdr[dd][j] = w_decay[(dd * 16 + 8 * (q4 & 1) + j) * 256 + h * 64 + 16 * dt + l15]; \
            bdr[dd] = b_decay[dd * 256 + h * 64 + 16 * dt + l15]; \
            _Pragma("unroll") for (int ks = 0; ks < 2; ++ks) xsn[dd][ks] = *(const bf16x8*)(Ubuf + (dd ? itemB : itemF) * 8192 + (16 * w + l15) * 64 + 8 * q4 + 32 * ks); } \
        _Pragma("unroll") for (int it = 0; it < 4; ++it) g6r[it] = *(const v2u*)(P + (size_t)(rowbase + 16 * it + l15) * PW + PC_G6 + h * 128 + 16 * w + 4 * q4); } while (0)
    if (tid == 0) nxtL[0] = __hip_atomic_fetch_add(ctr, 1u, __ATOMIC_RELAXED, __HIP_MEMORY_SCOPE_AGENT);
    __syncthreads(); int idx = (int)nxtL[0]; __syncthreads();
    if (idx < NV) GM_LOAD(idx);
    for (; idx < NV;) {
        if (tid == 0) nxtL[0] = __hip_atomic_fetch_add(ctr, 1u, __ATOMIC_RELAXED, __HIP_MEMORY_SCOPE_AGENT);
        GM_DEC(idx);
#pragma unroll
        for (int i = 0; i < 2; ++i) { const int n = tid + 512 * i; *(LAS v4u*)(vL + (n >> 4) * VS + (n & 15) * 8) = vraw[i]; }
        float kf[8], qf[8];
        kf[0] = pg8::bflo(kraw.x); kf[1] = pg8::bfhi(kraw.x); kf[2] = pg8::bflo(kraw.y); kf[3] = pg8::bfhi(kraw.y); kf[4] = pg8::bflo(kraw.z); kf[5] = pg8::bfhi(kraw.z); kf[6] = pg8::bflo(kraw.w); kf[7] = pg8::bfhi(kraw.w);
        qf[0] = pg8::bflo(qraw.x); qf[1] = pg8::bfhi(qraw.x); qf[2] = pg8::bflo(qraw.y); qf[3] = pg8::bfhi(qraw.y); qf[4] = pg8::bflo(qraw.z); qf[5] = pg8::bfhi(qraw.z); qf[6] = pg8::bflo(qraw.w); qf[7] = pg8::bfhi(qraw.w);
        float bv[2][2][4], tot[2][2];
#pragma unroll
        for (int dd = 0; dd < 2; ++dd) { bf16x8 yv;
#pragma unroll
            for (int j = 0; j < 8; ++j) { const unsigned hb = f2bf(wdr[dd][j]); const unsigned lb = f2bf(wdr[dd][j] - __uint_as_float(hb << 16)); yv[j] = (short)(q4 < 2 ? hb : lb); }
#pragma unroll
            for (int ii = 0; ii < 2; ++ii) { const int i = dd ? 1 - ii : ii;
                f32x4 z = {0.f, 0.f, 0.f, 0.f}; z = __builtin_amdgcn_mfma_f32_16x16x32_bf16(__builtin_bit_cast(bf16x8, lowr[dd][i]), yv, z, 0, 0, 0);
                float g[4];
#pragma unroll
                for (int r = 0; r < 4; ++r) { const float zz = z[r] + bdr[dd]; g[r] = (fminf(zz, 0.f) - __logf(1.f + __expf(-fabsf(zz)))) * (1.f / 16.f); }
                float run = 0.f;
                if (dd == 0) {
#pragma unroll
                    for (int r = 0; r < 4; ++r) { run += g[r]; bv[dd][i][r] = run; }
                    float sc = run; float t = __shfl_up(sc, 16); if (q4 >= 1) sc += t; t = __shfl_up(sc, 32); if (q4 >= 2) sc += t;
                    const float excl = sc - run; tot[dd][i] = __shfl(sc, 48 + l15);
#pragma unroll
                    for (int r = 0; r < 4; ++r) bv[dd][i][r] += excl + (i ? tot[dd][0] : 0.f);
                } else {
#pragma unroll
                    for (int r = 3; r >= 0; --r) { run += g[r]; bv[dd][i][r] = run; }
                    float sc = run; float t = __shfl_down(sc, 16); if (q4 <= 2) sc += t; t = __shfl_down(sc, 32); if (q4 <= 1) sc += t;
                    const float excl = sc - run; tot[dd][i] = __shfl(sc, l15);
#pragma unroll
                    for (int r = 0; r < 4; ++r) bv[dd][i][r] += excl + (i ? 0.f : tot[dd][1]);
                } }
            if (q4 == 0) segT[(dd * 2 + half) * 64 + 16 * dt + l15] = tot[dd][0] + tot[dd][1]; }
        __syncthreads();
        { const float otherF = segT[(0 * 2 + (1 - half)) * 64 + 16 * dt + l15], otherB = segT[(1 * 2 + (1 - half)) * 64 + 16 * dt + l15];
          const float addF = half ? otherF : 0.f, addB = half ? 0.f : otherB;
#pragma unroll
          for (int i = 0; i < 2; ++i)
#pragma unroll
              for (int r = 0; r < 4; ++r) { const int tok = 16 * (2 * half + i) + 4 * q4 + r; bF[tok * BS + 16 * dt + l15] = bv[0][i][r] + addF; bB[tok * BS + 16 * dt + l15] = bv[1][i][r] + addB; } }
        __syncthreads();
        const int nidx = (int)nxtL[0];
        { const f32x4 f0 = *(const LAS f32x4*)(bF + c * BS + 8 * ch), f1 = *(const LAS f32x4*)(bF + c * BS + 8 * ch + 4), r0 = *(const LAS f32x4*)(bB + c * BS + 8 * ch), r1 = *(const LAS f32x4*)(bB + c * BS + 8 * ch + 4);
          const float bf_[8] = {f0[0], f0[1], f0[2], f0[3], f1[0], f1[1], f1[2], f1[3]}, bb_[8] = {r0[0], r0[1], r0[2], r0[3], r1[0], r1[1], r1[2], r1[3]};
          float a_[8], b_[8];
#pragma unroll
          for (int k = 0; k < 8; ++k) { a_[k] = qf[k] * __expf(bf_[k]) * 0.125f; b_[k] = kf[k] * __expf(-bf_[k]); }
          v4u o; o.x = pk2(a_[0], a_[1]); o.y = pk2(a_[2], a_[3]); o.z = pk2(a_[4], a_[5]); o.w = pk2(a_[6], a_[7]); *(LAS v4u*)(qeF + c * GS + 8 * ch) = o;
          o.x = pk2(b_[0], b_[1]); o.y = pk2(b_[2], b_[3]); o.z = pk2(b_[4], b_[5]); o.w = pk2(b_[6], b_[7]); *(LAS v4u*)(keF + c * GS + 8 * ch) = o;
#pragma unroll
          for (int k = 0; k < 8; ++k) { a_[k] = qf[k] * __expf(bb_[k]) * 0.125f; b_[k] = kf[k] * __expf(-bb_[k]); }
          o.x = pk2(a_[0], a_[1]); o.y = pk2(a_[2], a_[3]); o.z = pk2(a_[4], a_[5]); o.w = pk2(a_[6], a_[7]); *(LAS v4u*)(qeB + c * GS + 8 * ch) = o;
          o.x = pk2(b_[0], b_[1]); o.y = pk2(b_[2], b_[3]); o.z = pk2(b_[4], b_[5]); o.w = pk2(b_[6], b_[7]); *(LAS v4u*)(keB + c * GS + 8 * ch) = o; }
        bf16x8 xs[2][2]; v2u g6c[4];
#pragma unroll
        for (int dd = 0; dd < 2; ++dd) { xs[dd][0] = xsn[dd][0]; xs[dd][1] = xsn[dd][1]; }
#pragma unroll
        for (int it = 0; it < 4; ++it) g6c[it] = g6r[it];
        if (nidx < NV) GM_LOAD(nidx);
        __syncthreads();
        { const int it = w >> 1;
#pragma unroll
          for (int jj = 0; jj < 2; ++jj) { const int jt = (w & 1) * 2 + jj; f32x4 acc = {0.f, 0.f, 0.f, 0.f}; const int i = 16 * it + l15, j0 = 16 * jt + 4 * q4;
              if (jt <= it) { f32x4 af = {0.f, 0.f, 0.f, 0.f};
#pragma unroll
                  for (int ks = 0; ks < 2; ++ks) { const bf16x8 x = *(const LAS bf16x8*)(keF + (16 * jt + l15) * GS + 8 * q4 + 32 * ks), y = *(const LAS bf16x8*)(qeF + (16 * it + l15) * GS + 8 * q4 + 32 * ks);
                      af = __builtin_amdgcn_mfma_f32_16x16x32_bf16(x, y, af, 0, 0, 0); }
#pragma unroll
                  for (int r = 0; r < 4; ++r) acc[r] += (j0 + r <= i) ? af[r] : 0.f; }
              if (jt >= it) { f32x4 ab = {0.f, 0.f, 0.f, 0.f};
#pragma unroll
                  for (int ks = 0; ks < 2; ++ks) { const bf16x8 x = *(const LAS bf16x8*)(keB + (16 * jt + l15) * GS + 8 * q4 + 32 * ks), y = *(const LAS bf16x8*)(qeB + (16 * it + l15) * GS + 8 * q4 + 32 * ks);
                      ab = __builtin_amdgcn_mfma_f32_16x16x32_bf16(x, y, ab, 0, 0, 0); }
#pragma unroll
                  for (int r = 0; r < 4; ++r) acc[r] += (j0 + r >= i) ? ab[r] : 0.f; }
              v2u o; o.x = pk2(acc[0], acc[1]); o.y = pk2(acc[2], acc[3]);
              *(LAS v2u*)(AL + (16 * it + l15) * GS + 16 * jt + 4 * q4) = o; } }
        bf16x8 xv[2];
#pragma unroll
        for (int ks = 0; ks < 2; ++ks) xv[ks] = tr_frag(vL, VS, 16 * w, ks, q4, qq, p3);
        __syncthreads();
        f32x4 oacc[4]; float ssq[4];
#pragma unroll
        for (int it = 0; it < 4; ++it) { f32x4 acc = {0.f, 0.f, 0.f, 0.f};
#pragma unroll
            for (int ks = 0; ks < 2; ++ks) { const bf16x8 y = *(const LAS bf16x8*)(AL + (16 * it + l15) * GS + 8 * q4 + 32 * ks); acc = __builtin_amdgcn_mfma_f32_16x16x32_bf16(xv[ks], y, acc, 0, 0, 0); }
#pragma unroll
            for (int ks = 0; ks < 2; ++ks) { const bf16x8 y = *(const LAS bf16x8*)(qeF + (16 * it + l15) * GS + 8 * q4 + 32 * ks); acc = __builtin_amdgcn_mfma_f32_16x16x32_bf16(xs[0][ks], y, acc, 0, 0, 0); }
#pragma unroll
            for (int ks = 0; ks < 2; ++ks) { const bf16x8 y = *(const LAS bf16x8*)(qeB + (16 * it + l15) * GS + 8 * q4 + 32 * ks); acc = __builtin_amdgcn_mfma_f32_16x16x32_bf16(xs[1][ks], y, acc, 0, 0, 0); }
            oacc[it] = acc; float sq = (acc[0] * acc[0] + acc[1] * acc[1]) + (acc[2] * acc[2] + acc[3] * acc[3]);
            sq += __shfl_xor(sq, 16); sq += __shfl_xor(sq, 32); ssq[it] = sq;
            if (q4 == 0) red[w * 64 + 16 * it + l15] = sq; }
        __syncthreads();
#pragma unroll
        for (int it = 0; it < 4; ++it) { float tsum = 0.f;
#pragma unroll
            for (int w2 = 0; w2 < 8; ++w2) tsum += red[w2 * 64 + 16 * it + l15];
            const float rstd = 1.f / sqrtf(tsum * (1.f / 128.f) + EPS);
            const float gq_[4] = {pg8::bflo(g6c[it].x), pg8::bfhi(g6c[it].x), pg8::bflo(g6c[it].y), pg8::bfhi(g6c[it].y)};
            float y[4];
#pragma unroll
            for (int r = 0; r < 4; ++r) y[r] = oacc[it][r] * rstd * gg4[r] * silu_f(gq_[r]);
            v2u o; o.x = pk2(y[0], y[1]); o.y = pk2(y[2], y[3]);
            *(v2u*)(OUT + (size_t)(rowbase + 16 * it + l15) * 512 + h * 128 + 16 * w + 4 * q4) = o; }
        __syncthreads();
        idx = nidx;
    }
#undef GM_DEC
#undef GM_LOAD
}

__device__ __forceinline__ void gla_pass1m(LAS unsigned char* lds, const bf16* P, const float* w_decay, const float* b_decay, bf16* Ubuf, float* dn, unsigned* ctr) {
    const int tid = opaque_tid(), lane = tid & 63, w = __builtin_amdgcn_readfirstlane(tid >> 6), l15 = lane & 15, q4 = lane >> 4, qq = (lane & 15) >> 2, p3 = lane & 3;
    constexpr int NV = 8 * 4 * 132;
    LAS bf16* klF = (LAS bf16*)(lds + GM_QEF); LAS bf16* klB = (LAS bf16*)(lds + GM_KEF); LAS bf16* vL = (LAS bf16*)(lds + GM_V);
    LAS float* bF = (LAS float*)(lds + GM_BF); LAS float* bB = (LAS float*)(lds + GM_BB); LAS float* segT = (LAS float*)(lds + GM_SEG);
    volatile LAS unsigned* nxtL = (volatile LAS unsigned*)(lds + GM_NXT);
    const int c = tid >> 3, ch = tid & 7, dt = w & 3, half = w >> 2;
    v4u vraw[2], kraw, lowr[2][2]; float wdr[2][8]; float bdr[2];
#define G1_DEC(idx_) const int p_ = (idx_) % 132, bh_ = (idx_) / 132, h = bh_ & 3, b = bh_ >> 2; const int rowbase = b * TB + (p_ < 4 ? TL + p_ * 64 : (p_ - 4) * 64); \
    const size_t itemF = (size_t)(bh_ * 2 + 0) * GLA_S + p_, itemB = (size_t)(bh_ * 2 + 1) * GLA_S + (p_ < 4 ? 3 - p_ : 135 - p_); (void)itemF; (void)itemB
#define G1_LOAD(idx_) do { G1_DEC(idx_); \
        _Pragma("unroll") for (int i = 0; i < 2; ++i) { const int n = tid + 512 * i; vraw[i] = *(const v4u*)(P + (size_t)(rowbase + (n >> 4)) * PW + PC_GV + h * 128 + (n & 15) * 8); } \
        kraw = *(const v4u*)(P + (size_t)(rowbase + c) * PW + h * 64 + ch * 8 + PC_GK); \
        _Pragma("unroll") for (int dd = 0; dd < 2; ++dd) { \
            _Pragma("unroll") for (int i = 0; i < 2; ++i) lowr[dd][i] = *(const v4u*)(P + (size_t)(rowbase + 16 * (2 * half + i) + l15) * PW + PC_LOW + dd * 16 + (q4 & 1) * 8); \
            _Pragma("unroll") for (int j = 0; j < 8; ++j) wdr[dd][j] = w_decay[(dd * 16 + 8 * (q4 & 1) + j) * 256 + h * 64 + 16 * dt + l15]; \
            bdr[dd] = b_decay[dd * 256 + h * 64 + 16 * dt + l15]; } } while (0)
    if (tid == 0) nxtL[0] = __hip_atomic_fetch_add(ctr, 1u, __ATOMIC_RELAXED, __HIP_MEMORY_SCOPE_AGENT);
    __syncthreads(); int idx = (int)nxtL[0]; __syncthreads();
    if (idx < NV) G1_LOAD(idx);
    for (; idx < NV;) {
        if (tid == 0) nxtL[0] = __hip_atomic_fetch_add(ctr, 1u, __ATOMIC_RELAXED, __HIP_MEMORY_SCOPE_AGENT);
        G1_DEC(idx);
#pragma unroll
        for (int i = 0; i < 2; ++i) { const int n = tid + 512 * i; *(LAS v4u*)(vL + (n >> 4) * VS + (n & 15) * 8) = vraw[i]; }
        float kf[8];
        kf[0] = pg8::bflo(kraw.x); kf[1] = pg8::bfhi(kraw.x); kf[2] = pg8::bflo(kraw.y); kf[3] = pg8::bfhi(kraw.y); kf[4] = pg8::bflo(kraw.z); kf[5] = pg8::bfhi(kraw.z); kf[6] = pg8::bflo(kraw.w); kf[7] = pg8::bfhi(kraw.w);
        float bv[2][2][4], tot[2][2];
#pragma unroll
        for (int dd = 0; dd < 2; ++dd) { bf16x8 yv;
#pragma unroll
            for (int j = 0; j < 8; ++j) { const unsigned hb = f2bf(wdr[dd][j]); const unsigned lb = f2bf(wdr[dd][j] - __uint_as_float(hb << 16)); yv[j] = (short)(q4 < 2 ? hb : lb); }
#pragma unroll
            for (int ii = 0; ii < 2; ++ii) { const int i = dd ? 1 - ii : ii;
                f32x4 z = {0.f, 0.f, 0.f, 0.f}; z = __builtin_amdgcn_mfma_f32_16x16x32_bf16(__builtin_bit_cast(bf16x8, lowr[dd][i]), yv, z, 0, 0, 0);
                float g[4];
#pragma unroll
                for (int r = 0; r < 4; ++r) { const float zz = z[r] + bdr[dd]; g[r] = (fminf(zz, 0.f) - __logf(1.f + __expf(-fabsf(zz)))) * (1.f / 16.f); }
                float run = 0.f;
                if (dd == 0) {
#pragma unroll
                    for (int r = 0; r < 4; ++r) { run += g[r]; bv[dd][i][r] = run; }
                    float sc = run; float t = __shfl_up(sc, 16); if (q4 >= 1) sc += t; t = __shfl_up(sc, 32); if (q4 >= 2) sc += t;
                    const float excl = sc - run; tot[dd][i] = __shfl(sc, 48 + l15);
#pragma unroll
                    for (int r = 0; r < 4; ++r) bv[dd][i][r] += excl + (i ? tot[dd][0] : 0.f);
                } else {
#pragma unroll
                    for (int r = 3; r >= 0; --r) { run += g[r]; bv[dd][i][r] = run; }
                    float sc = run; float t = __shfl_down(sc, 16); if (q4 <= 2) sc += t; t = __shfl_down(sc, 32); if (q4 <= 1) sc += t;
                    const float excl = sc - run; tot[dd][i] = __shfl(sc, l15);
#pragma unroll
                    for (int r = 0; r < 4; ++r) bv[dd][i][r] += excl + (i ? 0.f : tot[dd][1]);
                } }
            if (q4 == 0) segT[(dd * 2 + half) * 64 + 16 * dt + l15] = tot[dd][0] + tot[dd][1]; }
        __syncthreads();
        { const float otherF = segT[(0 * 2 + (1 - half)) * 64 + 16 * dt + l15], otherB = segT[(1 * 2 + (1 - half)) * 64 + 16 * dt + l15];
          const float addF = half ? otherF : 0.f, addB = half ? 0.f : otherB;
#pragma unroll
          for (int i = 0; i < 2; ++i)
#pragma unroll
              for (int r = 0; r < 4; ++r) { const int tok = 16 * (2 * half + i) + 4 * q4 + r; bF[tok * BS + 16 * dt + l15] = bv[0][i][r] + addF; bB[tok * BS + 16 * dt + l15] = bv[1][i][r] + addB; } }
        __syncthreads();
        const int nidx = (int)nxtL[0];
        { const f32x4 f0 = *(const LAS f32x4*)(bF + c * BS + 8 * ch), f1 = *(const LAS f32x4*)(bF + c * BS + 8 * ch + 4), r0 = *(const LAS f32x4*)(bB + c * BS + 8 * ch), r1 = *(const LAS f32x4*)(bB + c * BS + 8 * ch + 4);
          const f32x4 tf0 = *(const LAS f32x4*)(bF + 63 * BS + 8 * ch), tf1 = *(const LAS f32x4*)(bF + 63 * BS + 8 * ch + 4), tb0 = *(const LAS f32x4*)(bB + 8 * ch), tb1 = *(const LAS f32x4*)(bB + 8 * ch + 4);
          const float bf_[8] = {f0[0], f0[1], f0[2], f0[3], f1[0], f1[1], f1[2], f1[3]}, bb_[8] = {r0[0], r0[1], r0[2], r0[3], r1[0], r1[1], r1[2], r1[3]};
          const float tF[8] = {tf0[0], tf0[1], tf0[2], tf0[3], tf1[0], tf1[1], tf1[2], tf1[3]}, tB[8] = {tb0[0], tb0[1], tb0[2], tb0[3], tb1[0], tb1[1], tb1[2], tb1[3]};
          float a_[8];
#pragma unroll
          for (int k = 0; k < 8; ++k) a_[k] = kf[k] * __expf(tF[k] - bf_[k]);
          v4u o; o.x = pk2(a_[0], a_[1]); o.y = pk2(a_[2], a_[3]); o.z = pk2(a_[4], a_[5]); o.w = pk2(a_[6], a_[7]); *(LAS v4u*)(klF + c * GS + 8 * ch) = o;
#pragma unroll
          for (int k = 0; k < 8; ++k) a_[k] = kf[k] * __expf(tB[k] - bb_[k]);
          o.x = pk2(a_[0], a_[1]); o.y = pk2(a_[2], a_[3]); o.z = pk2(a_[4], a_[5]); o.w = pk2(a_[6], a_[7]); *(LAS v4u*)(klB + c * GS + 8 * ch) = o;
          if (tid < 8) { f32x4* dp = (f32x4*)(dn + itemF * 64 + 8 * ch); dp[0] = (f32x4){__expf(tF[0]), __expf(tF[1]), __expf(tF[2]), __expf(tF[3])}; dp[1] = (f32x4){__expf(tF[4]), __expf(tF[5]), __expf(tF[6]), __expf(tF[7])};
              f32x4* dq = (f32x4*)(dn + itemB * 64 + 8 * ch); dq[0] = (f32x4){__expf(tB[0]), __expf(tB[1]), __expf(tB[2]), __expf(tB[3])}; dq[1] = (f32x4){__expf(tB[4]), __expf(tB[5]), __expf(tB[6]), __expf(tB[7])}; } }
        if (nidx < NV) G1_LOAD(nidx);
        __syncthreads();
        { bf16x8 y[2];
#pragma unroll
          for (int ks = 0; ks < 2; ++ks) y[ks] = tr_frag(vL, VS, 16 * w, ks, q4, qq, p3);
#pragma unroll
          for (int dt2 = 0; dt2 < 4; ++dt2) { f32x4 accF = {0.f, 0.f, 0.f, 0.f}, accB = {0.f, 0.f, 0.f, 0.f};
#pragma unroll
              for (int ks = 0; ks < 2; ++ks) { const bf16x8 xf = tr_frag(klF, GS, 16 * dt2, ks, q4, qq, p3), xb = tr_frag(klB, GS, 16 * dt2, ks, q4, qq, p3);
                  accF = __builtin_amdgcn_mfma_f32_16x16x32_bf16(xf, y[ks], accF, 0, 0, 0); accB = __builtin_amdgcn_mfma_f32_16x16x32_bf16(xb, y[ks], accB, 0, 0, 0); }
              v2u o; o.x = pk2(accF[0], accF[1]); o.y = pk2(accF[2], accF[3]);
              *(v2u*)(Ubuf + itemF * 8192 + (16 * w + l15) * 64 + 16 * dt2 + 4 * q4) = o;
              o.x = pk2(accB[0], accB[1]); o.y = pk2(accB[2], accB[3]);
              *(v2u*)(Ubuf + itemB * 8192 + (16 * w + l15) * 64 + 16 * dt2 + 4 * q4) = o; } }
        __syncthreads();
        idx = nidx;
    }
#undef G1_DEC
#undef G1_LOAD
}

struct Args { const float* in[19]; float* out; unsigned char* ws; };
__global__ void __launch_bounds__(NTHR, 2) mk_fwd(Args args) {
    extern __shared__ __attribute__((aligned(16))) unsigned char lds_raw[];
    cg::grid_group grid = cg::this_grid();
    LAS unsigned char* lds = (LAS unsigned char*)lds_raw;
    const int G = gridDim.x, bx = blockIdx.x, NGW = G * NWAVES;
    unsigned long long pacc = 0ull, pt0 = 0ull; (void)pt0;
#define PB(k) do { if ((PROBE_MASK >> (k)) & 1ull) pt0 = __builtin_amdgcn_s_memrealtime(); } while (0)
#define PE(k) do { if ((PROBE_MASK >> (k)) & 1ull) pacc += __builtin_amdgcn_s_memrealtime() - pt0; } while (0)
#define GSYNC() do { xcd_barrier(xbar); if (PROBE_SYNC) { const unsigned long long t_ = __builtin_amdgcn_s_memrealtime(); xcd_barrier(xbar); pacc += __builtin_amdgcn_s_memrealtime() - t_; } } while (0)
#define PH_IDS const int tid = opaque_tid(), lane = tid & 63, wave = __builtin_amdgcn_readfirstlane(tid >> 6), gw = bx * NWAVES + wave; (void)lane; (void)gw
    unsigned char* ws = args.ws;
    const float* x = args.in[0]; const float* cvec = args.in[1]; const float* ctx = args.in[2]; const float* c_ctx = args.in[3]; const float* w_mod = args.in[4]; const float* b_mod = args.in[5];
    const float* g_norm = args.in[6]; const float* w_up = args.in[7]; const float* w_down = args.in[8]; const float* w_in = args.in[9]; const float* g_q = args.in[10]; const float* g_k = args.in[11];
    const float* w_decay = args.in[12]; const float* b_decay = args.in[13]; const float* g_gla = args.in[14]; const float* w_branch = args.in[15]; const float* b_gate = args.in[16]; const float* w_out = args.in[17]; const float* g_final = args.in[18];
    float* H = args.out;
    float* HC = (float*)(ws + WS_HCTX);
    float* mod = (float*)(ws + WS_MOD); float* dn = (float*)(ws + WS_DN);
    bf16* Wup1 = (bf16*)(ws + WS_WUP1); bf16* Wup2 = (bf16*)(ws + WS_WUP2); bf16* Wdn1 = (bf16*)(ws + WS_WDN1); bf16* Wdn2 = (bf16*)(ws + WS_WDN2); bf16* Win = (bf16*)(ws + WS_WIN);
    bf16* Wbr0 = (bf16*)(ws + WS_WBR0); bf16* Wbr1 = (bf16*)(ws + WS_WBR1); bf16* Wout = (bf16*)(ws + WS_WOUT);
    bf16* XN = (bf16*)(ws + WS_XN); bf16* OF = (bf16*)(ws + WS_OF); bf16* OB = (bf16*)(ws + WS_OB); bf16* PA = (bf16*)(ws + WS_A);
    bf16* HID = PA; bf16* Ubuf = XN; bf16* Z = XN;
    float* ssq1 = (float*)(ws + WS_SSQ1); float* ssq2 = (float*)(ws + WS_SSQ2); float* sW1 = (float*)(ws + WS_SW1); float* sW2 = (float*)(ws + WS_SW2);
    bf16* XN2 = OF;

    volatile LAS unsigned* xst = (volatile LAS unsigned*)(lds + LDS_BYTES - 64);
    if (threadIdx.x < 2) xst[threadIdx.x] = 0u;
    unsigned* barw = (unsigned*)ws;
    if (bx == 0) for (int i = threadIdx.x; i < XCD_BAR_WORDS + 128; i += NTHR) __hip_atomic_store(barw + i, 0u, __ATOMIC_RELAXED, __HIP_MEMORY_SCOPE_AGENT);
    XcdBarrier xbar; xbar.bar = barw; xbar.x = 0; xbar.st = xst;
    PB(0);
    {
        PH_IDS;
        LAS float* sc = (LAS float*)lds; LAS float* red = sc + 9 * 1024;
        for (int idx = tid; idx < 9 * 1024; idx += NTHR) { const int j = idx >> 10, k = idx & 1023; const float v = j < 8 ? cvec[j * 1024 + k] : c_ctx[k]; sc[idx] = silu_f(v); }
        __syncthreads();
        for (int it = bx; it < NMOD / 32; it += G) {
            const int cc = tid & 31, ks = tid >> 5, col = it * 32 + cc;
            float a[9];
#pragma unroll
            for (int j = 0; j < 9; ++j) a[j] = 0.f;
#pragma unroll 4
            for (int kk = 0; kk < 64; ++kk) { const int k = ks * 64 + kk; const float wv = w_mod[(size_t)k * NMOD + col];
#pragma unroll
                for (int j = 0; j < 9; ++j) a[j] += sc[j * 1024 + k] * wv; }
#pragma unroll
            for (int j = 0; j < 9; ++j) red[(ks * 9 + j) * 32 + cc] = a[j];
            __syncthreads();
            if (tid < 288) { const int j = tid >> 5, c2 = tid & 31; float s = b_mod[it * 32 + c2];
#pragma unroll
                for (int k2 = 0; k2 < 16; ++k2) s += red[(k2 * 9 + j) * 32 + c2];
                mod[(size_t)j * NMOD + it * 32 + c2] = s; }
            __syncthreads();
        }
        LAS float* scr = (LAS float*)(lds + 65536) + wave * 2176;
        constexpr int I_UP = 16 * 176, I_DN = 44 * 32;
        for (int it = gw; it < I_UP + I_DN; it += NGW) {
            int r = it;
            if (r < I_UP) { const int kb = r / 176, nb = r % 176; transpose_item(w_up, 1024, 5632, Wup1, 64 * kb, 32 * nb, up_dest(32 * nb), scr, lane); continue; } r -= I_UP;
            { const int kb = r / 32, nb = r % 32; transpose_item(w_down, DFF, 1024, Wdn1, 64 * kb, 32 * nb, 32 * nb, scr, lane); }
        }
        for (int i = bx * NTHR + tid; i < 224 * 1024 / 8; i += G * NTHR) ((v4u*)(Win + (size_t)4384 * 1024))[i] = (v4u){0u, 0u, 0u, 0u};
        for (int i = bx * NTHR + tid; i < MR; i += G * NTHR) { ssq1[i] = 0.f; ssq2[i] = 0.f; }
    }
    grid.sync();
    xbar.x = xb_xcc_id(); if (threadIdx.x == 0) xst[2] = xb_add(&barw[XB_XCNT(xbar.x)], 1u);
    PE(0); PB(1);
    { PH_IDS; norm_mod_rows(x, ctx, mod, g_norm + 0 * DM, 0, XN, true, gw, NGW, lane);
    }
    GSYNC(); PE(1); PB(2);
    if (threadIdx.x == 0) { bool uni = (xbar.x < 8u) && ((G & 7) == 0);
        for (unsigned j = 0; j < 16; ++j) { const unsigned cnt_ = xb_ld(&barw[XB_XCNT(j)]); uni = uni && (cnt_ == (j < 8u ? (unsigned)(G >> 3) : 0u)); }
        xst[3] = uni ? (xst[2] * 8u + xbar.x) : (unsigned)bx; }
    __syncthreads();
    const int vb = (int)xst[3];
    { pg8::Gemm g{XN, Wup1, MR, 5632, 1024, 1024, 1024}; pg8::StaticOrder S; S.init(MR, 5632, G, vb);
      pg8::EpiSwiglu E{HID, DFF}; pg8::gemm_phase<pg8::EpiSwiglu, pg8::StaticOrder, true, true>(lds, g, S, E); }
    { PH_IDS;
      const int rem_ = (264 * 22) % G, ir_ = rem_ ? vb - rem_ : vb, ni_ = rem_ ? G - rem_ : G;
      if (ir_ >= 0) {
      LAS float* sc = (LAS float*)lds; LAS float* red = sc + 9 * 1024;
      for (int it = ir_; it < 144 + 176; it += ni_) {
          const bool second = it >= 144; const int n0 = (second ? it - 144 : it) * 32; const int sub = second ? 2 : 1;
          __syncthreads();
          for (int idx = tid; idx < 9 * 1024; idx += NTHR) sc[idx] = mod[(size_t)(idx >> 10) * NMOD + (3 * sub) * DM + (idx & 1023)];
          __syncthreads();
          const int cc = tid & 31, ks = tid >> 5, nd = n0 + cc; int nsrc; const float* Wp; int ldw;
          if (!second) { Wp = w_in; ldw = 4384; nsrc = nd < 2304 ? nd : (nd < 4352 ? nd + 32 : (nd < 4384 ? nd - 2048 : -1)); }
          else { Wp = w_up + (size_t)1024 * 5632; ldw = 5632; const int tile = nd >> 8, within = nd & 255; nsrc = within < 128 ? 128 * tile + within : DFF + 128 * tile + (within - 128); }
          float a[9];
#pragma unroll
          for (int j = 0; j < 9; ++j) a[j] = 0.f;
          if (nsrc >= 0) {
#pragma unroll 4
              for (int kk = 0; kk < 64; ++kk) { const int k = ks * 64 + kk; const float wv = Wp[(size_t)k * ldw + nsrc];
#pragma unroll
                  for (int j = 0; j < 9; ++j) a[j] += sc[j * 1024 + k] * wv; } }
#pragma unroll
          for (int j = 0; j < 9; ++j) red[(ks * 9 + j) * 32 + cc] = a[j];
          __syncthreads();
          if (tid < 288) { const int j = tid >> 5, c2 = tid & 31; float sum = 0.f;
#pragma unroll
              for (int k2 = 0; k2 < 16; ++k2) sum += red[(k2 * 9 + j) * 32 + c2];
              (second ? sW2 + (size_t)j * 5632 : sW1 + (size_t)j * PW)[n0 + c2] = sum; }
      }
      __syncthreads(); } }
    GSYNC(); PE(2); PB(3);
    { pg8::Gemm g{HID, Wdn1, MR, 1024, DFF, DFF, DFF}; pg8::StaticOrder S; S.init(MR, 1024, G, vb);
      pg8::EpiRes<1, 2, 1, 1> E{x, ctx, H, HC, mod, g_norm + 1 * DM, XN, ssq1}; pg8::gemm_phase<pg8::EpiRes<1, 2, 1, 1>, pg8::StaticOrder, true, true>(lds, g, S, E); }
    { PH_IDS;
      const int rem = (264 * 4) % G, ir = rem ? vb - rem : vb, ni = rem ? G - rem : G;
      if (ir >= 0) {
          LAS float* scr = (LAS float*)(lds + 65536) + wave * 2176;
          constexpr int I_UP = 16 * 176, I_DN = 44 * 32, I_IN = 16 * 137, I_BR = 8 * 32, I_OUT = 16 * 32;
          constexpr int NITEMS = I_UP + I_DN + I_IN + 2 * I_BR + I_OUT;
          for (int it = ir * NWAVES + wave; it < NITEMS; it += ni * NWAVES) {
              int r = it;
              if (r < I_UP) { const int kb = r / 176, nb = r % 176; transpose_item(w_up + (size_t)1024 * 5632, 1024, 5632, Wup2, 64 * kb, 32 * nb, up_dest(32 * nb), scr, lane); continue; } r -= I_UP;
              if (r < I_DN) { const int kb = r / 32, nb = r % 32; transpose_item(w_down + (size_t)DFF * 1024, DFF, 1024, Wdn2, 64 * kb, 32 * nb, 32 * nb, scr, lane); continue; } r -= I_DN;
              if (r < I_IN) { const int kb = r / 137, nb = r % 137; transpose_item(w_in, 1024, 4384, Win, 64 * kb, 32 * nb, win_dest(32 * nb), scr, lane); continue; } r -= I_IN;
              if (r < 2 * I_BR) { const int l = r / I_BR; r %= I_BR; const int kb = r / 32, nb = r % 32; transpose_item(w_branch + (size_t)l * 512 * 1024, 512, 1024, l ? Wbr1 : Wbr0, 64 * kb, 32 * nb, 32 * nb, scr, lane); continue; } r -= 2 * I_BR;
              { const int kb = r / 32, nb = r % 32; transpose_item(w_out, 1024, 1024, Wout, 64 * kb, 32 * nb, 32 * nb, scr, lane); }
          }
      } }
    GSYNC(); PE(3); PB(4);
#if MK_STAGE >= 2
    { pg8::Gemm g{XN, Win, MR, PW, 1024, 1024, 1024}; pg8::StaticOrder S; S.init(MR, PW, G, vb);
      pg8::EpiInproj E{PA, PW, ssq1, sW1, PW}; pg8::gemm_phase<pg8::EpiInproj, pg8::StaticOrder, true, true>(lds, g, S, E); }
    GSYNC(); PE(4); PB(5);
    { PH_IDS;
      const int l16 = lane & 15, l7 = lane & 7, l3 = lane & 3, usub = lane >> 4; const bool is_hi = (lane & 4) != 0;
      float frq[8], gk8[8];
#pragma unroll
      for (int k = 0; k < 8; ++k) { frq[k] = __builtin_amdgcn_exp2f(-(float)(8 * (l3 & 1) + k) * (13.287712379549449f / 16.f)); gk8[k] = g_k[8 * l7 + k]; }
      for (int r0 = gw * 16; r0 < MR; r0 += NGW * 16) {
          const int t0 = r0 % TB; const bool isctx = t0 >= TL;
          v4u kv[4];
#pragma unroll
          for (int jj = 0; jj < 4; ++jj) kv[jj] = *(const v4u*)(PA + (size_t)(r0 + 4 * jj + usub) * PW + PC_K + l16 * 8);
#pragma unroll
          for (int jj = 0; jj < 4; ++jj) { bf16* rp = PA + (size_t)(r0 + 4 * jj + usub) * PW + PC_K + l16 * 8; const int t = t0 + 4 * jj + usub;
              const float pos = (l3 < 2) ? (float)(t >> 6) : (float)(t & 63);
              const v4u raw = kv[jj];
              float xv[8]; xv[0] = pg8::bflo(raw.x); xv[1] = pg8::bfhi(raw.x); xv[2] = pg8::bflo(raw.y); xv[3] = pg8::bfhi(raw.y); xv[4] = pg8::bflo(raw.z); xv[5] = pg8::bfhi(raw.z); xv[6] = pg8::bflo(raw.w); xv[7] = pg8::bfhi(raw.w);
              float ss = 0.f;
#pragma unroll
              for (int k = 0; k < 8; ++k) ss += xv[k] * xv[k];
              ss += __shfl_xor(ss, 1); ss += __shfl_xor(ss, 2); ss += __shfl_xor(ss, 4);
              const float rstd = 1.f / sqrtf(ss * (1.f / 64.f) + EPS);
              float o[8];
#pragma unroll
              for (int k = 0; k < 8; ++k) { const float ang = pos * frq[k]; const float cs_ = isctx ? 1.f : __cosf(ang), sn_ = isctx ? 0.f : __sinf(ang);
                  const float y = xv[k] * rstd * gk8[k]; const float py = __shfl_xor(y, 4);
                  o[k] = is_hi ? (py * sn_ + y * cs_) : (y * cs_ - py * sn_); }
              v4u w4; w4.x = pk2(o[0], o[1]); w4.y = pk2(o[2], o[3]); w4.z = pk2(o[4], o[5]); w4.w = pk2(o[6], o[7]);
              *(v4u*)rp = w4; } } }
    gla_pass1m(lds, PA, w_decay, b_decay, Ubuf, dn, barw + XCD_BAR_WORDS + 96);
    GSYNC(); PE(5); PB(6);
    { PH_IDS; const int tg = bx * NTHR + tid;
      for (int q = tg; q < 64 * 2048; q += G * NTHR) { const int chain = q >> 11, e4 = q & 2047; const int d0 = (4 * e4) & 63;
          f32x4 S = {0.f, 0.f, 0.f, 0.f};
          for (int s0 = 0; s0 < GLA_S; s0 += 12) { v2u ur[12]; f32x4 dv[12];
#pragma unroll
              for (int j = 0; j < 12; ++j) { const size_t item = (size_t)chain * GLA_S + s0 + j; ur[j] = (v2u){0u, 0u}; dv[j] = (f32x4){0.f, 0.f, 0.f, 0.f};
                  if (s0 + j < GLA_S - 1) { ur[j] = *(const v2u*)(Ubuf + item * 8192 + 4 * e4); dv[j] = *(const f32x4*)(dn + item * 64 + d0); } }
#pragma unroll
              for (int j = 0; j < 12; ++j) { const size_t item = (size_t)chain * GLA_S + s0 + j;
                  v2u o; o.x = pk2(S[0], S[1]); o.y = pk2(S[2], S[3]); *(v2u*)(Ubuf + item * 8192 + 4 * e4) = o;
                  S[0] = dv[j][0] * S[0] + __uint_as_float(ur[j].x << 16); S[1] = dv[j][1] * S[1] + __uint_as_float(ur[j].x & 0xffff0000u);
                  S[2] = dv[j][2] * S[2] + __uint_as_float(ur[j].y << 16); S[3] = dv[j][3] * S[3] + __uint_as_float(ur[j].y & 0xffff0000u); } } } }
    GSYNC(); PE(6); PB(7);
    bool fastsm;
    { const int l_ = opaque_tid() & 63; float gqm = fabsf(g_q[l_]), gkm = fabsf(g_k[l_]);
#pragma unroll
      for (int o = 1; o < 64; o <<= 1) { gqm = fmaxf(gqm, __shfl_xor(gqm, o)); gkm = fmaxf(gkm, __shfl_xor(gkm, o)); }
      fastsm = __builtin_amdgcn_readfirstlane((2.f * 11.5416f * gqm * gkm + 14.f < 100.f) ? 1 : 0) != 0; }
    { const attn_body::bf16* Qp = (const attn_body::bf16*)(PA + PC_Q); const attn_body::bf16* Kp = (const attn_body::bf16*)(PA + PC_K); const attn_body::bf16* Vp = (const attn_body::bf16*)(PA + PC_V);
      if ((G & 7) == 0) { const int b = vb & 7, ci = vb >> 3, nper = G >> 3;
          for (int idx = ci; idx < 256; idx += nper) { const int h = idx >> 5, qb = idx & 31;
              if (fastsm) attn_body::attn_unit<8, true>(b, h, h >> 2, qb, Qp, Kp, Vp, (attn_body::bf16*)(PA + PC_Q), (char*)lds_raw, g_q);
              else attn_body::attn_unit<8, false>(b, h, h >> 2, qb, Qp, Kp, Vp, (attn_body::bf16*)(PA + PC_Q), (char*)lds_raw, g_q); } }
      else { for (int u = vb; u < 2048; u += G) { const int b = u >> 8, h = (u >> 5) & 7, qb = u & 31; attn_body::attn_unit<8, false>(b, h, h >> 2, qb, Qp, Kp, Vp, (attn_body::bf16*)(PA + PC_Q), (char*)lds_raw, g_q); } }
    }
    __syncthreads();
    PE(7); PB(21);
    gla_pass3m(lds, PA, w_decay, b_decay, g_gla, Ubuf, OF, barw + XCD_BAR_WORDS + 64);
    PE(21); PB(8);
    GSYNC(); PE(8); PB(9);
    { pg8::Gemm g{PA + PC_Q, Wbr0, MR, 1024, 512, PW, 512}; pg8::StaticOrder S; S.init(NB * TL, 1024, G, vb, 1);
      pg8::EpiGate<0> E{PA, b_gate, Z}; pg8::gemm_phase<pg8::EpiGate<0>, pg8::StaticOrder, true, true>(lds, g, S, E); }
    __syncthreads();
    { pg8::Gemm g{OF, Wbr1, MR, 1024, 512, 512, 512}; pg8::StaticOrder S; S.init(NB * TL, 1024, G, vb, 1);
      pg8::EpiGate<1> E{PA, b_gate, Z}; pg8::gemm_phase<pg8::EpiGate<1>, pg8::StaticOrder, true, true>(lds, g, S, E); }
    GSYNC(); PE(9); PB(10);
    { pg8::Gemm g{Z, Wout, MR, 1024, 1024, 1024, 1024}; pg8::StaticOrder S; S.init(NB * TL, 1024, G, vb, 1);
      pg8::EpiRes<1, 5, 0, 2> E{H, HC, H, HC, mod, g_norm + 2 * DM, XN2, ssq2}; pg8::gemm_phase<pg8::EpiRes<1, 5, 0, 2>, pg8::StaticOrder, true, true>(lds, g, S, E); }
    GSYNC(); PE(10); PB(11);
#endif
#if MK_STAGE >= 3
    { pg8::Gemm g{XN2, Wup2, MR, 5632, 1024, 1024, 1024}; pg8::StaticOrder S; S.init(NB * TL, 5632, G, vb, 1);
      pg8::EpiSwigluN E{HID, DFF, ssq2, sW2, 5632}; pg8::gemm_phase<pg8::EpiSwigluN, pg8::StaticOrder, true, true>(lds, g, S, E); }
    GSYNC(); PE(11); PB(12);
    { pg8::Gemm g{HID, Wdn2, MR, 1024, DFF, DFF, DFF}; pg8::StaticOrder S; S.init(NB * TL, 1024, G, vb, 1);
      pg8::EpiRes<0, 8, 1, 0> E{H, HC, H, HC, mod, nullptr, nullptr, nullptr}; pg8::gemm_phase<pg8::EpiRes<0, 8, 1, 0>, pg8::StaticOrder, true, true>(lds, g, S, E); }
    GSYNC(); PE(12); PB(13);
#endif
    { PH_IDS; f32x4 gv[4];
#pragma unroll
      for (int j = 0; j < 4; ++j) gv[j] = *((const f32x4*)g_final + lane + 64 * j);
      for (int r0 = gw * 4; r0 < NB * TL; r0 += NGW * 4) { f32x4* p = (f32x4*)(H + (size_t)r0 * DM) + lane; f32x4 v[4][4]; float s[4] = {0.f, 0.f, 0.f, 0.f};
#pragma unroll
          for (int u = 0; u < 4; ++u)
#pragma unroll
              for (int j = 0; j < 4; ++j) v[u][j] = p[u * 256 + 64 * j];
#pragma unroll
          for (int u = 0; u < 4; ++u)
#pragma unroll
              for (int j = 0; j < 4; ++j) s[u] += (v[u][j].x * v[u][j].x + v[u][j].y * v[u][j].y) + (v[u][j].z * v[u][j].z + v[u][j].w * v[u][j].w);
#pragma unroll
          for (int u = 0; u < 4; ++u) { const float rstd = 1.f / sqrtf(wave_sum(s[u]) * (1.f / DM) + EPS);
#pragma unroll
              for (int j = 0; j < 4; ++j) p[u * 256 + 64 * j] = v[u][j] * rstd * gv[j]; } } }
    PE(13);
    if (PROBE_MASK != 0ull || PROBE_SYNC) { const unsigned long long te = __builtin_amdgcn_s_memrealtime() + (unsigned long long)PROBE_MULT * pacc; while (__builtin_amdgcn_s_memrealtime() < te) __builtin_amdgcn_s_sleep(32); }
}

extern "C" void kernel_launch(void* const* d_in, const int* in_sizes, int n_in, void* d_out, int out_size, void* d_ws, size_t ws_size, hipStream_t stream) {
    static int grid = 0;
    if (grid == 0) {
        int dev = 0, cus = 0, per_cu = 0;
        hipGetDevice(&dev); hipDeviceGetAttribute(&cus, hipDeviceAttributeMultiprocessorCount, dev);
        hipFuncSetAttribute((const void*)mk_fwd, hipFuncAttributeMaxDynamicSharedMemorySize, LDS_BYTES);
        hipOccupancyMaxActiveBlocksPerMultiprocessor(&per_cu, (const void*)mk_fwd, NTHR, LDS_BYTES);
        if (per_cu < 1) per_cu = 1;
        grid = cus * per_cu;
        if (n_in != 19 || ws_size < WS_END) { fprintf(stderr, "kernel_launch: unexpected n_in %d or ws_size %zu\n", n_in, ws_size); }
    }
    Args a{};
    for (int i = 0; i < 19; ++i) a.in[i] = (const float*)d_in[i];
    a.out = (float*)d_out; a.ws = (unsigned char*)d_ws;
    void* kargs[] = {&a};
    hipError_t e = hipLaunchCooperativeKernel((const void*)mk_fwd, dim3(grid), dim3(NTHR), kargs, LDS_BYTES, stream);
    if (e != hipSuccess) fprintf(stderr, "cooperative launch failed: %s (grid %d)\n", hipGetErrorString(e), grid);
}
```

```cpp
#include <hip/hip_runtime.h>
#include <cstdio>
#include <cstdint>
#ifndef MK_STAGE
#define MK_STAGE 3
#endif
#define PROBE_MASK 0ull
#define PROBE_SYNC 0
#define PROBE_MULT 4
__device__ __forceinline__ int opaque_tid() { int t; asm volatile("v_mov_b32 %0, %1" : "=v"(t) : "v"((int)threadIdx.x)); return t; }
namespace pg8 {
#define PG8_LAS __attribute__((address_space(3)))
typedef unsigned short bf16_t;
typedef short bf16x8 __attribute__((ext_vector_type(8)));
typedef float f32x4 __attribute__((ext_vector_type(4)));
typedef unsigned u32x4 __attribute__((ext_vector_type(4)));
constexpr int BM = 256, BK = 64, HALF = 128, HTB = HALF * BK * 2  , STAGE_BYTES = 8 * HTB, NXCD = 8, WGM = 4;

__host__ __device__ __forceinline__ int lds_byte(int r, int c) { const int st = (r >> 4) * 2 + (c >> 5), rr = r & 15, cc = c & 31, ob = rr * 64 + cc * 2; return st * 1024 + (ob ^ (((ob >> 9) & 1) << 5)); }
__host__ __device__ __forceinline__ void stage_rc(int b, int& R, int& C) { const int st = b / 1024, sb = b % 1024, swz = sb ^ (((sb >> 9) & 1) << 5); R = (st >> 1) * 16 + swz / 64; C = (st & 1) * 32 + (swz % 64) / 2; }
__host__ __device__ __forceinline__ int perm32(int rho) { const int n = rho >> 4, i = rho & 15; return 8 * (i >> 2) + 4 * n + (i & 3); }

struct Unit { int pm, pn; };
struct Gemm { const bf16_t* A; const bf16_t* Bt; int M, N, K, lda, ldb; };

struct StaticOrder {
    int nM, nN, nwg, G, c, skip;
    __host__ __device__ void init(int M, int N, int G_, int c_, int skip_ = 0) { nM = M / BM; nN = N / BM; nwg = nM * nN; G = G_; c = c_; skip = skip_; }
    __host__ __device__ bool next(int i, Unit& u) const {
        const long L = (long)i * G + c; if (L >= nwg) return false;
        int wgid = (int)L; { const int q = nwg / NXCD, r = nwg % NXCD, xcd = wgid % NXCD, off = wgid / NXCD; wgid = (xcd < r ? xcd * (q + 1) : r * (q + 1) + (xcd - r) * q) + off; }
        const int nig = WGM * nN, gid = wgid / nig, fm = gid * WGM, gsz = (nM - fm) < WGM ? (nM - fm) : WGM;
        u.pm = fm + ((wgid % nig) % gsz); u.pn = (wgid % nig) / gsz; if (skip) u.pm += u.pm / 32; return true;
    }
    __device__ __forceinline__ void a_ready(const Unit&) const {}
    __device__ __forceinline__ void done(const Unit&) const {}
};

__device__ __forceinline__ unsigned cvt_pk_bf16(float lo, float hi) { unsigned r; asm volatile("v_cvt_pk_bf16_f32 %0, %1, %2" : "=v"(r) : "v"(lo), "v"(hi)); return r; }
__device__ __forceinline__ float fsigmoid(float x) { return __builtin_amdgcn_rcpf(1.f + __builtin_amdgcn_exp2f(-1.4426950408889634f * x)); }
__device__ __forceinline__ float bflo(unsigned w) { return __uint_as_float(w << 16); }
__device__ __forceinline__ float bfhi(unsigned w) { return __uint_as_float(w & 0xffff0000u); }
constexpr int TPB = 33;
constexpr int PWID = 4608;

struct EpiPlain {
    static constexpr bool PERM = true, AFTER_DRAIN = false;
    bf16_t* O; int ldc;
    __device__ __forceinline__ void operator()(const f32x4 (&acc)[2][2][4][2], const Unit& u, int wr, int wc, int fr, int fq) const {
        const int row0 = u.pm * BM + wr * 64 + fr, col0 = u.pn * BM + wc * 32 + 8 * fq;
#pragma unroll
        for (int ai = 0; ai < 2; ++ai)
#pragma unroll
            for (int m = 0; m < 4; ++m) { bf16_t* rowp = O + (size_t)(row0 + ai * HALF + m * 16) * ldc + col0;
#pragma unroll
                for (int bj = 0; bj < 2; ++bj) { const f32x4 v0 = acc[ai][bj][m][0], v1 = acc[ai][bj][m][1];
                    u32x4 w; w.x = cvt_pk_bf16(v0[0], v0[1]); w.y = cvt_pk_bf16(v0[2], v0[3]); w.z = cvt_pk_bf16(v1[0], v1[1]); w.w = cvt_pk_bf16(v1[2], v1[3]);
                    *(u32x4*)(rowp + bj * HALF) = w; } }
    }
};
struct EpiSwiglu {
    static constexpr bool PERM = true, AFTER_DRAIN = false;
    bf16_t* O; int ldc;
    __device__ __forceinline__ void operator()(const f32x4 (&acc)[2][2][4][2], const Unit& u, int wr, int wc, int fr, int fq) const {
        const int row0 = u.pm * BM + wr * 64 + fr, col0 = u.pn * HALF + wc * 32 + 8 * fq;
#pragma unroll
        for (int ai = 0; ai < 2; ++ai)
#pragma unroll
            for (int m = 0; m < 4; ++m) { bf16_t* rowp = O + (size_t)(row0 + ai * HALF + m * 16) * ldc + col0;
                float h[8];
#pragma unroll
                for (int n = 0; n < 2; ++n)
#pragma unroll
                    for (int k = 0; k < 4; ++k) { const float a = acc[ai][0][m][n][k], b = acc[ai][1][m][n][k]; h[n * 4 + k] = a * fsigmoid(a) * b; }
                u32x4 w; w.x = cvt_pk_bf16(h[0], h[1]); w.y = cvt_pk_bf16(h[2], h[3]); w.z = cvt_pk_bf16(h[4], h[5]); w.w = cvt_pk_bf16(h[6], h[7]);
                *(u32x4*)rowp = w; }
    }
};
template <int XNOUT, int GIDX, int HALFCOEF, int NSUB> struct EpiRes {
    static constexpr bool PERM = true, AFTER_DRAIN = false;
    const float* src_lat; const float* src_ctx; float* dst_lat; float* dst_ctx; const float* mod; const float* gnorm; bf16_t* xn; float* ssq;
    static constexpr int gidx = GIDX, nsub = NSUB; static constexpr float coef = HALFCOEF ? 0.5f : 1.0f;
    __device__ __forceinline__ void operator()(const f32x4 (&acc)[2][2][4][2], const Unit& u, int wr, int wc, int fr, int fq) const {
        asm volatile("" : "+v"(fr));
        const int b = u.pm / TPB, j = u.pm % TPB; const bool isctx = (j == TPB - 1);
        const float* src = isctx ? src_ctx + (size_t)b * 256 * 1024 : src_lat + (size_t)(b * 8192 + j * 256) * 1024;
        float* dst = isctx ? dst_ctx + (size_t)b * 256 * 1024 : dst_lat + (size_t)(b * 8192 + j * 256) * 1024;
        const float* mrow = mod + (size_t)(isctx ? 8 : b) * 9216;
        const float* g = mrow + gidx * 1024;
        const int col0 = u.pn * BM + wc * 32 + 8 * fq;
        f32x4 gv[2][2], gs[2][2];
#pragma unroll
        for (int bj = 0; bj < 2; ++bj)
#pragma unroll
            for (int n = 0; n < 2; ++n) { gv[bj][n] = *(const f32x4*)(g + col0 + bj * HALF + 4 * n) * coef;
                if (XNOUT) gs[bj][n] = *(const f32x4*)(gnorm + col0 + bj * HALF + 4 * n) * (*(const f32x4*)(mrow + (3 * nsub + 1) * 1024 + col0 + bj * HALF + 4 * n) + 1.f); }
#pragma unroll
        for (int ai = 0; ai < 2; ++ai)
#pragma unroll
            for (int m = 0; m < 4; ++m) { const int rl = ai * HALF + wr * 64 + m * 16 + fr; const size_t off = (size_t)rl * 1024 + col0; float sq = 0.f;
#pragma unroll
                for (int bj = 0; bj < 2; ++bj) { f32x4 o[2];
#pragma unroll
                    for (int n = 0; n < 2; ++n) { const f32x4 sv = *(const f32x4*)(src + off + bj * HALF + 4 * n); o[n] = sv + gv[bj][n] * acc[ai][bj][m][n];
                        if (!(XNOUT && isctx)) *(f32x4*)(dst + off + bj * HALF + 4 * n) = o[n]; }
                    if (XNOUT) { sq += (o[0][0] * o[0][0] + o[0][1] * o[0][1]) + (o[0][2] * o[0][2] + o[0][3] * o[0][3]) + (o[1][0] * o[1][0] + o[1][1] * o[1][1]) + (o[1][2] * o[1][2] + o[1][3] * o[1][3]);
                        const f32x4 x0 = o[0] * gs[bj][0], x1 = o[1] * gs[bj][1];
                        u32x4 w; w.x = cvt_pk_bf16(x0[0], x0[1]); w.y = cvt_pk_bf16(x0[2], x0[3]); w.z = cvt_pk_bf16(x1[0], x1[1]); w.w = cvt_pk_bf16(x1[2], x1[3]);
                        *(u32x4*)(xn + (size_t)(u.pm * BM + rl) * 1024 + col0 + bj * HALF) = w; } }
                if (XNOUT) { sq += __shfl_xor(sq, 16); sq += __shfl_xor(sq, 32); if (fq == 0) atomicAdd(ssq + u.pm * BM + rl, sq); }
                if (m & 1) asm volatile("" ::: "memory"); }
    }
};
struct EpiInproj {
    static constexpr bool PERM = true, AFTER_DRAIN = false;
    bf16_t* O; int ldc; const float* ssq; const float* sw; int swld;
    __device__ __forceinline__ void operator()(const f32x4 (&acc)[2][2][4][2], const Unit& u, int wr, int wc, int fr, int fq) const {
        const int row0 = u.pm * BM + wr * 64 + fr, col0 = u.pn * BM + wc * 32 + 8 * fq;
        const float* swr = sw + (size_t)((u.pm % TPB == TPB - 1) ? 8 : u.pm / TPB) * swld + col0;
        f32x4 sv[2][2];
#pragma unroll
        for (int bj = 0; bj < 2; ++bj)
#pragma unroll
            for (int n = 0; n < 2; ++n) sv[bj][n] = *(const f32x4*)(swr + bj * HALF + 4 * n);
#pragma unroll
        for (int ai = 0; ai < 2; ++ai)
#pragma unroll
            for (int m = 0; m < 4; ++m) { const int row = row0 + ai * HALF + m * 16; bf16_t* rowp = O + (size_t)row * ldc + col0;
                const float rstd = 1.f / sqrtf(ssq[row] * (1.f / 1024.f) + 1e-6f);
#pragma unroll
                for (int bj = 0; bj < 2; ++bj) { const f32x4 v0 = acc[ai][bj][m][0] * rstd + sv[bj][0], v1 = acc[ai][bj][m][1] * rstd + sv[bj][1];
                    u32x4 w; w.x = cvt_pk_bf16(v0[0], v0[1]); w.y = cvt_pk_bf16(v0[2], v0[3]); w.z = cvt_pk_bf16(v1[0], v1[1]); w.w = cvt_pk_bf16(v1[2], v1[3]);
                    *(u32x4*)(rowp + bj * HALF) = w; } }
    }
};
struct EpiSwigluN {
    static constexpr bool PERM = true, AFTER_DRAIN = false;
    bf16_t* O; int ldc; const float* ssq; const float* sw; int swld;
    __device__ __forceinline__ void operator()(const f32x4 (&acc)[2][2][4][2], const Unit& u, int wr, int wc, int fr, int fq) const {
        const int row0 = u.pm * BM + wr * 64 + fr, col0 = u.pn * HALF + wc * 32 + 8 * fq;
        const float* swr = sw + (size_t)((u.pm % TPB == TPB - 1) ? 8 : u.pm / TPB) * swld + u.pn * BM + wc * 32 + 8 * fq;
        f32x4 sv[2][2];
#pragma unroll
        for (int bj = 0; bj < 2; ++bj)
#pragma unroll
            for (int n = 0; n < 2; ++n) sv[bj][n] = *(const f32x4*)(swr + bj * HALF + 4 * n);
#pragma unroll
        for (int ai = 0; ai < 2; ++ai)
#pragma unroll
            for (int m = 0; m < 4; ++m) { const int row = row0 + ai * HALF + m * 16; bf16_t* rowp = O + (size_t)row * ldc + col0;
                const float rstd = 1.f / sqrtf(ssq[row] * (1.f / 1024.f) + 1e-6f);
                float h[8];
#pragma unroll
                for (int n = 0; n < 2; ++n)
#pragma unroll
                    for (int k = 0; k < 4; ++k) { const float a = acc[ai][0][m][n][k] * rstd + sv[0][n][k], b = acc[ai][1][m][n][k] * rstd + sv[1][n][k]; h[n * 4 + k] = a * fsigmoid(a) * b; }
                u32x4 w; w.x = cvt_pk_bf16(h[0], h[1]); w.y = cvt_pk_bf16(h[2], h[3]); w.z = cvt_pk_bf16(h[4], h[5]); w.w = cvt_pk_bf16(h[6], h[7]);
                *(u32x4*)rowp = w; }
    }
};
template <int SECOND> struct EpiGate {
    static constexpr bool PERM = true, AFTER_DRAIN = false;
    const bf16_t* P; const float* bgate; bf16_t* Z;
    __device__ __forceinline__ void operator()(const f32x4 (&acc)[2][2][4][2], const Unit& u, int wr, int wc, int fr, int fq) const {
        const int row0 = u.pm * BM + wr * 64 + fr, col0 = u.pn * BM + wc * 32 + 8 * fq;
        f32x4 bg[2][2];
#pragma unroll
        for (int bj = 0; bj < 2; ++bj)
#pragma unroll
            for (int n = 0; n < 2; ++n) bg[bj][n] = *(const f32x4*)(bgate + 1024 * SECOND + col0 + bj * HALF + 4 * n);
#pragma unroll
        for (int ai = 0; ai < 2; ++ai)
#pragma unroll
            for (int m = 0; m < 4; ++m) { const size_t row = (size_t)(row0 + ai * HALF + m * 16);
#pragma unroll
                for (int bj = 0; bj < 2; ++bj) { const int c = col0 + bj * HALF;
                    const u32x4 gr = *(const u32x4*)(P + row * PWID + 2304 + 1024 * SECOND + c);
                    float v[8];
                    v[0] = fsigmoid(bflo(gr.x) + bg[bj][0][0]) * acc[ai][bj][m][0][0]; v[1] = fsigmoid(bfhi(gr.x) + bg[bj][0][1]) * acc[ai][bj][m][0][1];
                    v[2] = fsigmoid(bflo(gr.y) + bg[bj][0][2]) * acc[ai][bj][m][0][2]; v[3] = fsigmoid(bfhi(gr.y) + bg[bj][0][3]) * acc[ai][bj][m][0][3];
                    v[4] = fsigmoid(bflo(gr.z) + bg[bj][1][0]) * acc[ai][bj][m][1][0]; v[5] = fsigmoid(bfhi(gr.z) + bg[bj][1][1]) * acc[ai][bj][m][1][1];
                    v[6] = fsigmoid(bflo(gr.w) + bg[bj][1][2]) * acc[ai][bj][m][1][2]; v[7] = fsigmoid(bfhi(gr.w) + bg[bj][1][3]) * acc[ai][bj][m][1][3];
                    bf16_t* zp = Z + row * 1024 + c;
                    if (SECOND) { const u32x4 zr = *(const u32x4*)zp;
                        v[0] += bflo(zr.x); v[1] += bfhi(zr.x); v[2] += bflo(zr.y); v[3] += bfhi(zr.y); v[4] += bflo(zr.z); v[5] += bfhi(zr.z); v[6] += bflo(zr.w); v[7] += bfhi(zr.w); }
                    u32x4 w; w.x = cvt_pk_bf16(v[0], v[1]); w.y = cvt_pk_bf16(v[2], v[3]); w.z = cvt_pk_bf16(v[4], v[5]); w.w = cvt_pk_bf16(v[6], v[7]);
                    *(u32x4*)zp = w; } }
    }
};
template <class Epi, class Sched, bool ALIGN_EPI = false, bool SP2 = false>
__device__ __forceinline__ void gemm_phase(PG8_LAS unsigned char* lds, const Gemm g, const Sched& S, const Epi& E) {
    const int tid = opaque_tid(), wid = __builtin_amdgcn_readfirstlane(tid >> 6), lane = tid & 63, wr = wid >> 2, wc = wid & 3, fr = lane & 15, fq = lane >> 4;
    const int K = g.K, nt = K / BK;
    unsigned voffA[2], voffB[2];
#pragma unroll
    for (int i = 0; i < 2; ++i) { int R, C; stage_rc(tid * 16 + i * 8192, R, C); const int Rb = Epi::PERM ? ((R & ~31) + perm32(R & 31)) : R;
        voffA[i] = (unsigned)(R * g.lda + C) * 2u; voffB[i] = (unsigned)(Rb * g.ldb + C) * 2u; }
    const size_t kstep = (size_t)(BK * 2);
    const size_t hstepA = (size_t)HALF * g.lda * 2, hstepB = (size_t)HALF * g.ldb * 2;
    const size_t tstepA = 2 * hstepA, tstepB = 2 * hstepB;
    const unsigned ldsw = (unsigned)wid * 1024u;
    const int aoff = lds_byte(wr * 64 + fr, fq * 8), boff = lds_byte(wc * 32 + fr, fq * 8);
#define PG8_SA(b, h) (((b) * 2 + (h)) * HTB)
#define PG8_SB(b, h) ((4 + (b) * 2 + (h)) * HTB)
#define PG8_STAGE(bufoff, gbase, voff) do { _Pragma("unroll") for (int _i = 0; _i < 2; ++_i) \
        __builtin_amdgcn_global_load_lds((const unsigned*)((const char*)(gbase) + (voff)[_i]), (PG8_LAS unsigned*)(lds + (bufoff) + ldsw + _i * 8192), 16, 0, 0); } while (0)
#define PG8_LDA(dst, b, h) do { _Pragma("unroll") for (int m = 0; m < 4; ++m) _Pragma("unroll") for (int k = 0; k < 2; ++k) dst[m][k] = *(const PG8_LAS bf16x8*)(lds + PG8_SA(b, h) + aoff + m * 2048 + k * 1024); } while (0)
#define PG8_LDB(dst, b, h) do { _Pragma("unroll") for (int n = 0; n < 2; ++n) _Pragma("unroll") for (int k = 0; k < 2; ++k) dst[n][k] = *(const PG8_LAS bf16x8*)(lds + PG8_SB(b, h) + boff + n * 2048 + k * 1024); } while (0)
#define PG8_MMA(ai, bj, At, Bt) do { __builtin_amdgcn_s_setprio(1); _Pragma("unroll") for (int m = 0; m < 4; ++m) _Pragma("unroll") for (int n = 0; n < 2; ++n) _Pragma("unroll") for (int k = 0; k < 2; ++k) \
        acc[ai][bj][m][n] = __builtin_amdgcn_mfma_f32_16x16x32_bf16(Bt[n][k], At[m][k], acc[ai][bj][m][n], 0, 0, 0); __builtin_amdgcn_s_setprio(0); } while (0)
#define PG8_WAIT_V(n) asm volatile("s_waitcnt vmcnt(" #n ")" ::: "memory")
#define PG8_WAIT_L(n) asm volatile("s_waitcnt lgkmcnt(" #n ")" ::: "memory")
#define PG8_BAR __builtin_amdgcn_s_barrier()
#define PG8_SCHED __builtin_amdgcn_sched_barrier(0)
    Unit cur, nxt; int ui = 0;
    if (!S.next(0, cur)) return;
    f32x4 acc[2][2][4][2];
#pragma unroll
    for (int a = 0; a < 2; ++a)
#pragma unroll
        for (int b = 0; b < 2; ++b)
#pragma unroll
            for (int m = 0; m < 4; ++m)
#pragma unroll
                for (int n = 0; n < 2; ++n) acc[a][b][m][n] = (f32x4){0.f, 0.f, 0.f, 0.f};
    bf16x8 At[4][2], B0[2][2], B1[2][2];
    const char* cA = (const char*)g.A + (size_t)cur.pm * tstepA; const char* cB = (const char*)g.Bt + (size_t)cur.pn * tstepB;
    S.a_ready(cur);
    if constexpr (SP2) {
        PG8_STAGE(PG8_SB(0, 0), cB, voffB); PG8_STAGE(PG8_SB(0, 1), cB + hstepB, voffB); PG8_STAGE(PG8_SA(0, 0), cA, voffA); PG8_STAGE(PG8_SA(0, 1), cA + hstepA, voffA);
        if (wr == 1) PG8_BAR;
        PG8_WAIT_V(2); PG8_BAR;
        PG8_STAGE(PG8_SB(1, 0), cB + kstep, voffB); PG8_STAGE(PG8_SA(1, 0), cA + kstep, voffA); PG8_STAGE(PG8_SB(1, 1), cB + hstepB + kstep, voffB);
        PG8_WAIT_V(6); PG8_BAR;
    } else {
        PG8_STAGE(PG8_SB(0, 0), cB, voffB); PG8_STAGE(PG8_SA(0, 0), cA, voffA); PG8_STAGE(PG8_SB(0, 1), cB + hstepB, voffB); PG8_STAGE(PG8_SA(0, 1), cA + hstepA, voffA);
        if (wr == 1) PG8_BAR;
        PG8_WAIT_V(4); PG8_BAR;
        PG8_STAGE(PG8_SB(1, 0), cB + kstep, voffB); PG8_STAGE(PG8_SA(1, 0), cA + kstep, voffA); PG8_STAGE(PG8_SB(1, 1), cB + hstepB + kstep, voffB);
        PG8_WAIT_V(6); PG8_BAR;
    }
    for (;;) {
        const bool has_next = S.next(ui + 1, nxt);
        const char* nA = has_next ? (const char*)g.A + (size_t)nxt.pm * tstepA : cA; const char* nB = has_next ? (const char*)g.Bt + (size_t)nxt.pn * tstepB : cB;
        for (int t = 0; t < nt; t += 2) {
            const bool last = (t == nt - 2);
            const char* a1 = cA + (size_t)(t + 1) * kstep;
            const char* a2 = last ? nA : cA + (size_t)(t + 2) * kstep; const char* b2 = last ? nB : cB + (size_t)(t + 2) * kstep;
            const char* a3 = a2 + kstep; const char* b3 = b2 + kstep;
            if (last && has_next) S.a_ready(nxt);
            if constexpr (SP2) {
            PG8_LDB(B0, 0, 0); PG8_LDB(B1, 0, 1); PG8_SCHED; PG8_LDA(At, 0, 0); PG8_STAGE(PG8_SA(1, 1), a1 + hstepA, voffA);
            PG8_WAIT_V(8); PG8_WAIT_L(0); PG8_BAR; PG8_MMA(0, 0, At, B0); PG8_MMA(0, 1, At, B1); PG8_BAR; PG8_SCHED;
            PG8_LDA(At, 0, 1); PG8_STAGE(PG8_SB(0, 0), b2, voffB); PG8_STAGE(PG8_SB(0, 1), b2 + hstepB, voffB); PG8_STAGE(PG8_SA(0, 0), a2, voffA);
            PG8_WAIT_V(8); PG8_WAIT_L(0); PG8_BAR; PG8_MMA(1, 0, At, B0); PG8_MMA(1, 1, At, B1); PG8_BAR; PG8_SCHED;
            PG8_LDB(B0, 1, 0); PG8_LDB(B1, 1, 1); PG8_SCHED; PG8_LDA(At, 1, 0); PG8_STAGE(PG8_SA(0, 1), a2 + hstepA, voffA);
            PG8_WAIT_V(8); PG8_WAIT_L(0); PG8_BAR; PG8_MMA(0, 0, At, B0); PG8_MMA(0, 1, At, B1); PG8_BAR; PG8_SCHED;
            PG8_LDA(At, 1, 1); PG8_STAGE(PG8_SB(1, 0), b3, voffB); PG8_STAGE(PG8_SB(1, 1), b3 + hstepB, voffB); PG8_STAGE(PG8_SA(1, 0), a3, voffA);
            PG8_WAIT_V(8); PG8_WAIT_L(0); PG8_BAR; PG8_MMA(1, 0, At, B0); PG8_MMA(1, 1, At, B1); PG8_BAR; PG8_SCHED;
            } else {
            PG8_LDB(B0, 0, 0); PG8_SCHED; PG8_LDA(At, 0, 0); PG8_STAGE(PG8_SA(1, 1), a1 + hstepA, voffA);
            PG8_WAIT_L(8); PG8_BAR; PG8_WAIT_L(0); PG8_MMA(0, 0, At, B0); PG8_BAR; PG8_SCHED;
            PG8_LDB(B1, 0, 1); PG8_STAGE(PG8_SB(0, 0), b2, voffB);
            PG8_BAR; PG8_WAIT_L(0); PG8_MMA(0, 1, At, B1); PG8_BAR;
            PG8_LDA(At, 0, 1); PG8_STAGE(PG8_SA(0, 0), a2, voffA);
            PG8_BAR; PG8_WAIT_L(0); PG8_MMA(1, 0, At, B0); PG8_BAR; PG8_SCHED;
            PG8_STAGE(PG8_SB(0, 1), b2 + hstepB, voffB);
            PG8_WAIT_V(6); PG8_BAR; PG8_MMA(1, 1, At, B1); PG8_BAR;
            PG8_LDB(B0, 1, 0); PG8_SCHED; PG8_LDA(At, 1, 0); PG8_STAGE(PG8_SA(0, 1), a2 + hstepA, voffA);
            PG8_WAIT_L(8); PG8_BAR; PG8_WAIT_L(0); PG8_MMA(0, 0, At, B0); PG8_BAR; PG8_SCHED;
            PG8_LDB(B1, 1, 1); PG8_STAGE(PG8_SB(1, 0), b3, voffB);
            PG8_BAR; PG8_WAIT_L(0); PG8_MMA(0, 1, At, B1); PG8_BAR;
            PG8_LDA(At, 1, 1); PG8_STAGE(PG8_SA(1, 0), a3, voffA);
            PG8_BAR; PG8_WAIT_L(0); PG8_MMA(1, 0, At, B0); PG8_BAR; PG8_SCHED;
            PG8_STAGE(PG8_SB(1, 1), b3 + hstepB, voffB);
            PG8_WAIT_V(6); PG8_BAR; PG8_MMA(1, 1, At, B1); PG8_BAR;
            }
        }
        if constexpr (ALIGN_EPI) { if (wr == 0) PG8_BAR; }
        if constexpr (!Epi::AFTER_DRAIN) { E(acc, cur, wr, wc, fr, fq); S.done(cur); }
        if (!has_next) break;
#pragma unroll
        for (int a = 0; a < 2; ++a)
#pragma unroll
            for (int b = 0; b < 2; ++b)
#pragma unroll
                for (int m = 0; m < 4; ++m)
#pragma unroll
                    for (int n = 0; n < 2; ++n) acc[a][b][m][n] = (f32x4){0.f, 0.f, 0.f, 0.f};
        cur = nxt; cA = nA; cB = nB; ++ui;
        if constexpr (ALIGN_EPI) { if (wr == 1) PG8_BAR; }
    }
    PG8_WAIT_V(0);
    if constexpr (!ALIGN_EPI) { if (wr == 0) PG8_BAR; }
    PG8_BAR;
    if constexpr (Epi::AFTER_DRAIN) { E.fused(acc, cur, wr, wc, fr, fq, lds, wid, lane); S.done(cur); }
#undef PG8_SA
#undef PG8_SB
#undef PG8_STAGE
#undef PG8_LDA
#undef PG8_LDB
#undef PG8_MMA
#undef PG8_WAIT_V
#undef PG8_WAIT_L
#undef PG8_BAR
#undef PG8_SCHED
}
}
#include <hip/hip_bf16.h>
#include <cmath>
namespace attn_body {
using bf16=__hip_bfloat16;
using bf16x8=__attribute__((ext_vector_type(8)))short;
using s16x4=__attribute__((ext_vector_type(4)))short;
using f32x16=__attribute__((ext_vector_type(16)))float;
using u32x4=__attribute__((ext_vector_type(4)))unsigned;
constexpr int SEQ=8448,D=64,DM=4608,NTILES=132;
constexpr int NW=8,QBLK=32,QB=QBLK*NW,KVBLK=64;
constexpr int ATTN_PITCH=DM, ATTN_UNIT_ROWS=QB;
__device__ __forceinline__ int crow(int r,int hi){return (r&3)+8*(r>>2)+4*hi;}
#define SBAR() __builtin_amdgcn_sched_barrier(0)
__device__ __forceinline__ void cmask(f32x16&p0,f32x16&p1,int jb,int qrel,int hi){
  const float NEG=-INFINITY; int kb=64*jb+4*hi;
  #pragma unroll
  for(int r=0;r<16;++r){int kv=kb+(r&3)+8*(r>>2); if(kv>qrel)p0[r]=NEG; if(kv+32>qrel)p1[r]=NEG;}
}

constexpr int NSLOT=3, SLOTB=8192;
constexpr int LDS_K=0, LDS_V=NSLOT*SLOTB, LDS_WS=2*NSLOT*SLOTB, LDS_OST=LDS_WS+NW*64*4, LDS_BYTES=LDS_OST+NW*4096;
constexpr float C2=0.125f*1.4426950408889634f;
__device__ __forceinline__ void glds16(const void*gsrc,unsigned lds_dst){unsigned keep;
  asm volatile("s_mov_b32 %0, m0\n\ts_mov_b32 m0, %2\n\ts_nop 0\n\tglobal_load_lds_dwordx4 %1, off\n\ts_mov_b32 m0, %0":"=&s"(keep):"v"(gsrc),"s"(lds_dst):"memory");}
__device__ __forceinline__ float max3f(float a,float b,float c){float r;asm("v_max3_f32 %0, %1, %2, %3":"=v"(r):"v"(a),"v"(b),"v"(c));return r;}
__device__ __forceinline__ float max2f(float a,float b){float r;asm("v_max_f32_e32 %0, %1, %2":"=v"(r):"v"(a),"v"(b));return r;}
__device__ __forceinline__ float fadd_s(float a,float b){float r;asm("v_add_f32_e32 %0, %1, %2":"=v"(r):"v"(a),"v"(b));return r;}
__device__ __forceinline__ float fsub_s(float a,float b){float r;asm("v_sub_f32_e32 %0, %1, %2":"=v"(r):"v"(a),"v"(b));return r;}
typedef float f32x2_t __attribute__((ext_vector_type(2))); typedef __bf16 bf16x2_t __attribute__((ext_vector_type(2)));
__device__ __forceinline__ unsigned cvtpk_s(float lo,float hi){f32x2_t v={lo,hi};bf16x2_t b=__builtin_convertvector(v,bf16x2_t);return __builtin_bit_cast(unsigned,b);}
#define WAIT_BAR(N) asm volatile("s_waitcnt vmcnt(" #N ") lgkmcnt(0)\n\ts_barrier":::"memory")

__device__ __forceinline__ void qkt(f32x16&p0,f32x16&p1,const char*Kslot,const bf16x8*qr,const f32x16&negm,int r32,int hi){
  const char*kb=Kslot+hi*1024+r32*16;
  #pragma unroll
  for(int d0=0;d0<4;++d0){
    const bf16x8 b0=*reinterpret_cast<const bf16x8*>(kb+d0*2048);
    const bf16x8 b1=*reinterpret_cast<const bf16x8*>(kb+d0*2048+512);
    if(d0==0){p0=__builtin_amdgcn_mfma_f32_32x32x16_bf16(b0,qr[0],negm,0,0,0);p1=__builtin_amdgcn_mfma_f32_32x32x16_bf16(b1,qr[0],negm,0,0,0);}
    else{p0=__builtin_amdgcn_mfma_f32_32x32x16_bf16(b0,qr[d0],p0,0,0,0);p1=__builtin_amdgcn_mfma_f32_32x32x16_bf16(b1,qr[d0],p1,0,0,0);}}
}
typedef __attribute__((address_space(3))) const char* lds_cptr;
typedef short v4i16_t __attribute__((ext_vector_type(4)));
__device__ __forceinline__ void kload8(bf16x8*kf,lds_cptr kp){
  kf[0]=*(const __attribute__((address_space(3))) bf16x8*)(kp);      kf[1]=*(const __attribute__((address_space(3))) bf16x8*)(kp+512);
  kf[2]=*(const __attribute__((address_space(3))) bf16x8*)(kp+2048); kf[3]=*(const __attribute__((address_space(3))) bf16x8*)(kp+2560);
  kf[4]=*(const __attribute__((address_space(3))) bf16x8*)(kp+4096); kf[5]=*(const __attribute__((address_space(3))) bf16x8*)(kp+4608);
  kf[6]=*(const __attribute__((address_space(3))) bf16x8*)(kp+6144); kf[7]=*(const __attribute__((address_space(3))) bf16x8*)(kp+6656);
}
__device__ __forceinline__ void kload2(bf16x8*kf,lds_cptr kp,int j){ kf[2*j]=*(const __attribute__((address_space(3))) bf16x8*)(kp+j*2048); kf[2*j+1]=*(const __attribute__((address_space(3))) bf16x8*)(kp+j*2048+512); }
__device__ __forceinline__ s16x4 vtr(lds_cptr p){ return __builtin_bit_cast(s16x4,__builtin_amdgcn_ds_read_tr16_b64_v4i16((__attribute__((address_space(3))) v4i16_t*)p)); }
__device__ __forceinline__ float rowmax(const f32x16&p0,const f32x16&p1){
  float a=max3f(p0[0],p0[1],p1[0]),b=max3f(p0[2],p0[3],p1[1]);a=max3f(a,p1[2],p1[3]);
  #pragma unroll
  for(int r=4;r<16;r+=4){a=max3f(a,p0[r],p0[r+1]);b=max3f(b,p0[r+2],p0[r+3]);a=max3f(a,p1[r],p1[r+1]);b=max3f(b,p1[r+2],p1[r+3]);}
  const float m=max2f(a,b);
  auto rr=__builtin_amdgcn_permlane32_swap(__float_as_uint(m),__float_as_uint(m),false,false);
  return max2f(__uint_as_float(rr[0]),__uint_as_float(rr[1]));
}
__device__ __forceinline__ void pv(f32x16*o,int vb,bf16x8 pa0,bf16x8 pa1,bf16x8 pa2,bf16x8 pa3){
  #pragma unroll
  for(int d0=0;d0<2;++d0){s16x4 lo[4],hi[4];
    #pragma unroll
    for(int ks=0;ks<4;++ks){
      asm volatile("ds_read_b64_tr_b16 %0,%1 offset:%c2":"=&v"(lo[ks]):"v"(vb),"i"(d0*4096+ks*1024):"memory");
      asm volatile("ds_read_b64_tr_b16 %0,%1 offset:%c2":"=&v"(hi[ks]):"v"(vb),"i"(d0*4096+ks*1024+512):"memory");}
    asm volatile("s_waitcnt lgkmcnt(0)":::"memory");SBAR();
    #define PK(k) (bf16x8){lo[k][0],lo[k][1],lo[k][2],lo[k][3],hi[k][0],hi[k][1],hi[k][2],hi[k][3]}
    o[d0]=__builtin_amdgcn_mfma_f32_32x32x16_bf16(pa0,PK(0),o[d0],0,0,0);
    o[d0]=__builtin_amdgcn_mfma_f32_32x32x16_bf16(pa1,PK(1),o[d0],0,0,0);
    o[d0]=__builtin_amdgcn_mfma_f32_32x32x16_bf16(pa2,PK(2),o[d0],0,0,0);
    o[d0]=__builtin_amdgcn_mfma_f32_32x32x16_bf16(pa3,PK(3),o[d0],0,0,0);
    #undef PK
  }
}

#ifndef ATTN_STORE16
#define ATTN_STORE16(p,v) (*(u32x4*)(p)=(v))
#endif
template<int THRL,bool NOMAX> __device__ __forceinline__ void attn_unit(int b,int h,int hk,int qb,const bf16*Q,const bf16*__restrict__ K,const bf16*__restrict__ V,bf16*O,char*shm,const float*gq){
  const int tid=opaque_tid(),lane=tid&63,r32=lane&31,hi=lane>>5; const int wid=__builtin_amdgcn_readfirstlane(tid>>6);
  const long rowbase=(long)b*SEQ; const int q0=qb*QB;
  const bf16*Qw=Q+(rowbase+q0+wid*QBLK)*DM+h*D;
  const bf16*Kh=K+rowbase*DM+hk*D,*Vh=V+rowbase*DM+hk*D;
  const unsigned lds0=(unsigned)(uintptr_t)shm;
  float*wsf=(float*)(shm+LDS_WS)+wid*64;
  const bf16*ksrc=Kh+(long)lane*DM+wid*8;
  const bf16*vsrc=Vh+(long)(16*(wid&3)+(lane>>2))*DM+(wid>>2)*32+(lane&3)*8;
  const unsigned kdst=lds0+LDS_K+wid*1024, vdst=lds0+LDS_V+wid*1024;
  #define DMA_K(t,slot) glds16(ksrc+(long)(t)*KVBLK*DM,(unsigned)__builtin_amdgcn_readfirstlane(kdst+(slot)))
  #define DMA_V(t,slot) glds16(vsrc+(long)(t)*KVBLK*DM,(unsigned)__builtin_amdgcn_readfirstlane(vdst+(slot)))
  const int vb0=(int)(lds0+LDS_V)+((lane>>4)&1)*32+(lane&3)*8+(4*hi+((lane&15)>>2))*64;
  const char*Kbase=shm+LDS_K; bf16x8 kf[8];
  const lds_cptr shm3=(lds_cptr)shm; const lds_cptr kp0=shm3+LDS_K+hi*1024+r32*16; const lds_cptr vp0=shm3+LDS_V+((lane>>4)&1)*32+(lane&3)*8+(4*hi+((lane&15)>>2))*64;
  constexpr int NT=NTILES;
  DMA_K(0,0);DMA_V(0,0);DMA_K(1,SLOTB);
  bf16x8 qr[4];
  #pragma unroll
  for(int d0=0;d0<4;++d0)qr[d0]=*reinterpret_cast<const bf16x8*>(&Qw[(long)r32*DM+d0*16+hi*8]);
  { float xf[4][8]; float ss=0.f;
    #pragma unroll
    for(int d0=0;d0<4;++d0){
      #pragma unroll
      for(int k=0;k<8;++k){ xf[d0][k]=__uint_as_float(((unsigned)(unsigned short)qr[d0][k])<<16); ss+=xf[d0][k]*xf[d0][k]; } }
    ss+=__shfl_xor(ss,32);
    const float rstd=C2/sqrtf(ss*(1.f/64.f)+1e-6f);
    const int tq=q0+wid*QBLK+r32; const float posr=(float)(tq>>6),posc=(float)(tq&63);
    #pragma unroll
    for(int k=0;k<8;++k){
      const float fr=__builtin_amdgcn_exp2f(-(float)(8*hi+k)*(13.287712379549449f/16.f));
      const float a1=posr*fr,a2=posc*fr; const float c1=__cosf(a1),s1=__sinf(a1),c2=__cosf(a2),s2=__sinf(a2);
      const float y0=xf[0][k]*rstd*gq[8*hi+k],y2=xf[2][k]*rstd*gq[32+8*hi+k],y1=xf[1][k]*rstd*gq[16+8*hi+k],y3=xf[3][k]*rstd*gq[48+8*hi+k];
      xf[0][k]=y0*c1-y2*s1; xf[2][k]=y0*s1+y2*c1; xf[1][k]=y1*c2-y3*s2; xf[3][k]=y1*s2+y3*c2; }
    #pragma unroll
    for(int d0=0;d0<4;++d0){ u32x4 pw_; pw_[0]=cvtpk_s(xf[d0][0],xf[d0][1]); pw_[1]=cvtpk_s(xf[d0][2],xf[d0][3]); pw_[2]=cvtpk_s(xf[d0][4],xf[d0][5]); pw_[3]=cvtpk_s(xf[d0][6],xf[d0][7]); qr[d0]=__builtin_bit_cast(bf16x8,pw_); } }
  float mhat=0.f,l_reg=0.f;f32x16 o[2];o[0]=f32x16{};o[1]=f32x16{};f32x16 negm=f32x16{};asm volatile("":"+v"(negm));
  #define CMASK(P0,P1,t) do{}while(0)
  bool resc=false;
  #define START(P0,P1) do{ const float rm=rowmax(P0,P1); resc=false; \
    { const float dl=rm; mhat=fadd_s(mhat,dl); \
      _Pragma("unroll") for(int r=0;r<16;++r){P0[r]=fsub_s(P0[r],dl);P1[r]=fsub_s(P1[r],dl);} \
      _Pragma("unroll") for(int r=0;r<16;++r)negm[r]=-mhat; asm volatile("":"+v"(negm)); } \
    _Pragma("unroll") for(int r=0;r<16;++r)P0[r]=__builtin_amdgcn_exp2f(P0[r]); }while(0)
  #define RESC() do{ if(resc){ asm volatile("s_waitcnt lgkmcnt(0)":::"memory"); \
      _Pragma("unroll") for(int d_=0;d_<2;++d_) _Pragma("unroll") for(int r=0;r<16;++r)o[d_][r]*=wsf[crow(r,hi)]; } }while(0)
  f32x16 pA0,pA1,pB0,pB1;
  int sl_prev=0,sl_cur=0,sl_next=SLOTB;
  #define ROT() do{sl_prev=sl_cur;sl_cur=sl_next;sl_next=(sl_next==(NSLOT-1)*SLOTB)?0:sl_next+SLOTB;}while(0)
  DMA_K(2,2*SLOTB);
  WAIT_BAR(3);
  qkt(pA0,pA1,Kbase,qr,negm,r32,hi);asm volatile("s_nop 15\n\ts_nop 7":"+v"(pA0),"+v"(pA1));CMASK(pA0,pA1,0);
  START(pA0,pA1);
  _Pragma("unroll") for(int r=0;r<16;++r)pA1[r]=__builtin_amdgcn_exp2f(pA1[r]);
  WAIT_BAR(0);
  DMA_K(3,0);DMA_V(1,SLOTB);
  ROT();
  kload8(kf,kp0+sl_cur);
  WAIT_BAR(2);
  s16x4 vlo[8],vhi[8]; u32x4 pw0,pw1,pw2,pw3;
  #define PKW(P,B) cvtpk_s(P[B],P[B+1])
  #define PAF(k) __builtin_bit_cast(bf16x8,pw##k)
  #define VFR(i) (bf16x8){vlo[i][0],vlo[i][1],vlo[i][2],vlo[i][3],vhi[i][0],vhi[i][1],vhi[i][2],vhi[i][3]}
  #define PIN(x) asm volatile("":"+v"(x))
  #define MX3(a,b,c) __builtin_fmaxf(__builtin_fmaxf((a),(b)),(c))
  #define GAPA(MF,A0,A1,A2,A3,W0,W1,PW) do{ MF; sacc+=A0; sacc+=A1; sacc+=A2; sacc+=A3; PIN(sacc); W0; W1; PIN(PW); SBAR(); }while(0)
  #define EX(v) __builtin_amdgcn_exp2f(v)
  #define GAPB(MF,X,B) do{ MF; X[B]=EX(X[B]); X[B+1]=EX(X[B+1]); X[B+2]=EX(X[B+2]); X[B+3]=EX(X[B+3]); PIN(X); SBAR(); }while(0)
  #define VRD(i) do{ vlo[i]=vtr(vp_+(((i)>>2)*4096+((i)&3)*1024)); vhi[i]=vtr(vp_+(((i)>>2)*4096+((i)&3)*1024+512)); }while(0)
  #define KRD(G,j) do{ if(G){ kload2(kf,kp0+sl_next,j); SBAR(); } }while(0)
  #define STEP(C0,C1,P0,P1,t,GK,GV,GL) do{ SBAR(); \
    const lds_cptr vp_=vp0+sl_prev; \
    VRD(0); SBAR(); float sacc=(P0[0]+P0[1]); \
    GAPA(C0=__builtin_amdgcn_mfma_f32_32x32x16_bf16(kf[0],qr[0],negm,0,0,0), P0[2],P0[3],P0[4],P0[5],     pw0[0]=PKW(P0,0), pw0[1]=PKW(P0,2), pw0); \
    VRD(4); SBAR(); GAPA(C1=__builtin_amdgcn_mfma_f32_32x32x16_bf16(kf[1],qr[0],negm,0,0,0), P0[6],P0[7],P0[8],P0[9],     pw0[2]=PKW(P0,4), pw0[3]=PKW(P0,6), pw0); \
    VRD(1); SBAR(); GAPA(C0=__builtin_amdgcn_mfma_f32_32x32x16_bf16(kf[2],qr[1],C0,0,0,0),   P0[10],P0[11],P0[12],P0[13], pw1[0]=PKW(P0,8), pw1[1]=PKW(P0,10), pw1); \
    VRD(5); SBAR(); GAPA(C1=__builtin_amdgcn_mfma_f32_32x32x16_bf16(kf[3],qr[1],C1,0,0,0),   P0[14],P0[15],P1[0],P1[1],   pw1[2]=PKW(P0,12),pw1[3]=PKW(P0,14), pw1); \
    VRD(2); SBAR(); GAPA(C0=__builtin_amdgcn_mfma_f32_32x32x16_bf16(kf[4],qr[2],C0,0,0,0),   P1[2],P1[3],P1[4],P1[5],     pw2[0]=PKW(P1,0), pw2[1]=PKW(P1,2), pw2); \
    VRD(6); SBAR(); GAPA(C1=__builtin_amdgcn_mfma_f32_32x32x16_bf16(kf[5],qr[2],C1,0,0,0),   P1[6],P1[7],P1[8],P1[9],     pw2[2]=PKW(P1,4), pw2[3]=PKW(P1,6), pw2); \
    VRD(3); SBAR(); GAPA(C0=__builtin_amdgcn_mfma_f32_32x32x16_bf16(kf[6],qr[3],C0,0,0,0),   P1[10],P1[11],P1[12],P1[13], pw3[0]=PKW(P1,8), pw3[1]=PKW(P1,10), pw3); \
    VRD(7); SBAR(); GAPA(C1=__builtin_amdgcn_mfma_f32_32x32x16_bf16(kf[7],qr[3],C1,0,0,0),   P1[14],P1[15],0.f,0.f,       pw3[2]=PKW(P1,12),pw3[3]=PKW(P1,14), pw3); \
    l_reg+=sacc; \
    if(GK){DMA_K((t)+3,sl_cur);} if(GV){DMA_V((t)+1,sl_next);} \
    CMASK(C0,C1,t); \
    if constexpr(!NOMAX){ float a=MX3(C0[0],C0[1],C1[0]),b=MX3(C0[2],C0[3],C1[1]); a=MX3(a,C1[2],C1[3]); \
      _Pragma("unroll") for(int r=4;r<16;r+=4){a=MX3(a,C0[r],C0[r+1]);b=MX3(b,C0[r+2],C0[r+3]);a=MX3(a,C1[r],C1[r+1]);b=MX3(b,C1[r+2],C1[r+3]);} \
      float rm=__builtin_fmaxf(a,b); { auto rr=__builtin_amdgcn_permlane32_swap(__float_as_uint(rm),__float_as_uint(rm),false,false); rm=__builtin_fmaxf(__uint_as_float(rr[0]),__uint_as_float(rr[1])); } \
      resc=false; \
      if(__builtin_expect(__any(rm>(float)THRL),0)){ const float dl=__builtin_fmaxf(rm,0.f); mhat+=dl; \
        _Pragma("unroll") for(int r=0;r<16;++r){C0[r]-=dl;C1[r]-=dl;} \
        _Pragma("unroll") for(int r=0;r<16;++r)negm[r]=-mhat; asm volatile("":"+v"(negm)); \
        const float f=__builtin_amdgcn_exp2f(-dl); l_reg*=f; if(hi==0)wsf[r32]=f; resc=true; } } \
    SBAR(); \
    GAPB(o[0]=__builtin_amdgcn_mfma_f32_32x32x16_bf16(PAF(0),VFR(0),o[0],0,0,0), C0,0); \
    GAPB(o[1]=__builtin_amdgcn_mfma_f32_32x32x16_bf16(PAF(0),VFR(4),o[1],0,0,0), C0,4); \
    KRD(GL,0); GAPB(o[0]=__builtin_amdgcn_mfma_f32_32x32x16_bf16(PAF(1),VFR(1),o[0],0,0,0), C0,8); \
    KRD(GL,1); GAPB(o[1]=__builtin_amdgcn_mfma_f32_32x32x16_bf16(PAF(1),VFR(5),o[1],0,0,0), C0,12); \
    KRD(GL,2); GAPB(o[0]=__builtin_amdgcn_mfma_f32_32x32x16_bf16(PAF(2),VFR(2),o[0],0,0,0), C1,0); \
    KRD(GL,3); GAPB(o[1]=__builtin_amdgcn_mfma_f32_32x32x16_bf16(PAF(2),VFR(6),o[1],0,0,0), C1,4); \
    GAPB(o[0]=__builtin_amdgcn_mfma_f32_32x32x16_bf16(PAF(3),VFR(3),o[0],0,0,0), C1,8); \
    GAPB(o[1]=__builtin_amdgcn_mfma_f32_32x32x16_bf16(PAF(3),VFR(7),o[1],0,0,0), C1,12); \
    }while(0)
  int t=1;
  #undef CMASK
  #define CMASK(P0,P1,t) do{}while(0)
  for(;t+5<NT;t+=2){
    STEP(pB0,pB1,pA0,pA1,t,true,true,true);     WAIT_BAR(2); RESC(); ROT();
    STEP(pA0,pA1,pB0,pB1,t+1,true,true,true);   WAIT_BAR(2); RESC(); ROT();
  }
  #undef CMASK
  #define CMASK(P0,P1,t) do{}while(0)
  #define ENDW(tt) do{ if((tt)+3<NT){WAIT_BAR(2);} else if((tt)+2<NT){WAIT_BAR(1);} else {WAIT_BAR(0);} }while(0)
  for(;t+1<NT;t+=2){
    STEP(pB0,pB1,pA0,pA1,t,(t+3<NT),(t+1<NT),(t+1<NT));       ENDW(t);   RESC(); ROT();
    STEP(pA0,pA1,pB0,pB1,t+1,(t+4<NT),(t+2<NT),(t+2<NT));     ENDW(t+1); RESC(); ROT();
  }
  STEP(pB0,pB1,pA0,pA1,NT-1,false,false,false); RESC();
  { float sacc=pB0[0]+pB0[1]; _Pragma("unroll") for(int r=2;r<16;++r)sacc+=pB0[r]; _Pragma("unroll") for(int r=0;r<16;++r)sacc+=pB1[r]; l_reg+=sacc;
    pw0=(u32x4){PKW(pB0,0),PKW(pB0,2),PKW(pB0,4),PKW(pB0,6)};pw1=(u32x4){PKW(pB0,8),PKW(pB0,10),PKW(pB0,12),PKW(pB0,14)};pw2=(u32x4){PKW(pB1,0),PKW(pB1,2),PKW(pB1,4),PKW(pB1,6)};pw3=(u32x4){PKW(pB1,8),PKW(pB1,10),PKW(pB1,12),PKW(pB1,14)};
    SBAR(); pv(o,vb0+sl_cur,PAF(0),PAF(1),PAF(2),PAF(3)); }
  #undef PKW
  #undef PAF
  #undef VFR
  #undef PIN
  #undef MX3
  #undef GAPA
  #undef GAPB
  #undef EX
  #undef VRD
  #undef KRD
  #undef STEP
  #undef ENDW
  {auto rr=__builtin_amdgcn_permlane32_swap(__float_as_uint(l_reg),__float_as_uint(l_reg),false,false);l_reg=__uint_as_float(rr[0])+__uint_as_float(rr[1]);}
  if(hi==0)wsf[32+r32]=l_reg;asm volatile("s_waitcnt lgkmcnt(0)":::"memory");
  float rli[16];
  #pragma unroll
  for(int r=0;r<16;++r)rli[r]=__builtin_amdgcn_rcpf(wsf[32+crow(r,hi)]);
  bf16*Ow=O+(rowbase+q0+wid*QBLK)*DM+h*D;
  { bf16*stg=(bf16*)(shm+LDS_OST)+wid*2048;
    #pragma unroll
    for(int r=0;r<16;++r){const int orow=crow(r,hi);
      #pragma unroll
      for(int d0=0;d0<2;++d0)stg[orow*64+d0*32+r32]=__float2bfloat16(o[d0][r]*rli[r]);}
    asm volatile("s_waitcnt lgkmcnt(0)":::"memory");
    #pragma unroll
    for(int i=0;i<4;++i){const int row=i*8+(lane>>3),ch=lane&7; const u32x4 v=*(const u32x4*)(stg+row*64+ch*8); ATTN_STORE16(Ow+(long)row*DM+ch*8,v);} }
  asm volatile("s_waitcnt lgkmcnt(0)\n\ts_barrier":::"memory");
  #undef DMA_K
  #undef DMA_V
  #undef CMASK
  #undef START
  #undef RESC
  #undef ROT
}
constexpr int ATTN_LDS_BYTES=LDS_BYTES;
#undef SBAR
#undef WAIT_BAR
}
#include <hip/hip_cooperative_groups.h>
namespace cg = cooperative_groups;
#define LAS __attribute__((address_space(3)))
typedef unsigned short bf16;
typedef unsigned v4u __attribute__((ext_vector_type(4)));
typedef unsigned v2u __attribute__((ext_vector_type(2)));
typedef float f32x4 __attribute__((ext_vector_type(4)));
typedef short bf16x8 __attribute__((ext_vector_type(8)));

#define XB_TMO      128
#define XB_XCNT(j)  (256  + 64 * (j))
#define XB_XSUB(j)  (1280 + 64 * (j))
#define XB_XGEN(j)  (2304 + 64 * (j))
#define XB_TOP      3328
#define XB_TOPGEN   3392
#define XCD_BAR_WORDS 3456
#define XB_SPIN_CAP (1u << 18)

__device__ __forceinline__ unsigned xb_ld(unsigned* p)              { return __hip_atomic_load(p, __ATOMIC_RELAXED, __HIP_MEMORY_SCOPE_AGENT); }
__device__ __forceinline__ unsigned xb_add(unsigned* p, unsigned v) { return __hip_atomic_fetch_add(p, v, __ATOMIC_RELAXED, __HIP_MEMORY_SCOPE_AGENT); }
__device__ __forceinline__ unsigned xb_xcc_id() { return (unsigned)__builtin_amdgcn_s_getreg((3 << 11) | 20) & 0xFu; }
#define XB_SPIN(cond, bar) do { unsigned _sp = 0; while (cond) { __builtin_amdgcn_s_sleep(1); \
    if ((++_sp & 255u) == 0u) { if (xb_ld(&(bar)[XB_TMO])) break; if (_sp > XB_SPIN_CAP) { atomicAdd(&(bar)[XB_TMO], 1u); break; } } } } while (0)

struct XcdBarrier {
    unsigned* bar; unsigned x;
    volatile LAS unsigned* st;
};

__device__ __forceinline__ XcdBarrier xcd_barrier_post(unsigned* bar, volatile LAS unsigned* st) {
    XcdBarrier b; b.bar = bar; b.x = xb_xcc_id(); b.st = st;
    if (threadIdx.x == 0) (void)xb_add(&bar[XB_XCNT(b.x)], 1u);
    return b;
}
__device__ __forceinline__ void xcd_barrier_complete(unsigned* bar, unsigned x, unsigned& nloc, unsigned& nx) {
    const unsigned G = gridDim.x * gridDim.y * gridDim.z;
    unsigned sum, cnt, mine, sp = 0u;
    for (;;) {
        sum = 0u; cnt = 0u; mine = 0u;
#pragma unroll
        for (unsigned j = 0; j < 16; ++j) { const unsigned c = xb_ld(&bar[XB_XCNT(j)]); sum += c; cnt += (c > 0u) ? 1u : 0u; mine = (j == x) ? c : mine; }
        if (sum == G) break;
        __builtin_amdgcn_s_sleep(1);
        if ((++sp & 255u) == 0u) { if (xb_ld(&bar[XB_TMO])) break; if (sp > XB_SPIN_CAP) { atomicAdd(&bar[XB_TMO], 1u); break; } }
    }
    nloc = mine > 0u ? mine : 1u; nx = cnt > 0u ? cnt : 1u;
}

__device__ __forceinline__ void xcd_barrier(const XcdBarrier& b) {
    asm volatile("s_waitcnt vmcnt(0)" ::: "memory");
    __syncthreads();
    if (threadIdx.x == 0) {
        unsigned* bar = b.bar;
        __builtin_amdgcn_s_waitcnt(0);
        unsigned nloc = b.st[0], nx = b.st[1];
        if (nloc == 0u) { xcd_barrier_complete(bar, b.x, nloc, nx); b.st[0] = nloc; b.st[1] = nx; }
        const unsigned old = xb_add(&bar[XB_XSUB(b.x)], 1u);
        const unsigned gen = old / nloc;
        if (old + 1u == (gen + 1u) * nloc) {
            __builtin_amdgcn_fence(__ATOMIC_RELEASE, "agent");
            asm volatile("s_waitcnt vmcnt(0)" ::: "memory");
            const unsigned og = xb_add(&bar[XB_TOP], 1u);
            const unsigned tg = og / nx;
            if (og + 1u == (tg + 1u) * nx) xb_add(&bar[XB_TOPGEN], 1u);
            else XB_SPIN(xb_ld(&bar[XB_TOPGEN]) == tg, bar);
            __builtin_amdgcn_fence(__ATOMIC_ACQUIRE, "agent");
            xb_add(&bar[XB_XGEN(b.x)], 1u);
            asm volatile("s_waitcnt vmcnt(0)" ::: "memory");
        } else {
            XB_SPIN(xb_ld(&bar[XB_XGEN(b.x)]) == gen, bar);
            __builtin_amdgcn_fence(__ATOMIC_ACQUIRE, "agent");
            asm volatile("s_waitcnt vmcnt(0)" ::: "memory");
        }
    }
    __syncthreads();
}

constexpr int NB = 8, TL = 8192, TC = 256, TB = TL + TC  , MR = NB * TB  , DM = 1024, DFF = 2816, PW = 4608, NMOD = 9216;
constexpr float EPS = 1e-6f;
constexpr int LDS_BYTES = 147456, NTHR = 512, NWAVES = 8;
constexpr int PC_Q = 0, PC_K = 512, PC_V = 640, PC_GQ = 768, PC_GK = 1024, PC_GV = 1280, PC_G6 = 1792, PC_GATE = 2304, PC_LOW = 4352;
constexpr int GLA_S = 132, GLA_ITEMS = 64 * GLA_S;
constexpr size_t MiB = 1u << 20;
constexpr size_t WS_SSQ1 = 5 * MiB, WS_SSQ2 = 5 * MiB + 512 * 1024, WS_SW1 = 6 * MiB, WS_SW2 = 6 * MiB + 512 * 1024;
constexpr size_t WS_MOD = 1 * MiB, WS_DN = 2 * MiB, WS_WUP1 = 8 * MiB, WS_WUP2 = 20 * MiB, WS_WDN1 = 32 * MiB, WS_WDN2 = 38 * MiB, WS_WIN = 44 * MiB, WS_WBR0 = 54 * MiB, WS_WBR1 = 55 * MiB, WS_WOUT = 56 * MiB,
                 WS_HCTX = 64 * MiB, WS_XN = 72 * MiB, WS_OF = 204 * MiB, WS_OB = 270 * MiB, WS_A = 336 * MiB, WS_END = 932 * MiB;
static_assert(WS_XN + (size_t)MR * DM * 2 <= WS_OF && WS_OF + (size_t)MR * 512 * 2 <= WS_OB && WS_OB + (size_t)MR * 512 * 2 <= WS_A && WS_A + (size_t)MR * PW * 2 <= WS_END, "ws map");
static_assert((size_t)GLA_ITEMS * 8192 * 2 <= (size_t)MR * DM * 2 && WS_DN + (size_t)GLA_ITEMS * 64 * 4 <= WS_WUP1, "gla ws");

__device__ __forceinline__ unsigned f2bf(float f) { unsigned u = __builtin_bit_cast(unsigned, f); return (u + 0x7fffu + ((u >> 16) & 1u)) >> 16; }
typedef float pk_f32x2 __attribute__((ext_vector_type(2))); typedef __bf16 pk_bf16x2 __attribute__((ext_vector_type(2)));
__device__ __forceinline__ unsigned pk2(float lo, float hi) { const pk_f32x2 v = {lo, hi}; return __builtin_bit_cast(unsigned, __builtin_convertvector(v, pk_bf16x2)); }
__device__ __forceinline__ float bf2f(unsigned short h) { return __uint_as_float(((unsigned)h) << 16); }
__device__ __forceinline__ float wave_sum(float v) {
#pragma unroll
    for (int o = 1; o < 64; o <<= 1) v += __shfl_xor(v, o);
    return v;
}
__device__ __forceinline__ float silu_f(float v) { return v / (1.f + __expf(-v)); }

__device__ __forceinline__ void transpose_item(const float* W, int K, int N, bf16* WT, int k0, int n0, int drow0, LAS float* scr, int lane) {
#pragma unroll 8
    for (int i = 0; i < 32; ++i) { const int kk = 2 * i + (lane >> 5); scr[kk * 33 + (lane & 31)] = W[(size_t)(k0 + kk) * N + n0 + (lane & 31)]; }
    asm volatile("s_waitcnt lgkmcnt(0)" ::: "memory");
    const int c = lane & 7;
#pragma unroll
    for (int j = 0; j < 4; ++j) { const int n = (lane >> 3) + 8 * j; const LAS float* s = scr + (8 * c) * 33 + n;
        v4u o; o.x = pk2(s[0 * 33], s[1 * 33]); o.y = pk2(s[2 * 33], s[3 * 33]); o.z = pk2(s[4 * 33], s[5 * 33]); o.w = pk2(s[6 * 33], s[7 * 33]);
        *(v4u*)(WT + (size_t)(drow0 + n) * K + k0 + 8 * c) = o; }
    asm volatile("s_waitcnt lgkmcnt(0)" ::: "memory");
}
__device__ __forceinline__ int up_dest(int n0) { return n0 < DFF ? 256 * (n0 / 128) + (n0 % 128) : 256 * ((n0 - DFF) / 128) + 128 + ((n0 - DFF) % 128); }
__device__ __forceinline__ int win_dest(int n0) { return n0 < 2304 ? n0 : (n0 < 2336 ? n0 + 2048 : n0 - 32); }

__device__ __forceinline__ void norm_mod_rows(const float* lat, const float* ctxp, const float* mod, const float* g, int sub, bf16* XN, bool with_ctx, int gw, int NGW, int lane) {
    f32x4 gv[4];
#pragma unroll
    for (int j = 0; j < 4; ++j) gv[j] = *((const f32x4*)g + lane + 64 * j);
    for (int r0 = gw * 8; r0 < MR; r0 += NGW * 8) {
        const int b = r0 / TB, t = r0 % TB; const bool isctx = t >= TL;
        if (isctx && !with_ctx) continue;
        const float* src = isctx ? ctxp + (size_t)(b * TC + t - TL) * DM : lat + (size_t)(b * TL + t) * DM;
        const float* sh = mod + (size_t)(isctx ? 8 : b) * NMOD + (3 * sub) * DM; const float* sc = sh + DM;
        f32x4 v[8][4]; float s[8] = {0.f, 0.f, 0.f, 0.f, 0.f, 0.f, 0.f, 0.f}; f32x4 scv[4], shv[4];
#pragma unroll
        for (int u = 0; u < 8; ++u)
#pragma unroll
            for (int j = 0; j < 4; ++j) { v[u][j] = *((const f32x4*)(src + (size_t)u * DM) + lane + 64 * j); }
#pragma unroll
        for (int j = 0; j < 4; ++j) { scv[j] = *((const f32x4*)sc + lane + 64 * j) + 1.f; shv[j] = *((const f32x4*)sh + lane + 64 * j); }
#pragma unroll
        for (int u = 0; u < 8; ++u)
#pragma unroll
            for (int j = 0; j < 4; ++j) s[u] += (v[u][j].x * v[u][j].x + v[u][j].y * v[u][j].y) + (v[u][j].z * v[u][j].z + v[u][j].w * v[u][j].w);
#pragma unroll
        for (int u = 0; u < 8; ++u) {
            const float rstd = 1.f / sqrtf(wave_sum(s[u]) * (1.f / DM) + EPS);
            unsigned long long* o8 = (unsigned long long*)(XN + (size_t)(r0 + u) * DM) + lane;
#pragma unroll
            for (int j = 0; j < 4; ++j) {
                const f32x4 y = (v[u][j] * rstd * gv[j]) * scv[j] + shv[j];
                o8[64 * j] = (unsigned long long)pk2(y.x, y.y) | ((unsigned long long)pk2(y.z, y.w) << 32); } }
    }
}

constexpr int GS = 72, VS = 136;
constexpr int GL_QE = 0, GL_KE = 9216, GL_KL = 18432, GL_A = 27648, GL_V = 36864, GL_B = 54272, GL_BT = 71680, GL_SEG = 71936, BS = 68;
typedef short v4i16_t __attribute__((ext_vector_type(4)));
__device__ __forceinline__ bf16x8 tr_frag(const LAS bf16* base, int rs  , int col0, int ks, int q4, int qq, int p) {
    const LAS bf16* a0 = base + (32 * ks + 8 * q4 + qq) * rs + col0 + 4 * p;
    const v4i16_t t0 = __builtin_amdgcn_ds_read_tr16_b64_v4i16((LAS v4i16_t*)a0), t1 = __builtin_amdgcn_ds_read_tr16_b64_v4i16((LAS v4i16_t*)(a0 + 4 * rs));
    return (bf16x8){t0[0], t0[1], t0[2], t0[3], t1[0], t1[1], t1[2], t1[3]};
}
#define GLA_ROWOF(c) (rowbase + (dir ? 63 - (c) : (c)))
template <int PASS> __device__ __forceinline__ void gla_pass(LAS unsigned char* lds, const bf16* P, const float* w_decay, const float* b_decay, bf16* Ubuf, float* dn, bf16* OF, bf16* OB, int bx, int G, unsigned* ctr) {
    const int tid = opaque_tid(), lane = tid & 63, w = __builtin_amdgcn_readfirstlane(tid >> 6), l15 = lane & 15, q4 = lane >> 4, qq = (lane & 15) >> 2, p3 = lane & 3;
    constexpr int NV = PASS == 1 ? 64 * 131 : 64 * 128;
    LAS bf16* qeL = (LAS bf16*)(lds + GL_QE); LAS bf16* keL = (LAS bf16*)(lds + GL_KE); LAS bf16* klL = (LAS bf16*)(lds + GL_KL); LAS bf16* AL = (LAS bf16*)(lds + GL_A); LAS bf16* vL = (LAS bf16*)(lds + GL_V);
    LAS float* bL = (LAS float*)(lds + GL_B); LAS float* btL = (LAS float*)(lds + GL_BT); LAS float* segT = (LAS float*)(lds + GL_SEG);
    const int c = tid >> 3, ch = tid & 7, dt = w & 3, half = w >> 2;
    v4u vraw[2], kraw, qraw, lowf[2]; float wdr[8]; float bdr = 0.f; bf16x8 xsn[2];
    vraw[0] = vraw[1] = kraw = qraw = lowf[0] = lowf[1] = (v4u){0u, 0u, 0u, 0u}; xsn[0] = xsn[1] = (bf16x8){0, 0, 0, 0, 0, 0, 0, 0};
#pragma unroll
    for (int j = 0; j < 8; ++j) wdr[j] = 0.f;
#define GLA_DEC(idx_) const int chain = PASS == 1 ? (idx_) / 131 : (idx_) >> 7, s = PASS == 1 ? (idx_) % 131 : 4 + ((idx_) & 127), dir = chain & 1, h = (chain >> 1) & 3, b = chain >> 3; \
    const int rowbase = b * TB + (s < 4 ? TL + (dir ? 3 - s : s) * 64 : (dir ? 127 - (s - 4) : s - 4) * 64); const int item = chain * GLA_S + s; (void)item
#define GLA_LOAD(idx_) do { GLA_DEC(idx_); \
        _Pragma("unroll") for (int i = 0; i < 2; ++i) { const int n = tid + 512 * i; vraw[i] = *(const v4u*)(P + (size_t)GLA_ROWOF(n >> 4) * PW + PC_GV + h * 128 + (n & 15) * 8); } \
        { const size_t ro = (size_t)GLA_ROWOF(c) * PW + h * 64 + ch * 8; kraw = *(const v4u*)(P + ro + PC_GK); if (PASS == 3) qraw = *(const v4u*)(P + ro + PC_GQ); } \
        _Pragma("unroll") for (int i = 0; i < 2; ++i) lowf[i] = *(const v4u*)(P + (size_t)GLA_ROWOF(16 * (2 * half + i) + l15) * PW + PC_LOW + dir * 16 + (q4 & 1) * 8); \
        _Pragma("unroll") for (int j = 0; j < 8; ++j) wdr[j] = w_decay[(dir * 16 + 8 * (q4 & 1) + j) * 256 + h * 64 + 16 * dt + l15]; \
        bdr = b_decay[dir * 256 + h * 64 + 16 * dt + l15]; \
        if (PASS == 3) { _Pragma("unroll") for (int ks = 0; ks < 2; ++ks) xsn[ks] = *(const bf16x8*)(Ubuf + (size_t)item * 8192 + (16 * w + l15) * 64 + 8 * q4 + 32 * ks); } } while (0)
    volatile LAS unsigned* nxtL = (volatile LAS unsigned*)(lds + GL_SEG + 1024);
    int idx = bx;
    if (ctr) { if (tid == 0) nxtL[0] = __hip_atomic_fetch_add(ctr, 1u, __ATOMIC_RELAXED, __HIP_MEMORY_SCOPE_AGENT); __syncthreads(); idx = (int)nxtL[0]; __syncthreads(); }
    if (idx < NV) GLA_LOAD(idx);
    for (; idx < NV;) {
        int nidx = idx + G;
        if (ctr && tid == 0) nxtL[0] = __hip_atomic_fetch_add(ctr, 1u, __ATOMIC_RELAXED, __HIP_MEMORY_SCOPE_AGENT);
        GLA_DEC(idx);
#pragma unroll
        for (int i = 0; i < 2; ++i) { const int n = tid + 512 * i; *(LAS v4u*)(vL + (n >> 4) * VS + (n & 15) * 8) = vraw[i]; }
        float kf[8], qf[8];
        kf[0] = pg8::bflo(kraw.x); kf[1] = pg8::bfhi(kraw.x); kf[2] = pg8::bflo(kraw.y); kf[3] = pg8::bfhi(kraw.y); kf[4] = pg8::bflo(kraw.z); kf[5] = pg8::bfhi(kraw.z); kf[6] = pg8::bflo(kraw.w); kf[7] = pg8::bfhi(kraw.w);
        if (PASS == 3) { qf[0] = pg8::bflo(qraw.x); qf[1] = pg8::bfhi(qraw.x); qf[2] = pg8::bflo(qraw.y); qf[3] = pg8::bfhi(qraw.y); qf[4] = pg8::bflo(qraw.z); qf[5] = pg8::bfhi(qraw.z); qf[6] = pg8::bflo(qraw.w); qf[7] = pg8::bfhi(qraw.w); }
        float bv[2][4], tot[2];
        { bf16x8 yv;
#pragma unroll
          for (int j = 0; j < 8; ++j) { const unsigned hb = f2bf(wdr[j]); const unsigned lb = f2bf(wdr[j] - __uint_as_float(hb << 16)); yv[j] = (short)(q4 < 2 ? hb : lb); }
#pragma unroll
          for (int i = 0; i < 2; ++i) { f32x4 z = {0.f, 0.f, 0.f, 0.f}; z = __builtin_amdgcn_mfma_f32_16x16x32_bf16(__builtin_bit_cast(bf16x8, lowf[i]), yv, z, 0, 0, 0);
              float run = 0.f;
#pragma unroll
              for (int r = 0; r < 4; ++r) { const float zz = z[r] + bdr; run += (fminf(zz, 0.f) - __logf(1.f + __expf(-fabsf(zz)))) * (1.f / 16.f); bv[i][r] = run; }
              float sc = run; float t = __shfl_up(sc, 16); if (q4 >= 1) sc += t; t = __shfl_up(sc, 32); if (q4 >= 2) sc += t;
              const float excl = sc - run; tot[i] = __shfl(sc, 48 + l15);
#pragma unroll
              for (int r = 0; r < 4; ++r) bv[i][r] += excl + (i ? tot[0] : 0.f); }
          if (q4 == 0) segT[half * 64 + 16 * dt + l15] = tot[0] + tot[1]; }
        __syncthreads();
        { const float other = segT[(1 - half) * 64 + 16 * dt + l15]; const float add = half ? other : 0.f;
#pragma unroll
          for (int i = 0; i < 2; ++i)
#pragma unroll
              for (int r = 0; r < 4; ++r) bL[(16 * (2 * half + i) + 4 * q4 + r) * BS + 16 * dt + l15] = bv[i][r] + add;
          if (half == 0 && q4 == 0) btL[16 * dt + l15] = tot[0] + tot[1] + other; }
        __syncthreads();
        float bl[8], btot[8];
        { const f32x4 b0 = *(const LAS f32x4*)(bL + c * BS + 8 * ch), b1 = *(const LAS f32x4*)(bL + c * BS + 8 * ch + 4), t0 = *(const LAS f32x4*)(btL + 8 * ch), t1 = *(const LAS f32x4*)(btL + 8 * ch + 4);
          bl[0] = b0[0]; bl[1] = b0[1]; bl[2] = b0[2]; bl[3] = b0[3]; bl[4] = b1[0]; bl[5] = b1[1]; bl[6] = b1[2]; bl[7] = b1[3];
          btot[0] = t0[0]; btot[1] = t0[1]; btot[2] = t0[2]; btot[3] = t0[3]; btot[4] = t1[0]; btot[5] = t1[1]; btot[6] = t1[2]; btot[7] = t1[3]; }
        if (PASS == 1) {
            float kl[8];
#pragma unroll
            for (int k = 0; k < 8; ++k) kl[k] = kf[k] * __expf(btot[k] - bl[k]);
            v4u o; o.x = pk2(kl[0], kl[1]); o.y = pk2(kl[2], kl[3]); o.z = pk2(kl[4], kl[5]); o.w = pk2(kl[6], kl[7]);
            *(LAS v4u*)(klL + c * GS + 8 * ch) = o;
            if (tid < 8) { f32x4* dp = (f32x4*)(dn + (size_t)item * 64 + 8 * ch); dp[0] = (f32x4){__expf(btot[0]), __expf(btot[1]), __expf(btot[2]), __expf(btot[3])}; dp[1] = (f32x4){__expf(btot[4]), __expf(btot[5]), __expf(btot[6]), __expf(btot[7])}; }
        } else {
            float qe[8], ke[8];
#pragma unroll
            for (int k = 0; k < 8; ++k) { qe[k] = qf[k] * __expf(bl[k]) * 0.125f; ke[k] = kf[k] * __expf(-bl[k]); }
            v4u o; o.x = pk2(qe[0], qe[1]); o.y = pk2(qe[2], qe[3]); o.z = pk2(qe[4], qe[5]); o.w = pk2(qe[6], qe[7]);
            *(LAS v4u*)(qeL + c * GS + 8 * ch) = o;
            o.x = pk2(ke[0], ke[1]); o.y = pk2(ke[2], ke[3]); o.z = pk2(ke[4], ke[5]); o.w = pk2(ke[6], ke[7]);
            *(LAS v4u*)(keL + c * GS + 8 * ch) = o;
        }
        bf16x8 xs[2]; xs[0] = xsn[0]; xs[1] = xsn[1];
        if (ctr) nidx = (int)nxtL[0];
        if (nidx < NV) GLA_LOAD(nidx);
        __syncthreads();
        if (PASS == 1) {
            bf16x8 y[2];
#pragma unroll
            for (int ks = 0; ks < 2; ++ks) y[ks] = tr_frag(vL, VS, 16 * w, ks, q4, qq, p3);
#pragma unroll
            for (int dt = 0; dt < 4; ++dt) { f32x4 acc = {0.f, 0.f, 0.f, 0.f};
#pragma unroll
                for (int ks = 0; ks < 2; ++ks) { const bf16x8 x = tr_frag(klL, GS, 16 * dt, ks, q4, qq, p3); acc = __builtin_amdgcn_mfma_f32_16x16x32_bf16(x, y[ks], acc, 0, 0, 0); }
                v2u o; o.x = pk2(acc[0], acc[1]); o.y = pk2(acc[2], acc[3]);
                *(v2u*)(Ubuf + (size_t)item * 8192 + (16 * w + l15) * 64 + 16 * dt + 4 * q4) = o; }
        } else {
            { const int it = w >> 1;
#pragma unroll
              for (int jj = 0; jj < 2; ++jj) { const int jt = (w & 1) * 2 + jj; f32x4 acc = {0.f, 0.f, 0.f, 0.f};
                  if (jt <= it) {
#pragma unroll
                      for (int ks = 0; ks < 2; ++ks) { const bf16x8 x = *(const LAS bf16x8*)(keL + (16 * jt + l15) * GS + 8 * q4 + 32 * ks), y = *(const LAS bf16x8*)(qeL + (16 * it + l15) * GS + 8 * q4 + 32 * ks);
                          acc = __builtin_amdgcn_mfma_f32_16x16x32_bf16(x, y, acc, 0, 0, 0); }
                      const int i = 16 * it + l15, j0 = 16 * jt + 4 * q4;
#pragma unroll
                      for (int r = 0; r < 4; ++r) if (j0 + r > i) acc[r] = 0.f;
                  }
                  v2u o; o.x = pk2(acc[0], acc[1]); o.y = pk2(acc[2], acc[3]);
                  *(LAS v2u*)(AL + (16 * it + l15) * GS + 16 * jt + 4 * q4) = o; } }
            bf16x8 xv[2];
#pragma unroll
            for (int ks = 0; ks < 2; ++ks) xv[ks] = tr_frag(vL, VS, 16 * w, ks, q4, qq, p3);
            __syncthreads();
            bf16* Ob = dir ? OB : OF;
#pragma unroll
            for (int it = 0; it < 4; ++it) { f32x4 acc = {0.f, 0.f, 0.f, 0.f};
#pragma unroll
                for (int ks = 0; ks < 2; ++ks) { const bf16x8 y = *(const LAS bf16x8*)(AL + (16 * it + l15) * GS + 8 * q4 + 32 * ks); acc = __builtin_amdgcn_mfma_f32_16x16x32_bf16(xv[ks], y, acc, 0, 0, 0); }
#pragma unroll
                for (int ks = 0; ks < 2; ++ks) { const bf16x8 y = *(const LAS bf16x8*)(qeL + (16 * it + l15) * GS + 8 * q4 + 32 * ks); acc = __builtin_amdgcn_mfma_f32_16x16x32_bf16(xs[ks], y, acc, 0, 0, 0); }
                v2u o; o.x = pk2(acc[0], acc[1]); o.y = pk2(acc[2], acc[3]);
                *(v2u*)(Ob + (size_t)GLA_ROWOF(16 * it + l15) * 512 + h * 128 + 16 * w + 4 * q4) = o; }
        }
        __syncthreads();
        idx = nidx;
    }
#undef GLA_DEC
#undef GLA_LOAD
}

constexpr int GM_QEF = 0, GM_KEF = 9216, GM_QEB = 18432, GM_KEB = 27648, GM_A = 36864, GM_V = 46080, GM_BF = 63488, GM_BB = 80896, GM_SEG = 98304, GM_RED = 99328, GM_NXT = 101376;
__device__ __forceinline__ void gla_pass3m(LAS unsigned char* lds, const bf16* P, const float* w_decay, const float* b_decay, const float* g_gla, const bf16* Ubuf, bf16* OUT, unsigned* ctr) {
    const int tid = opaque_tid(), lane = tid & 63, w = __builtin_amdgcn_readfirstlane(tid >> 6), l15 = lane & 15, q4 = lane >> 4, qq = (lane & 15) >> 2, p3 = lane & 3;
    constexpr int NV = 8 * 4 * 128;
    LAS bf16* qeF = (LAS bf16*)(lds + GM_QEF); LAS bf16* keF = (LAS bf16*)(lds + GM_KEF); LAS bf16* qeB = (LAS bf16*)(lds + GM_QEB); LAS bf16* keB = (LAS bf16*)(lds + GM_KEB); LAS bf16* AL = (LAS bf16*)(lds + GM_A); LAS bf16* vL = (LAS bf16*)(lds + GM_V);
    LAS float* bF = (LAS float*)(lds + GM_BF); LAS float* bB = (LAS float*)(lds + GM_BB); LAS float* segT = (LAS float*)(lds + GM_SEG); LAS float* red = (LAS float*)(lds + GM_RED);
    volatile LAS unsigned* nxtL = (volatile LAS unsigned*)(lds + GM_NXT);
    const int c = tid >> 3, ch = tid & 7, dt = w & 3, half = w >> 2;
    v4u vraw[2], kraw, qraw, lowr[2][2]; float wdr[2][8]; float bdr[2]; bf16x8 xsn[2][2]; v2u g6r[4];
    float gg4[4];
#pragma unroll
    for (int r = 0; r < 4; ++r) gg4[r] = g_gla[16 * w + 4 * q4 + r];
#define GM_DEC(idx_) const int n_ = (idx_) & 127, h = ((idx_) >> 7) & 3, b = (idx_) >> 9; const int rowbase = b * TB + n_ * 64; \
    const size_t itemF = (size_t)((b * 4 + h) * 2 + 0) * GLA_S + 4 + n_, itemB = (size_t)((b * 4 + h) * 2 + 1) * GLA_S + 4 + (127 - n_); (void)itemF; (void)itemB
#define GM_LOAD(idx_) do { GM_DEC(idx_); \
        _Pragma("unroll") for (int i = 0; i < 2; ++i) { const int n = tid + 512 * i; vraw[i] = *(const v4u*)(P + (size_t)(rowbase + (n >> 4)) * PW + PC_GV + h * 128 + (n & 15) * 8); } \
        { const size_t ro = (size_t)(rowbase + c) * PW + h * 64 + ch * 8; kraw = *(const v4u*)(P + ro + PC_GK); qraw = *(const v4u*)(P + ro + PC_GQ); } \
        _Pragma("unroll") for (int dd = 0; dd < 2; ++dd) { \
            _Pragma("unroll") for (int i = 0; i < 2; ++i) lowr[dd][i] = *(const v4u*)(P + (size_t)(rowbase + 16 * (2 * half + i) + l15) * PW + PC_LOW + dd * 16 + (q4 & 1) * 8); \
            _Pragma("unroll") for (int j = 0; j < 8; ++j) wdr[dd][j] = w_decay[(dd * 16 + 8 * (q4 & 1) + j) * 256 + h * 64 + 16 * dt + l15]; \
            bdr[dd] = b_decay[dd * 256 + h * 64 + 16 * dt + l15]; \
            _Pragma("unroll") for (int ks = 0; ks < 2; ++ks) xsn[dd][ks] = *(const bf16x8*)(Ubuf + (dd ? itemB : itemF) * 8192 + (16 * w + l15) * 64 + 8 * q4 + 32 * ks); } \
        _Pragma("unroll") for (int it = 0; it < 4; ++it) g6r[it] = *(const v2u*)(P + (size_t)(rowbase + 16 * it + l15) * PW + PC_G6 + h * 128 + 16 * w + 4 * q4); } while (0)
    if (tid == 0) nxtL[0] = __hip_atomic_fetch_add(ctr, 1u, __ATOMIC_RELAXED, __HIP_MEMORY_SCOPE_AGENT);
    __syncthreads(); int idx = (int)nxtL[0]; __syncthreads();
    if (idx < NV) GM_LOAD(idx);
    for (; idx < NV;) {
        if (tid == 0) nxtL[0] = __hip_atomic_fetch_add(ctr, 1u, __ATOMIC_RELAXED, __HIP_MEMORY_SCOPE_AGENT);
        GM_DEC(idx);
#pragma unroll
        for (int i = 0; i < 2; ++i) { const int n = tid + 512 * i; *(LAS v4u*)(vL + (n >> 4) * VS + (n & 15) * 8) = vraw[i]; }
        float kf[8], qf[8];
        kf[0] = pg8::bflo(kraw.x); kf[1] = pg8::bfhi(kraw.x); kf[2] = pg8::bflo(kraw.y); kf[3] = pg8::bfhi(kraw.y); kf[4] = pg8::bflo(kraw.z); kf[5] = pg8::bfhi(kraw.z); kf[6] = pg8::bflo(kraw.w); kf[7] = pg8::bfhi(kraw.w);
        qf[0] = pg8::bflo(qraw.x); qf[1] = pg8::bfhi(qraw.x); qf[2] = pg8::bflo(qraw.y); qf[3] = pg8::bfhi(qraw.y); qf[4] = pg8::bflo(qraw.z); qf[5] = pg8::bfhi(qraw.z); qf[6] = pg8::bflo(qraw.w); qf[7] = pg8::bfhi(qraw.w);
        float bv[2][2][4], tot[2][2];
#pragma unroll
        for (int dd = 0; dd < 2; ++dd) { bf16x8 yv;
#pragma unroll
            for (int j = 0; j < 8; ++j) { const unsigned hb = f2bf(wdr[dd][j]); const unsigned lb = f2bf(wdr[dd][j] - __uint_as_float(hb << 16)); yv[j] = (short)(q4 < 2 ? hb : lb); }
#pragma unroll
            for (int ii = 0; ii < 2; ++ii) { const int i = dd ? 1 - ii : ii;
                f32x4 z = {0.f, 0.f, 0.f, 0.f}; z = __builtin_amdgcn_mfma_f32_16x16x32_bf16(__builtin_bit_cast(bf16x8, lowr[dd][i]), yv, z, 0, 0, 0);
                float g[4];
#pragma unroll
                for (int r = 0; r < 4; ++r) { const float zz = z[r] + bdr[dd]; g[r] = (fminf(zz, 0.f) - __logf(1.f + __expf(-fabsf(zz)))) * (1.f / 16.f); }
                float run = 0.f;
                if (dd == 0) {
#pragma unroll
                    for (int r = 0; r < 4; ++r) { run += g[r]; bv[dd][i][r] = run; }
                    float sc = run; float t = __shfl_up(sc, 16); if (q4 >= 1) sc += t; t = __shfl_up(sc, 32); if (q4 >= 2) sc += t;
                    const float excl = sc - run; tot[dd][i] = __shfl(sc, 48 + l15);
#pragma unroll
                    for (int r = 0; r < 4; ++r) bv[dd][i][r] += excl + (i ? tot[dd][0] : 0.f);
                } else {
#pragma unroll
                    for (int r = 3; r >= 0; --r) { run += g[r]; bv[dd][i][r] = run; }
                    float sc = run; float t = __shfl_down(sc, 16); if (q4 <= 2) sc += t; t = __shfl_down(sc, 32); if (q4 <= 1) sc += t;
                    const float excl = sc - run; tot[dd][i] = __shfl(sc, l15);
#pragma unroll
                    for (int r = 0; r < 4; ++r) bv[dd][i][r] += excl + (i ? 0.f : tot[dd][1]);
                } }
            if (q4 == 0) segT[(dd * 2 + half) * 64 + 16 * dt + l15] = tot[dd][0] + tot[dd][1]; }
        __syncthreads();
        { const float otherF = segT[(0 * 2 + (1 - half)) * 64 + 16 * dt + l15], otherB = segT[(1 * 2 + (1 - half)) * 64 + 16 * dt + l15];
          const float addF = half ? otherF : 0.f, addB = half ? 0.f : otherB;
#pragma unroll
          for (int i = 0; i < 2; ++i)
#pragma unroll
              for (int r = 0; r < 4; ++r) { const int tok = 16 * (2 * half + i) + 4 * q4 + r; bF[tok * BS + 16 * dt + l15] = bv[0][i][r] + addF; bB[tok * BS + 16 * dt + l15] = bv[1][i][r] + addB; } }
        __syncthreads();
        const int nidx = (int)nxtL[0];
        { const f32x4 f0 = *(const LAS f32x4*)(bF + c * BS + 8 * ch), f1 = *(const LAS f32x4*)(bF + c * BS + 8 * ch + 4), r0 = *(const LAS f32x4*)(bB + c * BS + 8 * ch), r1 = *(const LAS f32x4*)(bB + c * BS + 8 * ch + 4);
          const float bf_[8] = {f0[0], f0[1], f0[2], f0[3], f1[0], f1[1], f1[2], f1[3]}, bb_[8] = {r0[0], r0[1], r0[2], r0[3], r1[0], r1[1], r1[2], r1[3]};
          float a_[8], b_[8];
#pragma unroll
          for (int k = 0; k < 8; ++k) { a_[k] = qf[k] * __expf(bf_[k]) * 0.125f; b_[k] = kf[k] * __expf(-bf_[k]); }
          v4u o; o.x = pk2(a_[0], a_[1]); o.y = pk2(a_[2], a_[3]); o.z = pk2(a_[4], a_[5]); o.w = pk2(a_[6], a_[7]); *(LAS v4u*)(qeF + c * GS + 8 * ch) = o;
          o.x = pk2(b_[0], b_[1]); o.y = pk2(b_[2], b_[3]); o.z = pk2(b_[4], b_[5]); o.w = pk2(b_[6], b_[7]); *(LAS v4u*)(keF + c * GS + 8 * ch) = o;
#pragma unroll
          for (int k = 0; k < 8; ++k) { a_[k] = qf[k] * __expf(bb_[k]) * 0.125f; b_[k] = kf[k] * __expf(-bb_[k]); }
          o.x = pk2(a_[0], a_[1]); o.y = pk2(a_[2], a_[3]); o.z = pk2(a_[4], a_[5]); o.w = pk2(a_[6], a_[7]); *(LAS v4u*)(qeB + c * GS + 8 * ch) = o;
          o.x = pk2(b_[0], b_[1]); o.y = pk2(b_[2], b_[3]); o.z = pk2(b_[4], b_[5]); o.w = pk2(b_[6], b_[7]); *(LAS v4u*)(keB + c * GS + 8 * ch) = o; }
        bf16x8 xs[2][2]; v2u g6c[4];
#pragma unroll
        for (int dd = 0; dd < 2; ++dd) { xs[dd][0] = xsn[dd][0]; xs[dd][1] = xsn[dd][1]; }
#pragma unroll
        for (int it = 0; it < 4; ++it) g6c[it] = g6r[it];
        if (nidx < NV) GM_LOAD(nidx);
        __syncthreads();
        { const int it = w >> 1;
#pragma unroll
          for (int jj = 0; jj < 2; ++jj) { const int jt = (w & 1) * 2 + jj; f32x4 acc = {0.f, 0.f, 0.f, 0.f}; const int i = 16 * it + l15, j0 = 16 * jt + 4 * q4;
              if (jt <= it) { f32x4 af = {0.f, 0.f, 0.f, 0.f};
#pragma unroll
                  for (int ks = 0; ks < 2; ++ks) { const bf16x8 x = *(const LAS bf16x8*)(keF + (16 * jt + l15) * GS + 8 * q4 + 32 * ks), y = *(const LAS bf16x8*)(qeF + (16 * it + l15) * GS + 8 * q4 + 32 * ks);
                      af = __builtin_amdgcn_mfma_f32_16x16x32_bf16(x, y, af, 0, 0, 0); }
#pragma unroll
                  for (int r = 0; r < 4; ++r) acc[r] += (j0 + r <= i) ? af[r] : 0.f; }
              if (jt >= it) { f32x4 ab = {0.f, 0.f, 0.f, 0.f};
#pragma unroll
                  for (int ks = 0; ks < 2; ++ks) { const bf16x8 x = *(const LAS bf16x8*)(keB + (16 * jt + l15) * GS + 8 * q4 + 32 * ks), y = *(const LAS bf16x8*)(qeB + (16 * it + l15) * GS + 8 * q4 + 32 * ks);
                      ab = __builtin_amdgcn_mfma_f32_16x16x32_bf16(x, y, ab, 0, 0, 0); }
#pragma unroll
                  for (int r = 0; r < 4; ++r) acc[r] += (j0 + r >= i) ? ab[r] : 0.f; }
              v2u o; o.x = pk2(acc[0], acc[1]); o.y = pk2(acc[2], acc[3]);
              *(LAS v2u*)(AL + (16 * it + l15) * GS + 16 * jt + 4 * q4) = o; } }
        bf16x8 xv[2];
#pragma unroll
        for (int ks = 0; ks < 2; ++ks) xv[ks] = tr_frag(vL, VS, 16 * w, ks, q4, qq, p3);
        __syncthreads();
        f32x4 oacc[4]; float ssq[4];
#pragma unroll
        for (int it = 0; it < 4; ++it) { f32x4 acc = {0.f, 0.f, 0.f, 0.f};
#pragma unroll
            for (int ks = 0; ks < 2; ++ks) { const bf16x8 y = *(const LAS bf16x8*)(AL + (16 * it + l15) * GS + 8 * q4 + 32 * ks); acc = __builtin_amdgcn_mfma_f32_16x16x32_bf16(xv[ks], y, acc, 0, 0, 0); }
#pragma unroll
            for (int ks = 0; ks < 2; ++ks) { const bf16x8 y = *(const LAS bf16x8*)(qeF + (16 * it + l15) * GS + 8 * q4 + 32 * ks); acc = __builtin_amdgcn_mfma_f32_16x16x32_bf16(xs[0][ks], y, acc, 0, 0, 0); }
#pragma unroll
            for (int ks = 0; ks < 2; ++ks) { const bf16x8 y = *(const LAS bf16x8*)(qeB + (16 * it + l15) * GS + 8 * q4 + 32 * ks); acc = __builtin_amdgcn_mfma_f32_16x16x32_bf16(xs[1][ks], y, acc, 0, 0, 0); }
            oacc[it] = acc; float sq = (acc[0] * acc[0] + acc[1] * acc[1]) + (acc[2] * acc[2] + acc[3] * acc[3]);
            sq += __shfl_xor(sq, 16); sq += __shfl_xor(sq, 32); ssq[it] = sq;
            if (q4 == 0) red[w * 64 + 16 * it + l15] = sq; }
        __syncthreads();
#pragma unroll
        for (int it = 0; it < 4; ++it) { float tsum = 0.f;
#pragma unroll
            for (int w2 = 0; w2 < 8; ++w2) tsum += red[w2 * 64 + 16 * it + l15];
            const float rstd = 1.f / sqrtf(tsum * (1.f / 128.f) + EPS);
            const float gq_[4] = {pg8::bflo(g6c[it].x), pg8::bfhi(g6c[it].x), pg8::bflo(g6c[it].y), pg8::bfhi(g6c[it].y)};
            float y[4];
#pragma unroll
            for (int r = 0; r < 4; ++r) y[r] = oacc[it][r] * rstd * gg4[r] * silu_f(gq_[r]);
            v2u o; o.x = pk2(y[0], y[1]); o.y = pk2(y[2], y[3]);
            *(v2u*)(OUT + (size_t)(rowbase + 16 * it + l15) * 512 + h * 128 + 16 * w + 4 * q4) = o; }
        __syncthreads();
        idx = nidx;
    }
#undef GM_DEC
#undef GM_LOAD
}

__device__ __forceinline__ void gla_pass1m(LAS unsigned char* lds, const bf16* P, const float* w_decay, const float* b_decay, bf16* Ubuf, float* dn, unsigned* ctr) {
    const int tid = opaque_tid(), lane = tid & 63, w = __builtin_amdgcn_readfirstlane(tid >> 6), l15 = lane & 15, q4 = lane >> 4, qq = (lane & 15) >> 2, p3 = lane & 3;
    constexpr int NV = 8 * 4 * 132;
    LAS bf16* klF = (LAS bf16*)(lds + GM_QEF); LAS bf16* klB = (LAS bf16*)(lds + GM_KEF); LAS bf16* vL = (LAS bf16*)(lds + GM_V);
    LAS float* bF = (LAS float*)(lds + GM_BF); LAS float* bB = (LAS float*)(lds + GM_BB); LAS float* segT = (LAS float*)(lds + GM_SEG);
    volatile LAS unsigned* nxtL = (volatile LAS unsigned*)(lds + GM_NXT);
    const int c = tid >> 3, ch = tid & 7, dt = w & 3, half = w >> 2;
    v4u vraw[2], kraw, lowr[2][2]; float wdr[2][8]; float bdr[2];
#define G1_DEC(idx_) const int p_ = (idx_) % 132, bh_ = (idx_) / 132, h = bh_ & 3, b = bh_ >> 2; const int rowbase = b * TB + (p_ < 4 ? TL + p_ * 64 : (p_ - 4) * 64); \
    const size_t itemF = (size_t)(bh_ * 2 + 0) * GLA_S + p_, itemB = (size_t)(bh_ * 2 + 1) * GLA_S + (p_ < 4 ? 3 - p_ : 135 - p_); (void)itemF; (void)itemB
#define G1_LOAD(idx_) do { G1_DEC(idx_); \
        _Pragma("unroll") for (int i = 0; i < 2; ++i) { const int n = tid + 512 * i; vraw[i] = *(const v4u*)(P + (size_t)(rowbase + (n >> 4)) * PW + PC_GV + h * 128 + (n & 15) * 8); } \
        kraw = *(const v4u*)(P + (size_t)(rowbase + c) * PW + h * 64 + ch * 8 + PC_GK); \
        _Pragma("unroll") for (int dd = 0; dd < 2; ++dd) { \
            _Pragma("unroll") for (int i = 0; i < 2; ++i) lowr[dd][i] = *(const v4u*)(P + (size_t)(rowbase + 16 * (2 * half + i) + l15) * PW + PC_LOW + dd * 16 + (q4 & 1) * 8); \
            _Pragma("unroll") for (int j = 0; j < 8; ++j) wdr[dd][j] = w_decay[(dd * 16 + 8 * (q4 & 1) + j) * 256 + h * 64 + 16 * dt + l15]; \
            bdr[dd] = b_decay[dd * 256 + h * 64 + 16 * dt + l15]; } } while (0)
    if (tid == 0) nxtL[0] = __hip_atomic_fetch_add(ctr, 1u, __ATOMIC_RELAXED, __HIP_MEMORY_SCOPE_AGENT);
    __syncthreads(); int idx = (int)nxtL[0]; __syncthreads();
    if (idx < NV) G1_LOAD(idx);
    for (; idx < NV;) {
        if (tid == 0) nxtL[0] = __hip_atomic_fetch_add(ctr, 1u, __ATOMIC_RELAXED, __HIP_MEMORY_SCOPE_AGENT);
        G1_DEC(idx);
#pragma unroll
        for (int i = 0; i < 2; ++i) { const int n = tid + 512 * i; *(LAS v4u*)(vL + (n >> 4) * VS + (n & 15) * 8) = vraw[i]; }
        float kf[8];
        kf[0] = pg8::bflo(kraw.x); kf[1] = pg8::bfhi(kraw.x); kf[2] = pg8::bflo(kraw.y); kf[3] = pg8::bfhi(kraw.y); kf[4] = pg8::bflo(kraw.z); kf[5] = pg8::bfhi(kraw.z); kf[6] = pg8::bflo(kraw.w); kf[7] = pg8::bfhi(kraw.w);
        float bv[2][2][4], tot[2][2];
#pragma unroll
        for (int dd = 0; dd < 2; ++dd) { bf16x8 yv;
#pragma unroll
            for (int j = 0; j < 8; ++j) { const unsigned hb = f2bf(wdr[dd][j]); const unsigned lb = f2bf(wdr[dd][j] - __uint_as_float(hb << 16)); yv[j] = (short)(q4 < 2 ? hb : lb); }
#pragma unroll
            for (int ii = 0; ii < 2; ++ii) { const int i = dd ? 1 - ii : ii;
                f32x4 z = {0.f, 0.f, 0.f, 0.f}; z = __builtin_amdgcn_mfma_f32_16x16x32_bf16(__builtin_bit_cast(bf16x8, lowr[dd][i]), yv, z, 0, 0, 0);
                float g[4];
#pragma unroll
                for (int r = 0; r < 4; ++r) { const float zz = z[r] + bdr[dd]; g[r] = (fminf(zz, 0.f) - __logf(1.f + __expf(-fabsf(zz)))) * (1.f / 16.f); }
                float run = 0.f;
                if (dd == 0) {
#pragma unroll
                    for (int r = 0; r < 4; ++r) { run += g[r]; bv[dd][i][r] = run; }
                    float sc = run; float t = __shfl_up(sc, 16); if (q4 >= 1) sc += t; t = __shfl_up(sc, 32); if (q4 >= 2) sc += t;
                    const float excl = sc - run; tot[dd][i] = __shfl(sc, 48 + l15);
#pragma unroll
                    for (int r = 0; r < 4; ++r) bv[dd][i][r] += excl + (i ? tot[dd][0] : 0.f);
                } else {
#pragma unroll
                    for (int r = 3; r >= 0; --r) { run += g[r]; bv[dd][i][r] = run; }
                    float sc = run; float t = __shfl_down(sc, 16); if (q4 <= 2) sc += t; t = __shfl_down(sc, 32); if (q4 <= 1) sc += t;
                    const float excl = sc - run; tot[dd][i] = __shfl(sc, l15);
#pragma unroll
                    for (int r = 0; r < 4; ++r) bv[dd][i][r] += excl + (i ? 0.f : tot[dd][1]);
                } }
            if (q4 == 0) segT[(dd * 2 + half) * 64 + 16 * dt + l15] = tot[dd][0] + tot[dd][1]; }
        __syncthreads();
        { const float otherF = segT[(0 * 2 + (1 - half)) * 64 + 16 * dt + l15], otherB = segT[(1 * 2 + (1 - half)) * 64 + 16 * dt + l15];
          const float addF = half ? otherF : 0.f, addB = half ? 0.f : otherB;
#pragma unroll
          for (int i = 0; i < 2; ++i)
#pragma unroll
              for (int r = 0; r < 4; ++r) { const int tok = 16 * (2 * half + i) + 4 * q4 + r; bF[tok * BS + 16 * dt + l15] = bv[0][i][r] + addF; bB[tok * BS + 16 * dt + l15] = bv[1][i][r] + addB; } }
        __syncthreads();
        const int nidx = (int)nxtL[0];
        { const f32x4 f0 = *(const LAS f32x4*)(bF + c * BS + 8 * ch), f1 = *(const LAS f32x4*)(bF + c * BS + 8 * ch + 4), r0 = *(const LAS f32x4*)(bB + c * BS + 8 * ch), r1 = *(const LAS f32x4*)(bB + c * BS + 8 * ch + 4);
          const f32x4 tf0 = *(const LAS f32x4*)(bF + 63 * BS + 8 * ch), tf1 = *(const LAS f32x4*)(bF + 63 * BS + 8 * ch + 4), tb0 = *(const LAS f32x4*)(bB + 8 * ch), tb1 = *(const LAS f32x4*)(bB + 8 * ch + 4);
          const float bf_[8] = {f0[0], f0[1], f0[2], f0[3], f1[0], f1[1], f1[2], f1[3]}, bb_[8] = {r0[0], r0[1], r0[2], r0[3], r1[0], r1[1], r1[2], r1[3]};
          const float tF[8] = {tf0[0], tf0[1], tf0[2], tf0[3], tf1[0], tf1[1], tf1[2], tf1[3]}, tB[8] = {tb0[0], tb0[1], tb0[2], tb0[3], tb1[0], tb1[1], tb1[2], tb1[3]};
          float a_[8];
#pragma unroll
          for (int k = 0; k < 8; ++k) a_[k] = kf[k] * __expf(tF[k] - bf_[k]);
          v4u o; o.x = pk2(a_[0], a_[1]); o.y = pk2(a_[2], a_[3]); o.z = pk2(a_[4], a_[5]); o.w = pk2(a_[6], a_[7]); *(LAS v4u*)(klF + c * GS + 8 * ch) = o;
#pragma unroll
          for (int k = 0; k < 8; ++k) a_[k] = kf[k] * __expf(tB[k] - bb_[k]);
          o.x = pk2(a_[0], a_[1]); o.y = pk2(a_[2], a_[3]); o.z = pk2(a_[4], a_[5]); o.w = pk2(a_[6], a_[7]); *(LAS v4u*)(klB + c * GS + 8 * ch) = o;
          if (tid < 8) { f32x4* dp = (f32x4*)(dn + itemF * 64 + 8 * ch); dp[0] = (f32x4){__expf(tF[0]), __expf(tF[1]), __expf(tF[2]), __expf(tF[3])}; dp[1] = (f32x4){__expf(tF[4]), __expf(tF[5]), __expf(tF[6]), __expf(tF[7])};
              f32x4* dq = (f32x4*)(dn + itemB * 64 + 8 * ch); dq[0] = (f32x4){__expf(tB[0]), __expf(tB[1]), __expf(tB[2]), __expf(tB[3])}; dq[1] = (f32x4){__expf(tB[4]), __expf(tB[5]), __expf(tB[6]), __expf(tB[7])}; } }
        if (nidx < NV) G1_LOAD(nidx);
        __syncthreads();
        { bf16x8 y[2];
#pragma unroll
          for (int ks = 0; ks < 2; ++ks) y[ks] = tr_frag(vL, VS, 16 * w, ks, q4, qq, p3);
#pragma unroll
          for (int dt2 = 0; dt2 < 4; ++dt2) { f32x4 accF = {0.f, 0.f, 0.f, 0.f}, accB = {0.f, 0.f, 0.f, 0.f};
#pragma unroll
              for (int ks = 0; ks < 2; ++ks) { const bf16x8 xf = tr_frag(klF, GS, 16 * dt2, ks, q4, qq, p3), xb = tr_frag(klB, GS, 16 * dt2, ks, q4, qq, p3);
                  accF = __builtin_amdgcn_mfma_f32_16x16x32_bf16(xf, y[ks], accF, 0, 0, 0); accB = __builtin_amdgcn_mfma_f32_16x16x32_bf16(xb, y[ks], accB, 0, 0, 0); }
              v2u o; o.x = pk2(accF[0], accF[1]); o.y = pk2(accF[2], accF[3]);
              *(v2u*)(Ubuf + itemF * 8192 + (16 * w + l15) * 64 + 16 * dt2 + 4 * q4) = o;
              o.x = pk2(accB[0], accB[1]); o.y = pk2(accB[2], accB[3]);
              *(v2u*)(Ubuf + itemB * 8192 + (16 * w + l15) * 64 + 16 * dt2 + 4 * q4) = o; } }
        __syncthreads();
        idx = nidx;
    }
#undef G1_DEC
#undef G1_LOAD
}

struct Args { const float* in[19]; float* out; unsigned char* ws; };
__global__ void __launch_bounds__(NTHR, 2) mk_fwd(Args args) {
    extern __shared__ __attribute__((aligned(16))) unsigned char lds_raw[];
    cg::grid_group grid = cg::this_grid();
    LAS unsigned char* lds = (LAS unsigned char*)lds_raw;
    const int G = gridDim.x, bx = blockIdx.x, NGW = G * NWAVES;
    unsigned long long pacc = 0ull, pt0 = 0ull; (void)pt0;
#define PB(k) do { if ((PROBE_MASK >> (k)) & 1ull) pt0 = __builtin_amdgcn_s_memrealtime(); } while (0)
#define PE(k) do { if ((PROBE_MASK >> (k)) & 1ull) pacc += __builtin_amdgcn_s_memrealtime() - pt0; } while (0)
#define GSYNC() do { xcd_barrier(xbar); if (PROBE_SYNC) { const unsigned long long t_ = __builtin_amdgcn_s_memrealtime(); xcd_barrier(xbar); pacc += __builtin_amdgcn_s_memrealtime() - t_; } } while (0)
#define PH_IDS const int tid = opaque_tid(), lane = tid & 63, wave = __builtin_amdgcn_readfirstlane(tid >> 6), gw = bx * NWAVES + wave; (void)lane; (void)gw
    unsigned char* ws = args.ws;
    const float* x = args.in[0]; const float* cvec = args.in[1]; const float* ctx = args.in[2]; const float* c_ctx = args.in[3]; const float* w_mod = args.in[4]; const float* b_mod = args.in[5];
    const float* g_norm = args.in[6]; const float* w_up = args.in[7]; const float* w_down = args.in[8]; const float* w_in = args.in[9]; const float* g_q = args.in[10]; const float* g_k = args.in[11];
    const float* w_decay = args.in[12]; const float* b_decay = args.in[13]; const float* g_gla = args.in[14]; const float* w_branch = args.in[15]; const float* b_gate = args.in[16]; const float* w_out = args.in[17]; const float* g_final = args.in[18];
    float* H = args.out;
    float* HC = (float*)(ws + WS_HCTX);
    float* mod = (float*)(ws + WS_MOD); float* dn = (float*)(ws + WS_DN);
    bf16* Wup1 = (bf16*)(ws + WS_WUP1); bf16* Wup2 = (bf16*)(ws + WS_WUP2); bf16* Wdn1 = (bf16*)(ws + WS_WDN1); bf16* Wdn2 = (bf16*)(ws + WS_WDN2); bf16* Win = (bf16*)(ws + WS_WIN);
    bf16* Wbr0 = (bf16*)(ws + WS_WBR0); bf16* Wbr1 = (bf16*)(ws + WS_WBR1); bf16* Wout = (bf16*)(ws + WS_WOUT);
    bf16* XN = (bf16*)(ws + WS_XN); bf16* OF = (bf16*)(ws + WS_OF); bf16* OB = (bf16*)(ws + WS_OB); bf16* PA = (bf16*)(ws + WS_A);
    bf16* HID = PA; bf16* Ubuf = XN; bf16* Z = XN;
    float* ssq1 = (float*)(ws + WS_SSQ1); float* ssq2 = (float*)(ws + WS_SSQ2); float* sW1 = (float*)(ws + WS_SW1); float* sW2 = (float*)(ws + WS_SW2);
    bf16* XN2 = OF;

    volatile LAS unsigned* xst = (volatile LAS unsigned*)(lds + LDS_BYTES - 64);
    if (threadIdx.x < 2) xst[threadIdx.x] = 0u;
    unsigned* barw = (unsigned*)ws;
    if (bx == 0) for (int i = threadIdx.x; i < XCD_BAR_WORDS + 128; i += NTHR) __hip_atomic_store(barw + i, 0u, __ATOMIC_RELAXED, __HIP_MEMORY_SCOPE_AGENT);
    XcdBarrier xbar; xbar.bar = barw; xbar.x = 0; xbar.st = xst;
    PB(0);
    {
        PH_IDS;
        LAS float* sc = (LAS float*)lds; LAS float* red = sc + 9 * 1024;
        for (int idx = tid; idx < 9 * 1024; idx += NTHR) { const int j = idx >> 10, k = idx & 1023; const float v = j < 8 ? cvec[j * 1024 + k] : c_ctx[k]; sc[idx] = silu_f(v); }
        __syncthreads();
        for (int it = bx; it < NMOD / 32; it += G) {
            const int cc = tid & 31, ks = tid >> 5, col = it * 32 + cc;
            float a[9];
#pragma unroll
            for (int j = 0; j < 9; ++j) a[j] = 0.f;
#pragma unroll 4
            for (int kk = 0; kk < 64; ++kk) { const int k = ks * 64 + kk; const float wv = w_mod[(size_t)k * NMOD + col];
#pragma unroll
                for (int j = 0; j < 9; ++j) a[j] += sc[j * 1024 + k] * wv; }
#pragma unroll
            for (int j = 0; j < 9; ++j) red[(ks * 9 + j) * 32 + cc] = a[j];
            __syncthreads();
            if (tid < 288) { const int j = tid >> 5, c2 = tid & 31; float s = b_mod[it * 32 + c2];
#pragma unroll
                for (int k2 = 0; k2 < 16; ++k2) s += red[(k2 * 9 + j) * 32 + c2];
                mod[(size_t)j * NMOD + it * 32 + c2] = s; }
            __syncthreads();
        }
        LAS float* scr = (LAS float*)(lds + 65536) + wave * 2176;
        constexpr int I_UP = 16 * 176, I_DN = 44 * 32;
        for (int it = gw; it < I_UP + I_DN; it += NGW) {
            int r = it;
            if (r < I_UP) { const int kb = r / 176, nb = r % 176; transpose_item(w_up, 1024, 5632, Wup1, 64 * kb, 32 * nb, up_dest(32 * nb), scr, lane); continue; } r -= I_UP;
            { const int kb = r / 32, nb = r % 32; transpose_item(w_down, DFF, 1024, Wdn1, 64 * kb, 32 * nb, 32 * nb, scr, lane); }
        }
        for (int i = bx * NTHR + tid; i < 224 * 1024 / 8; i += G * NTHR) ((v4u*)(Win + (size_t)4384 * 1024))[i] = (v4u){0u, 0u, 0u, 0u};
        for (int i = bx * NTHR + tid; i < MR; i += G * NTHR) { ssq1[i] = 0.f; ssq2[i] = 0.f; }
    }
    grid.sync();
    xbar.x = xb_xcc_id(); if (threadIdx.x == 0) xst[2] = xb_add(&barw[XB_XCNT(xbar.x)], 1u);
    PE(0); PB(1);
    { PH_IDS; norm_mod_rows(x, ctx, mod, g_norm + 0 * DM, 0, XN, true, gw, NGW, lane);
    }
    GSYNC(); PE(1); PB(2);
    if (threadIdx.x == 0) { bool uni = (xbar.x < 8u) && ((G & 7) == 0);
        for (unsigned j = 0; j < 16; ++j) { const unsigned cnt_ = xb_ld(&barw[XB_XCNT(j)]); uni = uni && (cnt_ == (j < 8u ? (unsigned)(G >> 3) : 0u)); }
        xst[3] = uni ? (xst[2] * 8u + xbar.x) : (unsigned)bx; }
    __syncthreads();
    const int vb = (int)xst[3];
    { pg8::Gemm g{XN, Wup1, MR, 5632, 1024, 1024, 1024}; pg8::StaticOrder S; S.init(MR, 5632, G, vb);
      pg8::EpiSwiglu E{HID, DFF}; pg8::gemm_phase<pg8::EpiSwiglu, pg8::StaticOrder, true, true>(lds, g, S, E); }
    { PH_IDS;
      const int rem_ = (264 * 22) % G, ir_ = rem_ ? vb - rem_ : vb, ni_ = rem_ ? G - rem_ : G;
      if (ir_ >= 0) {
      LAS float* sc = (LAS float*)lds; LAS float* red = sc + 9 * 1024;
      for (int it = ir_; it < 144 + 176; it += ni_) {
          const bool second = it >= 144; const int n0 = (second ? it - 144 : it) * 32; const int sub = second ? 2 : 1;
          __syncthreads();
          for (int idx = tid; idx < 9 * 1024; idx += NTHR) sc[idx] = mod[(size_t)(idx >> 10) * NMOD + (3 * sub) * DM + (idx & 1023)];
          __syncthreads();
          const int cc = tid & 31, ks = tid >> 5, nd = n0 + cc; int nsrc; const float* Wp; int ldw;
          if (!second) { Wp = w_in; ldw = 4384; nsrc = nd < 2304 ? nd : (nd < 4352 ? nd + 32 : (nd < 4384 ? nd - 2048 : -1)); }
          else { Wp = w_up + (size_t)1024 * 5632; ldw = 5632; const int tile = nd >> 8, within = nd & 255; nsrc = within < 128 ? 128 * tile + within : DFF + 128 * tile + (within - 128); }
          float a[9];
#pragma unroll
          for (int j = 0; j < 9; ++j) a[j] = 0.f;
          if (nsrc >= 0) {
#pragma unroll 4
              for (int kk = 0; kk < 64; ++kk) { const int k = ks * 64 + kk; const float wv = Wp[(size_t)k * ldw + nsrc];
#pragma unroll
                  for (int j = 0; j < 9; ++j) a[j] += sc[j * 1024 + k] * wv; } }
#pragma unroll
          for (int j = 0; j < 9; ++j) red[(ks * 9 + j) * 32 + cc] = a[j];
          __syncthreads();
          if (tid < 288) { const int j = tid >> 5, c2 = tid & 31; float sum = 0.f;
#pragma unroll
              for (int k2 = 0; k2 < 16; ++k2) sum += red[(k2 * 9 + j) * 32 + c2];
              (second ? sW2 + (size_t)j * 5632 : sW1 + (size_t)j * PW)[n0 + c2] = sum; }
      }
      __syncthreads(); } }
    GSYNC(); PE(2); PB(3);
    { pg8::Gemm g{HID, Wdn1, MR, 1024, DFF, DFF, DFF}; pg8::StaticOrder S; S.init(MR, 1024, G, vb);
      pg8::EpiRes<1, 2, 1, 1> E{x, ctx, H, HC, mod, g_norm + 1 * DM, XN, ssq1}; pg8::gemm_phase<pg8::EpiRes<1, 2, 1, 1>, pg8::StaticOrder, true, true>(lds, g, S, E); }
    { PH_IDS;
      const int rem = (264 * 4) % G, ir = rem ? vb - rem : vb, ni = rem ? G - rem : G;
      if (ir >= 0) {
          LAS float* scr = (LAS float*)(lds + 65536) + wave * 2176;
          constexpr int I_UP = 16 * 176, I_DN = 44 * 32, I_IN = 16 * 137, I_BR = 8 * 32, I_OUT = 16 * 32;
          constexpr int NITEMS = I_UP + I_DN + I_IN + 2 * I_BR + I_OUT;
          for (int it = ir * NWAVES + wave; it < NITEMS; it += ni * NWAVES) {
              int r = it;
              if (r < I_UP) { const int kb = r / 176, nb = r % 176; transpose_item(w_up + (size_t)1024 * 5632, 1024, 5632, Wup2, 64 * kb, 32 * nb, up_dest(32 * nb), scr, lane); continue; } r -= I_UP;
              if (r < I_DN) { const int kb = r / 32, nb = r % 32; transpose_item(w_down + (size_t)DFF * 1024, DFF, 1024, Wdn2, 64 * kb, 32 * nb, 32 * nb, scr, lane); continue; } r -= I_DN;
              if (r < I_IN) { const int kb = r / 137, nb = r % 137; transpose_item(w_in, 1024, 4384, Win, 64 * kb, 32 * nb, win_dest(32 * nb), scr, lane); continue; } r -= I_IN;
              if (r < 2 * I_BR) { const int l = r / I_BR; r %= I_BR; const int kb = r / 32, nb = r % 32; transpose_item(w_branch + (size_t)l * 512 * 1024, 512, 1024, l ? Wbr1 : Wbr0, 64 * kb, 32 * nb, 32 * nb, scr, lane); continue; } r -= 2 * I_BR;
              { const int kb = r / 32, nb = r % 32; transpose_item(w_out, 1024, 1024, Wout, 64 * kb, 32 * nb, 32 * nb, scr, lane); }
          }
      } }
    GSYNC(); PE(3); PB(4);
#if MK_STAGE >= 2
    { pg8::Gemm g{XN, Win, MR, PW, 1024, 1024, 1024}; pg8::StaticOrder S; S.init(MR, PW, G, vb);
      pg8::EpiInproj E{PA, PW, ssq1, sW1, PW}; pg8::gemm_phase<pg8::EpiInproj, pg8::StaticOrder, true, true>(lds, g, S, E); }
    GSYNC(); PE(4); PB(5);
    { PH_IDS;
      const int l16 = lane & 15, l7 = lane & 7, l3 = lane & 3, usub = lane >> 4; const bool is_hi = (lane & 4) != 0;
      float frq[8], gk8[8];
#pragma unroll
      for (int k = 0; k < 8; ++k) { frq[k] = __builtin_amdgcn_exp2f(-(float)(8 * (l3 & 1) + k) * (13.287712379549449f / 16.f)); gk8[k] = g_k[8 * l7 + k]; }
      for (int r0 = gw * 16; r0 < MR; r0 += NGW * 16) {
          const int t0 = r0 % TB; const bool isctx = t0 >= TL;
          v4u kv[4];
#pragma unroll
          for (int jj = 0; jj < 4; ++jj) kv[jj] = *(const v4u*)(PA + (size_t)(r0 + 4 * jj + usub) * PW + PC_K + l16 * 8);
#pragma unroll
          for (int jj = 0; jj < 4; ++jj) { bf16* rp = PA + (size_t)(r0 + 4 * jj + usub) * PW + PC_K + l16 * 8; const int t = t0 + 4 * jj + usub;
              const float pos = (l3 < 2) ? (float)(t >> 6) : (float)(t & 63);
              const v4u raw = kv[jj];
              float xv[8]; xv[0] = pg8::bflo(raw.x); xv[1] = pg8::bfhi(raw.x); xv[2] = pg8::bflo(raw.y); xv[3] = pg8::bfhi(raw.y); xv[4] = pg8::bflo(raw.z); xv[5] = pg8::bfhi(raw.z); xv[6] = pg8::bflo(raw.w); xv[7] = pg8::bfhi(raw.w);
              float ss = 0.f;
#pragma unroll
              for (int k = 0; k < 8; ++k) ss += xv[k] * xv[k];
              ss += __shfl_xor(ss, 1); ss += __shfl_xor(ss, 2); ss += __shfl_xor(ss, 4);
              const float rstd = 1.f / sqrtf(ss * (1.f / 64.f) + EPS);
              float o[8];
#pragma unroll
              for (int k = 0; k < 8; ++k) { const float ang = pos * frq[k]; const float cs_ = isctx ? 1.f : __cosf(ang), sn_ = isctx ? 0.f : __sinf(ang);
                  const float y = xv[k] * rstd * gk8[k]; const float py = __shfl_xor(y, 4);
                  o[k] = is_hi ? (py * sn_ + y * cs_) : (y * cs_ - py * sn_); }
              v4u w4; w4.x = pk2(o[0], o[1]); w4.y = pk2(o[2], o[3]); w4.z = pk2(o[4], o[5]); w4.w = pk2(o[6], o[7]);
              *(v4u*)rp = w4; } } }
    gla_pass1m(lds, PA, w_decay, b_decay, Ubuf, dn, barw + XCD_BAR_WORDS + 96);
    GSYNC(); PE(5); PB(6);
    PE(6); PB(7);
    bool fastsm;
    { const int l_ = opaque_tid() & 63; float gqm = fabsf(g_q[l_]), gkm = fabsf(g_k[l_]);
#pragma unroll
      for (int o = 1; o < 64; o <<= 1) { gqm = fmaxf(gqm, __shfl_xor(gqm, o)); gkm = fmaxf(gkm, __shfl_xor(gkm, o)); }
      fastsm = __builtin_amdgcn_readfirstlane((2.f * 11.5416f * gqm * gkm + 14.f < 100.f) ? 1 : 0) != 0; }
    { const attn_body::bf16* Qp = (const attn_body::bf16*)(PA + PC_Q); const attn_body::bf16* Kp = (const attn_body::bf16*)(PA + PC_K); const attn_body::bf16* Vp = (const attn_body::bf16*)(PA + PC_V);
      if ((G & 7) == 0) { const int b = vb & 7, ci = vb >> 3, nper = G >> 3;
          for (int idx = ci; idx < 256; idx += nper) { const int h = idx >> 5, qb = idx & 31;
              if (fastsm) attn_body::attn_unit<8, true>(b, h, h >> 2, qb, Qp, Kp, Vp, (attn_body::bf16*)(PA + PC_Q), (char*)lds_raw, g_q);
              else attn_body::attn_unit<8, false>(b, h, h >> 2, qb, Qp, Kp, Vp, (attn_body::bf16*)(PA + PC_Q), (char*)lds_raw, g_q); } }
      else { for (int u = vb; u < 2048; u += G) { const int b = u >> 8, h = (u >> 5) & 7, qb = u & 31; attn_body::attn_unit<8, false>(b, h, h >> 2, qb, Qp, Kp, Vp, (attn_body::bf16*)(PA + PC_Q), (char*)lds_raw, g_q); } }
    }
    __syncthreads();
    PE(7); PB(21);
    { PH_IDS; (void)wave;
      unsigned* ctr2 = barw + XCD_BAR_WORDS + 32; unsigned* done2 = barw + XCD_BAR_WORDS + 48;
      volatile LAS unsigned* nx = (volatile LAS unsigned*)(lds + 131072);
      for (;;) {
          __syncthreads();
          if (tid == 0) nx[0] = __hip_atomic_fetch_add(ctr2, 1u, __ATOMIC_RELAXED, __HIP_MEMORY_SCOPE_AGENT);
          __syncthreads();
          const int item2 = (int)nx[0];
          if (item2 >= 256) break;
          const int chain = item2 >> 2, e4 = (item2 & 3) * 512 + tid; const int d0 = (4 * e4) & 63;
          f32x4 S = {0.f, 0.f, 0.f, 0.f};
          for (int s0 = 0; s0 < GLA_S; s0 += 12) { v2u ur[12]; f32x4 dv[12];
#pragma unroll
              for (int j = 0; j < 12; ++j) { const size_t item = (size_t)chain * GLA_S + s0 + j; ur[j] = (v2u){0u, 0u}; dv[j] = (f32x4){0.f, 0.f, 0.f, 0.f};
                  if (s0 + j < GLA_S - 1) { ur[j] = *(const v2u*)(Ubuf + item * 8192 + 4 * e4); dv[j] = *(const f32x4*)(dn + item * 64 + d0); } }
#pragma unroll
              for (int j = 0; j < 12; ++j) { const size_t item = (size_t)chain * GLA_S + s0 + j;
                  v2u o; o.x = pk2(S[0], S[1]); o.y = pk2(S[2], S[3]); *(v2u*)(Ubuf + item * 8192 + 4 * e4) = o;
                  S[0] = dv[j][0] * S[0] + __uint_as_float(ur[j].x << 16); S[1] = dv[j][1] * S[1] + __uint_as_float(ur[j].x & 0xffff0000u);
                  S[2] = dv[j][2] * S[2] + __uint_as_float(ur[j].y << 16); S[3] = dv[j][3] * S[3] + __uint_as_float(ur[j].y & 0xffff0000u); } }
          asm volatile("s_waitcnt vmcnt(0)" ::: "memory");
          __syncthreads();
          if (tid == 0) { __builtin_amdgcn_fence(__ATOMIC_RELEASE, "agent"); asm volatile("s_waitcnt vmcnt(0)" ::: "memory"); __hip_atomic_fetch_add(done2, 1u, __ATOMIC_RELAXED, __HIP_MEMORY_SCOPE_AGENT); }
      }
      if (tid == 0) { unsigned sp = 0u; while (__hip_atomic_load(done2, __ATOMIC_RELAXED, __HIP_MEMORY_SCOPE_AGENT) < 256u) { __builtin_amdgcn_s_sleep(2); if (++sp > (1u << 24)) break; }
          __builtin_amdgcn_fence(__ATOMIC_ACQUIRE, "agent"); asm volatile("s_waitcnt vmcnt(0)" ::: "memory"); }
      __syncthreads(); }
    gla_pass3m(lds, PA, w_decay, b_decay, g_gla, Ubuf, OF, barw + XCD_BAR_WORDS + 64);
    PE(21); PB(8);
    GSYNC(); PE(8); PB(9);
    { pg8::Gemm g{PA + PC_Q, Wbr0, MR, 1024, 512, PW, 512}; pg8::StaticOrder S; S.init(NB * TL, 1024, G, vb, 1);
      pg8::EpiGate<0> E{PA, b_gate, Z}; pg8::gemm_phase<pg8::EpiGate<0>, pg8::StaticOrder, true, true>(lds, g, S, E); }
    __syncthreads();
    { pg8::Gemm g{OF, Wbr1, MR, 1024, 512, 512, 512}; pg8::StaticOrder S; S.init(NB * TL, 1024, G, vb, 1);
      pg8::EpiGate<1> E{PA, b_gate, Z}; pg8::gemm_phase<pg8::EpiGate<1>, pg8::StaticOrder, true, true>(lds, g, S, E); }
    GSYNC(); PE(9); PB(10);
    { pg8::Gemm g{Z, Wout, MR, 1024, 1024, 1024, 1024}; pg8::StaticOrder S; S.init(NB * TL, 1024, G, vb, 1);
      pg8::EpiRes<1, 5, 0, 2> E{H, HC, H, HC, mod, g_norm + 2 * DM, XN2, ssq2}; pg8::gemm_phase<pg8::EpiRes<1, 5, 0, 2>, pg8::StaticOrder, true, true>(lds, g, S, E); }
    GSYNC(); PE(10); PB(11);
#endif
#if MK_STAGE >= 3
    { pg8::Gemm g{XN2, Wup2, MR, 5632, 1024, 1024, 1024}; pg8::StaticOrder S; S.init(NB * TL, 5632, G, vb, 1);
      pg8::EpiSwigluN E{HID, DFF, ssq2, sW2, 5632}; pg8::gemm_phase<pg8::EpiSwigluN, pg8::StaticOrder, true, true>(lds, g, S, E); }
    GSYNC(); PE(11); PB(12);
    { pg8::Gemm g{HID, Wdn2, MR, 1024, DFF, DFF, DFF}; pg8::StaticOrder S; S.init(NB * TL, 1024, G, vb, 1);
      pg8::EpiRes<0, 8, 1, 0> E{H, HC, H, HC, mod, nullptr, nullptr, nullptr}; pg8::gemm_phase<pg8::EpiRes<0, 8, 1, 0>, pg8::StaticOrder, true, true>(lds, g, S, E); }
    GSYNC(); PE(12); PB(13);
#endif
    { PH_IDS; f32x4 gv[4];
#pragma unroll
      for (int j = 0; j < 4; ++j) gv[j] = *((const f32x4*)g_final + lane + 64 * j);
      for (int r0 = gw * 4; r0 < NB * TL; r0 += NGW * 4) { f32x4* p = (f32x4*)(H + (size_t)r0 * DM) + lane; f32x4 v[4][4]; float s[4] = {0.f, 0.f, 0.f, 0.f};
#pragma unroll
          for (int u = 0; u < 4; ++u)
#pragma unroll
              for (int j = 0; j < 4; ++j) v[u][j] = p[u * 256 + 64 * j];
#pragma unroll
          for (int u = 0; u < 4; ++u)
#pragma unroll
              for (int j = 0; j < 4; ++j) s[u] += (v[u][j].x * v[u][j].x + v[u][j].y * v[u][j].y) + (v[u][j].z * v[u][j].z + v[u][j].w * v[u][j].w);
#pragma unroll
          for (int u = 0; u < 4; ++u) { const float rstd = 1.f / sqrtf(wave_sum(s[u]) * (1.f / DM) + EPS);
#pragma unroll
              for (int j = 0; j < 4; ++j) p[u * 256 + 64 * j] = v[u][j] * rstd * gv[j]; } } }
    PE(13);
    if (PROBE_MASK != 0ull || PROBE_SYNC) { const unsigned long long te = __builtin_amdgcn_s_memrealtime() + (unsigned long long)PROBE_MULT * pacc; while (__builtin_amdgcn_s_memrealtime() < te) __builtin_amdgcn_s_sleep(32); }
}

extern "C" void kernel_launch(void* const* d_in, const int* in_sizes, int n_in, void* d_out, int out_size, void* d_ws, size_t ws_size, hipStream_t stream) {
    static int grid = 0;
    if (grid == 0) {
        int dev = 0, cus = 0, per_cu = 0;
        hipGetDevice(&dev); hipDeviceGetAttribute(&cus, hipDeviceAttributeMultiprocessorCount, dev);
        hipFuncSetAttribute((const void*)mk_fwd, hipFuncAttributeMaxDynamicSharedMemorySize, LDS_BYTES);
        hipOccupancyMaxActiveBlocksPerMultiprocessor(&per_cu, (const void*)mk_fwd, NTHR, LDS_BYTES);
        if (per_cu < 1) per_cu = 1;
        grid = cus * per_cu;
        if (n_in != 19 || ws_size < WS_END) { fprintf(stderr, "kernel_launch: unexpected n_in %d or ws_size %zu\n", n_in, ws_size); }
    }
    Args a{};
    for (int i = 0; i < 19; ++i) a.in[i] = (const float*)d_in[i];
    a.out = (float*)d_out; a.ws = (unsigned char*)d_ws;
    void* kargs[] = {&a};
    hipError_t e = hipLaunchCooperativeKernel((const void*)mk_fwd, dim3(grid), dim3(NTHR), kargs, LDS_BYTES, stream);
    if (e != hipSuccess) fprintf(stderr, "cooperative launch failed: %s (grid %d)\n", hipGetErrorString(e), grid);
}
```
